# Optimizing an MI355X kernel written in HIP

```python
import jax, jax.numpy as jnp
from jax import lax
import numpy as np

D_MODEL = 1024
BATCH = 16
SEQ = 2048
DEPTH = 2

CHUNK = 64
RW_HEAD_DIM = 64
RW_WIDTH = D_MODEL // 2
RW_HEADS = RW_WIDTH // RW_HEAD_DIM
DECAY_LORA = 64
AAA_LORA = 64
AT_HEAD_DIM = 64
AT_WIDTH = D_MODEL // 2
AT_HEADS = AT_WIDTH // AT_HEAD_DIM
LEFT_CHUNKS = 8
BAND_CHUNKS = LEFT_CHUNKS + 1
REL_CLIP = 2 * CHUNK
SG_CHUNK = 128
SG_WIDTH = D_MODEL
SG_GROUPS = 8
SG_GROUP_DIM = SG_WIDTH // SG_GROUPS
SHIFT_WIDTH = 3 * RW_WIDTH + DECAY_LORA + AAA_LORA
EVEN_IN = SHIFT_WIDTH + RW_WIDTH + 4 * AT_WIDTH
EVEN_MIX = RW_WIDTH + AT_WIDTH
ODD_IN = 3 * SG_WIDTH
RMS_EPS = 1e-6
LN_EPS = 1e-5
GN_EPS = 64e-5
NEG_INF = -1e30

kernel_name = "hybrid_rwkv7_chunkattn_gmlp_encoder"


def rmsnorm(x, g):
    x32 = x.astype(jnp.float32)
    y = x32 * lax.rsqrt(jnp.mean(x32 * x32, axis=-1, keepdims=True) + RMS_EPS)
    return (y * g.astype(jnp.float32)).astype(x.dtype)


def token_shift(p, mu):
    p_prev = jnp.pad(p, ((0, 0), (1, 0), (0, 0)))[:, :-1]
    return p + (p_prev - p) * mu


def rwkv7_mix(p_r, p_k, p_v, p_wd, p_ad, w0, w2, a0, a2, k_k, k_a, r_k, lnx_g, lnx_b):
    B, S, W = p_r.shape
    H, N = RW_HEADS, RW_HEAD_DIM
    f32 = jnp.float32
    r = p_r.astype(f32)
    k = p_k.astype(f32)
    v = p_v.astype(f32)
    w = -jax.nn.softplus(-(w0.astype(f32) + jnp.tanh(p_wd.astype(f32)) @ w2.astype(f32))) - 0.5
    decay = jnp.exp(-jnp.exp(w))
    a = jax.nn.sigmoid(a0.astype(f32) + p_ad.astype(f32) @ a2.astype(f32))
    heads = lambda t: t.reshape(B, S, H, N)
    kk = heads(k * k_k.astype(f32))
    kk = kk / jnp.maximum(jnp.sqrt(jnp.sum(kk * kk, axis=-1, keepdims=True)), 1e-12)
    k = k * (1.0 + (a - 1.0) * k_a.astype(f32))
    r_h, k_h, v_h, a_h = heads(r), heads(k), heads(v), heads(a)
    tm = lambda t: jnp.moveaxis(t, 1, 0)

    def step(state, inp):
        r_t, w_t, k_t, v_t, a_t, b_t = inp
        sa = jnp.einsum('bhvk,bhk->bhv', state, a_t)
        state = (state * w_t[:, :, None, :]
                 + sa[..., None] * b_t[:, :, None, :]
                 + v_t[..., None] * k_t[:, :, None, :])
        y_t = jnp.einsum('bhvk,bhk->bhv', state, r_t)
        return state, y_t

    s0 = jnp.zeros((B, H, N, N), f32)
    _, y = lax.scan(step, s0, (tm(r_h), tm(heads(decay)), tm(k_h), tm(v_h), tm(-kk), tm(kk * a_h)))
    y = jnp.moveaxis(y, 0, 1)
    mu = jnp.mean(y, axis=-1, keepdims=True)
    var = jnp.mean(jnp.square(y - mu), axis=-1, keepdims=True)
    y = ((y - mu) * lax.rsqrt(var + GN_EPS)).reshape(B, S, W)
    y = y * lnx_g.astype(f32) + lnx_b.astype(f32)
    bonus = jnp.sum(r_h * k_h * r_k.astype(f32), axis=-1, keepdims=True) * v_h
    y = y + bonus.reshape(B, S, W)
    return y.astype(p_r.dtype)


def chunk_attention(q, k, v, bias_table):
    B, S, W = q.shape
    H, Dh, L = AT_HEADS, AT_HEAD_DIM, CHUNK
    NC = S // L
    to_chunks = lambda t: t.reshape(B, NC, L, H, Dh).transpose(0, 3, 1, 2, 4)
    pad = ((0, 0), (0, 0), (LEFT_CHUNKS, 0), (0, 0), (0, 0))
    qc = to_chunks(q)
    kp = jnp.pad(to_chunks(k), pad)
    vp = jnp.pad(to_chunks(v), pad)
    qi = jnp.arange(L)
    kj = jnp.arange(BAND_CHUNKS * L)
    rel = LEFT_CHUNKS * L + qi[:, None] - kj[None, :]
    idx = jnp.clip(rel, -REL_CLIP, REL_CLIP) + REL_CLIP
    bias = bias_table[:, idx].astype(jnp.float32)
    scale = 1.0 / np.sqrt(Dh)

    def one_chunk(args):
        q_blk, c = args
        kb = lax.dynamic_slice_in_dim(kp, c, BAND_CHUNKS, axis=2).reshape(B, H, BAND_CHUNKS * L, Dh)
        vb = lax.dynamic_slice_in_dim(vp, c, BAND_CHUNKS, axis=2).reshape(B, H, BAND_CHUNKS * L, Dh)
        s = jnp.einsum('bhqd,bhkd->bhqk', q_blk, kb).astype(jnp.float32) * scale + bias
        valid = kj >= (LEFT_CHUNKS - c) * L
        s = jnp.where(valid[None, None, None, :], s, NEG_INF)
        p = jax.nn.softmax(s, axis=-1)
        return jnp.einsum('bhqk,bhkd->bhqd', p.astype(vb.dtype), vb)

    out = lax.map(one_chunk, (jnp.moveaxis(qc, 2, 0), jnp.arange(NC)))
    return out.transpose(1, 0, 3, 2, 4).reshape(B, S, W)


def spatial_gating(u, v, ln_g, ln_b, sg_w, sg_b):
    B, S, W = u.shape
    NB = S // SG_CHUNK
    v32 = v.astype(jnp.float32)
    mu = jnp.mean(v32, axis=-1, keepdims=True)
    var = jnp.mean(jnp.square(v32 - mu), axis=-1, keepdims=True)
    v = ((v32 - mu) * lax.rsqrt(var + LN_EPS) * ln_g.astype(jnp.float32)
         + ln_b.astype(jnp.float32)).astype(u.dtype)
    pos = jnp.arange(SG_CHUNK)
    mask = (pos[None, :] // CHUNK) <= (pos[:, None] // CHUNK)
    w = sg_w * mask[None].astype(sg_w.dtype)
    vb = v.reshape(B, NB, SG_CHUNK, SG_GROUPS, SG_GROUP_DIM)
    sv = jnp.einsum('gij,bnjgc->bnigc', w, vb) + sg_b.T[None, None, :, :, None]
    return u * sv.reshape(B, S, W)


def even_layer(h, g, w_in, shift_mu, w0, w2, a0, a2, k_k, k_a, r_k, lnx_g, lnx_b, att_bias, w_out):
    p = rmsnorm(h, g) @ w_in
    p_shift = token_shift(p[..., :SHIFT_WIDTH], shift_mu)
    p_r, p_k, p_v, p_wd, p_ad = jnp.split(
        p_shift, [RW_WIDTH, 2 * RW_WIDTH, 3 * RW_WIDTH, 3 * RW_WIDTH + DECAY_LORA], axis=-1)
    rest = p[..., SHIFT_WIDTH:]
    gate_a, q_b, k_b, v_b, gate_b = jnp.split(
        rest, [RW_WIDTH, RW_WIDTH + AT_WIDTH, RW_WIDTH + 2 * AT_WIDTH, RW_WIDTH + 3 * AT_WIDTH], axis=-1)
    y_a = rwkv7_mix(p_r, p_k, p_v, p_wd, p_ad, w0, w2, a0, a2, k_k, k_a, r_k, lnx_g, lnx_b)
    y_a = y_a * jax.nn.silu(gate_a)
    y_b = chunk_attention(q_b, k_b, v_b, att_bias) * jax.nn.silu(gate_b)
    return h + jnp.concatenate([y_a, y_b], axis=-1) @ w_out


def odd_layer(h, g, w_in, ln_g, ln_b, sg_w, sg_b, w_out):
    p = rmsnorm(h, g) @ w_in
    u, v, gate = jnp.split(p, [SG_WIDTH, 2 * SG_WIDTH], axis=-1)
    y = spatial_gating(jax.nn.gelu(u), jax.nn.gelu(v), ln_g, ln_b, sg_w, sg_b)
    return h + (y * jax.nn.silu(gate)) @ w_out


def setup_inputs(seed: int = 0) -> dict:
    key = jax.random.key(seed)
    ks = jax.random.split(key, 24)
    ne = (DEPTH + 1) // 2
    no = DEPTH // 2
    nrm = lambda k, shape, s: jax.random.normal(k, shape, jnp.float32) * s
    return {
        "x": nrm(ks[0], (BATCH, SEQ, D_MODEL), 1.0),
        "norm_g": 1.0 + nrm(ks[1], (DEPTH, D_MODEL), 0.01),
        "w_in_e": nrm(ks[2], (ne, D_MODEL, EVEN_IN), D_MODEL ** -0.5),
        "shift_mu": jax.random.uniform(ks[3], (ne, SHIFT_WIDTH), jnp.float32),
        "rw_w0": jax.random.uniform(ks[4], (ne, RW_WIDTH), jnp.float32, -4.0, 1.0),
        "rw_w2": nrm(ks[5], (ne, DECAY_LORA, RW_WIDTH), 0.5 * DECAY_LORA ** -0.5),
        "rw_a0": nrm(ks[6], (ne, RW_WIDTH), 0.1),
        "rw_a2": nrm(ks[7], (ne, AAA_LORA, RW_WIDTH), 0.5 * AAA_LORA ** -0.5),
        "rw_kk": 0.85 + nrm(ks[8], (ne, RW_WIDTH), 0.02),
        "rw_ka": 1.0 + nrm(ks[9], (ne, RW_WIDTH), 0.02),
        "rw_rk": nrm(ks[10], (ne, RW_HEADS, RW_HEAD_DIM), 0.1),
        "rw_lnx_g": 1.0 + nrm(ks[11], (ne, RW_WIDTH), 0.01),
        "rw_lnx_b": nrm(ks[12], (ne, RW_WIDTH), 0.01),
        "att_bias": nrm(ks[13], (ne, AT_HEADS, 2 * REL_CLIP + 1), 0.1),
        "w_out_e": nrm(ks[14], (ne, EVEN_MIX, D_MODEL), 0.5 * EVEN_MIX ** -0.5),
        "w_in_o": nrm(ks[15], (no, D_MODEL, ODD_IN), D_MODEL ** -0.5),
        "sg_ln_g": 1.0 + nrm(ks[16], (no, SG_WIDTH), 0.01),
        "sg_ln_b": nrm(ks[17], (no, SG_WIDTH), 0.01),
        "sg_w": nrm(ks[18], (no, SG_GROUPS, SG_CHUNK, SG_CHUNK), SG_CHUNK ** -0.5),
        "sg_b": 1.0 + nrm(ks[19], (no, SG_GROUPS, SG_CHUNK), 0.01),
        "w_out_o": nrm(ks[20], (no, SG_WIDTH, D_MODEL), 0.5 * SG_WIDTH ** -0.5),
        "final_g": 1.0 + nrm(ks[21], (D_MODEL,), 0.01),
    }


def reference(x, norm_g, w_in_e, shift_mu, rw_w0, rw_w2, rw_a0, rw_a2, rw_kk, rw_ka, rw_rk,
              rw_lnx_g, rw_lnx_b, att_bias, w_out_e, w_in_o, sg_ln_g, sg_ln_b, sg_w, sg_b,
              w_out_o, final_g):
    h = x
    for layer in range(DEPTH):
        i = layer // 2
        if layer % 2 == 0:
            h = even_layer(h, norm_g[layer], w_in_e[i], shift_mu[i], rw_w0[i], rw_w2[i], rw_a0[i],
                           rw_a2[i], rw_kk[i], rw_ka[i], rw_rk[i], rw_lnx_g[i], rw_lnx_b[i],
                           att_bias[i], w_out_e[i])
        else:
            h = odd_layer(h, norm_g[layer], w_in_o[i], sg_ln_g[i], sg_ln_b[i], sg_w[i], sg_b[i],
                          w_out_o[i])
    return rmsnorm(h, final_g)
```

```cpp
#include <hip/hip_runtime.h>
#include <hip/hip_cooperative_groups.h>
#include <cstdio>
#include <cstdint>
namespace cg = cooperative_groups;
#ifndef USE_PG8
#define USE_PG8 0
#endif
#ifndef N_LAUNCH_MODE
#define N_LAUNCH_MODE 0
#endif
namespace pg8 {
#define PG8_LAS __attribute__((address_space(3)))
typedef unsigned short bf16_t;
typedef short bf16x8 __attribute__((ext_vector_type(8)));
typedef float f32x4 __attribute__((ext_vector_type(4)));
typedef unsigned u32x4 __attribute__((ext_vector_type(4)));
constexpr int BM = 256, BK = 64, HALF = 128, HTB = HALF * BK * 2  , STAGE_BYTES = 8 * HTB, NXCD = 8, WGM = 8;

__host__ __device__ __forceinline__ int lds_byte(int r, int c) { const int st = (r >> 4) * 2 + (c >> 5), rr = r & 15, cc = c & 31, ob = rr * 64 + cc * 2; return st * 1024 + (ob ^ (((ob >> 9) & 1) << 5)); }
__host__ __device__ __forceinline__ void stage_rc(int b, int& R, int& C) { const int st = b / 1024, sb = b % 1024, swz = sb ^ (((sb >> 9) & 1) << 5); R = (st >> 1) * 16 + swz / 64; C = (st & 1) * 32 + (swz % 64) / 2; }
__host__ __device__ __forceinline__ int perm32(int rho) { const int n = rho >> 4, i = rho & 15; return 8 * (i >> 2) + 4 * n + (i & 3); }

struct Unit { int pm, pn; };
struct Gemm { const bf16_t* A; const bf16_t* Bt; int M, N, K; };

struct StaticOrder {
    int nM, nN, nwg, G, c;
    __host__ __device__ void init(int M, int N, int G_, int c_) { nM = M / BM; nN = N / BM; nwg = nM * nN; G = G_; c = c_; }
    __host__ __device__ bool next(int i, Unit& u) const {
        const long L = (long)i * G + c; if (L >= nwg) return false;
        int wgid = (int)L; { const int q = nwg / NXCD, r = nwg % NXCD, xcd = wgid % NXCD, off = wgid / NXCD; wgid = (xcd < r ? xcd * (q + 1) : r * (q + 1) + (xcd - r) * q) + off; }
        const int nig = WGM * nN, gid = wgid / nig, fm = gid * WGM, gsz = (nM - fm) < WGM ? (nM - fm) : WGM;
        u.pm = fm + ((wgid % nig) % gsz); u.pn = (wgid % nig) / gsz; return true;
    }
    __device__ __forceinline__ void a_ready(const Unit&) const {}
    __device__ __forceinline__ void done(const Unit&) const {}
};

__device__ __forceinline__ unsigned cvt_pk_bf16(float lo, float hi) { unsigned r; asm volatile("v_cvt_pk_bf16_f32 %0, %1, %2" : "=v"(r) : "v"(lo), "v"(hi)); return r; }
typedef float f32x2 __attribute__((ext_vector_type(2)));
__device__ __forceinline__ f32x2 gelu_pk(f32x2 v) {
    const f32x2 av = __builtin_elementwise_abs(v), d = av * 0.2316418882f + 1.0f;
    f32x2 t; t.x = __builtin_amdgcn_rcpf(d.x); t.y = __builtin_amdgcn_rcpf(d.y);
    f32x2 q = t * 0.5307027145f + (-0.7265760135f); q = q * t + 0.7107068705f; q = q * t + (-0.142248368f); q = q * t + 0.127414796f; q = q * t;
    const f32x2 s = (v * v) * (-0.72134752044f);
    f32x2 e; e.x = __builtin_amdgcn_exp2f(s.x); e.y = __builtin_amdgcn_exp2f(s.y);
    const f32x2 m = v * (q * e), r = v - m;
    f32x2 o; o.x = v.x < 0.f ? m.x : r.x; o.y = v.y < 0.f ? m.y : r.y; return o;
}

template <int ACT  > struct EpiBf16 {
    static constexpr bool PERM = true, AFTER_DRAIN = false; static_assert(ACT == 0 || ACT == 1, "EpiBf16: ACT is 0 (none) or 1 (gelu_pk)");
    bf16_t* O; int ldc; const float* bias; int split_cols; size_t split_stride; float scale0;
    __device__ __forceinline__ void operator()(const f32x4 (&acc)[2][2][4][2], const Unit& u, int wr, int wc, int fr, int fq) const {
        const int row0 = u.pm * BM + wr * 64 + fr; int colt = u.pn * BM; bf16_t* base = O;
        float sc = 1.f; if (split_cols) { const int t = colt / split_cols; base += (size_t)t * split_stride; colt -= t * split_cols; if (t == 0) sc = scale0; }
        const int col0 = colt + wc * 32 + 8 * fq, bcol0 = u.pn * BM + wc * 32 + 8 * fq;
        f32x4 bv[2][2];
#pragma unroll
        for (int bj = 0; bj < 2; ++bj)
#pragma unroll
            for (int n = 0; n < 2; ++n) bv[bj][n] = bias ? *(const f32x4*)(bias + bcol0 + bj * HALF + 4 * n) : (f32x4){0.f, 0.f, 0.f, 0.f};
#pragma unroll
        for (int ai = 0; ai < 2; ++ai)
#pragma unroll
            for (int m = 0; m < 4; ++m) { bf16_t* rowp = base + (size_t)(row0 + ai * HALF + m * 16) * ldc + col0;
#pragma unroll
                for (int bj = 0; bj < 2; ++bj) { f32x4 v0 = acc[ai][bj][m][0] + bv[bj][0], v1 = acc[ai][bj][m][1] + bv[bj][1];
                    if (ACT == 1) { f32x2 a = gelu_pk((f32x2){v0[0], v0[1]}), b = gelu_pk((f32x2){v0[2], v0[3]}), c = gelu_pk((f32x2){v1[0], v1[1]}), d = gelu_pk((f32x2){v1[2], v1[3]});
                        v0 = (f32x4){a.x, a.y, b.x, b.y}; v1 = (f32x4){c.x, c.y, d.x, d.y}; }
                    v0 = v0 * sc; v1 = v1 * sc; u32x4 w; w.x = cvt_pk_bf16(v0[0], v0[1]); w.y = cvt_pk_bf16(v0[2], v0[3]); w.z = cvt_pk_bf16(v1[0], v1[1]); w.w = cvt_pk_bf16(v1[2], v1[3]);
                    *(u32x4*)(rowp + bj * HALF) = w; } }
    }
};
template <class Epi, class Sched, bool ALIGN_EPI = false, bool SP2 = false>
__device__ __forceinline__ void gemm_phase(PG8_LAS unsigned char* lds, const Gemm g, const Sched& S, const Epi& E) {
    const int tid = threadIdx.x, wid = __builtin_amdgcn_readfirstlane(tid >> 6), lane = tid & 63, wr = wid >> 2, wc = wid & 3, fr = lane & 15, fq = lane >> 4;
    const int K = g.K, nt = K / BK;
    unsigned voffA[2], voffB[2];
#pragma unroll
    for (int i = 0; i < 2; ++i) { int R, C; stage_rc(tid * 16 + i * 8192, R, C); const int Rb = Epi::PERM ? ((R & ~31) + perm32(R & 31)) : R;
        voffA[i] = (unsigned)(R * K + C) * 2u; voffB[i] = (unsigned)(Rb * K + C) * 2u; }
    const size_t kstep = (size_t)(BK * 2);
    const size_t hstep = (size_t)HALF * K * 2;
    const size_t tstep = 2 * hstep;
    const unsigned ldsw = (unsigned)wid * 1024u;
    const int aoff = lds_byte(wr * 64 + fr, fq * 8), boff = lds_byte(wc * 32 + fr, fq * 8);
#define PG8_SA(b, h) (((b) * 2 + (h)) * HTB)
#define PG8_SB(b, h) ((4 + (b) * 2 + (h)) * HTB)
#define PG8_STAGE(bufoff, gbase, voff) do { _Pragma("unroll") for (int _i = 0; _i < 2; ++_i) \
        __builtin_amdgcn_global_load_lds((const unsigned*)((const char*)(gbase) + (voff)[_i]), (PG8_LAS unsigned*)(lds + (bufoff) + ldsw + _i * 8192), 16, 0, 0); } while (0)
#define PG8_LDA(dst, b, h) do { _Pragma("unroll") for (int m = 0; m < 4; ++m) _Pragma("unroll") for (int k = 0; k < 2; ++k) dst[m][k] = *(const PG8_LAS bf16x8*)(lds + PG8_SA(b, h) + aoff + m * 2048 + k * 1024); } while (0)
#define PG8_LDB(dst, b, h) do { _Pragma("unroll") for (int n = 0; n < 2; ++n) _Pragma("unroll") for (int k = 0; k < 2; ++k) dst[n][k] = *(const PG8_LAS bf16x8*)(lds + PG8_SB(b, h) + boff + n * 2048 + k * 1024); } while (0)
#define PG8_MMA(ai, bj, At, Bt) do { __builtin_amdgcn_s_setprio(1); _Pragma("unroll") for (int m = 0; m < 4; ++m) _Pragma("unroll") for (int n = 0; n < 2; ++n) _Pragma("unroll") for (int k = 0; k < 2; ++k) \
        acc[ai][bj][m][n] = __builtin_amdgcn_mfma_f32_16x16x32_bf16(Bt[n][k], At[m][k], acc[ai][bj][m][n], 0, 0, 0); __builtin_amdgcn_s_setprio(0); } while (0)
#define PG8_WAIT_V(n) asm volatile("s_waitcnt vmcnt(" #n ")" ::: "memory")
#define PG8_WAIT_L(n) asm volatile("s_waitcnt lgkmcnt(" #n ")" ::: "memory")
#define PG8_BAR __builtin_amdgcn_s_barrier()
#define PG8_SCHED __builtin_amdgcn_sched_barrier(0)
    Unit cur, nxt; int ui = 0;
    if (!S.next(0, cur)) return;
    f32x4 acc[2][2][4][2];
#pragma unroll
    for (int a = 0; a < 2; ++a)
#pragma unroll
        for (int b = 0; b < 2; ++b)
#pragma unroll
            for (int m = 0; m < 4; ++m)
#pragma unroll
                for (int n = 0; n < 2; ++n) acc[a][b][m][n] = (f32x4){0.f, 0.f, 0.f, 0.f};
    bf16x8 At[4][2], B0[2][2], B1[2][2];
    const char* cA = (const char*)g.A + (size_t)cur.pm * tstep; const char* cB = (const char*)g.Bt + (size_t)cur.pn * tstep;
    S.a_ready(cur);
    if constexpr (SP2) {
        PG8_STAGE(PG8_SB(0, 0), cB, voffB); PG8_STAGE(PG8_SB(0, 1), cB + hstep, voffB); PG8_STAGE(PG8_SA(0, 0), cA, voffA); PG8_STAGE(PG8_SA(0, 1), cA + hstep, voffA);
        if (wr == 1) PG8_BAR;
        PG8_WAIT_V(2); PG8_BAR;
        PG8_STAGE(PG8_SB(1, 0), cB + kstep, voffB); PG8_STAGE(PG8_SA(1, 0), cA + kstep, voffA); PG8_STAGE(PG8_SB(1, 1), cB + hstep + kstep, voffB);
        PG8_WAIT_V(6); PG8_BAR;
    } else {
        PG8_STAGE(PG8_SB(0, 0), cB, voffB); PG8_STAGE(PG8_SA(0, 0), cA, voffA); PG8_STAGE(PG8_SB(0, 1), cB + hstep, voffB); PG8_STAGE(PG8_SA(0, 1), cA + hstep, voffA);
        if (wr == 1) PG8_BAR;
        PG8_WAIT_V(4); PG8_BAR;
        PG8_STAGE(PG8_SB(1, 0), cB + kstep, voffB); PG8_STAGE(PG8_SA(1, 0), cA + kstep, voffA); PG8_STAGE(PG8_SB(1, 1), cB + hstep + kstep, voffB);
        PG8_WAIT_V(6); PG8_BAR;
    }
    for (;;) {
        const bool has_next = S.next(ui + 1, nxt);
        const char* nA = has_next ? (const char*)g.A + (size_t)nxt.pm * tstep : cA; const char* nB = has_next ? (const char*)g.Bt + (size_t)nxt.pn * tstep : cB;
        for (int t = 0; t < nt; t += 2) {
            const bool last = (t == nt - 2);
            const char* a1 = cA + (size_t)(t + 1) * kstep;
            const char* a2 = last ? nA : cA + (size_t)(t + 2) * kstep; const char* b2 = last ? nB : cB + (size_t)(t + 2) * kstep;
            const char* a3 = a2 + kstep; const char* b3 = b2 + kstep;
            if (last && has_next) S.a_ready(nxt);
            if constexpr (SP2) {
            PG8_LDB(B0, 0, 0); PG8_LDB(B1, 0, 1); PG8_SCHED; PG8_LDA(At, 0, 0); PG8_STAGE(PG8_SA(1, 1), a1 + hstep, voffA);
            PG8_WAIT_V(8); PG8_WAIT_L(0); PG8_BAR; PG8_MMA(0, 0, At, B0); PG8_MMA(0, 1, At, B1); PG8_BAR; PG8_SCHED;
            PG8_LDA(At, 0, 1); PG8_STAGE(PG8_SB(0, 0), b2, voffB); PG8_STAGE(PG8_SB(0, 1), b2 + hstep, voffB); PG8_STAGE(PG8_SA(0, 0), a2, voffA);
            PG8_WAIT_V(8); PG8_WAIT_L(0); PG8_BAR; PG8_MMA(1, 0, At, B0); PG8_MMA(1, 1, At, B1); PG8_BAR; PG8_SCHED;
            PG8_LDB(B0, 1, 0); PG8_LDB(B1, 1, 1); PG8_SCHED; PG8_LDA(At, 1, 0); PG8_STAGE(PG8_SA(0, 1), a2 + hstep, voffA);
            PG8_WAIT_V(8); PG8_WAIT_L(0); PG8_BAR; PG8_MMA(0, 0, At, B0); PG8_MMA(0, 1, At, B1); PG8_BAR; PG8_SCHED;
            PG8_LDA(At, 1, 1); PG8_STAGE(PG8_SB(1, 0), b3, voffB); PG8_STAGE(PG8_SB(1, 1), b3 + hstep, voffB); PG8_STAGE(PG8_SA(1, 0), a3, voffA);
            PG8_WAIT_V(8); PG8_WAIT_L(0); PG8_BAR; PG8_MMA(1, 0, At, B0); PG8_MMA(1, 1, At, B1); PG8_BAR; PG8_SCHED;
            } else {
            PG8_LDB(B0, 0, 0); PG8_SCHED; PG8_LDA(At, 0, 0); PG8_STAGE(PG8_SA(1, 1), a1 + hstep, voffA);
            PG8_WAIT_L(8); PG8_BAR; PG8_WAIT_L(0); PG8_MMA(0, 0, At, B0); PG8_BAR; PG8_SCHED;
            PG8_LDB(B1, 0, 1); PG8_STAGE(PG8_SB(0, 0), b2, voffB);
            PG8_BAR; PG8_WAIT_L(0); PG8_MMA(0, 1, At, B1); PG8_BAR;
            PG8_LDA(At, 0, 1); PG8_STAGE(PG8_SA(0, 0), a2, voffA);
            PG8_BAR; PG8_WAIT_L(0); PG8_MMA(1, 0, At, B0); PG8_BAR; PG8_SCHED;
            PG8_STAGE(PG8_SB(0, 1), b2 + hstep, voffB);
            PG8_WAIT_V(6); PG8_BAR; PG8_MMA(1, 1, At, B1); PG8_BAR;
            PG8_LDB(B0, 1, 0); PG8_SCHED; PG8_LDA(At, 1, 0); PG8_STAGE(PG8_SA(0, 1), a2 + hstep, voffA);
            PG8_WAIT_L(8); PG8_BAR; PG8_WAIT_L(0); PG8_MMA(0, 0, At, B0); PG8_BAR; PG8_SCHED;
            PG8_LDB(B1, 1, 1); PG8_STAGE(PG8_SB(1, 0), b3, voffB);
            PG8_BAR; PG8_WAIT_L(0); PG8_MMA(0, 1, At, B1); PG8_BAR;
            PG8_LDA(At, 1, 1); PG8_STAGE(PG8_SA(1, 0), a3, voffA);
            PG8_BAR; PG8_WAIT_L(0); PG8_MMA(1, 0, At, B0); PG8_BAR; PG8_SCHED;
            PG8_STAGE(PG8_SB(1, 1), b3 + hstep, voffB);
            PG8_WAIT_V(6); PG8_BAR; PG8_MMA(1, 1, At, B1); PG8_BAR;
            }
        }
        if constexpr (ALIGN_EPI) { if (wr == 0) PG8_BAR; }
        if constexpr (!Epi::AFTER_DRAIN) { E(acc, cur, wr, wc, fr, fq); S.done(cur); }
        if (!has_next) break;
#pragma unroll
        for (int a = 0; a < 2; ++a)
#pragma unroll
            for (int b = 0; b < 2; ++b)
#pragma unroll
                for (int m = 0; m < 4; ++m)
#pragma unroll
                    for (int n = 0; n < 2; ++n) acc[a][b][m][n] = (f32x4){0.f, 0.f, 0.f, 0.f};
        cur = nxt; cA = nA; cB = nB; ++ui;
        if constexpr (ALIGN_EPI) { if (wr == 1) PG8_BAR; }
    }
    PG8_WAIT_V(0);
    if constexpr (!ALIGN_EPI) { if (wr == 0) PG8_BAR; }
    PG8_BAR;
    if constexpr (Epi::AFTER_DRAIN) { E.fused(acc, cur, wr, wc, fr, fq, lds, wid, lane); S.done(cur); }
#undef PG8_SA
#undef PG8_SB
#undef PG8_STAGE
#undef PG8_LDA
#undef PG8_LDB
#undef PG8_MMA
#undef PG8_WAIT_V
#undef PG8_WAIT_L
#undef PG8_BAR
#undef PG8_SCHED
}
}

namespace mk {
typedef unsigned short bf16_t;
typedef float f32x4 __attribute__((ext_vector_type(4)));
typedef unsigned u32x4 __attribute__((ext_vector_type(4)));
typedef unsigned u32x2 __attribute__((ext_vector_type(2)));
#define LAS __attribute__((address_space(3)))

constexpr int BATCH = 16, SEQ = 2048, DM = 1024, M = BATCH * SEQ;
constexpr int NA = 1792, NB = 2560, N1 = NA + NB;
constexpr int N3 = 3072;
constexpr int EVEN_IN = 4224, SHIFT_W = 1664;
constexpr float RMS_EPS = 1e-6f, LN_EPS = 1e-5f, GN_EPS = 64e-5f;
constexpr int NTHR = 512;

constexpr size_t MiB = 1u << 20;
constexpr size_t WS_RS0 = 0, WS_RS1 = 128 * 1024, WS_RS2 = 256 * 1024, WS_VSUM = 384 * 1024, WS_VSQ = 512 * 1024, WS_BON = 1 * MiB;
constexpr size_t WS_W1T = 4 * MiB, WS_W2T = 13 * MiB, WS_W3T = 15 * MiB, WS_W4T = 21 * MiB;
constexpr size_t WS_XN = 24 * MiB;
constexpr size_t WS_PA = 88 * MiB;
constexpr size_t WS_PB = 200 * MiB;
constexpr size_t WS_YMIX = 360 * MiB;
constexpr size_t WS_END = 424 * MiB;
constexpr size_t WS_P1 = WS_PA;
constexpr int LDS_BYTES = 147456;

struct Args {
    const float* in[22];
    float* out; unsigned char* ws;
    int lo, hi;
};
enum { I_X = 0, I_NORMG, I_WINE, I_SHMU, I_W0, I_W2, I_A0, I_A2, I_KK, I_KA, I_RK, I_LNXG, I_LNXB, I_ABIAS, I_WOUTE, I_WINO, I_SGLNG, I_SGLNB, I_SGW, I_SGB, I_WOUTO, I_FG };

__device__ __forceinline__ unsigned short f2bf(float f) { unsigned u = __float_as_uint(f); return (unsigned short)((u + 0x7fffu + ((u >> 16) & 1u)) >> 16); }
__device__ __forceinline__ float bf2f(unsigned short h) { return __uint_as_float((unsigned)h << 16); }
__device__ __forceinline__ unsigned pk2(float lo, float hi) { return (unsigned)f2bf(lo) | ((unsigned)f2bf(hi) << 16); }
__device__ __forceinline__ float bflo(unsigned w) { return __uint_as_float(w << 16); }
__device__ __forceinline__ float bfhi(unsigned w) { return __uint_as_float(w & 0xffff0000u); }
__device__ __forceinline__ float wave_sum(float v) {
#pragma unroll
    for (int o = 1; o < 64; o <<= 1) v += __shfl_xor(v, o);
    return v;
}
__device__ __forceinline__ float sigmoidf_(float x) { return 1.0f / (1.0f + __expf(-x)); }
__device__ __forceinline__ float siluf_(float x) { return x * sigmoidf_(x); }
__device__ __forceinline__ float gelu_tanh(float x) { const float y = 0.7978845608028654f * (x + 0.044715f * x * x * x); return x * sigmoidf_(2.0f * y); }

__device__ __forceinline__ void phase_prologue(const Args& a) {
    const int tid = threadIdx.x, lane = tid & 63, wave = tid >> 6;
    unsigned char* ws = a.ws;
    const int gtid = blockIdx.x * NTHR + tid, nthr = gridDim.x * NTHR;
    constexpr int NTOT = N1 + 1024 + N3 + 1024;
    for (int it = gtid; it < NTOT * 128; it += nthr) {
        int n = it % NTOT; const int k8 = it / NTOT;
        const float* src; const float* g; int N, col; bf16_t* dst; bool zero = false;
        if (n < N1) { src = a.in[I_WINE]; g = a.in[I_NORMG]; N = EVEN_IN; dst = (bf16_t*)(ws + WS_W1T) + (size_t)n * 1024;
            if (n < SHIFT_W) col = n; else if (n < NA) { col = 0; zero = true; } else col = n - (NA - SHIFT_W); }
        else if ((n -= N1) < 1024) { src = a.in[I_WOUTE]; g = nullptr; N = 1024; col = n; dst = (bf16_t*)(ws + WS_W2T) + (size_t)n * 1024; }
        else if ((n -= 1024) < N3) { src = a.in[I_WINO]; g = a.in[I_NORMG] + 1024; N = N3; col = n; dst = (bf16_t*)(ws + WS_W3T) + (size_t)n * 1024; }
        else { n -= N3; src = a.in[I_WOUTO]; g = nullptr; N = 1024; col = n; dst = (bf16_t*)(ws + WS_W4T) + (size_t)n * 1024; }
        float v[8];
#pragma unroll
        for (int j = 0; j < 8; ++j) { const int k = k8 * 8 + j; float x = zero ? 0.f : src[(size_t)k * N + col]; if (g) x *= g[k]; v[j] = x; }
        u32x4 o; o.x = pk2(v[0], v[1]); o.y = pk2(v[2], v[3]); o.z = pk2(v[4], v[5]); o.w = pk2(v[6], v[7]);
        *(u32x4*)(dst + k8 * 8) = o;
    }
    const float* x = a.in[I_X]; bf16_t* XN = (bf16_t*)(ws + WS_XN); float* rs0 = (float*)(ws + WS_RS0);
    const int gw = blockIdx.x * 8 + wave, NGW = gridDim.x * 8;
    for (int m = gw; m < M; m += NGW) {
        const f32x4* xr = (const f32x4*)(x + (size_t)m * DM) + lane; float s = 0.f; f32x4 v[4];
#pragma unroll
        for (int j = 0; j < 4; ++j) { v[j] = xr[64 * j]; s += (v[j].x * v[j].x + v[j].y * v[j].y) + (v[j].z * v[j].z + v[j].w * v[j].w); }
        s = wave_sum(s);
        u32x2* o = (u32x2*)(XN + (size_t)m * DM) + lane;
#pragma unroll
        for (int j = 0; j < 4; ++j) { u32x2 w; w.x = pk2(v[j].x, v[j].y); w.y = pk2(v[j].z, v[j].w); o[64 * j] = w; }
        if (lane == 0) rs0[m] = s;
    }
    float* rs1 = (float*)(ws + WS_RS1); float* rs2 = (float*)(ws + WS_RS2); float* vsum = (float*)(ws + WS_VSUM); float* vsq = (float*)(ws + WS_VSQ);
    for (int i = gtid; i < M; i += nthr) { rs1[i] = 0.f; rs2[i] = 0.f; vsum[i] = 0.f; vsq[i] = 0.f; }
}

struct EpiG1 {
    const float* rs0; bf16_t* PA; bf16_t* PB;
    __device__ __forceinline__ void operator()(int row, int col, f32x4 v0, f32x4 v1) const {
        const float rinv = rsqrtf(rs0[row] * (1.0f / DM) + RMS_EPS);
        v0 = v0 * rinv; v1 = v1 * rinv;
        u32x4 w; w.x = pk2(v0[0], v0[1]); w.y = pk2(v0[2], v0[3]); w.z = pk2(v1[0], v1[1]); w.w = pk2(v1[2], v1[3]);
        bf16_t* dst = col < NA ? PA + (size_t)row * NA + col : PB + (size_t)row * NB + (col - NA);
        *(u32x4*)dst = w;
    }
};
struct EpiG2 {
    const float* x; float* out; bf16_t* HB; float* rs1;
    __device__ __forceinline__ void operator()(int row, int col, f32x4 v0, f32x4 v1) const {
        const size_t off = (size_t)row * DM + col;
        v0 = v0 + *(const f32x4*)(x + off); v1 = v1 + *(const f32x4*)(x + off + 4);
        *(f32x4*)(out + off) = v0; *(f32x4*)(out + off + 4) = v1;
        u32x4 w; w.x = pk2(v0[0], v0[1]); w.y = pk2(v0[2], v0[3]); w.z = pk2(v1[0], v1[1]); w.w = pk2(v1[2], v1[3]);
        *(u32x4*)(HB + off) = w;
        const float s = (v0[0] * v0[0] + v0[1] * v0[1]) + (v0[2] * v0[2] + v0[3] * v0[3]) + (v1[0] * v1[0] + v1[1] * v1[1]) + (v1[2] * v1[2] + v1[3] * v1[3]);
        unsafeAtomicAdd(rs1 + row, s);
    }
};
struct EpiG3 {
    const float* rs1; bf16_t* P1; float* vsum; float* vsq;
    __device__ __forceinline__ void operator()(int row, int col, f32x4 v0, f32x4 v1) const {
        const float rinv = rsqrtf(rs1[row] * (1.0f / DM) + RMS_EPS);
        float v[8];
#pragma unroll
        for (int j = 0; j < 4; ++j) { v[j] = v0[j] * rinv; v[4 + j] = v1[j] * rinv; }
        if (col < 2048) {
#pragma unroll
            for (int j = 0; j < 8; ++j) v[j] = gelu_tanh(v[j]);
            if (col >= 1024) {
                float s = 0.f, q = 0.f;
#pragma unroll
                for (int j = 0; j < 8; ++j) { s += v[j]; q += v[j] * v[j]; }
                unsafeAtomicAdd(vsum + row, s); unsafeAtomicAdd(vsq + row, q);
            }
        } else {
#pragma unroll
            for (int j = 0; j < 8; ++j) v[j] = siluf_(v[j]);
        }
        u32x4 w; w.x = pk2(v[0], v[1]); w.y = pk2(v[2], v[3]); w.z = pk2(v[4], v[5]); w.w = pk2(v[6], v[7]);
        *(u32x4*)(P1 + (size_t)row * N3 + col) = w;
    }
};
struct EpiG4 {
    float* out; float* rs2;
    __device__ __forceinline__ void operator()(int row, int col, f32x4 v0, f32x4 v1) const {
        const size_t off = (size_t)row * DM + col;
        v0 = v0 + *(const f32x4*)(out + off); v1 = v1 + *(const f32x4*)(out + off + 4);
        *(f32x4*)(out + off) = v0; *(f32x4*)(out + off + 4) = v1;
        const float s = (v0[0] * v0[0] + v0[1] * v0[1]) + (v0[2] * v0[2] + v0[3] * v0[3]) + (v1[0] * v1[0] + v1[1] * v1[1]) + (v1[2] * v1[2] + v1[3] * v1[3]);
        unsafeAtomicAdd(rs2 + row, s);
    }
};

template <class F> struct EpiAdapt {
    static constexpr bool PERM = true, AFTER_DRAIN = false;
    F f;
    __device__ __forceinline__ void operator()(const pg8::f32x4 (&acc)[2][2][4][2], const pg8::Unit& u, int wr, int wc, int fr, int fq) const {
#pragma unroll
        for (int ai = 0; ai < 2; ++ai)
#pragma unroll
            for (int m = 0; m < 4; ++m) {
                const int row = u.pm * 256 + ai * 128 + wr * 64 + m * 16 + fr;
#pragma unroll
                for (int bj = 0; bj < 2; ++bj) { const int col = u.pn * 256 + bj * 128 + wc * 32 + 8 * fq; f(row, col, acc[ai][bj][m][0], acc[ai][bj][m][1]); }
            }
    }
};

template <class F> __device__ __forceinline__ void gemm_naive(float* lds, const bf16_t* A, const bf16_t* Bt, int Mm, int N, int K, const F& f) {
    const int tid = threadIdx.x, ty = tid >> 4, tx = tid & 15;
    float* As = lds; float* Bs = lds + 32 * 132;
    const int ntn = N / 128, ntiles = (Mm / 128) * ntn;
    for (int tile = blockIdx.x; tile < ntiles; tile += gridDim.x) {
        const int tm = tile / ntn, tn = tile % ntn;
        float acc[4][8];
#pragma unroll
        for (int i = 0; i < 4; ++i)
#pragma unroll
            for (int j = 0; j < 8; ++j) acc[i][j] = 0.f;
        for (int k0 = 0; k0 < K; k0 += 32) {
            { const int row = tid >> 2, kc = (tid & 3) * 8;
              const u32x4 va = *(const u32x4*)(A + (size_t)(tm * 128 + row) * K + k0 + kc);
              const u32x4 vb = *(const u32x4*)(Bt + (size_t)(tn * 128 + row) * K + k0 + kc);
              As[(kc + 0) * 132 + row] = bflo(va.x); As[(kc + 1) * 132 + row] = bfhi(va.x); As[(kc + 2) * 132 + row] = bflo(va.y); As[(kc + 3) * 132 + row] = bfhi(va.y);
              As[(kc + 4) * 132 + row] = bflo(va.z); As[(kc + 5) * 132 + row] = bfhi(va.z); As[(kc + 6) * 132 + row] = bflo(va.w); As[(kc + 7) * 132 + row] = bfhi(va.w);
              Bs[(kc + 0) * 132 + row] = bflo(vb.x); Bs[(kc + 1) * 132 + row] = bfhi(vb.x); Bs[(kc + 2) * 132 + row] = bflo(vb.y); Bs[(kc + 3) * 132 + row] = bfhi(vb.y);
              Bs[(kc + 4) * 132 + row] = bflo(vb.z); Bs[(kc + 5) * 132 + row] = bfhi(vb.z); Bs[(kc + 6) * 132 + row] = bflo(vb.w); Bs[(kc + 7) * 132 + row] = bfhi(vb.w); }
            __syncthreads();
#pragma unroll 8
            for (int kk = 0; kk < 32; ++kk) {
                const f32x4 a4 = *(const f32x4*)(As + kk * 132 + ty * 4);
                const f32x4 b0 = *(const f32x4*)(Bs + kk * 132 + tx * 8), b1 = *(const f32x4*)(Bs + kk * 132 + tx * 8 + 4);
#pragma unroll
                for (int i = 0; i < 4; ++i) {
#pragma unroll
                    for (int j = 0; j < 4; ++j) { acc[i][j] += a4[i] * b0[j]; acc[i][4 + j] += a4[i] * b1[j]; }
                }
            }
            __syncthreads();
        }
#pragma unroll
        for (int i = 0; i < 4; ++i) f(tm * 128 + ty * 4 + i, tn * 128 + tx * 8, (f32x4){acc[i][0], acc[i][1], acc[i][2], acc[i][3]}, (f32x4){acc[i][4], acc[i][5], acc[i][6], acc[i][7]});
    }
}

template <class F> __device__ __forceinline__ void gemm_any(unsigned char* lds, const bf16_t* A, const bf16_t* Bt, int Mm, int N, int K, const F& f) {
#if USE_PG8
    pg8::Gemm g{A, Bt, Mm, N, K}; pg8::StaticOrder S; S.init(Mm, N, (int)gridDim.x, (int)blockIdx.x);
    EpiAdapt<F> E{f};
    pg8::gemm_phase<EpiAdapt<F>, pg8::StaticOrder, true, true>((PG8_LAS unsigned char*)lds, g, S, E);
#else
    gemm_naive((float*)lds, A, Bt, Mm, N, K, f);
#endif
}

__device__ __forceinline__ void phase_prep(const Args& a, unsigned char* ldsb) {
    const int tid = threadIdx.x, lane = tid & 63, wave = tid >> 6;
    unsigned char* ws = a.ws;
    const bf16_t* PA = (const bf16_t*)(ws + WS_PA);
    bf16_t* R = (bf16_t*)a.out; bf16_t* KP = R + (size_t)M * 512; bf16_t* V = KP + (size_t)M * 512; bf16_t* AN = V + (size_t)M * 512;
    bf16_t* YM = (bf16_t*)(ws + WS_YMIX); float* DEC = (float*)(ws + WS_XN); float* BON = (float*)(ws + WS_BON);
    const float* mu = a.in[I_SHMU];
    float* sw = (float*)ldsb; float* sad = sw + 512;
    const int c = tid;
    const float w0 = a.in[I_W0][c], a0 = a.in[I_A0][c], kkc = a.in[I_KK][c], kac = a.in[I_KA][c], rkc = a.in[I_RK][c];
    const float mur = mu[c], muk = mu[512 + c], muv = mu[1024 + c];
    const float* w2 = a.in[I_W2]; const float* a2 = a.in[I_A2];
    for (int u = blockIdx.x; u < M / 8; u += gridDim.x) {
        const int t0 = u * 8;
        { const int tok = tid >> 6, j = tid & 63; const int t = t0 + tok; const bool first = (t % SEQ) == 0;
          const float pw = bf2f(PA[(size_t)t * NA + 1536 + j]), pa = bf2f(PA[(size_t)t * NA + 1600 + j]);
          const float qw = first ? 0.f : bf2f(PA[(size_t)(t - 1) * NA + 1536 + j]), qa = first ? 0.f : bf2f(PA[(size_t)(t - 1) * NA + 1600 + j]);
          sw[tid] = tanhf(pw + (qw - pw) * mu[1536 + j]); sad[tid] = pa + (qa - pa) * mu[1600 + j]; }
        __syncthreads();
        float accw[8], acca[8];
#pragma unroll
        for (int i = 0; i < 8; ++i) { accw[i] = w0; acca[i] = a0; }
        for (int j = 0; j < 64; ++j) {
            const float w2v = w2[j * 512 + c], a2v = a2[j * 512 + c];
#pragma unroll
            for (int i = 0; i < 8; ++i) { accw[i] += sw[i * 64 + j] * w2v; acca[i] += sad[i * 64 + j] * a2v; }
        }
#pragma unroll
        for (int i = 0; i < 8; ++i) {
            const int t = t0 + i; const bool first = (t % SEQ) == 0;
            const bf16_t* p = PA + (size_t)t * NA; const bf16_t* q = p - NA;
            float r = bf2f(p[c]), k = bf2f(p[512 + c]), v = bf2f(p[1024 + c]);
            const float rp = first ? 0.f : bf2f(q[c]), kp_ = first ? 0.f : bf2f(q[512 + c]), vp = first ? 0.f : bf2f(q[1024 + c]);
            r += (rp - r) * mur; k += (kp_ - k) * muk; v += (vp - v) * muv;
            const float z = accw[i];
            const float sp = fmaxf(-z, 0.f) + log1pf(__expf(-fabsf(z)));
            const float w = -sp - 0.5f;
            const float dec = __expf(-__expf(w));
            const float av = sigmoidf_(acca[i]);
            float kk = k * kkc; const float ss = wave_sum(kk * kk); kk = kk / fmaxf(sqrtf(ss), 1e-12f);
            const float kn = k * (1.0f + (av - 1.0f) * kac);
            const float bon = wave_sum(r * kn * rkc);
            const size_t o = (size_t)t * 512 + c;
            R[o] = f2bf(r); KP[o] = f2bf(kn); V[o] = f2bf(v); AN[o] = f2bf(-kk); YM[(size_t)t * 1024 + c] = f2bf(kk * av); DEC[o] = dec;
            if (lane == 0) BON[t * 8 + wave] = bon;
        }
        __syncthreads();
    }
}

__device__ __forceinline__ float rdlane(float x, int k) { return __uint_as_float(__builtin_amdgcn_readlane(__float_as_uint(x), k)); }
__device__ __forceinline__ void phase_scan_naive(const Args& a) {
    const int tid = threadIdx.x, lane = tid & 63, wave = tid >> 6;
    if (wave != 0) return;
    unsigned char* ws = a.ws;
    const bf16_t* R = (const bf16_t*)a.out; const bf16_t* KP = R + (size_t)M * 512; const bf16_t* V = KP + (size_t)M * 512; const bf16_t* AN = V + (size_t)M * 512;
    bf16_t* YM = (bf16_t*)(ws + WS_YMIX); const float* DEC = (const float*)(ws + WS_XN); const float* BON = (const float*)(ws + WS_BON);
    const bf16_t* PB = (const bf16_t*)(ws + WS_PB);
    for (int u = blockIdx.x; u < BATCH * 8; u += gridDim.x) {
        const int b = u >> 3, h = u & 7;
        const float lg = a.in[I_LNXG][h * 64 + lane], lb = a.in[I_LNXB][h * 64 + lane];
        float s[64];
#pragma unroll
        for (int k = 0; k < 64; ++k) s[k] = 0.f;
        for (int t = 0; t < SEQ; ++t) {
            const int tok = b * SEQ + t; const size_t o = (size_t)tok * 512 + h * 64 + lane;
            const float ca = bf2f(AN[o]), cw = DEC[o], cb = bf2f(YM[(size_t)tok * 1024 + h * 64 + lane]), ck = bf2f(KP[o]), cr = bf2f(R[o]), vv = bf2f(V[o]);
            float sa = 0.f;
#pragma unroll
            for (int k = 0; k < 64; ++k) sa += s[k] * rdlane(ca, k);
            float y = 0.f;
#pragma unroll
            for (int k = 0; k < 64; ++k) { s[k] = s[k] * rdlane(cw, k) + sa * rdlane(cb, k) + vv * rdlane(ck, k); y += s[k] * rdlane(cr, k); }
            const float mean = wave_sum(y) * (1.0f / 64.0f); const float d = y - mean; const float var = wave_sum(d * d) * (1.0f / 64.0f);
            float yn = d * rsqrtf(var + GN_EPS) * lg + lb;
            yn += BON[tok * 8 + h] * vv;
            const float g = bf2f(PB[(size_t)tok * NB + h * 64 + lane]);
            YM[(size_t)tok * 1024 + h * 64 + lane] = f2bf(yn * siluf_(g));
        }
    }
}

__device__ __forceinline__ void phase_attn_naive(const Args& a) {
    const int tid = threadIdx.x, lane = tid & 63, wave = tid >> 6;
    unsigned char* ws = a.ws;
    const bf16_t* PB = (const bf16_t*)(ws + WS_PB); bf16_t* YM = (bf16_t*)(ws + WS_YMIX);
    for (int u = blockIdx.x * 8 + wave; u < BATCH * 8 * 32; u += gridDim.x * 8) {
        const int c = u & 31, h = (u >> 5) & 7, b = u >> 8;
        const int t = b * SEQ + c * 64 + lane;
        float q[64], acc[64];
        { const u32x4* qp = (const u32x4*)(PB + (size_t)t * NB + 512 + h * 64);
#pragma unroll
          for (int i = 0; i < 8; ++i) { const u32x4 w = qp[i]; q[8 * i] = bflo(w.x) * 0.125f; q[8 * i + 1] = bfhi(w.x) * 0.125f; q[8 * i + 2] = bflo(w.y) * 0.125f; q[8 * i + 3] = bfhi(w.y) * 0.125f;
              q[8 * i + 4] = bflo(w.z) * 0.125f; q[8 * i + 5] = bfhi(w.z) * 0.125f; q[8 * i + 6] = bflo(w.w) * 0.125f; q[8 * i + 7] = bfhi(w.w) * 0.125f; } }
#pragma unroll
        for (int d = 0; d < 64; ++d) acc[d] = 0.f;
        float m = -1e30f, l = 0.f;
        const float* bt = a.in[I_ABIAS] + h * 257;
        const int k0 = (c - 8 > 0 ? c - 8 : 0) * 64, k1 = (c + 1) * 64;
        for (int kj = k0; kj < k1; ++kj) {
            const bf16_t* kr = PB + (size_t)(b * SEQ + kj) * NB + 1024 + h * 64;
            float s = 0.f;
#pragma unroll
            for (int i = 0; i < 8; ++i) { const u32x4 w = ((const u32x4*)kr)[i];
                s += q[8 * i] * bflo(w.x) + q[8 * i + 1] * bfhi(w.x) + q[8 * i + 2] * bflo(w.y) + q[8 * i + 3] * bfhi(w.y) + q[8 * i + 4] * bflo(w.z) + q[8 * i + 5] * bfhi(w.z) + q[8 * i + 6] * bflo(w.w) + q[8 * i + 7] * bfhi(w.w); }
            int rel = c * 64 + lane - kj; rel = rel < -128 ? -128 : (rel > 128 ? 128 : rel);
            s += bt[rel + 128];
            const float mn = fmaxf(m, s), al = __expf(m - mn), p = __expf(s - mn);
            l = l * al + p; m = mn;
            const bf16_t* vr = kr + 512;
#pragma unroll
            for (int i = 0; i < 8; ++i) { const u32x4 w = ((const u32x4*)vr)[i];
                acc[8 * i] = acc[8 * i] * al + p * bflo(w.x); acc[8 * i + 1] = acc[8 * i + 1] * al + p * bfhi(w.x); acc[8 * i + 2] = acc[8 * i + 2] * al + p * bflo(w.y); acc[8 * i + 3] = acc[8 * i + 3] * al + p * bfhi(w.y);
                acc[8 * i + 4] = acc[8 * i + 4] * al + p * bflo(w.z); acc[8 * i + 5] = acc[8 * i + 5] * al + p * bfhi(w.z); acc[8 * i + 6] = acc[8 * i + 6] * al + p * bflo(w.w); acc[8 * i + 7] = acc[8 * i + 7] * al + p * bfhi(w.w); }
        }
        const float il = 1.0f / l;
        const u32x4* gp = (const u32x4*)(PB + (size_t)t * NB + 2048 + h * 64);
        u32x4* op = (u32x4*)(YM + (size_t)t * 1024 + 512 + h * 64);
#pragma unroll
        for (int i = 0; i < 8; ++i) { const u32x4 g = gp[i]; u32x4 o;
            o.x = pk2(acc[8 * i] * il * siluf_(bflo(g.x)), acc[8 * i + 1] * il * siluf_(bfhi(g.x))); o.y = pk2(acc[8 * i + 2] * il * siluf_(bflo(g.y)), acc[8 * i + 3] * il * siluf_(bfhi(g.y)));
            o.z = pk2(acc[8 * i + 4] * il * siluf_(bflo(g.z)), acc[8 * i + 5] * il * siluf_(bfhi(g.z))); o.w = pk2(acc[8 * i + 6] * il * siluf_(bflo(g.w)), acc[8 * i + 7] * il * siluf_(bfhi(g.w)));
            op[i] = o; }
    }
}

__device__ __forceinline__ void phase_sg_naive(const Args& a, unsigned char* ldsb) {
    const int tid = threadIdx.x;
    unsigned char* ws = a.ws;
    const bf16_t* P1 = (const bf16_t*)(ws + WS_P1); bf16_t* Y2 = (bf16_t*)(ws + WS_YMIX);
    const float* vsum = (const float*)(ws + WS_VSUM); const float* vsq = (const float*)(ws + WS_VSQ);
    float* vn = (float*)ldsb;
    const int c = tid & 127, i0 = tid >> 7;
    for (int u = blockIdx.x; u < BATCH * 16 * 8; u += gridDim.x) {
        const int g = u & 7, nb = (u >> 3) & 15, b = u >> 7;
        const int tbase = b * SEQ + nb * 128;
        const float lg = a.in[I_SGLNG][g * 128 + c], lb = a.in[I_SGLNB][g * 128 + c];
        for (int j = i0; j < 128; j += 4) {
            const int t = tbase + j; const float mean = vsum[t] * (1.0f / 1024.0f); const float var = vsq[t] * (1.0f / 1024.0f) - mean * mean;
            const float rstd = rsqrtf(fmaxf(var, 0.f) + LN_EPS);
            vn[j * 128 + c] = (bf2f(P1[(size_t)t * N3 + 1024 + g * 128 + c]) - mean) * rstd * lg + lb;
        }
        __syncthreads();
        const float* wg = a.in[I_SGW] + (size_t)g * 128 * 128; const float* sb = a.in[I_SGB] + g * 128;
        for (int i = i0; i < 128; i += 4) {
            const int jend = (i < 64) ? 64 : 128;
            float acc = 0.f;
            for (int j = 0; j < jend; ++j) acc += wg[i * 128 + j] * vn[j * 128 + c];
            const int t = tbase + i;
            const float uu = bf2f(P1[(size_t)t * N3 + g * 128 + c]), gt = bf2f(P1[(size_t)t * N3 + 2048 + g * 128 + c]);
            Y2[(size_t)t * 1024 + g * 128 + c] = f2bf(uu * (acc + sb[i]) * gt);
        }
        __syncthreads();
    }
}

__device__ __forceinline__ void phase_final(const Args& a) {
    const int tid = threadIdx.x, lane = tid & 63, wave = tid >> 6;
    const float* rs2 = (const float*)(a.ws + WS_RS2); const float* fg = a.in[I_FG];
    const int gw = blockIdx.x * 8 + wave, NGW = gridDim.x * 8;
    f32x4 g4[4];
#pragma unroll
    for (int j = 0; j < 4; ++j) g4[j] = ((const f32x4*)fg)[lane + 64 * j];
    for (int m = gw; m < M; m += NGW) {
        const float rinv = rsqrtf(rs2[m] * (1.0f / DM) + RMS_EPS);
        f32x4* p = (f32x4*)(a.out + (size_t)m * DM) + lane;
#pragma unroll
        for (int j = 0; j < 4; ++j) { f32x4 v = p[64 * j]; v = v * rinv * g4[j]; p[64 * j] = v; }
    }
}

__global__ void __launch_bounds__(NTHR, 2) mega(Args a) {
    extern __shared__ __attribute__((aligned(16))) unsigned char lds[];
    unsigned char* ws = a.ws;
    const int lo = a.lo, hi = a.hi;
#define IN(k) (lo <= (k) && (k) < hi)
#define SEAM(k) do { if (IN(k) && IN((k) + 1)) { cg::this_grid().sync(); } } while (0)
    if (IN(0)) { phase_prologue(a); }
    SEAM(0);
    if (IN(1)) { EpiG1 f{(const float*)(ws + WS_RS0), (bf16_t*)(ws + WS_PA), (bf16_t*)(ws + WS_PB)};
        gemm_any(lds, (const bf16_t*)(ws + WS_XN), (const bf16_t*)(ws + WS_W1T), M, N1, DM, f); }
    SEAM(1);
    if (IN(2)) { phase_prep(a, lds); }
    SEAM(2);
    if (IN(3)) { phase_scan_naive(a); phase_attn_naive(a); }
    SEAM(3);
    if (IN(4)) { EpiG2 f{a.in[I_X], a.out, (bf16_t*)(ws + WS_XN), (float*)(ws + WS_RS1)};
        gemm_any(lds, (const bf16_t*)(ws + WS_YMIX), (const bf16_t*)(ws + WS_W2T), M, DM, DM, f); }
    SEAM(4);
    if (IN(5)) { EpiG3 f{(const float*)(ws + WS_RS1), (bf16_t*)(ws + WS_P1), (float*)(ws + WS_VSUM), (float*)(ws + WS_VSQ)};
        gemm_any(lds, (const bf16_t*)(ws + WS_XN), (const bf16_t*)(ws + WS_W3T), M, N3, DM, f); }
    SEAM(5);
    if (IN(6)) { phase_sg_naive(a, lds); }
    SEAM(6);
    if (IN(7)) { EpiG4 f{a.out, (float*)(ws + WS_RS2)};
        gemm_any(lds, (const bf16_t*)(ws + WS_YMIX), (const bf16_t*)(ws + WS_W4T), M, DM, DM, f); }
    SEAM(7);
    if (IN(8)) { phase_final(a); }
#undef IN
#undef SEAM
}
constexpr int NPHASE = 9;
}

extern "C" void kernel_launch(void* const* d_in, const int* in_sizes, int n_in, void* d_out, int out_size, void* d_ws, size_t ws_size, hipStream_t stream) {
    using namespace mk;
    static int grid = 0;
    if (grid == 0) {
        if (n_in != 22 || out_size != M * DM || ws_size < WS_END) { fprintf(stderr, "kernel_launch: unexpected shapes (n_in %d out %d ws %zu)\n", n_in, out_size, ws_size); grid = -1; return; }
        int dev = 0, cus = 0, per_cu = 0;
        hipGetDevice(&dev); hipDeviceGetAttribute(&cus, hipDeviceAttributeMultiprocessorCount, dev);
        if (hipFuncSetAttribute((const void*)mega, hipFuncAttributeMaxDynamicSharedMemorySize, LDS_BYTES) != hipSuccess) { fprintf(stderr, "kernel_launch: hipFuncSetAttribute failed\n"); grid = -1; return; }
        if (hipOccupancyMaxActiveBlocksPerMultiprocessor(&per_cu, (const void*)mega, NTHR, LDS_BYTES) != hipSuccess || per_cu < 1) { fprintf(stderr, "kernel_launch: occupancy query says %d\n", per_cu); per_cu = 1; }
        (void)hipGetLastError();
        grid = cus * 1;
        if (grid <= 0) grid = 256;
    }
    if (grid < 0) return;
    Args a{};
    for (int i = 0; i < 22; ++i) a.in[i] = (const float*)d_in[i];
    a.out = (float*)d_out; a.ws = (unsigned char*)d_ws;
#if N_LAUNCH_MODE == 1
    a.lo = 0; a.hi = NPHASE;
    void* args[] = {&a};
    hipError_t e = hipLaunchCooperativeKernel((const void*)mega, dim3(grid), dim3(NTHR), args, LDS_BYTES, stream);
    if (e != hipSuccess) fprintf(stderr, "kernel_launch: cooperative launch failed: %s (grid %d)\n", hipGetErrorString(e), grid);
#else
    for (int ph = 0; ph < NPHASE; ++ph) {
        a.lo = ph; a.hi = ph + 1;
        hipLaunchKernelGGL(mega, dim3(grid), dim3(NTHR), LDS_BYTES, stream, a);
    }
#endif
}
```

```cpp
#include <hip/hip_runtime.h>
#include <hip/hip_cooperative_groups.h>
#include <cstdio>
#include <cstdint>
namespace cg = cooperative_groups;
#ifndef USE_PG8
#define USE_PG8 1
#endif
#ifndef N_LAUNCH_MODE
#define N_LAUNCH_MODE 1
#endif
#ifndef PHMASK
#define PHMASK 0x1ff
#endif
#ifndef USE_NAIVE_MIX
#define USE_NAIVE_MIX 0
#endif
namespace pg8 {
#define PG8_LAS __attribute__((address_space(3)))
typedef unsigned short bf16_t;
typedef short bf16x8 __attribute__((ext_vector_type(8)));
typedef float f32x4 __attribute__((ext_vector_type(4)));
typedef unsigned u32x4 __attribute__((ext_vector_type(4)));
constexpr int BM = 256, BK = 64, HALF = 128, HTB = HALF * BK * 2  , STAGE_BYTES = 8 * HTB, NXCD = 8, WGM = 8;

__host__ __device__ __forceinline__ int lds_byte(int r, int c) { const int st = (r >> 4) * 2 + (c >> 5), rr = r & 15, cc = c & 31, ob = rr * 64 + cc * 2; return st * 1024 + (ob ^ (((ob >> 9) & 1) << 5)); }
__host__ __device__ __forceinline__ void stage_rc(int b, int& R, int& C) { const int st = b / 1024, sb = b % 1024, swz = sb ^ (((sb >> 9) & 1) << 5); R = (st >> 1) * 16 + swz / 64; C = (st & 1) * 32 + (swz % 64) / 2; }
__host__ __device__ __forceinline__ int perm32(int rho) { const int n = rho >> 4, i = rho & 15; return 8 * (i >> 2) + 4 * n + (i & 3); }

struct Unit { int pm, pn; };
struct Gemm { const bf16_t* A; const bf16_t* Bt; int M, N, K; };

struct StaticOrder {
    int nM, nN, nwg, G, c;
    __host__ __device__ void init(int M, int N, int G_, int c_) { nM = M / BM; nN = N / BM; nwg = nM * nN; G = G_; c = c_; }
    __host__ __device__ bool next(int i, Unit& u) const {
        const long L = (long)i * G + c; if (L >= nwg) return false;
        int wgid = (int)L; { const int q = nwg / NXCD, r = nwg % NXCD, xcd = wgid % NXCD, off = wgid / NXCD; wgid = (xcd < r ? xcd * (q + 1) : r * (q + 1) + (xcd - r) * q) + off; }
        const int nig = WGM * nN, gid = wgid / nig, fm = gid * WGM, gsz = (nM - fm) < WGM ? (nM - fm) : WGM;
        u.pm = fm + ((wgid % nig) % gsz); u.pn = (wgid % nig) / gsz; return true;
    }
    __device__ __forceinline__ void a_ready(const Unit&) const {}
    __device__ __forceinline__ void done(const Unit&) const {}
};

__device__ __forceinline__ unsigned cvt_pk_bf16(float lo, float hi) { unsigned r; asm volatile("v_cvt_pk_bf16_f32 %0, %1, %2" : "=v"(r) : "v"(lo), "v"(hi)); return r; }
typedef float f32x2 __attribute__((ext_vector_type(2)));
__device__ __forceinline__ f32x2 gelu_pk(f32x2 v) {
    const f32x2 av = __builtin_elementwise_abs(v), d = av * 0.2316418882f + 1.0f;
    f32x2 t; t.x = __builtin_amdgcn_rcpf(d.x); t.y = __builtin_amdgcn_rcpf(d.y);
    f32x2 q = t * 0.5307027145f + (-0.7265760135f); q = q * t + 0.7107068705f; q = q * t + (-0.142248368f); q = q * t + 0.127414796f; q = q * t;
    const f32x2 s = (v * v) * (-0.72134752044f);
    f32x2 e; e.x = __builtin_amdgcn_exp2f(s.x); e.y = __builtin_amdgcn_exp2f(s.y);
    const f32x2 m = v * (q * e), r = v - m;
    f32x2 o; o.x = v.x < 0.f ? m.x : r.x; o.y = v.y < 0.f ? m.y : r.y; return o;
}

template <int ACT  > struct EpiBf16 {
    static constexpr bool PERM = true, AFTER_DRAIN = false; static_assert(ACT == 0 || ACT == 1, "EpiBf16: ACT is 0 (none) or 1 (gelu_pk)");
    bf16_t* O; int ldc; const float* bias; int split_cols; size_t split_stride; float scale0;
    __device__ __forceinline__ void operator()(const f32x4 (&acc)[2][2][4][2], const Unit& u, int wr, int wc, int fr, int fq) const {
        const int row0 = u.pm * BM + wr * 64 + fr; int colt = u.pn * BM; bf16_t* base = O;
        float sc = 1.f; if (split_cols) { const int t = colt / split_cols; base += (size_t)t * split_stride; colt -= t * split_cols; if (t == 0) sc = scale0; }
        const int col0 = colt + wc * 32 + 8 * fq, bcol0 = u.pn * BM + wc * 32 + 8 * fq;
        f32x4 bv[2][2];
#pragma unroll
        for (int bj = 0; bj < 2; ++bj)
#pragma unroll
            for (int n = 0; n < 2; ++n) bv[bj][n] = bias ? *(const f32x4*)(bias + bcol0 + bj * HALF + 4 * n) : (f32x4){0.f, 0.f, 0.f, 0.f};
#pragma unroll
        for (int ai = 0; ai < 2; ++ai)
#pragma unroll
            for (int m = 0; m < 4; ++m) { bf16_t* rowp = base + (size_t)(row0 + ai * HALF + m * 16) * ldc + col0;
#pragma unroll
                for (int bj = 0; bj < 2; ++bj) { f32x4 v0 = acc[ai][bj][m][0] + bv[bj][0], v1 = acc[ai][bj][m][1] + bv[bj][1];
                    if (ACT == 1) { f32x2 a = gelu_pk((f32x2){v0[0], v0[1]}), b = gelu_pk((f32x2){v0[2], v0[3]}), c = gelu_pk((f32x2){v1[0], v1[1]}), d = gelu_pk((f32x2){v1[2], v1[3]});
                        v0 = (f32x4){a.x, a.y, b.x, b.y}; v1 = (f32x4){c.x, c.y, d.x, d.y}; }
                    v0 = v0 * sc; v1 = v1 * sc; u32x4 w; w.x = cvt_pk_bf16(v0[0], v0[1]); w.y = cvt_pk_bf16(v0[2], v0[3]); w.z = cvt_pk_bf16(v1[0], v1[1]); w.w = cvt_pk_bf16(v1[2], v1[3]);
                    *(u32x4*)(rowp + bj * HALF) = w; } }
    }
};
template <class Epi, class Sched, bool ALIGN_EPI = false, bool SP2 = false>
__device__ __forceinline__ void gemm_phase(PG8_LAS unsigned char* lds, const Gemm g, const Sched& S, const Epi& E) {
    const int tid = threadIdx.x, wid = __builtin_amdgcn_readfirstlane(tid >> 6), lane = tid & 63, wr = wid >> 2, wc = wid & 3, fr = lane & 15, fq = lane >> 4;
    const int K = g.K, nt = K / BK;
    unsigned voffA[2], voffB[2];
#pragma unroll
    for (int i = 0; i < 2; ++i) { int R, C; stage_rc(tid * 16 + i * 8192, R, C); const int Rb = Epi::PERM ? ((R & ~31) + perm32(R & 31)) : R;
        voffA[i] = (unsigned)(R * K + C) * 2u; voffB[i] = (unsigned)(Rb * K + C) * 2u; }
    const size_t kstep = (size_t)(BK * 2);
    const size_t hstep = (size_t)HALF * K * 2;
    const size_t tstep = 2 * hstep;
    const unsigned ldsw = (unsigned)wid * 1024u;
    const int aoff = lds_byte(wr * 64 + fr, fq * 8), boff = lds_byte(wc * 32 + fr, fq * 8);
#define PG8_SA(b, h) (((b) * 2 + (h)) * HTB)
#define PG8_SB(b, h) ((4 + (b) * 2 + (h)) * HTB)
#define PG8_STAGE(bufoff, gbase, voff) do { _Pragma("unroll") for (int _i = 0; _i < 2; ++_i) \
        __builtin_amdgcn_global_load_lds((const unsigned*)((const char*)(gbase) + (voff)[_i]), (PG8_LAS unsigned*)(lds + (bufoff) + ldsw + _i * 8192), 16, 0, 0); } while (0)
#define PG8_LDA(dst, b, h) do { _Pragma("unroll") for (int m = 0; m < 4; ++m) _Pragma("unroll") for (int k = 0; k < 2; ++k) dst[m][k] = *(const PG8_LAS bf16x8*)(lds + PG8_SA(b, h) + aoff + m * 2048 + k * 1024); } while (0)
#define PG8_LDB(dst, b, h) do { _Pragma("unroll") for (int n = 0; n < 2; ++n) _Pragma("unroll") for (int k = 0; k < 2; ++k) dst[n][k] = *(const PG8_LAS bf16x8*)(lds + PG8_SB(b, h) + boff + n * 2048 + k * 1024); } while (0)
#define PG8_MMA(ai, bj, At, Bt) do { __builtin_amdgcn_s_setprio(1); _Pragma("unroll") for (int m = 0; m < 4; ++m) _Pragma("unroll") for (int n = 0; n < 2; ++n) _Pragma("unroll") for (int k = 0; k < 2; ++k) \
        acc[ai][bj][m][n] = __builtin_amdgcn_mfma_f32_16x16x32_bf16(Bt[n][k], At[m][k], acc[ai][bj][m][n], 0, 0, 0); __builtin_amdgcn_s_setprio(0); } while (0)
#define PG8_WAIT_V(n) asm volatile("s_waitcnt vmcnt(" #n ")" ::: "memory")
#define PG8_WAIT_L(n) asm volatile("s_waitcnt lgkmcnt(" #n ")" ::: "memory")
#define PG8_BAR __builtin_amdgcn_s_barrier()
#define PG8_SCHED __builtin_amdgcn_sched_barrier(0)
    Unit cur, nxt; int ui = 0;
    if (!S.next(0, cur)) return;
    f32x4 acc[2][2][4][2];
#pragma unroll
    for (int a = 0; a < 2; ++a)
#pragma unroll
        for (int b = 0; b < 2; ++b)
#pragma unroll
            for (int m = 0; m < 4; ++m)
#pragma unroll
                for (int n = 0; n < 2; ++n) acc[a][b][m][n] = (f32x4){0.f, 0.f, 0.f, 0.f};
    bf16x8 At[4][2], B0[2][2], B1[2][2];
    const char* cA = (const char*)g.A + (size_t)cur.pm * tstep; const char* cB = (const char*)g.Bt + (size_t)cur.pn * tstep;
    S.a_ready(cur);
    if constexpr (SP2) {
        PG8_STAGE(PG8_SB(0, 0), cB, voffB); PG8_STAGE(PG8_SB(0, 1), cB + hstep, voffB); PG8_STAGE(PG8_SA(0, 0), cA, voffA); PG8_STAGE(PG8_SA(0, 1), cA + hstep, voffA);
        if (wr == 1) PG8_BAR;
        PG8_WAIT_V(2); PG8_BAR;
        PG8_STAGE(PG8_SB(1, 0), cB + kstep, voffB); PG8_STAGE(PG8_SA(1, 0), cA + kstep, voffA); PG8_STAGE(PG8_SB(1, 1), cB + hstep + kstep, voffB);
        PG8_WAIT_V(6); PG8_BAR;
    } else {
        PG8_STAGE(PG8_SB(0, 0), cB, voffB); PG8_STAGE(PG8_SA(0, 0), cA, voffA); PG8_STAGE(PG8_SB(0, 1), cB + hstep, voffB); PG8_STAGE(PG8_SA(0, 1), cA + hstep, voffA);
        if (wr == 1) PG8_BAR;
        PG8_WAIT_V(4); PG8_BAR;
        PG8_STAGE(PG8_SB(1, 0), cB + kstep, voffB); PG8_STAGE(PG8_SA(1, 0), cA + kstep, voffA); PG8_STAGE(PG8_SB(1, 1), cB + hstep + kstep, voffB);
        PG8_WAIT_V(6); PG8_BAR;
    }
    for (;;) {
        const bool has_next = S.next(ui + 1, nxt);
        const char* nA = has_next ? (const char*)g.A + (size_t)nxt.pm * tstep : cA; const char* nB = has_next ? (const char*)g.Bt + (size_t)nxt.pn * tstep : cB;
        for (int t = 0; t < nt; t += 2) {
            const bool last = (t == nt - 2);
            const char* a1 = cA + (size_t)(t + 1) * kstep;
            const char* a2 = last ? nA : cA + (size_t)(t + 2) * kstep; const char* b2 = last ? nB : cB + (size_t)(t + 2) * kstep;
            const char* a3 = a2 + kstep; const char* b3 = b2 + kstep;
            if (last && has_next) S.a_ready(nxt);
            if constexpr (SP2) {
            PG8_LDB(B0, 0, 0); PG8_LDB(B1, 0, 1); PG8_SCHED; PG8_LDA(At, 0, 0); PG8_STAGE(PG8_SA(1, 1), a1 + hstep, voffA);
            PG8_WAIT_V(8); PG8_WAIT_L(0); PG8_BAR; PG8_MMA(0, 0, At, B0); PG8_MMA(0, 1, At, B1); PG8_BAR; PG8_SCHED;
            PG8_LDA(At, 0, 1); PG8_STAGE(PG8_SB(0, 0), b2, voffB); PG8_STAGE(PG8_SB(0, 1), b2 + hstep, voffB); PG8_STAGE(PG8_SA(0, 0), a2, voffA);
            PG8_WAIT_V(8); PG8_WAIT_L(0); PG8_BAR; PG8_MMA(1, 0, At, B0); PG8_MMA(1, 1, At, B1); PG8_BAR; PG8_SCHED;
            PG8_LDB(B0, 1, 0); PG8_LDB(B1, 1, 1); PG8_SCHED; PG8_LDA(At, 1, 0); PG8_STAGE(PG8_SA(0, 1), a2 + hstep, voffA);
            PG8_WAIT_V(8); PG8_WAIT_L(0); PG8_BAR; PG8_MMA(0, 0, At, B0); PG8_MMA(0, 1, At, B1); PG8_BAR; PG8_SCHED;
            PG8_LDA(At, 1, 1); PG8_STAGE(PG8_SB(1, 0), b3, voffB); PG8_STAGE(PG8_SB(1, 1), b3 + hstep, voffB); PG8_STAGE(PG8_SA(1, 0), a3, voffA);
            PG8_WAIT_V(8); PG8_WAIT_L(0); PG8_BAR; PG8_MMA(1, 0, At, B0); PG8_MMA(1, 1, At, B1); PG8_BAR; PG8_SCHED;
            } else {
            PG8_LDB(B0, 0, 0); PG8_SCHED; PG8_LDA(At, 0, 0); PG8_STAGE(PG8_SA(1, 1), a1 + hstep, voffA);
            PG8_WAIT_L(8); PG8_BAR; PG8_WAIT_L(0); PG8_MMA(0, 0, At, B0); PG8_BAR; PG8_SCHED;
            PG8_LDB(B1, 0, 1); PG8_STAGE(PG8_SB(0, 0), b2, voffB);
            PG8_BAR; PG8_WAIT_L(0); PG8_MMA(0, 1, At, B1); PG8_BAR;
            PG8_LDA(At, 0, 1); PG8_STAGE(PG8_SA(0, 0), a2, voffA);
            PG8_BAR; PG8_WAIT_L(0); PG8_MMA(1, 0, At, B0); PG8_BAR; PG8_SCHED;
            PG8_STAGE(PG8_SB(0, 1), b2 + hstep, voffB);
            PG8_WAIT_V(6); PG8_BAR; PG8_MMA(1, 1, At, B1); PG8_BAR;
            PG8_LDB(B0, 1, 0); PG8_SCHED; PG8_LDA(At, 1, 0); PG8_STAGE(PG8_SA(0, 1), a2 + hstep, voffA);
            PG8_WAIT_L(8); PG8_BAR; PG8_WAIT_L(0); PG8_MMA(0, 0, At, B0); PG8_BAR; PG8_SCHED;
            PG8_LDB(B1, 1, 1); PG8_STAGE(PG8_SB(1, 0), b3, voffB);
            PG8_BAR; PG8_WAIT_L(0); PG8_MMA(0, 1, At, B1); PG8_BAR;
            PG8_LDA(At, 1, 1); PG8_STAGE(PG8_SA(1, 0), a3, voffA);
            PG8_BAR; PG8_WAIT_L(0); PG8_MMA(1, 0, At, B0); PG8_BAR; PG8_SCHED;
            PG8_STAGE(PG8_SB(1, 1), b3 + hstep, voffB);
            PG8_WAIT_V(6); PG8_BAR; PG8_MMA(1, 1, At, B1); PG8_BAR;
            }
        }
        if constexpr (ALIGN_EPI) { if (wr == 0) PG8_BAR; }
        if constexpr (!Epi::AFTER_DRAIN) { E(acc, cur, wr, wc, fr, fq); S.done(cur); }
        if (!has_next) break;
#pragma unroll
        for (int a = 0; a < 2; ++a)
#pragma unroll
            for (int b = 0; b < 2; ++b)
#pragma unroll
                for (int m = 0; m < 4; ++m)
#pragma unroll
                    for (int n = 0; n < 2; ++n) acc[a][b][m][n] = (f32x4){0.f, 0.f, 0.f, 0.f};
        cur = nxt; cA = nA; cB = nB; ++ui;
        if constexpr (ALIGN_EPI) { if (wr == 1) PG8_BAR; }
    }
    PG8_WAIT_V(0);
    if constexpr (!ALIGN_EPI) { if (wr == 0) PG8_BAR; }
    PG8_BAR;
    if constexpr (Epi::AFTER_DRAIN) { E.fused(acc, cur, wr, wc, fr, fq, lds, wid, lane); S.done(cur); }
#undef PG8_SA
#undef PG8_SB
#undef PG8_STAGE
#undef PG8_LDA
#undef PG8_LDB
#undef PG8_MMA
#undef PG8_WAIT_V
#undef PG8_WAIT_L
#undef PG8_BAR
#undef PG8_SCHED
}
}

namespace mk {
typedef unsigned short bf16_t;
typedef float f32x4 __attribute__((ext_vector_type(4)));
typedef unsigned u32x4 __attribute__((ext_vector_type(4)));
typedef unsigned u32x2 __attribute__((ext_vector_type(2)));
#define LAS __attribute__((address_space(3)))

constexpr int BATCH = 16, SEQ = 2048, DM = 1024, M = BATCH * SEQ;
constexpr int NA = 1792, NB = 2560, N1 = NA + NB;
constexpr int N3 = 3072;
constexpr int EVEN_IN = 4224, SHIFT_W = 1664;
constexpr float RMS_EPS = 1e-6f, LN_EPS = 1e-5f, GN_EPS = 64e-5f;
constexpr int NTHR = 512;

constexpr size_t MiB = 1u << 20;
constexpr size_t WS_CTR = 768 * 1024;
constexpr size_t WS_RS0 = 0, WS_RS1 = 128 * 1024, WS_RS2 = 256 * 1024, WS_VSUM = 384 * 1024, WS_VSQ = 512 * 1024, WS_BON = 1 * MiB;
constexpr size_t WS_W1T = 4 * MiB, WS_W2T = 13 * MiB, WS_W3T = 15 * MiB, WS_W4T = 21 * MiB;
constexpr size_t WS_XN = 24 * MiB;
constexpr size_t WS_PA = 88 * MiB;
constexpr size_t WS_PB = 200 * MiB;
constexpr size_t WS_YMIX = 360 * MiB;
constexpr size_t WS_END = 424 * MiB;
constexpr size_t WS_P1 = WS_PA;
constexpr int LDS_BYTES = 147456;

struct Args {
    const float* in[22];
    float* out; unsigned char* ws;
    int lo, hi;
};
enum { I_X = 0, I_NORMG, I_WINE, I_SHMU, I_W0, I_W2, I_A0, I_A2, I_KK, I_KA, I_RK, I_LNXG, I_LNXB, I_ABIAS, I_WOUTE, I_WINO, I_SGLNG, I_SGLNB, I_SGW, I_SGB, I_WOUTO, I_FG };

__device__ __forceinline__ unsigned short f2bf(float f) { unsigned u = __float_as_uint(f); return (unsigned short)((u + 0x7fffu + ((u >> 16) & 1u)) >> 16); }
__device__ __forceinline__ float bf2f(unsigned short h) { return __uint_as_float((unsigned)h << 16); }
__device__ __forceinline__ unsigned pk2(float lo, float hi) { return (unsigned)f2bf(lo) | ((unsigned)f2bf(hi) << 16); }
__device__ __forceinline__ float bflo(unsigned w) { return __uint_as_float(w << 16); }
__device__ __forceinline__ float bfhi(unsigned w) { return __uint_as_float(w & 0xffff0000u); }
__device__ __forceinline__ float wave_sum(float v) {
#pragma unroll
    for (int o = 1; o < 64; o <<= 1) v += __shfl_xor(v, o);
    return v;
}
__device__ __forceinline__ float sigmoidf_(float x) { return 1.0f / (1.0f + __expf(-x)); }
__device__ __forceinline__ float siluf_(float x) { return x * sigmoidf_(x); }
__device__ __forceinline__ float gelu_tanh(float x) { const float y = 0.7978845608028654f * (x + 0.044715f * x * x * x); return x * sigmoidf_(2.0f * y); }

__device__ __forceinline__ void phase_prologue(const Args& a) {
    const int tid = threadIdx.x, lane = tid & 63, wave = tid >> 6;
    unsigned char* ws = a.ws;
    const int gtid = blockIdx.x * NTHR + tid, nthr = gridDim.x * NTHR;
    constexpr int NTOT = N1 + 1024 + N3 + 1024;
    for (int it = gtid; it < NTOT * 128; it += nthr) {
        int n = it % NTOT; const int k8 = it / NTOT;
        const float* src; const float* g; int N, col; bf16_t* dst; bool zero = false;
        if (n < N1) { src = a.in[I_WINE]; g = a.in[I_NORMG]; N = EVEN_IN; dst = (bf16_t*)(ws + WS_W1T) + (size_t)n * 1024;
            if (n < SHIFT_W) col = n; else if (n < NA) { col = 0; zero = true; } else col = n - (NA - SHIFT_W); }
        else if ((n -= N1) < 1024) { src = a.in[I_WOUTE]; g = nullptr; N = 1024; col = n; dst = (bf16_t*)(ws + WS_W2T) + (size_t)n * 1024; }
        else if ((n -= 1024) < N3) { src = a.in[I_WINO]; g = a.in[I_NORMG] + 1024; N = N3; col = n; dst = (bf16_t*)(ws + WS_W3T) + (size_t)n * 1024; }
        else { n -= N3; src = a.in[I_WOUTO]; g = nullptr; N = 1024; col = n; dst = (bf16_t*)(ws + WS_W4T) + (size_t)n * 1024; }
        float v[8];
#pragma unroll
        for (int j = 0; j < 8; ++j) { const int k = k8 * 8 + j; float x = zero ? 0.f : src[(size_t)k * N + col]; if (g) x *= g[k]; v[j] = x; }
        u32x4 o; o.x = pk2(v[0], v[1]); o.y = pk2(v[2], v[3]); o.z = pk2(v[4], v[5]); o.w = pk2(v[6], v[7]);
        *(u32x4*)(dst + k8 * 8) = o;
    }
    const float* x = a.in[I_X]; bf16_t* XN = (bf16_t*)(ws + WS_XN); float* rs0 = (float*)(ws + WS_RS0);
    const int gw = blockIdx.x * 8 + wave, NGW = gridDim.x * 8;
    for (int m = gw; m < M; m += NGW) {
        const f32x4* xr = (const f32x4*)(x + (size_t)m * DM) + lane; float s = 0.f; f32x4 v[4];
#pragma unroll
        for (int j = 0; j < 4; ++j) { v[j] = xr[64 * j]; s += (v[j].x * v[j].x + v[j].y * v[j].y) + (v[j].z * v[j].z + v[j].w * v[j].w); }
        s = wave_sum(s);
        u32x2* o = (u32x2*)(XN + (size_t)m * DM) + lane;
#pragma unroll
        for (int j = 0; j < 4; ++j) { u32x2 w; w.x = pk2(v[j].x, v[j].y); w.y = pk2(v[j].z, v[j].w); o[64 * j] = w; }
        if (lane == 0) rs0[m] = s;
    }
    float* rs1 = (float*)(ws + WS_RS1); float* rs2 = (float*)(ws + WS_RS2); float* vsum = (float*)(ws + WS_VSUM); float* vsq = (float*)(ws + WS_VSQ);
    for (int i = gtid; i < M; i += nthr) { rs1[i] = 0.f; rs2[i] = 0.f; vsum[i] = 0.f; vsq[i] = 0.f; }
    if (gtid == 0) *(unsigned*)(ws + WS_CTR) = 0u;
}

struct EpiG1 {
    const float* rs0; bf16_t* PA; bf16_t* PB;
    __device__ __forceinline__ void operator()(int row, int col, f32x4 v0, f32x4 v1) const {
        const float rinv = rsqrtf(rs0[row] * (1.0f / DM) + RMS_EPS);
        v0 = v0 * rinv; v1 = v1 * rinv;
        u32x4 w; w.x = pk2(v0[0], v0[1]); w.y = pk2(v0[2], v0[3]); w.z = pk2(v1[0], v1[1]); w.w = pk2(v1[2], v1[3]);
        bf16_t* dst = col < NA ? PA + (size_t)row * NA + col : PB + (size_t)row * NB + (col - NA);
        *(u32x4*)dst = w;
    }
};
struct EpiG2 {
    const float* x; float* out; bf16_t* HB; float* rs1;
    __device__ __forceinline__ void operator()(int row, int col, f32x4 v0, f32x4 v1) const {
        const size_t off = (size_t)row * DM + col;
        v0 = v0 + *(const f32x4*)(x + off); v1 = v1 + *(const f32x4*)(x + off + 4);
        *(f32x4*)(out + off) = v0; *(f32x4*)(out + off + 4) = v1;
        u32x4 w; w.x = pk2(v0[0], v0[1]); w.y = pk2(v0[2], v0[3]); w.z = pk2(v1[0], v1[1]); w.w = pk2(v1[2], v1[3]);
        *(u32x4*)(HB + off) = w;
        const float s = (v0[0] * v0[0] + v0[1] * v0[1]) + (v0[2] * v0[2] + v0[3] * v0[3]) + (v1[0] * v1[0] + v1[1] * v1[1]) + (v1[2] * v1[2] + v1[3] * v1[3]);
        unsafeAtomicAdd(rs1 + row, s);
    }
};
struct EpiG3 {
    const float* rs1; bf16_t* P1; float* vsum; float* vsq;
    __device__ __forceinline__ void operator()(int row, int col, f32x4 v0, f32x4 v1) const {
        const float rinv = rsqrtf(rs1[row] * (1.0f / DM) + RMS_EPS);
        float v[8];
#pragma unroll
        for (int j = 0; j < 4; ++j) { v[j] = v0[j] * rinv; v[4 + j] = v1[j] * rinv; }
        if (col < 2048) {
#pragma unroll
            for (int j = 0; j < 8; ++j) v[j] = gelu_tanh(v[j]);
            if (col >= 1024) {
                float s = 0.f, q = 0.f;
#pragma unroll
                for (int j = 0; j < 8; ++j) { s += v[j]; q += v[j] * v[j]; }
                unsafeAtomicAdd(vsum + row, s); unsafeAtomicAdd(vsq + row, q);
            }
        } else {
#pragma unroll
            for (int j = 0; j < 8; ++j) v[j] = siluf_(v[j]);
        }
        u32x4 w; w.x = pk2(v[0], v[1]); w.y = pk2(v[2], v[3]); w.z = pk2(v[4], v[5]); w.w = pk2(v[6], v[7]);
        *(u32x4*)(P1 + (size_t)row * N3 + col) = w;
    }
};
struct EpiG4 {
    float* out; float* rs2;
    __device__ __forceinline__ void operator()(int row, int col, f32x4 v0, f32x4 v1) const {
        const size_t off = (size_t)row * DM + col;
        v0 = v0 + *(const f32x4*)(out + off); v1 = v1 + *(const f32x4*)(out + off + 4);
        *(f32x4*)(out + off) = v0; *(f32x4*)(out + off + 4) = v1;
        const float s = (v0[0] * v0[0] + v0[1] * v0[1]) + (v0[2] * v0[2] + v0[3] * v0[3]) + (v1[0] * v1[0] + v1[1] * v1[1]) + (v1[2] * v1[2] + v1[3] * v1[3]);
        unsafeAtomicAdd(rs2 + row, s);
    }
};

template <class F> struct EpiAdapt {
    static constexpr bool PERM = true, AFTER_DRAIN = false;
    F f;
    __device__ __forceinline__ void operator()(const pg8::f32x4 (&acc)[2][2][4][2], const pg8::Unit& u, int wr, int wc, int fr, int fq) const {
#pragma unroll
        for (int ai = 0; ai < 2; ++ai)
#pragma unroll
            for (int m = 0; m < 4; ++m) {
                const int row = u.pm * 256 + ai * 128 + wr * 64 + m * 16 + fr;
#pragma unroll
                for (int bj = 0; bj < 2; ++bj) { const int col = u.pn * 256 + bj * 128 + wc * 32 + 8 * fq; f(row, col, acc[ai][bj][m][0], acc[ai][bj][m][1]); }
            }
    }
};

template <class F> __device__ __forceinline__ void gemm_naive(float* lds, const bf16_t* A, const bf16_t* Bt, int Mm, int N, int K, const F& f) {
    const int tid = threadIdx.x, ty = tid >> 4, tx = tid & 15;
    float* As = lds; float* Bs = lds + 32 * 132;
    const int ntn = N / 128, ntiles = (Mm / 128) * ntn;
    for (int tile = blockIdx.x; tile < ntiles; tile += gridDim.x) {
        const int tm = tile / ntn, tn = tile % ntn;
        float acc[4][8];
#pragma unroll
        for (int i = 0; i < 4; ++i)
#pragma unroll
            for (int j = 0; j < 8; ++j) acc[i][j] = 0.f;
        for (int k0 = 0; k0 < K; k0 += 32) {
            { const int row = tid >> 2, kc = (tid & 3) * 8;
              const u32x4 va = *(const u32x4*)(A + (size_t)(tm * 128 + row) * K + k0 + kc);
              const u32x4 vb = *(const u32x4*)(Bt + (size_t)(tn * 128 + row) * K + k0 + kc);
              As[(kc + 0) * 132 + row] = bflo(va.x); As[(kc + 1) * 132 + row] = bfhi(va.x); As[(kc + 2) * 132 + row] = bflo(va.y); As[(kc + 3) * 132 + row] = bfhi(va.y);
              As[(kc + 4) * 132 + row] = bflo(va.z); As[(kc + 5) * 132 + row] = bfhi(va.z); As[(kc + 6) * 132 + row] = bflo(va.w); As[(kc + 7) * 132 + row] = bfhi(va.w);
              Bs[(kc + 0) * 132 + row] = bflo(vb.x); Bs[(kc + 1) * 132 + row] = bfhi(vb.x); Bs[(kc + 2) * 132 + row] = bflo(vb.y); Bs[(kc + 3) * 132 + row] = bfhi(vb.y);
              Bs[(kc + 4) * 132 + row] = bflo(vb.z); Bs[(kc + 5) * 132 + row] = bfhi(vb.z); Bs[(kc + 6) * 132 + row] = bflo(vb.w); Bs[(kc + 7) * 132 + row] = bfhi(vb.w); }
            __syncthreads();
#pragma unroll 8
            for (int kk = 0; kk < 32; ++kk) {
                const f32x4 a4 = *(const f32x4*)(As + kk * 132 + ty * 4);
                const f32x4 b0 = *(const f32x4*)(Bs + kk * 132 + tx * 8), b1 = *(const f32x4*)(Bs + kk * 132 + tx * 8 + 4);
#pragma unroll
                for (int i = 0; i < 4; ++i) {
#pragma unroll
                    for (int j = 0; j < 4; ++j) { acc[i][j] += a4[i] * b0[j]; acc[i][4 + j] += a4[i] * b1[j]; }
                }
            }
            __syncthreads();
        }
#pragma unroll
        for (int i = 0; i < 4; ++i) f(tm * 128 + ty * 4 + i, tn * 128 + tx * 8, (f32x4){acc[i][0], acc[i][1], acc[i][2], acc[i][3]}, (f32x4){acc[i][4], acc[i][5], acc[i][6], acc[i][7]});
    }
}

template <class F> __device__ __forceinline__ void gemm_any(unsigned char* lds, const bf16_t* A, const bf16_t* Bt, int Mm, int N, int K, const F& f) {
#if USE_PG8
    pg8::Gemm g{A, Bt, Mm, N, K}; pg8::StaticOrder S; S.init(Mm, N, (int)gridDim.x, (int)blockIdx.x);
    EpiAdapt<F> E{f};
    pg8::gemm_phase<EpiAdapt<F>, pg8::StaticOrder, true, true>((PG8_LAS unsigned char*)lds, g, S, E);
#else
    gemm_naive((float*)lds, A, Bt, Mm, N, K, f);
#endif
}

__device__ __forceinline__ void phase_prep(const Args& a, unsigned char* ldsb) {
    const int tid = threadIdx.x, lane = tid & 63, wave = tid >> 6;
    unsigned char* ws = a.ws;
    const bf16_t* PA = (const bf16_t*)(ws + WS_PA);
    bf16_t* R = (bf16_t*)a.out; bf16_t* KP = R + (size_t)M * 512; bf16_t* V = KP + (size_t)M * 512; bf16_t* AN = V + (size_t)M * 512;
    bf16_t* YM = (bf16_t*)(ws + WS_YMIX); float* DEC = (float*)(ws + WS_XN); float* BON = (float*)(ws + WS_BON);
    const float* mu = a.in[I_SHMU];
    float* sw = (float*)ldsb; float* sad = sw + 512;
    const int c = tid;
    const float w0 = a.in[I_W0][c], a0 = a.in[I_A0][c], kkc = a.in[I_KK][c], kac = a.in[I_KA][c], rkc = a.in[I_RK][c];
    const float mur = mu[c], muk = mu[512 + c], muv = mu[1024 + c];
    const float* w2 = a.in[I_W2]; const float* a2 = a.in[I_A2];
    for (int u = blockIdx.x; u < M / 8; u += gridDim.x) {
        const int t0 = u * 8;
        { const int tok = tid >> 6, j = tid & 63; const int t = t0 + tok; const bool first = (t % SEQ) == 0;
          const float pw = bf2f(PA[(size_t)t * NA + 1536 + j]), pa = bf2f(PA[(size_t)t * NA + 1600 + j]);
          const float qw = first ? 0.f : bf2f(PA[(size_t)(t - 1) * NA + 1536 + j]), qa = first ? 0.f : bf2f(PA[(size_t)(t - 1) * NA + 1600 + j]);
          sw[tid] = tanhf(pw + (qw - pw) * mu[1536 + j]); sad[tid] = pa + (qa - pa) * mu[1600 + j]; }
        __syncthreads();
        float accw[8], acca[8];
#pragma unroll
        for (int i = 0; i < 8; ++i) { accw[i] = w0; acca[i] = a0; }
        for (int j = 0; j < 64; ++j) {
            const float w2v = w2[j * 512 + c], a2v = a2[j * 512 + c];
#pragma unroll
            for (int i = 0; i < 8; ++i) { accw[i] += sw[i * 64 + j] * w2v; acca[i] += sad[i * 64 + j] * a2v; }
        }
#pragma unroll
        for (int i = 0; i < 8; ++i) {
            const int t = t0 + i; const bool first = (t % SEQ) == 0;
            const bf16_t* p = PA + (size_t)t * NA; const bf16_t* q = p - NA;
            float r = bf2f(p[c]), k = bf2f(p[512 + c]), v = bf2f(p[1024 + c]);
            const float rp = first ? 0.f : bf2f(q[c]), kp_ = first ? 0.f : bf2f(q[512 + c]), vp = first ? 0.f : bf2f(q[1024 + c]);
            r += (rp - r) * mur; k += (kp_ - k) * muk; v += (vp - v) * muv;
            const float z = accw[i];
            const float sp = fmaxf(-z, 0.f) + log1pf(__expf(-fabsf(z)));
            const float w = -sp - 0.5f;
            const float dec = __expf(-__expf(w));
            const float av = sigmoidf_(acca[i]);
            float kk = k * kkc; const float ss = wave_sum(kk * kk); kk = kk / fmaxf(sqrtf(ss), 1e-12f);
            const float kn = k * (1.0f + (av - 1.0f) * kac);
            const float bon = wave_sum(r * kn * rkc);
            const size_t o = (size_t)t * 512 + c;
            R[o] = f2bf(r); KP[o] = f2bf(kn); V[o] = f2bf(v); AN[o] = f2bf(-kk); YM[(size_t)t * 1024 + c] = f2bf(kk * av); DEC[o] = dec;
            if (lane == 0) BON[t * 8 + wave] = bon;
        }
        __syncthreads();
    }
}

__device__ __forceinline__ float rdlane(float x, int k) { return __uint_as_float(__builtin_amdgcn_readlane(__float_as_uint(x), k)); }
__device__ __forceinline__ void phase_scan_naive(const Args& a) {
    const int tid = threadIdx.x, lane = tid & 63, wave = tid >> 6;
    if (wave != 0) return;
    unsigned char* ws = a.ws;
    const bf16_t* R = (const bf16_t*)a.out; const bf16_t* KP = R + (size_t)M * 512; const bf16_t* V = KP + (size_t)M * 512; const bf16_t* AN = V + (size_t)M * 512;
    bf16_t* YM = (bf16_t*)(ws + WS_YMIX); const float* DEC = (const float*)(ws + WS_XN); const float* BON = (const float*)(ws + WS_BON);
    const bf16_t* PB = (const bf16_t*)(ws + WS_PB);
    for (int u = blockIdx.x; u < BATCH * 8; u += gridDim.x) {
        const int b = u >> 3, h = u & 7;
        const float lg = a.in[I_LNXG][h * 64 + lane], lb = a.in[I_LNXB][h * 64 + lane];
        float s[64];
#pragma unroll
        for (int k = 0; k < 64; ++k) s[k] = 0.f;
        for (int t = 0; t < SEQ; ++t) {
            const int tok = b * SEQ + t; const size_t o = (size_t)tok * 512 + h * 64 + lane;
            const float ca = bf2f(AN[o]), cw = DEC[o], cb = bf2f(YM[(size_t)tok * 1024 + h * 64 + lane]), ck = bf2f(KP[o]), cr = bf2f(R[o]), vv = bf2f(V[o]);
            float sa = 0.f;
#pragma unroll
            for (int k = 0; k < 64; ++k) sa += s[k] * rdlane(ca, k);
            float y = 0.f;
#pragma unroll
            for (int k = 0; k < 64; ++k) { s[k] = s[k] * rdlane(cw, k) + sa * rdlane(cb, k) + vv * rdlane(ck, k); y += s[k] * rdlane(cr, k); }
            const float mean = wave_sum(y) * (1.0f / 64.0f); const float d = y - mean; const float var = wave_sum(d * d) * (1.0f / 64.0f);
            float yn = d * rsqrtf(var + GN_EPS) * lg + lb;
            yn += BON[tok * 8 + h] * vv;
            const float g = bf2f(PB[(size_t)tok * NB + h * 64 + lane]);
            YM[(size_t)tok * 1024 + h * 64 + lane] = f2bf(yn * siluf_(g));
        }
    }
}

__device__ __forceinline__ void phase_attn_naive(const Args& a) {
    const int tid = threadIdx.x, lane = tid & 63, wave = tid >> 6;
    unsigned char* ws = a.ws;
    const bf16_t* PB = (const bf16_t*)(ws + WS_PB); bf16_t* YM = (bf16_t*)(ws + WS_YMIX);
    for (int u = blockIdx.x * 8 + wave; u < BATCH * 8 * 32; u += gridDim.x * 8) {
        const int c = u & 31, h = (u >> 5) & 7, b = u >> 8;
        const int t = b * SEQ + c * 64 + lane;
        float q[64], acc[64];
        { const u32x4* qp = (const u32x4*)(PB + (size_t)t * NB + 512 + h * 64);
#pragma unroll
          for (int i = 0; i < 8; ++i) { const u32x4 w = qp[i]; q[8 * i] = bflo(w.x) * 0.125f; q[8 * i + 1] = bfhi(w.x) * 0.125f; q[8 * i + 2] = bflo(w.y) * 0.125f; q[8 * i + 3] = bfhi(w.y) * 0.125f;
              q[8 * i + 4] = bflo(w.z) * 0.125f; q[8 * i + 5] = bfhi(w.z) * 0.125f; q[8 * i + 6] = bflo(w.w) * 0.125f; q[8 * i + 7] = bfhi(w.w) * 0.125f; } }
#pragma unroll
        for (int d = 0; d < 64; ++d) acc[d] = 0.f;
        float m = -1e30f, l = 0.f;
        const float* bt = a.in[I_ABIAS] + h * 257;
        const int k0 = (c - 8 > 0 ? c - 8 : 0) * 64, k1 = (c + 1) * 64;
        for (int kj = k0; kj < k1; ++kj) {
            const bf16_t* kr = PB + (size_t)(b * SEQ + kj) * NB + 1024 + h * 64;
            float s = 0.f;
#pragma unroll
            for (int i = 0; i < 8; ++i) { const u32x4 w = ((const u32x4*)kr)[i];
                s += q[8 * i] * bflo(w.x) + q[8 * i + 1] * bfhi(w.x) + q[8 * i + 2] * bflo(w.y) + q[8 * i + 3] * bfhi(w.y) + q[8 * i + 4] * bflo(w.z) + q[8 * i + 5] * bfhi(w.z) + q[8 * i + 6] * bflo(w.w) + q[8 * i + 7] * bfhi(w.w); }
            int rel = c * 64 + lane - kj; rel = rel < -128 ? -128 : (rel > 128 ? 128 : rel);
            s += bt[rel + 128];
            const float mn = fmaxf(m, s), al = __expf(m - mn), p = __expf(s - mn);
            l = l * al + p; m = mn;
            const bf16_t* vr = kr + 512;
#pragma unroll
            for (int i = 0; i < 8; ++i) { const u32x4 w = ((const u32x4*)vr)[i];
                acc[8 * i] = acc[8 * i] * al + p * bflo(w.x); acc[8 * i + 1] = acc[8 * i + 1] * al + p * bfhi(w.x); acc[8 * i + 2] = acc[8 * i + 2] * al + p * bflo(w.y); acc[8 * i + 3] = acc[8 * i + 3] * al + p * bfhi(w.y);
                acc[8 * i + 4] = acc[8 * i + 4] * al + p * bflo(w.z); acc[8 * i + 5] = acc[8 * i + 5] * al + p * bfhi(w.z); acc[8 * i + 6] = acc[8 * i + 6] * al + p * bflo(w.w); acc[8 * i + 7] = acc[8 * i + 7] * al + p * bfhi(w.w); }
        }
        const float il = 1.0f / l;
        const u32x4* gp = (const u32x4*)(PB + (size_t)t * NB + 2048 + h * 64);
        u32x4* op = (u32x4*)(YM + (size_t)t * 1024 + 512 + h * 64);
#pragma unroll
        for (int i = 0; i < 8; ++i) { const u32x4 g = gp[i]; u32x4 o;
            o.x = pk2(acc[8 * i] * il * siluf_(bflo(g.x)), acc[8 * i + 1] * il * siluf_(bfhi(g.x))); o.y = pk2(acc[8 * i + 2] * il * siluf_(bflo(g.y)), acc[8 * i + 3] * il * siluf_(bfhi(g.y)));
            o.z = pk2(acc[8 * i + 4] * il * siluf_(bflo(g.z)), acc[8 * i + 5] * il * siluf_(bfhi(g.z))); o.w = pk2(acc[8 * i + 6] * il * siluf_(bflo(g.w)), acc[8 * i + 7] * il * siluf_(bfhi(g.w)));
            op[i] = o; }
    }
}


typedef _Float16 h8 __attribute__((ext_vector_type(8)));
typedef _Float16 h4 __attribute__((ext_vector_type(4)));
typedef float f32x2 __attribute__((ext_vector_type(2)));
typedef short bf16x8 __attribute__((ext_vector_type(8)));
template <int CTRL> __device__ __forceinline__ float dpp_add(float x) { return x + __uint_as_float(__builtin_amdgcn_update_dpp(0, __float_as_uint(x), CTRL, 0xf, 0xf, true)); }
__device__ __forceinline__ float red8(float x) { x = dpp_add<0xB1>(x); x = dpp_add<0x4E>(x); x = dpp_add<0x141>(x); return x; }
__device__ __forceinline__ float red16(float x) { x = dpp_add<0x128>(x); x = dpp_add<0x124>(x); x = dpp_add<0x122>(x); x = dpp_add<0x121>(x); return x; }
constexpr int SC_PH = 0, SC_VV = 40960, SC_SC = 57344, SC_YY = 57856;
constexpr int TC = 32;

__device__ __forceinline__ void scan_unit(const Args& a, LAS unsigned char* lds, int u) {
    const int tid = threadIdx.x, lane = tid & 63, wave = tid >> 6;
    const int b = u >> 3, h = u & 7;
    unsigned char* ws = a.ws;
    const bf16_t* R = (const bf16_t*)a.out; const bf16_t* KP = R + (size_t)M * 512; const bf16_t* V = KP + (size_t)M * 512; const bf16_t* AN = V + (size_t)M * 512;
    bf16_t* YM = (bf16_t*)(ws + WS_YMIX); const float* DEC = (const float*)(ws + WS_XN); const float* BON = (const float*)(ws + WS_BON);
    const bf16_t* PB = (const bf16_t*)(ws + WS_PB);
    const int st = tid >> 4, sq = tid & 15;
    const int row = wave * 8 + (lane >> 3), cg = lane & 7;
    const int colbase = h * 64 + 4 * sq;
    const f32x4 lg = *(const f32x4*)(a.in[I_LNXG] + colbase), lb = *(const f32x4*)(a.in[I_LNXB] + colbase);
    float s[8];
#pragma unroll
    for (int j = 0; j < 8; ++j) s[j] = 0.f;
    u32x2 gR, gK, gV, gA, gB; f32x4 gD;
#define SC_GLOAD(c) do { const size_t tok_ = (size_t)b * SEQ + (c) * TC + st; const size_t o_ = tok_ * 512 + colbase; \
        gR = *(const u32x2*)(R + o_); gK = *(const u32x2*)(KP + o_); gV = *(const u32x2*)(V + o_); gA = *(const u32x2*)(AN + o_); \
        gB = *(const u32x2*)(YM + tok_ * 1024 + colbase); gD = *(const f32x4*)(DEC + o_); } while (0)
#define SC_STAGE(buf) do { \
        const float r0 = bflo(gR.x), r1 = bfhi(gR.x), r2 = bflo(gR.y), r3 = bfhi(gR.y); \
        const float k0 = bflo(gK.x), k1 = bfhi(gK.x), k2 = bflo(gK.y), k3 = bfhi(gK.y); \
        const float b0 = bflo(gB.x), b1 = bfhi(gB.x), b2 = bflo(gB.y), b3 = bfhi(gB.y); \
        LAS h4* ph4 = (LAS h4*)(lds + SC_PH) + (size_t)(((buf) * TC + st) * 5) * 16 + sq; \
        ph4[0]  = (h4){(_Float16)bflo(gA.x), (_Float16)bfhi(gA.x), (_Float16)bflo(gA.y), (_Float16)bfhi(gA.y)}; \
        ph4[16] = (h4){(_Float16)(1.0f - gD.x), (_Float16)(1.0f - gD.y), (_Float16)(1.0f - gD.z), (_Float16)(1.0f - gD.w)}; \
        ph4[32] = (h4){(_Float16)b0, (_Float16)b1, (_Float16)b2, (_Float16)b3}; \
        ph4[48] = (h4){(_Float16)k0, (_Float16)k1, (_Float16)k2, (_Float16)k3}; \
        ph4[64] = (h4){(_Float16)(gD.x * r0), (_Float16)(gD.y * r1), (_Float16)(gD.z * r2), (_Float16)(gD.w * r3)}; \
        *((LAS f32x4*)(lds + SC_VV) + ((buf) * TC + st) * 16 + sq) = (f32x4){bflo(gV.x), bfhi(gV.x), bflo(gV.y), bfhi(gV.y)}; \
        float br_ = (b0 * r0 + b1 * r1) + (b2 * r2 + b3 * r3), kr_ = (k0 * r0 + k1 * r1) + (k2 * r2 + k3 * r3); \
        br_ = red16(br_); kr_ = red16(kr_); \
        if (sq == 0) *((LAS f32x2*)(lds + SC_SC) + (buf) * TC + st) = (f32x2){br_, kr_}; } while (0)
    SC_GLOAD(0); SC_STAGE(0);
    __syncthreads();
    for (int c = 0; c < SEQ / TC; ++c) {
        const int buf = c & 1;
        if (c + 1 < SEQ / TC) SC_GLOAD(c + 1);
        const size_t tokE = (size_t)b * SEQ + c * TC + st;
        const u32x2 gG = *(const u32x2*)(PB + tokE * NB + colbase);
        const float bon = BON[tokE * 8 + h];
        {
            const LAS h8* ph8 = (const LAS h8*)(lds + SC_PH) + buf * TC * 40 + cg;
            const LAS float* vvp = (const LAS float*)(lds + SC_VV) + buf * TC * 64 + row;
            const LAS f32x2* scp = (const LAS f32x2*)(lds + SC_SC) + buf * TC;
            LAS float* yyp = (LAS float*)(lds + SC_YY) + row;
            h8 cA = ph8[0], cE = ph8[8], cB = ph8[16], cK = ph8[24], cW = ph8[32]; float cv = vvp[0]; f32x2 cs = scp[0];
#pragma unroll 2
            for (int t = 0; t < TC; ++t) {
                const int tn = (t + 1 < TC) ? t + 1 : t;
                const h8 nA = ph8[tn * 40], nE = ph8[tn * 40 + 8], nB = ph8[tn * 40 + 16], nK = ph8[tn * 40 + 24], nW = ph8[tn * 40 + 32]; const float nv = vvp[tn * 64]; const f32x2 ns = scp[tn];
                float sa0 = 0.f, sa1 = 0.f, yw0 = 0.f, yw1 = 0.f;
#pragma unroll
                for (int j = 0; j < 4; ++j) { sa0 = __builtin_fmaf(s[j], (float)cA[j], sa0); sa1 = __builtin_fmaf(s[4 + j], (float)cA[4 + j], sa1);
                                              yw0 = __builtin_fmaf(s[j], (float)cW[j], yw0); yw1 = __builtin_fmaf(s[4 + j], (float)cW[4 + j], yw1); }
                float sa = red8(sa0 + sa1), yw = red8(yw0 + yw1);
#pragma unroll
                for (int j = 0; j < 8; ++j) { float uu = __builtin_fmaf(sa, (float)cB[j], s[j]); uu = __builtin_fmaf(cv, (float)cK[j], uu); s[j] = __builtin_fmaf(-(float)cE[j], s[j], uu); }
                const float y = yw + sa * cs.x + cv * cs.y;
                if (cg == 0) yyp[t * 64] = y;
                cA = nA; cE = nE; cB = nB; cK = nK; cW = nW; cv = nv; cs = ns;
            }
        }
        __syncthreads();
        {
            const f32x4 y4 = *((const LAS f32x4*)(lds + SC_YY) + st * 16 + sq);
            const f32x4 v4 = *((const LAS f32x4*)(lds + SC_VV) + (buf * TC + st) * 16 + sq);
            const float mean = red16((y4.x + y4.y) + (y4.z + y4.w)) * (1.0f / 64.0f);
            const f32x4 d = y4 - mean;
            const float var = red16((d.x * d.x + d.y * d.y) + (d.z * d.z + d.w * d.w)) * (1.0f / 64.0f);
            const float rstd = rsqrtf(var + GN_EPS);
            f32x4 o = d * rstd * lg + lb + v4 * bon;
            o.x *= siluf_(bflo(gG.x)); o.y *= siluf_(bfhi(gG.x)); o.z *= siluf_(bflo(gG.y)); o.w *= siluf_(bfhi(gG.y));
            u32x2 w; w.x = pk2(o.x, o.y); w.y = pk2(o.z, o.w);
            *(u32x2*)(YM + tokE * 1024 + colbase) = w;
        }
        if (c + 1 < SEQ / TC) SC_STAGE(buf ^ 1);
        __syncthreads();
    }
#undef SC_GLOAD
#undef SC_STAGE
}

constexpr int AT_KS = 0, AT_VT = 18432, AT_BT = 36864, AT_PITCH = 144;
__device__ __forceinline__ void attn_unit(const Args& a, LAS unsigned char* lds, int u) {
    const int tid = threadIdx.x, lane = tid & 63, wave = tid >> 6, fr = lane & 15, quad = lane >> 4;
    const int cp = u & 15, h = (u >> 4) & 7, b = u >> 7;
    unsigned char* ws = a.ws;
    const bf16_t* PB = (const bf16_t*)(ws + WS_PB); bf16_t* YM = (bf16_t*)(ws + WS_YMIX);
    const int c0 = 2 * cp, cq = c0 + (wave >> 2), qrow = (wave & 3) * 16 + fr;
    const size_t tq = (size_t)b * SEQ + cq * 64 + qrow;
    constexpr float LOG2E = 1.4426950408889634f;
    if (tid < 257) ((LAS float*)(lds + AT_BT))[tid] = a.in[I_ABIAS][h * 257 + tid] * LOG2E;
    bf16x8 qf[2];
    qf[0] = *(const bf16x8*)(PB + tq * NB + 512 + h * 64 + 8 * quad); qf[1] = *(const bf16x8*)(PB + tq * NB + 512 + h * 64 + 32 + 8 * quad);
    f32x4 O[4];
#pragma unroll
    for (int i = 0; i < 4; ++i) O[i] = (f32x4){0.f, 0.f, 0.f, 0.f};
    float m = -1e30f, l = 0.f;
    const int kfirst = c0 - 8 > 0 ? c0 - 8 : 0, klast = c0 + 1;
    const int kkey = tid >> 3, kdch = tid & 7;
    const int vkey = tid & 63, vdch = tid >> 6;
    const int vpos = (vkey & 32) + 8 * ((vkey >> 2) & 3) + 4 * ((vkey >> 4) & 1) + (vkey & 3);
    u32x4 gk, gv;
#define AT_GLD(kc) do { gk = *(const u32x4*)(PB + ((size_t)b * SEQ + (kc) * 64 + kkey) * NB + 1024 + h * 64 + kdch * 8); \
                        gv = *(const u32x4*)(PB + ((size_t)b * SEQ + (kc) * 64 + vkey) * NB + 1536 + h * 64 + vdch * 8); } while (0)
#define AT_SST(buf) do { *(LAS u32x4*)(lds + AT_KS + (buf) * 9216 + kkey * AT_PITCH + kdch * 16) = gk; \
        LAS unsigned short* vt_ = (LAS unsigned short*)(lds + AT_VT + (buf) * 9216) + (vdch * 8) * (AT_PITCH / 2) + vpos; \
        vt_[0 * 72] = (unsigned short)(gv.x & 0xffffu); vt_[1 * 72] = (unsigned short)(gv.x >> 16); vt_[2 * 72] = (unsigned short)(gv.y & 0xffffu); vt_[3 * 72] = (unsigned short)(gv.y >> 16); \
        vt_[4 * 72] = (unsigned short)(gv.z & 0xffffu); vt_[5 * 72] = (unsigned short)(gv.z >> 16); vt_[6 * 72] = (unsigned short)(gv.w & 0xffffu); vt_[7 * 72] = (unsigned short)(gv.w >> 16); } while (0)
    AT_GLD(kfirst); AT_SST(0);
    __syncthreads();
    for (int kc = kfirst; kc <= klast; ++kc) {
        const int buf = (kc - kfirst) & 1;
        if (kc < klast) AT_GLD(kc + 1);
        if (kc <= cq && kc >= cq - 8) {
            const LAS unsigned char* ks = lds + AT_KS + buf * 9216 + fr * AT_PITCH + quad * 16;
            const LAS unsigned char* vt = lds + AT_VT + buf * 9216 + fr * AT_PITCH + quad * 16;
            f32x4 sc[4];
#pragma unroll
            for (int kt = 0; kt < 4; ++kt) {
                sc[kt] = (f32x4){0.f, 0.f, 0.f, 0.f};
#pragma unroll
                for (int k2 = 0; k2 < 2; ++k2) { const bf16x8 kf = *(const LAS bf16x8*)(ks + kt * 16 * AT_PITCH + k2 * 64); sc[kt] = __builtin_amdgcn_mfma_f32_16x16x32_bf16(kf, qf[k2], sc[kt], 0, 0, 0); }
            }
            const int dch = cq - kc;
            const LAS float* bt = (const LAS float*)(lds + AT_BT);
            float mx = -1e30f;
            if (dch >= 3) {
                const float bc = bt[256];
#pragma unroll
                for (int kt = 0; kt < 4; ++kt)
#pragma unroll
                    for (int j = 0; j < 4; ++j) { sc[kt][j] = __builtin_fmaf(sc[kt][j], 0.125f * LOG2E, bc); mx = fmaxf(mx, sc[kt][j]); }
            } else {
                const int base = dch * 64 + qrow + 128 - 4 * quad;
#pragma unroll
                for (int kt = 0; kt < 4; ++kt)
#pragma unroll
                    for (int j = 0; j < 4; ++j) { int idx = base - kt * 16 - j; idx = idx > 256 ? 256 : idx; sc[kt][j] = __builtin_fmaf(sc[kt][j], 0.125f * LOG2E, bt[idx]); mx = fmaxf(mx, sc[kt][j]); }
            }
            mx = fmaxf(mx, __shfl_xor(mx, 16)); mx = fmaxf(mx, __shfl_xor(mx, 32));
            const float mn = fmaxf(m, mx), al = __builtin_amdgcn_exp2f(m - mn); m = mn;
            float ps = 0.f;
#pragma unroll
            for (int kt = 0; kt < 4; ++kt)
#pragma unroll
                for (int j = 0; j < 4; ++j) { sc[kt][j] = __builtin_amdgcn_exp2f(sc[kt][j] - mn); ps += sc[kt][j]; }
            l = l * al + ps;
#pragma unroll
            for (int i = 0; i < 4; ++i) O[i] = O[i] * al;
#pragma unroll
            for (int s2 = 0; s2 < 2; ++s2) {
                u32x4 pw; pw.x = pk2(sc[2 * s2][0], sc[2 * s2][1]); pw.y = pk2(sc[2 * s2][2], sc[2 * s2][3]); pw.z = pk2(sc[2 * s2 + 1][0], sc[2 * s2 + 1][1]); pw.w = pk2(sc[2 * s2 + 1][2], sc[2 * s2 + 1][3]);
                const bf16x8 pf = __builtin_bit_cast(bf16x8, pw);
#pragma unroll
                for (int dt = 0; dt < 4; ++dt) { const bf16x8 vf = *(const LAS bf16x8*)(vt + dt * 16 * AT_PITCH + s2 * 64); O[dt] = __builtin_amdgcn_mfma_f32_16x16x32_bf16(vf, pf, O[dt], 0, 0, 0); }
            }
        }
        if (kc < klast) AT_SST(buf ^ 1);
        __syncthreads();
    }
#undef AT_GLD
#undef AT_SST
    l += __shfl_xor(l, 16); l += __shfl_xor(l, 32);
    const float il = 1.0f / l;
#pragma unroll
    for (int dt = 0; dt < 4; ++dt) {
        const int dcol = h * 64 + dt * 16 + 4 * quad;
        const u32x2 g = *(const u32x2*)(PB + tq * NB + 2048 + dcol);
        const f32x4 o = O[dt] * il;
        u32x2 w; w.x = pk2(o[0] * siluf_(bflo(g.x)), o[1] * siluf_(bfhi(g.x))); w.y = pk2(o[2] * siluf_(bflo(g.y)), o[3] * siluf_(bfhi(g.y)));
        *(u32x2*)(YM + tq * 1024 + 512 + dcol) = w;
    }
}

__device__ __forceinline__ void phase_mix(const Args& a, LAS unsigned char* lds) {
    unsigned* ctr = (unsigned*)(a.ws + WS_CTR);
    for (int u = blockIdx.x; u < BATCH * 8; u += gridDim.x) scan_unit(a, lds, u);
    LAS int* uw = (LAS int*)(lds + 40000);
    for (;;) {
        __syncthreads();
        if (threadIdx.x == 0) *uw = (int)atomicAdd(ctr, 1u);
        __syncthreads();
        const int u = *uw;
        if (u >= BATCH * 8 * 16) break;
        attn_unit(a, lds, u);
    }
}

__device__ __forceinline__ void phase_sg_naive(const Args& a, unsigned char* ldsb) {
    const int tid = threadIdx.x;
    unsigned char* ws = a.ws;
    const bf16_t* P1 = (const bf16_t*)(ws + WS_P1); bf16_t* Y2 = (bf16_t*)(ws + WS_YMIX);
    const float* vsum = (const float*)(ws + WS_VSUM); const float* vsq = (const float*)(ws + WS_VSQ);
    float* vn = (float*)ldsb;
    const int c = tid & 127, i0 = tid >> 7;
    for (int u = blockIdx.x; u < BATCH * 16 * 8; u += gridDim.x) {
        const int g = u & 7, nb = (u >> 3) & 15, b = u >> 7;
        const int tbase = b * SEQ + nb * 128;
        const float lg = a.in[I_SGLNG][g * 128 + c], lb = a.in[I_SGLNB][g * 128 + c];
        for (int j = i0; j < 128; j += 4) {
            const int t = tbase + j; const float mean = vsum[t] * (1.0f / 1024.0f); const float var = vsq[t] * (1.0f / 1024.0f) - mean * mean;
            const float rstd = rsqrtf(fmaxf(var, 0.f) + LN_EPS);
            vn[j * 128 + c] = (bf2f(P1[(size_t)t * N3 + 1024 + g * 128 + c]) - mean) * rstd * lg + lb;
        }
        __syncthreads();
        const float* wg = a.in[I_SGW] + (size_t)g * 128 * 128; const float* sb = a.in[I_SGB] + g * 128;
        for (int i = i0; i < 128; i += 4) {
            const int jend = (i < 64) ? 64 : 128;
            float acc = 0.f;
            for (int j = 0; j < jend; ++j) acc += wg[i * 128 + j] * vn[j * 128 + c];
            const int t = tbase + i;
            const float uu = bf2f(P1[(size_t)t * N3 + g * 128 + c]), gt = bf2f(P1[(size_t)t * N3 + 2048 + g * 128 + c]);
            Y2[(size_t)t * 1024 + g * 128 + c] = f2bf(uu * (acc + sb[i]) * gt);
        }
        __syncthreads();
    }
}

__device__ __forceinline__ void phase_final(const Args& a) {
    const int tid = threadIdx.x, lane = tid & 63, wave = tid >> 6;
    const float* rs2 = (const float*)(a.ws + WS_RS2); const float* fg = a.in[I_FG];
    const int gw = blockIdx.x * 8 + wave, NGW = gridDim.x * 8;
    f32x4 g4[4];
#pragma unroll
    for (int j = 0; j < 4; ++j) g4[j] = ((const f32x4*)fg)[lane + 64 * j];
    for (int m = gw; m < M; m += NGW) {
        const float rinv = rsqrtf(rs2[m] * (1.0f / DM) + RMS_EPS);
        f32x4* p = (f32x4*)(a.out + (size_t)m * DM) + lane;
#pragma unroll
        for (int j = 0; j < 4; ++j) { f32x4 v = p[64 * j]; v = v * rinv * g4[j]; p[64 * j] = v; }
    }
}

template <int PHM> __global__ void __launch_bounds__(NTHR, 2) mega(Args a) {
    extern __shared__ __attribute__((aligned(16))) unsigned char lds[];
    unsigned char* ws = a.ws;
    const int lo = a.lo, hi = a.hi;
#define IN(k) (((PHM >> (k)) & 1) && lo <= (k) && (k) < hi)
#define SEAM(k) do { if (IN(k) && IN((k) + 1)) { cg::this_grid().sync(); } } while (0)
    if (IN(0)) { phase_prologue(a); }
    SEAM(0);
    if (IN(1)) { EpiG1 f{(const float*)(ws + WS_RS0), (bf16_t*)(ws + WS_PA), (bf16_t*)(ws + WS_PB)};
        gemm_any(lds, (const bf16_t*)(ws + WS_XN), (const bf16_t*)(ws + WS_W1T), M, N1, DM, f); }
    SEAM(1);
    if (IN(2)) { phase_prep(a, lds); }
    SEAM(2);
    #if USE_NAIVE_MIX
    if (IN(3)) { phase_scan_naive(a); phase_attn_naive(a); }
#else
    if (IN(3)) { phase_mix(a, (LAS unsigned char*)lds); }
#endif
    SEAM(3);
    if (IN(4)) { EpiG2 f{a.in[I_X], a.out, (bf16_t*)(ws + WS_XN), (float*)(ws + WS_RS1)};
        gemm_any(lds, (const bf16_t*)(ws + WS_YMIX), (const bf16_t*)(ws + WS_W2T), M, DM, DM, f); }
    SEAM(4);
    if (IN(5)) { EpiG3 f{(const float*)(ws + WS_RS1), (bf16_t*)(ws + WS_P1), (float*)(ws + WS_VSUM), (float*)(ws + WS_VSQ)};
        gemm_any(lds, (const bf16_t*)(ws + WS_XN), (const bf16_t*)(ws + WS_W3T), M, N3, DM, f); }
    SEAM(5);
    if (IN(6)) { phase_sg_naive(a, lds); }
    SEAM(6);
    if (IN(7)) { EpiG4 f{a.out, (float*)(ws + WS_RS2)};
        gemm_any(lds, (const bf16_t*)(ws + WS_YMIX), (const bf16_t*)(ws + WS_W4T), M, DM, DM, f); }
    SEAM(7);
    if (IN(8)) { phase_final(a); }
#undef IN
#undef SEAM
}
constexpr int NPHASE = 9;
}

extern "C" void kernel_launch(void* const* d_in, const int* in_sizes, int n_in, void* d_out, int out_size, void* d_ws, size_t ws_size, hipStream_t stream) {
    using namespace mk;
    static int grid = 0;
    if (grid == 0) {
        if (n_in != 22 || out_size != M * DM || ws_size < WS_END) { fprintf(stderr, "kernel_launch: unexpected shapes (n_in %d out %d ws %zu)\n", n_in, out_size, ws_size); grid = -1; return; }
        int dev = 0, cus = 0, per_cu = 0;
        (void)hipGetDevice(&dev); (void)hipDeviceGetAttribute(&cus, hipDeviceAttributeMultiprocessorCount, dev);
#if N_LAUNCH_MODE == 1
        if (hipFuncSetAttribute((const void*)mega<0x1ff>, hipFuncAttributeMaxDynamicSharedMemorySize, LDS_BYTES) != hipSuccess) { fprintf(stderr, "kernel_launch: hipFuncSetAttribute failed\n"); grid = -1; return; }
        if (hipOccupancyMaxActiveBlocksPerMultiprocessor(&per_cu, (const void*)mega<0x1ff>, NTHR, LDS_BYTES) != hipSuccess || per_cu < 1) { fprintf(stderr, "kernel_launch: occupancy query says %d\n", per_cu); per_cu = 1; }
#else
        if (hipFuncSetAttribute((const void*)mega<0x1f7>, hipFuncAttributeMaxDynamicSharedMemorySize, LDS_BYTES) != hipSuccess || hipFuncSetAttribute((const void*)mega<0x008>, hipFuncAttributeMaxDynamicSharedMemorySize, LDS_BYTES) != hipSuccess) { fprintf(stderr, "kernel_launch: hipFuncSetAttribute failed\n"); grid = -1; return; }
#endif
        (void)hipGetLastError();
        grid = cus * 1;
        if (grid <= 0) grid = 256;
    }
    if (grid < 0) return;
    Args a{};
    for (int i = 0; i < 22; ++i) a.in[i] = (const float*)d_in[i];
    a.out = (float*)d_out; a.ws = (unsigned char*)d_ws;
#if N_LAUNCH_MODE == 2
    {
        void* args[] = {&a};
        a.lo = 0; a.hi = 3;
        hipError_t e = hipLaunchCooperativeKernel((const void*)mega<0x1f7>, dim3(grid), dim3(NTHR), args, LDS_BYTES, stream);
        if (e != hipSuccess) fprintf(stderr, "kernel_launch: cooperative launch A failed: %s (grid %d)\n", hipGetErrorString(e), grid);
        a.lo = 3; a.hi = 4;
        hipLaunchKernelGGL(mega<0x008>, dim3(grid), dim3(NTHR), LDS_BYTES, stream, a);
        a.lo = 4; a.hi = NPHASE;
        e = hipLaunchCooperativeKernel((const void*)mega<0x1f7>, dim3(grid), dim3(NTHR), args, LDS_BYTES, stream);
        if (e != hipSuccess) fprintf(stderr, "kernel_launch: cooperative launch B failed: %s (grid %d)\n", hipGetErrorString(e), grid);
    }
#elif N_LAUNCH_MODE == 1
    a.lo = 0; a.hi = NPHASE;
    void* args[] = {&a};
    hipError_t e = hipLaunchCooperativeKernel((const void*)mega<0x1ff>, dim3(grid), dim3(NTHR), args, LDS_BYTES, stream);
    if (e != hipSuccess) fprintf(stderr, "kernel_launch: cooperative launch failed: %s (grid %d)\n", hipGetErrorString(e), grid);
#else
    for (int ph = 0; ph < NPHASE; ++ph) {
        a.lo = ph; a.hi = ph + 1;
        if (ph == 3) hipLaunchKernelGGL(mega<0x008>, dim3(grid), dim3(NTHR), LDS_BYTES, stream, a);
        else hipLaunchKernelGGL(mega<0x1f7>, dim3(grid), dim3(NTHR), LDS_BYTES, stream, a);
    }
#endif
}
```

```cpp
#if defined(__HIP_DEVICE_COMPILE__)
#pragma clang attribute push(__attribute__((target("no-packed-fp32-ops"))), apply_to = function)
#endif
#include <hip/hip_runtime.h>
#include <hip/hip_cooperative_groups.h>
#include <cstdio>
#include <cstdint>
namespace cg = cooperative_groups;
#ifndef USE_PG8
#define USE_PG8 1
#endif
#ifndef N_LAUNCH_MODE
#define N_LAUNCH_MODE 1
#endif
#ifndef PHMASK
#define PHMASK 0x1ff
#endif
#ifndef USE_NAIVE_MIX
#define USE_NAIVE_MIX 0
#endif
#ifndef PROBE
#define PROBE 0
#endif
namespace pg8 {
#define PG8_LAS __attribute__((address_space(3)))
typedef unsigned short bf16_t;
typedef short bf16x8 __attribute__((ext_vector_type(8)));
typedef float f32x4 __attribute__((ext_vector_type(4)));
typedef unsigned u32x4 __attribute__((ext_vector_type(4)));
constexpr int BM = 256, BK = 64, HALF = 128, HTB = HALF * BK * 2  , STAGE_BYTES = 8 * HTB, NXCD = 8, WGM = 8;

__host__ __device__ __forceinline__ int lds_byte(int r, int c) { const int st = (r >> 4) * 2 + (c >> 5), rr = r & 15, cc = c & 31, ob = rr * 64 + cc * 2; return st * 1024 + (ob ^ (((ob >> 9) & 1) << 5)); }
__host__ __device__ __forceinline__ void stage_rc(int b, int& R, int& C) { const int st = b / 1024, sb = b % 1024, swz = sb ^ (((sb >> 9) & 1) << 5); R = (st >> 1) * 16 + swz / 64; C = (st & 1) * 32 + (swz % 64) / 2; }
__host__ __device__ __forceinline__ int perm32(int rho) { const int n = rho >> 4, i = rho & 15; return 8 * (i >> 2) + 4 * n + (i & 3); }

struct Unit { int pm, pn; };
struct Gemm { const bf16_t* A; const bf16_t* Bt; int M, N, K; };

struct StaticOrder {
    int nM, nN, nwg, G, c;
    __host__ __device__ void init(int M, int N, int G_, int c_) { nM = M / BM; nN = N / BM; nwg = nM * nN; G = G_; c = c_; }
    __host__ __device__ bool next(int i, Unit& u) const {
        const long L = (long)i * G + c; if (L >= nwg) return false;
        int wgid = (int)L; { const int q = nwg / NXCD, r = nwg % NXCD, xcd = wgid % NXCD, off = wgid / NXCD; wgid = (xcd < r ? xcd * (q + 1) : r * (q + 1) + (xcd - r) * q) + off; }
        const int nig = WGM * nN, gid = wgid / nig, fm = gid * WGM, gsz = (nM - fm) < WGM ? (nM - fm) : WGM;
        u.pm = fm + ((wgid % nig) % gsz); u.pn = (wgid % nig) / gsz; return true;
    }
    __device__ __forceinline__ void a_ready(const Unit&) const {}
    __device__ __forceinline__ void done(const Unit&) const {}
};

__device__ __forceinline__ unsigned cvt_pk_bf16(float lo, float hi) { unsigned r; asm volatile("v_cvt_pk_bf16_f32 %0, %1, %2" : "=v"(r) : "v"(lo), "v"(hi)); return r; }
typedef float f32x2 __attribute__((ext_vector_type(2)));
__device__ __forceinline__ f32x2 gelu_pk(f32x2 v) {
    const f32x2 av = __builtin_elementwise_abs(v), d = av * 0.2316418882f + 1.0f;
    f32x2 t; t.x = __builtin_amdgcn_rcpf(d.x); t.y = __builtin_amdgcn_rcpf(d.y);
    f32x2 q = t * 0.5307027145f + (-0.7265760135f); q = q * t + 0.7107068705f; q = q * t + (-0.142248368f); q = q * t + 0.127414796f; q = q * t;
    const f32x2 s = (v * v) * (-0.72134752044f);
    f32x2 e; e.x = __builtin_amdgcn_exp2f(s.x); e.y = __builtin_amdgcn_exp2f(s.y);
    const f32x2 m = v * (q * e), r = v - m;
    f32x2 o; o.x = v.x < 0.f ? m.x : r.x; o.y = v.y < 0.f ? m.y : r.y; return o;
}

template <int ACT  > struct EpiBf16 {
    static constexpr bool PERM = true, AFTER_DRAIN = false; static_assert(ACT == 0 || ACT == 1, "EpiBf16: ACT is 0 (none) or 1 (gelu_pk)");
    bf16_t* O; int ldc; const float* bias; int split_cols; size_t split_stride; float scale0;
    __device__ __forceinline__ void operator()(const f32x4 (&acc)[2][2][4][2], const Unit& u, int wr, int wc, int fr, int fq) const {
        const int row0 = u.pm * BM + wr * 64 + fr; int colt = u.pn * BM; bf16_t* base = O;
        float sc = 1.f; if (split_cols) { const int t = colt / split_cols; base += (size_t)t * split_stride; colt -= t * split_cols; if (t == 0) sc = scale0; }
        const int col0 = colt + wc * 32 + 8 * fq, bcol0 = u.pn * BM + wc * 32 + 8 * fq;
        f32x4 bv[2][2];
#pragma unroll
        for (int bj = 0; bj < 2; ++bj)
#pragma unroll
            for (int n = 0; n < 2; ++n) bv[bj][n] = bias ? *(const f32x4*)(bias + bcol0 + bj * HALF + 4 * n) : (f32x4){0.f, 0.f, 0.f, 0.f};
#pragma unroll
        for (int ai = 0; ai < 2; ++ai)
#pragma unroll
            for (int m = 0; m < 4; ++m) { bf16_t* rowp = base + (size_t)(row0 + ai * HALF + m * 16) * ldc + col0;
#pragma unroll
                for (int bj = 0; bj < 2; ++bj) { f32x4 v0 = acc[ai][bj][m][0] + bv[bj][0], v1 = acc[ai][bj][m][1] + bv[bj][1];
                    if (ACT == 1) { f32x2 a = gelu_pk((f32x2){v0[0], v0[1]}), b = gelu_pk((f32x2){v0[2], v0[3]}), c = gelu_pk((f32x2){v1[0], v1[1]}), d = gelu_pk((f32x2){v1[2], v1[3]});
                        v0 = (f32x4){a.x, a.y, b.x, b.y}; v1 = (f32x4){c.x, c.y, d.x, d.y}; }
                    v0 = v0 * sc; v1 = v1 * sc; u32x4 w; w.x = cvt_pk_bf16(v0[0], v0[1]); w.y = cvt_pk_bf16(v0[2], v0[3]); w.z = cvt_pk_bf16(v1[0], v1[1]); w.w = cvt_pk_bf16(v1[2], v1[3]);
                    *(u32x4*)(rowp + bj * HALF) = w; } }
    }
};
template <class Epi, class Sched, bool ALIGN_EPI = false, bool SP2 = false>
__device__ __forceinline__ void gemm_phase(PG8_LAS unsigned char* lds, const Gemm g, const Sched& S, const Epi& E) {
    const int tid = threadIdx.x, wid = __builtin_amdgcn_readfirstlane(tid >> 6), lane = tid & 63, wr = wid >> 2, wc = wid & 3, fr = lane & 15, fq = lane >> 4;
    const int K = g.K, nt = K / BK;
    unsigned voffA[2], voffB[2];
#pragma unroll
    for (int i = 0; i < 2; ++i) { int R, C; stage_rc(tid * 16 + i * 8192, R, C); const int Rb = Epi::PERM ? ((R & ~31) + perm32(R & 31)) : R;
        voffA[i] = (unsigned)(R * K + C) * 2u; voffB[i] = (unsigned)(Rb * K + C) * 2u; }
    const size_t kstep = (size_t)(BK * 2);
    const size_t hstep = (size_t)HALF * K * 2;
    const size_t tstep = 2 * hstep;
    const unsigned ldsw = (unsigned)wid * 1024u;
    const int aoff = lds_byte(wr * 64 + fr, fq * 8), boff = lds_byte(wc * 32 + fr, fq * 8);
#define PG8_SA(b, h) (((b) * 2 + (h)) * HTB)
#define PG8_SB(b, h) ((4 + (b) * 2 + (h)) * HTB)
#define PG8_STAGE(bufoff, gbase, voff) do { _Pragma("unroll") for (int _i = 0; _i < 2; ++_i) \
        __builtin_amdgcn_global_load_lds((const unsigned*)((const char*)(gbase) + (voff)[_i]), (PG8_LAS unsigned*)(lds + (bufoff) + ldsw + _i * 8192), 16, 0, 0); } while (0)
#define PG8_LDA(dst, b, h) do { _Pragma("unroll") for (int m = 0; m < 4; ++m) _Pragma("unroll") for (int k = 0; k < 2; ++k) dst[m][k] = *(const PG8_LAS bf16x8*)(lds + PG8_SA(b, h) + aoff + m * 2048 + k * 1024); } while (0)
#define PG8_LDB(dst, b, h) do { _Pragma("unroll") for (int n = 0; n < 2; ++n) _Pragma("unroll") for (int k = 0; k < 2; ++k) dst[n][k] = *(const PG8_LAS bf16x8*)(lds + PG8_SB(b, h) + boff + n * 2048 + k * 1024); } while (0)
#define PG8_MMA(ai, bj, At, Bt) do { __builtin_amdgcn_s_setprio(1); _Pragma("unroll") for (int m = 0; m < 4; ++m) _Pragma("unroll") for (int n = 0; n < 2; ++n) _Pragma("unroll") for (int k = 0; k < 2; ++k) \
        acc[ai][bj][m][n] = __builtin_amdgcn_mfma_f32_16x16x32_bf16(Bt[n][k], At[m][k], acc[ai][bj][m][n], 0, 0, 0); __builtin_amdgcn_s_setprio(0); } while (0)
#define PG8_WAIT_V(n) asm volatile("s_waitcnt vmcnt(" #n ")" ::: "memory")
#define PG8_WAIT_L(n) asm volatile("s_waitcnt lgkmcnt(" #n ")" ::: "memory")
#define PG8_BAR __builtin_amdgcn_s_barrier()
#define PG8_SCHED __builtin_amdgcn_sched_barrier(0)
    Unit cur, nxt; int ui = 0;
    if (!S.next(0, cur)) return;
    f32x4 acc[2][2][4][2];
#pragma unroll
    for (int a = 0; a < 2; ++a)
#pragma unroll
        for (int b = 0; b < 2; ++b)
#pragma unroll
            for (int m = 0; m < 4; ++m)
#pragma unroll
                for (int n = 0; n < 2; ++n) acc[a][b][m][n] = (f32x4){0.f, 0.f, 0.f, 0.f};
    bf16x8 At[4][2], B0[2][2], B1[2][2];
    const char* cA = (const char*)g.A + (size_t)cur.pm * tstep; const char* cB = (const char*)g.Bt + (size_t)cur.pn * tstep;
    S.a_ready(cur);
    if constexpr (SP2) {
        PG8_STAGE(PG8_SB(0, 0), cB, voffB); PG8_STAGE(PG8_SB(0, 1), cB + hstep, voffB); PG8_STAGE(PG8_SA(0, 0), cA, voffA); PG8_STAGE(PG8_SA(0, 1), cA + hstep, voffA);
        if (wr == 1) PG8_BAR;
        PG8_WAIT_V(2); PG8_BAR;
        PG8_STAGE(PG8_SB(1, 0), cB + kstep, voffB); PG8_STAGE(PG8_SA(1, 0), cA + kstep, voffA); PG8_STAGE(PG8_SB(1, 1), cB + hstep + kstep, voffB);
        PG8_WAIT_V(6); PG8_BAR;
    } else {
        PG8_STAGE(PG8_SB(0, 0), cB, voffB); PG8_STAGE(PG8_SA(0, 0), cA, voffA); PG8_STAGE(PG8_SB(0, 1), cB + hstep, voffB); PG8_STAGE(PG8_SA(0, 1), cA + hstep, voffA);
        if (wr == 1) PG8_BAR;
        PG8_WAIT_V(4); PG8_BAR;
        PG8_STAGE(PG8_SB(1, 0), cB + kstep, voffB); PG8_STAGE(PG8_SA(1, 0), cA + kstep, voffA); PG8_STAGE(PG8_SB(1, 1), cB + hstep + kstep, voffB);
        PG8_WAIT_V(6); PG8_BAR;
    }
    for (;;) {
        const bool has_next = S.next(ui + 1, nxt);
        const char* nA = has_next ? (const char*)g.A + (size_t)nxt.pm * tstep : cA; const char* nB = has_next ? (const char*)g.Bt + (size_t)nxt.pn * tstep : cB;
        for (int t = 0; t < nt; t += 2) {
            const bool last = (t == nt - 2);
            const char* a1 = cA + (size_t)(t + 1) * kstep;
            const char* a2 = last ? nA : cA + (size_t)(t + 2) * kstep; const char* b2 = last ? nB : cB + (size_t)(t + 2) * kstep;
            const char* a3 = a2 + kstep; const char* b3 = b2 + kstep;
            if (last && has_next) S.a_ready(nxt);
            if constexpr (SP2) {
            PG8_LDB(B0, 0, 0); PG8_LDB(B1, 0, 1); PG8_SCHED; PG8_LDA(At, 0, 0); PG8_STAGE(PG8_SA(1, 1), a1 + hstep, voffA);
            PG8_WAIT_V(8); PG8_WAIT_L(0); PG8_BAR; PG8_MMA(0, 0, At, B0); PG8_MMA(0, 1, At, B1); PG8_BAR; PG8_SCHED;
            PG8_LDA(At, 0, 1); PG8_STAGE(PG8_SB(0, 0), b2, voffB); PG8_STAGE(PG8_SB(0, 1), b2 + hstep, voffB); PG8_STAGE(PG8_SA(0, 0), a2, voffA);
            PG8_WAIT_V(8); PG8_WAIT_L(0); PG8_BAR; PG8_MMA(1, 0, At, B0); PG8_MMA(1, 1, At, B1); PG8_BAR; PG8_SCHED;
            PG8_LDB(B0, 1, 0); PG8_LDB(B1, 1, 1); PG8_SCHED; PG8_LDA(At, 1, 0); PG8_STAGE(PG8_SA(0, 1), a2 + hstep, voffA);
            PG8_WAIT_V(8); PG8_WAIT_L(0); PG8_BAR; PG8_MMA(0, 0, At, B0); PG8_MMA(0, 1, At, B1); PG8_BAR; PG8_SCHED;
            PG8_LDA(At, 1, 1); PG8_STAGE(PG8_SB(1, 0), b3, voffB); PG8_STAGE(PG8_SB(1, 1), b3 + hstep, voffB); PG8_STAGE(PG8_SA(1, 0), a3, voffA);
            PG8_WAIT_V(8); PG8_WAIT_L(0); PG8_BAR; PG8_MMA(1, 0, At, B0); PG8_MMA(1, 1, At, B1); PG8_BAR; PG8_SCHED;
            } else {
            PG8_LDB(B0, 0, 0); PG8_SCHED; PG8_LDA(At, 0, 0); PG8_STAGE(PG8_SA(1, 1), a1 + hstep, voffA);
            PG8_WAIT_L(8); PG8_BAR; PG8_WAIT_L(0); PG8_MMA(0, 0, At, B0); PG8_BAR; PG8_SCHED;
            PG8_LDB(B1, 0, 1); PG8_STAGE(PG8_SB(0, 0), b2, voffB);
            PG8_BAR; PG8_WAIT_L(0); PG8_MMA(0, 1, At, B1); PG8_BAR;
            PG8_LDA(At, 0, 1); PG8_STAGE(PG8_SA(0, 0), a2, voffA);
            PG8_BAR; PG8_WAIT_L(0); PG8_MMA(1, 0, At, B0); PG8_BAR; PG8_SCHED;
            PG8_STAGE(PG8_SB(0, 1), b2 + hstep, voffB);
            PG8_WAIT_V(6); PG8_BAR; PG8_MMA(1, 1, At, B1); PG8_BAR;
            PG8_LDB(B0, 1, 0); PG8_SCHED; PG8_LDA(At, 1, 0); PG8_STAGE(PG8_SA(0, 1), a2 + hstep, voffA);
            PG8_WAIT_L(8); PG8_BAR; PG8_WAIT_L(0); PG8_MMA(0, 0, At, B0); PG8_BAR; PG8_SCHED;
            PG8_LDB(B1, 1, 1); PG8_STAGE(PG8_SB(1, 0), b3, voffB);
            PG8_BAR; PG8_WAIT_L(0); PG8_MMA(0, 1, At, B1); PG8_BAR;
            PG8_LDA(At, 1, 1); PG8_STAGE(PG8_SA(1, 0), a3, voffA);
            PG8_BAR; PG8_WAIT_L(0); PG8_MMA(1, 0, At, B0); PG8_BAR; PG8_SCHED;
            PG8_STAGE(PG8_SB(1, 1), b3 + hstep, voffB);
            PG8_WAIT_V(6); PG8_BAR; PG8_MMA(1, 1, At, B1); PG8_BAR;
            }
        }
        if constexpr (ALIGN_EPI) { if (wr == 0) PG8_BAR; }
        if constexpr (!Epi::AFTER_DRAIN) { E(acc, cur, wr, wc, fr, fq); S.done(cur); }
        if (!has_next) break;
#pragma unroll
        for (int a = 0; a < 2; ++a)
#pragma unroll
            for (int b = 0; b < 2; ++b)
#pragma unroll
                for (int m = 0; m < 4; ++m)
#pragma unroll
                    for (int n = 0; n < 2; ++n) acc[a][b][m][n] = (f32x4){0.f, 0.f, 0.f, 0.f};
        cur = nxt; cA = nA; cB = nB; ++ui;
        if constexpr (ALIGN_EPI) { if (wr == 1) PG8_BAR; }
    }
    PG8_WAIT_V(0);
    if constexpr (!ALIGN_EPI) { if (wr == 0) PG8_BAR; }
    PG8_BAR;
    if constexpr (Epi::AFTER_DRAIN) { E.fused(acc, cur, wr, wc, fr, fq, lds, wid, lane); S.done(cur); }
#undef PG8_SA
#undef PG8_SB
#undef PG8_STAGE
#undef PG8_LDA
#undef PG8_LDB
#undef PG8_MMA
#undef PG8_WAIT_V
#undef PG8_WAIT_L
#undef PG8_BAR
#undef PG8_SCHED
}
}

namespace mk {
typedef unsigned short bf16_t;
typedef float f32x4 __attribute__((ext_vector_type(4)));
typedef unsigned u32x4 __attribute__((ext_vector_type(4)));
typedef unsigned u32x2 __attribute__((ext_vector_type(2)));
typedef float f32x2 __attribute__((ext_vector_type(2)));
#define LAS __attribute__((address_space(3)))

constexpr int BATCH = 16, SEQ = 2048, DM = 1024, M = BATCH * SEQ;
constexpr int NA = 1792, NB = 2560, N1 = NA + NB;
constexpr int N3 = 3072;
constexpr int EVEN_IN = 4224, SHIFT_W = 1664;
constexpr float RMS_EPS = 1e-6f, LN_EPS = 1e-5f, GN_EPS = 64e-5f;
constexpr int NTHR = 512;

constexpr size_t MiB = 1u << 20;
constexpr size_t WS_CTR = 768 * 1024;
constexpr size_t WS_LW = 23 * MiB + 512 * 1024;
constexpr size_t WS_SGW = 23 * MiB;
constexpr size_t WS_RS0 = 0, WS_RS1 = 128 * 1024, WS_RS2 = 256 * 1024, WS_VSUM = 384 * 1024, WS_VSQ = 512 * 1024, WS_BON = 1 * MiB;
constexpr size_t WS_W1T = 4 * MiB, WS_W2T = 13 * MiB, WS_W3T = 15 * MiB, WS_W4T = 21 * MiB;
constexpr size_t WS_XN = 24 * MiB;
constexpr size_t WS_PA = 88 * MiB;
constexpr size_t WS_PB = 200 * MiB;
constexpr size_t WS_YMIX = 360 * MiB;
constexpr size_t WS_END = 424 * MiB;
constexpr size_t WS_P1 = WS_PA;
constexpr int LDS_BYTES = 147456;

struct Args {
    const float* in[22];
    float* out; unsigned char* ws;
    int lo, hi;
};
enum { I_X = 0, I_NORMG, I_WINE, I_SHMU, I_W0, I_W2, I_A0, I_A2, I_KK, I_KA, I_RK, I_LNXG, I_LNXB, I_ABIAS, I_WOUTE, I_WINO, I_SGLNG, I_SGLNB, I_SGW, I_SGB, I_WOUTO, I_FG };

__device__ __forceinline__ unsigned short f2bf(float f) { unsigned u = __float_as_uint(f); return (unsigned short)((u + 0x7fffu + ((u >> 16) & 1u)) >> 16); }
__device__ __forceinline__ float bf2f(unsigned short h) { return __uint_as_float((unsigned)h << 16); }
__device__ __forceinline__ unsigned pk2(float lo, float hi) { return (unsigned)f2bf(lo) | ((unsigned)f2bf(hi) << 16); }
__device__ __forceinline__ float bflo(unsigned w) { return __uint_as_float(w << 16); }
__device__ __forceinline__ float bfhi(unsigned w) { return __uint_as_float(w & 0xffff0000u); }
__device__ __forceinline__ float wave_sum(float v) {
#pragma unroll
    for (int o = 1; o < 64; o <<= 1) v += __shfl_xor(v, o);
    return v;
}
__device__ __forceinline__ float sigmoidf_(float x) { return 1.0f / (1.0f + __expf(-x)); }
__device__ __forceinline__ float siluf_(float x) { return x * sigmoidf_(x); }
__device__ __forceinline__ float gelu_tanh(float x) { const float y = 0.7978845608028654f * (x + 0.044715f * x * x * x); return x * sigmoidf_(2.0f * y); }

__device__ __forceinline__ void phase_prologue(const Args& a, unsigned char* ldsb) {
    const int tid = threadIdx.x, lane = tid & 63, wave = tid >> 6;
    unsigned char* ws = a.ws;
    const int gtid = blockIdx.x * NTHR + tid, nthr = gridDim.x * NTHR;
    {
        LAS float* scr = (LAS float*)((LAS unsigned char*)ldsb + wave * 8448);
        constexpr int NB1 = N1 / 32, NB2 = 32, NB3 = N3 / 32, NB4 = 32, NITEM = (NB1 + NB2 + NB3 + NB4) * 16;
        for (int it = blockIdx.x * 8 + wave; it < NITEM; it += gridDim.x * 8) {
            int nb = it >> 4; const int k0 = (it & 15) * 64;
            const float* src; const float* g; int N, col0; bf16_t* dst; bool zero = false;
            if (nb < NB1) { const int n0 = nb * 32; src = a.in[I_WINE]; g = a.in[I_NORMG]; N = EVEN_IN; dst = (bf16_t*)(ws + WS_W1T) + (size_t)n0 * 1024;
                if (n0 < SHIFT_W) col0 = n0; else if (n0 < NA) { col0 = 0; zero = true; } else col0 = n0 - (NA - SHIFT_W); }
            else if ((nb -= NB1) < NB2) { src = a.in[I_WOUTE]; g = nullptr; N = 1024; col0 = nb * 32; dst = (bf16_t*)(ws + WS_W2T) + (size_t)col0 * 1024; }
            else if ((nb -= NB2) < NB3) { src = a.in[I_WINO]; g = a.in[I_NORMG] + 1024; N = N3; col0 = nb * 32; dst = (bf16_t*)(ws + WS_W3T) + (size_t)col0 * 1024; }
            else { nb -= NB3; src = a.in[I_WOUTO]; g = nullptr; N = 1024; col0 = nb * 32; dst = (bf16_t*)(ws + WS_W4T) + (size_t)col0 * 1024; }
#pragma unroll 8
            for (int i = 0; i < 32; ++i) { const int kk = 2 * i + (lane >> 5); float x = zero ? 0.f : src[(size_t)(k0 + kk) * N + col0 + (lane & 31)]; if (g) x *= g[k0 + kk]; scr[kk * 33 + (lane & 31)] = x; }
            asm volatile("s_waitcnt lgkmcnt(0)" ::: "memory");
            const int c8 = lane & 7;
#pragma unroll
            for (int j = 0; j < 4; ++j) { const int n = (lane >> 3) + 8 * j; const LAS float* sp = scr + (8 * c8) * 33 + n;
                u32x4 o; o.x = pk2(sp[0 * 33], sp[1 * 33]); o.y = pk2(sp[2 * 33], sp[3 * 33]); o.z = pk2(sp[4 * 33], sp[5 * 33]); o.w = pk2(sp[6 * 33], sp[7 * 33]);
                *(u32x4*)(dst + (size_t)n * 1024 + k0 + 8 * c8) = o; }
            asm volatile("s_waitcnt lgkmcnt(0)" ::: "memory");
        }
    }
    const float* x = a.in[I_X]; bf16_t* XN = (bf16_t*)(ws + WS_XN); float* rs0 = (float*)(ws + WS_RS0);
    const int gw = blockIdx.x * 8 + wave, NGW = gridDim.x * 8;
    for (int m = gw; m < M; m += NGW) {
        const f32x4* xr = (const f32x4*)(x + (size_t)m * DM) + lane; float s = 0.f; f32x4 v[4];
#pragma unroll
        for (int j = 0; j < 4; ++j) { v[j] = xr[64 * j]; s += (v[j].x * v[j].x + v[j].y * v[j].y) + (v[j].z * v[j].z + v[j].w * v[j].w); }
        s = wave_sum(s);
        u32x2* o = (u32x2*)(XN + (size_t)m * DM) + lane;
#pragma unroll
        for (int j = 0; j < 4; ++j) { u32x2 w; w.x = pk2(v[j].x, v[j].y); w.y = pk2(v[j].z, v[j].w); o[64 * j] = w; }
        if (lane == 0) rs0[m] = s;
    }
    float* rs1 = (float*)(ws + WS_RS1); float* rs2 = (float*)(ws + WS_RS2); float* vsum = (float*)(ws + WS_VSUM); float* vsq = (float*)(ws + WS_VSQ);
    for (int i = gtid; i < M; i += nthr) { rs1[i] = 0.f; rs2[i] = 0.f; vsum[i] = 0.f; vsq[i] = 0.f; }
    { bf16_t* LW = (bf16_t*)(ws + WS_LW); const float* w2 = a.in[I_W2]; const float* a2 = a.in[I_A2];
      for (int i = gtid; i < 2 * 512 * 64; i += nthr) { const int j = i & 63, cc = (i >> 6) & 511, mat = i >> 15; LW[i] = f2bf((mat ? a2 : w2)[j * 512 + cc]); } }
    { bf16_t* SGW = (bf16_t*)(ws + WS_SGW); const float* sgw = a.in[I_SGW];
      for (int i = gtid; i < 8 * 128 * 128; i += nthr) { const int jj = i & 127, ii = (i >> 7) & 127; SGW[i] = f2bf(((jj >> 6) <= (ii >> 6)) ? sgw[i] : 0.f); } }
}

struct EpiG1 {
    const float* rs0; bf16_t* PA; bf16_t* PB;
    static constexpr int NSTAT = 0;
    __device__ __forceinline__ void commit(int, float, float) const {}
    __device__ __forceinline__ f32x2 operator()(int row, int col, f32x4 v0, f32x4 v1) const {
        const float rinv = rsqrtf(rs0[row] * (1.0f / DM) + RMS_EPS);
        v0 = v0 * rinv; v1 = v1 * rinv;
        u32x4 w; w.x = pk2(v0[0], v0[1]); w.y = pk2(v0[2], v0[3]); w.z = pk2(v1[0], v1[1]); w.w = pk2(v1[2], v1[3]);
        bf16_t* dst = col < NA ? PA + (size_t)row * NA + col : PB + (size_t)row * NB + (col - NA);
        *(u32x4*)dst = w;
        return (f32x2){0.f, 0.f};
    }
};
struct EpiG2 {
    const float* x; float* out; bf16_t* HB; float* rs1;
    static constexpr int NSTAT = 1;
    __device__ __forceinline__ void commit(int row, float s0, float) const { unsafeAtomicAdd(rs1 + row, s0); }
    __device__ __forceinline__ f32x2 operator()(int row, int col, f32x4 v0, f32x4 v1) const {
        const size_t off = (size_t)row * DM + col;
        v0 = v0 + *(const f32x4*)(x + off); v1 = v1 + *(const f32x4*)(x + off + 4);
        *(f32x4*)(out + off) = v0; *(f32x4*)(out + off + 4) = v1;
        u32x4 w; w.x = pk2(v0[0], v0[1]); w.y = pk2(v0[2], v0[3]); w.z = pk2(v1[0], v1[1]); w.w = pk2(v1[2], v1[3]);
        *(u32x4*)(HB + off) = w;
        const float s = (v0[0] * v0[0] + v0[1] * v0[1]) + (v0[2] * v0[2] + v0[3] * v0[3]) + (v1[0] * v1[0] + v1[1] * v1[1]) + (v1[2] * v1[2] + v1[3] * v1[3]);
        return (f32x2){s, 0.f};
    }
};
struct EpiG3 {
    const float* rs1; bf16_t* P1; float* vsum; float* vsq;
    static constexpr int NSTAT = 2;
    __device__ __forceinline__ void commit(int row, float s0, float s1) const { if (s1 != 0.f) { unsafeAtomicAdd(vsum + row, s0); unsafeAtomicAdd(vsq + row, s1); } }
    __device__ __forceinline__ f32x2 operator()(int row, int col, f32x4 v0, f32x4 v1) const {
        f32x2 ret = (f32x2){0.f, 0.f};
        const float rinv = rsqrtf(rs1[row] * (1.0f / DM) + RMS_EPS);
        float v[8];
#pragma unroll
        for (int j = 0; j < 4; ++j) { v[j] = v0[j] * rinv; v[4 + j] = v1[j] * rinv; }
        if (col < 2048) {
#pragma unroll
            for (int j = 0; j < 8; ++j) v[j] = gelu_tanh(v[j]);
            if (col >= 1024) {
                float s = 0.f, q = 0.f;
#pragma unroll
                for (int j = 0; j < 8; ++j) { s += v[j]; q += v[j] * v[j]; }
                ret = (f32x2){s, q};
            }
        } else {
#pragma unroll
            for (int j = 0; j < 8; ++j) v[j] = siluf_(v[j]);
        }
        u32x4 w; w.x = pk2(v[0], v[1]); w.y = pk2(v[2], v[3]); w.z = pk2(v[4], v[5]); w.w = pk2(v[6], v[7]);
        *(u32x4*)(P1 + (size_t)row * N3 + col) = w;
        return ret;
    }
};
struct EpiG4 {
    float* out; float* rs2;
    static constexpr int NSTAT = 1;
    __device__ __forceinline__ void commit(int row, float s0, float) const { unsafeAtomicAdd(rs2 + row, s0); }
    __device__ __forceinline__ f32x2 operator()(int row, int col, f32x4 v0, f32x4 v1) const {
        const size_t off = (size_t)row * DM + col;
        v0 = v0 + *(const f32x4*)(out + off); v1 = v1 + *(const f32x4*)(out + off + 4);
        *(f32x4*)(out + off) = v0; *(f32x4*)(out + off + 4) = v1;
        const float s = (v0[0] * v0[0] + v0[1] * v0[1]) + (v0[2] * v0[2] + v0[3] * v0[3]) + (v1[0] * v1[0] + v1[1] * v1[1]) + (v1[2] * v1[2] + v1[3] * v1[3]);
        return (f32x2){s, 0.f};
    }
};

template <class F> struct EpiAdapt {
    static constexpr bool PERM = true, AFTER_DRAIN = false;
    F f;
    __device__ __forceinline__ void operator()(const pg8::f32x4 (&acc)[2][2][4][2], const pg8::Unit& u, int wr, int wc, int fr, int fq) const {
#pragma unroll
        for (int ai = 0; ai < 2; ++ai)
#pragma unroll
            for (int m = 0; m < 4; ++m) {
                const int row = u.pm * 256 + ai * 128 + wr * 64 + m * 16 + fr;
                f32x2 st = (f32x2){0.f, 0.f};
#pragma unroll
                for (int bj = 0; bj < 2; ++bj) { const int col = u.pn * 256 + bj * 128 + wc * 32 + 8 * fq; const f32x2 r = f(row, col, acc[ai][bj][m][0], acc[ai][bj][m][1]); st = st + r; }
                if (F::NSTAT >= 1) { st.x += __shfl_xor(st.x, 16); st.x += __shfl_xor(st.x, 32); }
                if (F::NSTAT >= 2) { st.y += __shfl_xor(st.y, 16); st.y += __shfl_xor(st.y, 32); }
                if (F::NSTAT >= 1 && fq == 0) f.commit(row, st.x, st.y);
            }
    }
};

template <class F> __device__ __forceinline__ void gemm_naive(float* lds, const bf16_t* A, const bf16_t* Bt, int Mm, int N, int K, const F& f) {
    const int tid = threadIdx.x, ty = tid >> 4, tx = tid & 15;
    float* As = lds; float* Bs = lds + 32 * 132;
    const int ntn = N / 128, ntiles = (Mm / 128) * ntn;
    for (int tile = blockIdx.x; tile < ntiles; tile += gridDim.x) {
        const int tm = tile / ntn, tn = tile % ntn;
        float acc[4][8];
#pragma unroll
        for (int i = 0; i < 4; ++i)
#pragma unroll
            for (int j = 0; j < 8; ++j) acc[i][j] = 0.f;
        for (int k0 = 0; k0 < K; k0 += 32) {
            { const int row = tid >> 2, kc = (tid & 3) * 8;
              const u32x4 va = *(const u32x4*)(A + (size_t)(tm * 128 + row) * K + k0 + kc);
              const u32x4 vb = *(const u32x4*)(Bt + (size_t)(tn * 128 + row) * K + k0 + kc);
              As[(kc + 0) * 132 + row] = bflo(va.x); As[(kc + 1) * 132 + row] = bfhi(va.x); As[(kc + 2) * 132 + row] = bflo(va.y); As[(kc + 3) * 132 + row] = bfhi(va.y);
              As[(kc + 4) * 132 + row] = bflo(va.z); As[(kc + 5) * 132 + row] = bfhi(va.z); As[(kc + 6) * 132 + row] = bflo(va.w); As[(kc + 7) * 132 + row] = bfhi(va.w);
              Bs[(kc + 0) * 132 + row] = bflo(vb.x); Bs[(kc + 1) * 132 + row] = bfhi(vb.x); Bs[(kc + 2) * 132 + row] = bflo(vb.y); Bs[(kc + 3) * 132 + row] = bfhi(vb.y);
              Bs[(kc + 4) * 132 + row] = bflo(vb.z); Bs[(kc + 5) * 132 + row] = bfhi(vb.z); Bs[(kc + 6) * 132 + row] = bflo(vb.w); Bs[(kc + 7) * 132 + row] = bfhi(vb.w); }
            __syncthreads();
#pragma unroll 8
            for (int kk = 0; kk < 32; ++kk) {
                const f32x4 a4 = *(const f32x4*)(As + kk * 132 + ty * 4);
                const f32x4 b0 = *(const f32x4*)(Bs + kk * 132 + tx * 8), b1 = *(const f32x4*)(Bs + kk * 132 + tx * 8 + 4);
#pragma unroll
                for (int i = 0; i < 4; ++i) {
#pragma unroll
                    for (int j = 0; j < 4; ++j) { acc[i][j] += a4[i] * b0[j]; acc[i][4 + j] += a4[i] * b1[j]; }
                }
            }
            __syncthreads();
        }
#pragma unroll
        for (int i = 0; i < 4; ++i) { const f32x2 r = f(tm * 128 + ty * 4 + i, tn * 128 + tx * 8, (f32x4){acc[i][0], acc[i][1], acc[i][2], acc[i][3]}, (f32x4){acc[i][4], acc[i][5], acc[i][6], acc[i][7]}); if (F::NSTAT >= 1) f.commit(tm * 128 + ty * 4 + i, r.x, r.y); }
    }
}

template <class F> __device__ __forceinline__ void gemm_any(unsigned char* lds, const bf16_t* A, const bf16_t* Bt, int Mm, int N, int K, const F& f) {
#if USE_PG8
    pg8::Gemm g{A, Bt, Mm, N, K}; pg8::StaticOrder S; S.init(Mm, N, (int)gridDim.x, (int)blockIdx.x);
    EpiAdapt<F> E{f};
    pg8::gemm_phase<EpiAdapt<F>, pg8::StaticOrder, true, true>((PG8_LAS unsigned char*)lds, g, S, E);
#else
    gemm_naive((float*)lds, A, Bt, Mm, N, K, f);
#endif
}

typedef short pbf16x8 __attribute__((ext_vector_type(8)));
template <int CTRL> __device__ __forceinline__ float pdpp_add(float x) { return x + __uint_as_float(__builtin_amdgcn_update_dpp(0, __float_as_uint(x), CTRL, 0xf, 0xf, true)); }
__device__ __forceinline__ float wave_sum_dpp(float x) {
    x = pdpp_add<0x128>(x); x = pdpp_add<0x124>(x); x = pdpp_add<0x122>(x); x = pdpp_add<0x121>(x);
    const unsigned u = __float_as_uint(x);
    return (__uint_as_float(__builtin_amdgcn_readlane(u, 0)) + __uint_as_float(__builtin_amdgcn_readlane(u, 16))) + (__uint_as_float(__builtin_amdgcn_readlane(u, 32)) + __uint_as_float(__builtin_amdgcn_readlane(u, 48)));
}
__device__ __forceinline__ void phase_prep(const Args& a, unsigned char* ldsb) {
    const int tid = threadIdx.x, lane = tid & 63, wave = tid >> 6, fr = lane & 15, quad = lane >> 4;
    unsigned char* ws = a.ws;
    const bf16_t* PA = (const bf16_t*)(ws + WS_PA);
    bf16_t* R = (bf16_t*)a.out; bf16_t* KP = R + (size_t)M * 512; bf16_t* V = KP + (size_t)M * 512; bf16_t* AN = V + (size_t)M * 512;
    bf16_t* YM = (bf16_t*)(ws + WS_YMIX); float* DEC = (float*)(ws + WS_XN); float* BON = (float*)(ws + WS_BON);
    const float* mu = a.in[I_SHMU];
    LAS unsigned char* lds = (LAS unsigned char*)ldsb;
    constexpr int XPB = 272;
    constexpr int RES_OFF = 4352;
    if (blockIdx.x == 0 && tid == 0) *(unsigned*)(ws + WS_CTR) = 0u;
    const int c = tid;
    const float w0 = a.in[I_W0][c], a0 = a.in[I_A0][c], kkc = a.in[I_KK][c], kac = a.in[I_KA][c], rkc = a.in[I_RK][c];
    const float mur = mu[c], muk = mu[512 + c], muv = mu[1024 + c];
    const bf16_t* LW = (const bf16_t*)(ws + WS_LW);
    pbf16x8 wf[2][4][2];
#pragma unroll
    for (int mat = 0; mat < 2; ++mat)
#pragma unroll
        for (int mt = 0; mt < 4; ++mt)
#pragma unroll
            for (int ks = 0; ks < 2; ++ks) wf[mat][mt][ks] = *(const pbf16x8*)(LW + (size_t)(mat * 512 + wave * 64 + mt * 16 + fr) * 64 + ks * 32 + 8 * quad);
    const int stok = tid >> 5, sj4 = (tid & 31) * 4;
    const f32x4 smu = *(const f32x4*)(mu + 1536 + sj4);
    for (int u = blockIdx.x; u < M / 16; u += gridDim.x) {
        const int t0 = u * 16;
        {   const int t = t0 + stok; const bool first = (t % SEQ) == 0;
            const u32x2 pw = *(const u32x2*)(PA + (size_t)t * NA + 1536 + sj4);
            u32x2 qw = pw; if (!first) qw = *(const u32x2*)(PA + (size_t)(t - 1) * NA + 1536 + sj4);
            float x0 = bflo(pw.x), x1 = bfhi(pw.x), x2 = bflo(pw.y), x3 = bfhi(pw.y);
            const float y0 = first ? 0.f : bflo(qw.x), y1 = first ? 0.f : bfhi(qw.x), y2 = first ? 0.f : bflo(qw.y), y3 = first ? 0.f : bfhi(qw.y);
            x0 += (y0 - x0) * smu.x; x1 += (y1 - x1) * smu.y; x2 += (y2 - x2) * smu.z; x3 += (y3 - x3) * smu.w;
            if (sj4 < 64) { x0 = 1.0f - 2.0f / (__expf(2.0f * x0) + 1.0f); x1 = 1.0f - 2.0f / (__expf(2.0f * x1) + 1.0f); x2 = 1.0f - 2.0f / (__expf(2.0f * x2) + 1.0f); x3 = 1.0f - 2.0f / (__expf(2.0f * x3) + 1.0f); }
            u32x2 o; o.x = pk2(x0, x1); o.y = pk2(x2, x3);
            *(LAS u32x2*)(lds + stok * XPB + sj4 * 2) = o; }
        __syncthreads();
#pragma unroll
        for (int mat = 0; mat < 2; ++mat)
#pragma unroll
            for (int mt = 0; mt < 4; ++mt) {
                f32x4 acc = (f32x4){0.f, 0.f, 0.f, 0.f};
#pragma unroll
                for (int ks = 0; ks < 2; ++ks) { const pbf16x8 xf = *(const LAS pbf16x8*)(lds + fr * XPB + (mat * 64 + ks * 32 + 8 * quad) * 2); acc = __builtin_amdgcn_mfma_f32_16x16x32_bf16(wf[mat][mt][ks], xf, acc, 0, 0, 0); }
                *(LAS f32x4*)(lds + RES_OFF + ((mat * 16 + fr) * 512 + wave * 64 + mt * 16 + 4 * quad) * 4) = acc;
            }
        __syncthreads();
        float rp, kp_, vp;
        { const bool first = (t0 % SEQ) == 0; const bf16_t* q = PA + (size_t)(t0 - 1) * NA;
          rp = first ? 0.f : bf2f(q[c]); kp_ = first ? 0.f : bf2f(q[512 + c]); vp = first ? 0.f : bf2f(q[1024 + c]); }
#pragma unroll 4
        for (int i = 0; i < 16; ++i) {
            const int t = t0 + i;
            const bf16_t* p = PA + (size_t)t * NA;
            const float rc = bf2f(p[c]), kc = bf2f(p[512 + c]), vc = bf2f(p[1024 + c]);
            const float r = rc + (rp - rc) * mur, k = kc + (kp_ - kc) * muk, v = vc + (vp - vc) * muv;
            rp = rc; kp_ = kc; vp = vc;
            const float z = *(const LAS float*)(lds + RES_OFF + (i * 512 + c) * 4) + w0;
            const float za = *(const LAS float*)(lds + RES_OFF + ((16 + i) * 512 + c) * 4) + a0;
            const float sp = fmaxf(-z, 0.f) + __logf(1.0f + __expf(-fabsf(z)));
            const float w = -sp - 0.5f;
            const float dec = __expf(-__expf(w));
            const float av = sigmoidf_(za);
            float kk = k * kkc; const float ss = wave_sum_dpp(kk * kk); kk = kk / fmaxf(sqrtf(ss), 1e-12f);
            const float kn = k * (1.0f + (av - 1.0f) * kac);
            const float bon = wave_sum_dpp(r * kn * rkc);
            const size_t o = (size_t)t * 512 + c;
            R[o] = f2bf(r); KP[o] = f2bf(kn); V[o] = f2bf(v); AN[o] = f2bf(-kk); YM[(size_t)t * 1024 + c] = f2bf(kk * av); DEC[o] = dec;
            if (lane == 0) BON[t * 8 + wave] = bon;
        }
    }
}

__device__ __forceinline__ float rdlane(float x, int k) { return __uint_as_float(__builtin_amdgcn_readlane(__float_as_uint(x), k)); }
__device__ __forceinline__ void phase_scan_naive(const Args& a) {
    const int tid = threadIdx.x, lane = tid & 63, wave = tid >> 6;
    if (wave != 0) return;
    unsigned char* ws = a.ws;
    const bf16_t* R = (const bf16_t*)a.out; const bf16_t* KP = R + (size_t)M * 512; const bf16_t* V = KP + (size_t)M * 512; const bf16_t* AN = V + (size_t)M * 512;
    bf16_t* YM = (bf16_t*)(ws + WS_YMIX); const float* DEC = (const float*)(ws + WS_XN); const float* BON = (const float*)(ws + WS_BON);
    const bf16_t* PB = (const bf16_t*)(ws + WS_PB);
    for (int u = blockIdx.x; u < BATCH * 8; u += gridDim.x) {
        const int b = u >> 3, h = u & 7;
        const float lg = a.in[I_LNXG][h * 64 + lane], lb = a.in[I_LNXB][h * 64 + lane];
        float s[64];
#pragma unroll
        for (int k = 0; k < 64; ++k) s[k] = 0.f;
        for (int t = 0; t < SEQ; ++t) {
            const int tok = b * SEQ + t; const size_t o = (size_t)tok * 512 + h * 64 + lane;
            const float ca = bf2f(AN[o]), cw = DEC[o], cb = bf2f(YM[(size_t)tok * 1024 + h * 64 + lane]), ck = bf2f(KP[o]), cr = bf2f(R[o]), vv = bf2f(V[o]);
            float sa = 0.f;
#pragma unroll
            for (int k = 0; k < 64; ++k) sa += s[k] * rdlane(ca, k);
            float y = 0.f;
#pragma unroll
            for (int k = 0; k < 64; ++k) { s[k] = s[k] * rdlane(cw, k) + sa * rdlane(cb, k) + vv * rdlane(ck, k); y += s[k] * rdlane(cr, k); }
            const float mean = wave_sum(y) * (1.0f / 64.0f); const float d = y - mean; const float var = wave_sum(d * d) * (1.0f / 64.0f);
            float yn = d * rsqrtf(var + GN_EPS) * lg + lb;
            yn += BON[tok * 8 + h] * vv;
            const float g = bf2f(PB[(size_t)tok * NB + h * 64 + lane]);
            YM[(size_t)tok * 1024 + h * 64 + lane] = f2bf(yn * siluf_(g));
        }
    }
}

__device__ __forceinline__ void phase_attn_naive(const Args& a) {
    const int tid = threadIdx.x, lane = tid & 63, wave = tid >> 6;
    unsigned char* ws = a.ws;
    const bf16_t* PB = (const bf16_t*)(ws + WS_PB); bf16_t* YM = (bf16_t*)(ws + WS_YMIX);
    for (int u = blockIdx.x * 8 + wave; u < BATCH * 8 * 32; u += gridDim.x * 8) {
        const int c = u & 31, h = (u >> 5) & 7, b = u >> 8;
        const int t = b * SEQ + c * 64 + lane;
        float q[64], acc[64];
        { const u32x4* qp = (const u32x4*)(PB + (size_t)t * NB + 512 + h * 64);
#pragma unroll
          for (int i = 0; i < 8; ++i) { const u32x4 w = qp[i]; q[8 * i] = bflo(w.x) * 0.125f; q[8 * i + 1] = bfhi(w.x) * 0.125f; q[8 * i + 2] = bflo(w.y) * 0.125f; q[8 * i + 3] = bfhi(w.y) * 0.125f;
              q[8 * i + 4] = bflo(w.z) * 0.125f; q[8 * i + 5] = bfhi(w.z) * 0.125f; q[8 * i + 6] = bflo(w.w) * 0.125f; q[8 * i + 7] = bfhi(w.w) * 0.125f; } }
#pragma unroll
        for (int d = 0; d < 64; ++d) acc[d] = 0.f;
        float m = -1e30f, l = 0.f;
        const float* bt = a.in[I_ABIAS] + h * 257;
        const int k0 = (c - 8 > 0 ? c - 8 : 0) * 64, k1 = (c + 1) * 64;
        for (int kj = k0; kj < k1; ++kj) {
            const bf16_t* kr = PB + (size_t)(b * SEQ + kj) * NB + 1024 + h * 64;
            float s = 0.f;
#pragma unroll
            for (int i = 0; i < 8; ++i) { const u32x4 w = ((const u32x4*)kr)[i];
                s += q[8 * i] * bflo(w.x) + q[8 * i + 1] * bfhi(w.x) + q[8 * i + 2] * bflo(w.y) + q[8 * i + 3] * bfhi(w.y) + q[8 * i + 4] * bflo(w.z) + q[8 * i + 5] * bfhi(w.z) + q[8 * i + 6] * bflo(w.w) + q[8 * i + 7] * bfhi(w.w); }
            int rel = c * 64 + lane - kj; rel = rel < -128 ? -128 : (rel > 128 ? 128 : rel);
            s += bt[rel + 128];
            const float mn = fmaxf(m, s), al = __expf(m - mn), p = __expf(s - mn);
            l = l * al + p; m = mn;
            const bf16_t* vr = kr + 512;
#pragma unroll
            for (int i = 0; i < 8; ++i) { const u32x4 w = ((const u32x4*)vr)[i];
                acc[8 * i] = acc[8 * i] * al + p * bflo(w.x); acc[8 * i + 1] = acc[8 * i + 1] * al + p * bfhi(w.x); acc[8 * i + 2] = acc[8 * i + 2] * al + p * bflo(w.y); acc[8 * i + 3] = acc[8 * i + 3] * al + p * bfhi(w.y);
                acc[8 * i + 4] = acc[8 * i + 4] * al + p * bflo(w.z); acc[8 * i + 5] = acc[8 * i + 5] * al + p * bfhi(w.z); acc[8 * i + 6] = acc[8 * i + 6] * al + p * bflo(w.w); acc[8 * i + 7] = acc[8 * i + 7] * al + p * bfhi(w.w); }
        }
        const float il = 1.0f / l;
        const u32x4* gp = (const u32x4*)(PB + (size_t)t * NB + 2048 + h * 64);
        u32x4* op = (u32x4*)(YM + (size_t)t * 1024 + 512 + h * 64);
#pragma unroll
        for (int i = 0; i < 8; ++i) { const u32x4 g = gp[i]; u32x4 o;
            o.x = pk2(acc[8 * i] * il * siluf_(bflo(g.x)), acc[8 * i + 1] * il * siluf_(bfhi(g.x))); o.y = pk2(acc[8 * i + 2] * il * siluf_(bflo(g.y)), acc[8 * i + 3] * il * siluf_(bfhi(g.y)));
            o.z = pk2(acc[8 * i + 4] * il * siluf_(bflo(g.z)), acc[8 * i + 5] * il * siluf_(bfhi(g.z))); o.w = pk2(acc[8 * i + 6] * il * siluf_(bflo(g.w)), acc[8 * i + 7] * il * siluf_(bfhi(g.w)));
            op[i] = o; }
    }
}


typedef _Float16 h8 __attribute__((ext_vector_type(8)));
typedef _Float16 h4 __attribute__((ext_vector_type(4)));
typedef short bf16x8 __attribute__((ext_vector_type(8)));
template <int CTRL> __device__ __forceinline__ float dpp_add(float x) { return x + __uint_as_float(__builtin_amdgcn_update_dpp(0, __float_as_uint(x), CTRL, 0xf, 0xf, true)); }
__device__ __forceinline__ float red8(float x) { x = dpp_add<0xB1>(x); x = dpp_add<0x4E>(x); x = dpp_add<0x141>(x); return x; }
__device__ __forceinline__ float red16(float x) { x = dpp_add<0x128>(x); x = dpp_add<0x124>(x); x = dpp_add<0x122>(x); x = dpp_add<0x121>(x); return x; }
constexpr int SC_PH = 0, SC_VV = 40960, SC_SC = 57344, SC_YY = 57856;
constexpr int TC = 32;

__device__ __forceinline__ void scan_unit(const Args& a, LAS unsigned char* lds, int u) {
    const int tid = threadIdx.x, lane = tid & 63, wave = tid >> 6;
    const int b = u >> 3, h = u & 7;
    unsigned char* ws = a.ws;
    const bf16_t* R = (const bf16_t*)a.out; const bf16_t* KP = R + (size_t)M * 512; const bf16_t* V = KP + (size_t)M * 512; const bf16_t* AN = V + (size_t)M * 512;
    bf16_t* YM = (bf16_t*)(ws + WS_YMIX); const float* DEC = (const float*)(ws + WS_XN); const float* BON = (const float*)(ws + WS_BON);
    const bf16_t* PB = (const bf16_t*)(ws + WS_PB);
    const int st = tid >> 4, sq = tid & 15;
    const int row = wave * 8 + (lane >> 3), cg = lane & 7;
    const int colbase = h * 64 + 4 * sq;
    const f32x4 lg = *(const f32x4*)(a.in[I_LNXG] + colbase), lb = *(const f32x4*)(a.in[I_LNXB] + colbase);
    float s[8];
#pragma unroll
    for (int j = 0; j < 8; ++j) s[j] = 0.f;
    u32x2 gR, gK, gV, gA, gB; f32x4 gD;
#define SC_GLOAD(c) do { const size_t tok_ = (size_t)b * SEQ + (c) * TC + st; const size_t o_ = tok_ * 512 + colbase; \
        gR = *(const u32x2*)(R + o_); gK = *(const u32x2*)(KP + o_); gV = *(const u32x2*)(V + o_); gA = *(const u32x2*)(AN + o_); \
        gB = *(const u32x2*)(YM + tok_ * 1024 + colbase); gD = *(const f32x4*)(DEC + o_); } while (0)
#define SC_STAGE(buf) do { \
        const float r0 = bflo(gR.x), r1 = bfhi(gR.x), r2 = bflo(gR.y), r3 = bfhi(gR.y); \
        const float k0 = bflo(gK.x), k1 = bfhi(gK.x), k2 = bflo(gK.y), k3 = bfhi(gK.y); \
        const float b0 = bflo(gB.x), b1 = bfhi(gB.x), b2 = bflo(gB.y), b3 = bfhi(gB.y); \
        LAS h4* ph4 = (LAS h4*)(lds + SC_PH) + (size_t)(((buf) * TC + st) * 5) * 16 + sq; \
        ph4[0]  = (h4){(_Float16)bflo(gA.x), (_Float16)bfhi(gA.x), (_Float16)bflo(gA.y), (_Float16)bfhi(gA.y)}; \
        ph4[16] = (h4){(_Float16)(1.0f - gD.x), (_Float16)(1.0f - gD.y), (_Float16)(1.0f - gD.z), (_Float16)(1.0f - gD.w)}; \
        ph4[32] = (h4){(_Float16)b0, (_Float16)b1, (_Float16)b2, (_Float16)b3}; \
        ph4[48] = (h4){(_Float16)k0, (_Float16)k1, (_Float16)k2, (_Float16)k3}; \
        ph4[64] = (h4){(_Float16)(gD.x * r0), (_Float16)(gD.y * r1), (_Float16)(gD.z * r2), (_Float16)(gD.w * r3)}; \
        *((LAS f32x4*)(lds + SC_VV) + ((buf) * TC + st) * 16 + sq) = (f32x4){bflo(gV.x), bfhi(gV.x), bflo(gV.y), bfhi(gV.y)}; \
        float br_ = (b0 * r0 + b1 * r1) + (b2 * r2 + b3 * r3), kr_ = (k0 * r0 + k1 * r1) + (k2 * r2 + k3 * r3); \
        br_ = red16(br_); kr_ = red16(kr_); \
        if (sq == 0) *((LAS f32x2*)(lds + SC_SC) + (buf) * TC + st) = (f32x2){br_, kr_}; } while (0)
    SC_GLOAD(0); SC_STAGE(0);
    __syncthreads();
    for (int c = 0; c < SEQ / TC; ++c) {
        const int buf = c & 1;
        if (c + 1 < SEQ / TC) SC_GLOAD(c + 1);
        const size_t tokE = (size_t)b * SEQ + c * TC + st;
        const u32x2 gG = *(const u32x2*)(PB + tokE * NB + colbase);
        const float bon = BON[tokE * 8 + h];
        {
            const LAS h8* ph8 = (const LAS h8*)(lds + SC_PH) + buf * TC * 40 + cg;
            const LAS float* vvp = (const LAS float*)(lds + SC_VV) + buf * TC * 64 + row;
            const LAS f32x2* scp = (const LAS f32x2*)(lds + SC_SC) + buf * TC;
            LAS float* yyp = (LAS float*)(lds + SC_YY) + row;
            h8 cA = ph8[0], cE = ph8[8], cB = ph8[16], cK = ph8[24], cW = ph8[32]; float cv = vvp[0]; f32x2 cs = scp[0];
#pragma unroll 2
            for (int t = 0; t < TC; ++t) {
                const int tn = (t + 1 < TC) ? t + 1 : t;
                const h8 nA = ph8[tn * 40], nE = ph8[tn * 40 + 8], nB = ph8[tn * 40 + 16], nK = ph8[tn * 40 + 24], nW = ph8[tn * 40 + 32]; const float nv = vvp[tn * 64]; const f32x2 ns = scp[tn];
                float sa0 = 0.f, sa1 = 0.f, yw0 = 0.f, yw1 = 0.f;
#pragma unroll
                for (int j = 0; j < 4; ++j) { sa0 = __builtin_fmaf(s[j], (float)cA[j], sa0); sa1 = __builtin_fmaf(s[4 + j], (float)cA[4 + j], sa1);
                                              yw0 = __builtin_fmaf(s[j], (float)cW[j], yw0); yw1 = __builtin_fmaf(s[4 + j], (float)cW[4 + j], yw1); }
                float sa = red8(sa0 + sa1), yw = red8(yw0 + yw1);
#pragma unroll
                for (int j = 0; j < 8; ++j) { float uu = __builtin_fmaf(sa, (float)cB[j], s[j]); uu = __builtin_fmaf(cv, (float)cK[j], uu); s[j] = __builtin_fmaf(-(float)cE[j], s[j], uu); }
                const float y = yw + sa * cs.x + cv * cs.y;
                yyp[t * 64] = y;
                cA = nA; cE = nE; cB = nB; cK = nK; cW = nW; cv = nv; cs = ns;
            }
        }
        __syncthreads();
        {
            const f32x4 y4 = *((const LAS f32x4*)(lds + SC_YY) + st * 16 + sq);
            const f32x4 v4 = *((const LAS f32x4*)(lds + SC_VV) + (buf * TC + st) * 16 + sq);
            const float mean = red16((y4.x + y4.y) + (y4.z + y4.w)) * (1.0f / 64.0f);
            const f32x4 d = y4 - mean;
            const float var = red16((d.x * d.x + d.y * d.y) + (d.z * d.z + d.w * d.w)) * (1.0f / 64.0f);
            const float rstd = rsqrtf(var + GN_EPS);
            f32x4 o = d * rstd * lg + lb + v4 * bon;
            o.x *= siluf_(bflo(gG.x)); o.y *= siluf_(bfhi(gG.x)); o.z *= siluf_(bflo(gG.y)); o.w *= siluf_(bfhi(gG.y));
            u32x2 w; w.x = pk2(o.x, o.y); w.y = pk2(o.z, o.w);
            *(u32x2*)(YM + tokE * 1024 + colbase) = w;
        }
        if (c + 1 < SEQ / TC) SC_STAGE(buf ^ 1);
        __syncthreads();
    }
#undef SC_GLOAD
#undef SC_STAGE
}

constexpr int AT_KS = 0, AT_VT = 18432, AT_BT = 36864, AT_PITCH = 144;
__device__ __forceinline__ void attn_unit(const Args& a, LAS unsigned char* lds, int u) {
    const int tid = threadIdx.x, lane = tid & 63, wave = tid >> 6, fr = lane & 15, quad = lane >> 4;
    const int cp = u & 15, h = (u >> 4) & 7, b = u >> 7;
    unsigned char* ws = a.ws;
    const bf16_t* PB = (const bf16_t*)(ws + WS_PB); bf16_t* YM = (bf16_t*)(ws + WS_YMIX);
    const int c0 = 2 * cp, cq = c0 + (wave >> 2), qrow = (wave & 3) * 16 + fr;
    const size_t tq = (size_t)b * SEQ + cq * 64 + qrow;
    constexpr float LOG2E = 1.4426950408889634f;
    if (tid < 257) ((LAS float*)(lds + AT_BT))[tid] = a.in[I_ABIAS][h * 257 + tid] * LOG2E;
    bf16x8 qf[2];
    qf[0] = *(const bf16x8*)(PB + tq * NB + 512 + h * 64 + 8 * quad); qf[1] = *(const bf16x8*)(PB + tq * NB + 512 + h * 64 + 32 + 8 * quad);
    f32x4 O[4];
#pragma unroll
    for (int i = 0; i < 4; ++i) O[i] = (f32x4){0.f, 0.f, 0.f, 0.f};
    float m = -1e30f, l = 0.f;
    const int kfirst = c0 - 8 > 0 ? c0 - 8 : 0, klast = c0 + 1;
    const int kkey = tid >> 3, kdch = tid & 7;
    const int vkey = tid & 63, vdch = tid >> 6;
    const int vpos = (vkey & 32) + 8 * ((vkey >> 2) & 3) + 4 * ((vkey >> 4) & 1) + (vkey & 3);
    u32x4 gk, gv;
#define AT_GLD(kc) do { gk = *(const u32x4*)(PB + ((size_t)b * SEQ + (kc) * 64 + kkey) * NB + 1024 + h * 64 + kdch * 8); \
                        gv = *(const u32x4*)(PB + ((size_t)b * SEQ + (kc) * 64 + vkey) * NB + 1536 + h * 64 + vdch * 8); } while (0)
#define AT_SST(buf) do { *(LAS u32x4*)(lds + AT_KS + (buf) * 9216 + kkey * AT_PITCH + kdch * 16) = gk; \
        LAS unsigned short* vt_ = (LAS unsigned short*)(lds + AT_VT + (buf) * 9216) + (vdch * 8) * (AT_PITCH / 2) + vpos; \
        vt_[0 * 72] = (unsigned short)(gv.x & 0xffffu); vt_[1 * 72] = (unsigned short)(gv.x >> 16); vt_[2 * 72] = (unsigned short)(gv.y & 0xffffu); vt_[3 * 72] = (unsigned short)(gv.y >> 16); \
        vt_[4 * 72] = (unsigned short)(gv.z & 0xffffu); vt_[5 * 72] = (unsigned short)(gv.z >> 16); vt_[6 * 72] = (unsigned short)(gv.w & 0xffffu); vt_[7 * 72] = (unsigned short)(gv.w >> 16); } while (0)
    AT_GLD(kfirst); AT_SST(0);
    __syncthreads();
    for (int kc = kfirst; kc <= klast; ++kc) {
        const int buf = (kc - kfirst) & 1;
        if (kc < klast) AT_GLD(kc + 1);
        if (kc <= cq && kc >= cq - 8) {
            const LAS unsigned char* ks = lds + AT_KS + buf * 9216 + fr * AT_PITCH + quad * 16;
            const LAS unsigned char* vt = lds + AT_VT + buf * 9216 + fr * AT_PITCH + quad * 16;
            f32x4 sc[4];
#pragma unroll
            for (int kt = 0; kt < 4; ++kt) {
                sc[kt] = (f32x4){0.f, 0.f, 0.f, 0.f};
#pragma unroll
                for (int k2 = 0; k2 < 2; ++k2) { const bf16x8 kf = *(const LAS bf16x8*)(ks + kt * 16 * AT_PITCH + k2 * 64); sc[kt] = __builtin_amdgcn_mfma_f32_16x16x32_bf16(kf, qf[k2], sc[kt], 0, 0, 0); }
            }
            const int dch = cq - kc;
            const LAS float* bt = (const LAS float*)(lds + AT_BT);
            float mx = -1e30f;
            if (dch >= 3) {
                const float bc = bt[256];
#pragma unroll
                for (int kt = 0; kt < 4; ++kt)
#pragma unroll
                    for (int j = 0; j < 4; ++j) { sc[kt][j] = __builtin_fmaf(sc[kt][j], 0.125f * LOG2E, bc); mx = fmaxf(mx, sc[kt][j]); }
            } else {
                const int base = dch * 64 + qrow + 128 - 4 * quad;
#pragma unroll
                for (int kt = 0; kt < 4; ++kt)
#pragma unroll
                    for (int j = 0; j < 4; ++j) { int idx = base - kt * 16 - j; idx = idx > 256 ? 256 : idx; sc[kt][j] = __builtin_fmaf(sc[kt][j], 0.125f * LOG2E, bt[idx]); mx = fmaxf(mx, sc[kt][j]); }
            }
            mx = fmaxf(mx, __shfl_xor(mx, 16)); mx = fmaxf(mx, __shfl_xor(mx, 32));
            const float mn = fmaxf(m, mx), al = __builtin_amdgcn_exp2f(m - mn); m = mn;
            float ps = 0.f;
#pragma unroll
            for (int kt = 0; kt < 4; ++kt)
#pragma unroll
                for (int j = 0; j < 4; ++j) { sc[kt][j] = __builtin_amdgcn_exp2f(sc[kt][j] - mn); ps += sc[kt][j]; }
            l = l * al + ps;
#pragma unroll
            for (int i = 0; i < 4; ++i) O[i] = O[i] * al;
#pragma unroll
            for (int s2 = 0; s2 < 2; ++s2) {
                u32x4 pw; pw.x = pk2(sc[2 * s2][0], sc[2 * s2][1]); pw.y = pk2(sc[2 * s2][2], sc[2 * s2][3]); pw.z = pk2(sc[2 * s2 + 1][0], sc[2 * s2 + 1][1]); pw.w = pk2(sc[2 * s2 + 1][2], sc[2 * s2 + 1][3]);
                const bf16x8 pf = __builtin_bit_cast(bf16x8, pw);
#pragma unroll
                for (int dt = 0; dt < 4; ++dt) { const bf16x8 vf = *(const LAS bf16x8*)(vt + dt * 16 * AT_PITCH + s2 * 64); O[dt] = __builtin_amdgcn_mfma_f32_16x16x32_bf16(vf, pf, O[dt], 0, 0, 0); }
            }
        }
        if (kc < klast) AT_SST(buf ^ 1);
        __syncthreads();
    }
#undef AT_GLD
#undef AT_SST
    l += __shfl_xor(l, 16); l += __shfl_xor(l, 32);
    const float il = 1.0f / l;
#pragma unroll
    for (int dt = 0; dt < 4; ++dt) {
        const int dcol = h * 64 + dt * 16 + 4 * quad;
        const u32x2 g = *(const u32x2*)(PB + tq * NB + 2048 + dcol);
        const f32x4 o = O[dt] * il;
        u32x2 w; w.x = pk2(o[0] * siluf_(bflo(g.x)), o[1] * siluf_(bfhi(g.x))); w.y = pk2(o[2] * siluf_(bflo(g.y)), o[3] * siluf_(bfhi(g.y)));
        *(u32x2*)(YM + tq * 1024 + 512 + dcol) = w;
    }
}

__device__ __forceinline__ void phase_mix(const Args& a, LAS unsigned char* lds, bool do_scan = true, bool do_attn = true) {
    unsigned* ctr = (unsigned*)(a.ws + WS_CTR);
    if (do_scan) for (int u = blockIdx.x; u < BATCH * 8; u += gridDim.x) scan_unit(a, lds, u);
    LAS int* uw = (LAS int*)(lds + 40000);
    if (do_attn) for (;;) {
        __syncthreads();
        if (threadIdx.x == 0) *uw = (int)atomicAdd(ctr, 1u);
        __syncthreads();
        const int u = *uw;
        if (u >= BATCH * 8 * 16) break;
        attn_unit(a, lds, u);
    }
}

__device__ __forceinline__ void phase_sg_naive(const Args& a, unsigned char* ldsb) {
    const int tid = threadIdx.x;
    unsigned char* ws = a.ws;
    const bf16_t* P1 = (const bf16_t*)(ws + WS_P1); bf16_t* Y2 = (bf16_t*)(ws + WS_YMIX);
    const float* vsum = (const float*)(ws + WS_VSUM); const float* vsq = (const float*)(ws + WS_VSQ);
    float* vn = (float*)ldsb;
    const int c = tid & 127, i0 = tid >> 7;
    for (int u = blockIdx.x; u < BATCH * 16 * 8; u += gridDim.x) {
        const int g = u & 7, nb = (u >> 3) & 15, b = u >> 7;
        const int tbase = b * SEQ + nb * 128;
        const float lg = a.in[I_SGLNG][g * 128 + c], lb = a.in[I_SGLNB][g * 128 + c];
        for (int j = i0; j < 128; j += 4) {
            const int t = tbase + j; const float mean = vsum[t] * (1.0f / 1024.0f); const float var = vsq[t] * (1.0f / 1024.0f) - mean * mean;
            const float rstd = rsqrtf(fmaxf(var, 0.f) + LN_EPS);
            vn[j * 128 + c] = (bf2f(P1[(size_t)t * N3 + 1024 + g * 128 + c]) - mean) * rstd * lg + lb;
        }
        __syncthreads();
        const float* wg = a.in[I_SGW] + (size_t)g * 128 * 128; const float* sb = a.in[I_SGB] + g * 128;
        for (int i = i0; i < 128; i += 4) {
            const int jend = (i < 64) ? 64 : 128;
            float acc = 0.f;
            for (int j = 0; j < jend; ++j) acc += wg[i * 128 + j] * vn[j * 128 + c];
            const int t = tbase + i;
            const float uu = bf2f(P1[(size_t)t * N3 + g * 128 + c]), gt = bf2f(P1[(size_t)t * N3 + 2048 + g * 128 + c]);
            Y2[(size_t)t * 1024 + g * 128 + c] = f2bf(uu * (acc + sb[i]) * gt);
        }
        __syncthreads();
    }
}


__device__ __forceinline__ void phase_sg(const Args& a, LAS unsigned char* lds) {
    const int tid = threadIdx.x, lane = tid & 63, wave = tid >> 6, fr = lane & 15, quad = lane >> 4;
    unsigned char* ws = a.ws;
    const bf16_t* P1 = (const bf16_t*)(ws + WS_P1); bf16_t* Y2 = (bf16_t*)(ws + WS_YMIX); const bf16_t* SGW = (const bf16_t*)(ws + WS_SGW);
    const float* vsum = (const float*)(ws + WS_VSUM); const float* vsq = (const float*)(ws + WS_VSQ);
    constexpr int VPB = 272;
    const int sj = tid & 127, scc = tid >> 7;
    constexpr int NUN = BATCH * 16 * 8;
    const int per = (NUN + (int)gridDim.x - 1) / (int)gridDim.x;
    const int u0 = blockIdx.x * per, u1 = (u0 + per < NUN) ? u0 + per : NUN;
    for (int u = u0; u < u1; ++u) {
        const int g = u >> 8, b = (u >> 4) & 15, nb = u & 15;
        const int tbase = b * SEQ + nb * 128;
        {
            const int t = tbase + sj; const float mean = vsum[t] * (1.0f / 1024.0f); const float var = vsq[t] * (1.0f / 1024.0f) - mean * mean;
            const float rstd = rsqrtf(fmaxf(var, 0.f) + LN_EPS);
#pragma unroll
            for (int q = 0; q < 4; ++q) {
                const int c8 = (scc + 4 * q) * 8;
                const u32x4 w = *(const u32x4*)(P1 + (size_t)t * N3 + 1024 + g * 128 + c8);
                const f32x4 g0 = *(const f32x4*)(a.in[I_SGLNG] + g * 128 + c8), g1 = *(const f32x4*)(a.in[I_SGLNG] + g * 128 + c8 + 4);
                const f32x4 b0 = *(const f32x4*)(a.in[I_SGLNB] + g * 128 + c8), b1 = *(const f32x4*)(a.in[I_SGLNB] + g * 128 + c8 + 4);
                LAS unsigned short* vt = (LAS unsigned short*)lds + c8 * (VPB / 2) + sj;
                vt[0 * (VPB / 2)] = f2bf((bflo(w.x) - mean) * rstd * g0.x + b0.x); vt[1 * (VPB / 2)] = f2bf((bfhi(w.x) - mean) * rstd * g0.y + b0.y);
                vt[2 * (VPB / 2)] = f2bf((bflo(w.y) - mean) * rstd * g0.z + b0.z); vt[3 * (VPB / 2)] = f2bf((bfhi(w.y) - mean) * rstd * g0.w + b0.w);
                vt[4 * (VPB / 2)] = f2bf((bflo(w.z) - mean) * rstd * g1.x + b1.x); vt[5 * (VPB / 2)] = f2bf((bfhi(w.z) - mean) * rstd * g1.y + b1.y);
                vt[6 * (VPB / 2)] = f2bf((bflo(w.w) - mean) * rstd * g1.z + b1.z); vt[7 * (VPB / 2)] = f2bf((bfhi(w.w) - mean) * rstd * g1.w + b1.w);
            }
        }
        const int irow = 16 * wave + fr;
        bf16x8 wf[4];
#pragma unroll
        for (int ks = 0; ks < 4; ++ks) wf[ks] = *(const bf16x8*)(SGW + (size_t)(g * 128 + irow) * 128 + ks * 32 + 8 * quad);
        __syncthreads();
        f32x4 acc[8];
#pragma unroll
        for (int ct = 0; ct < 8; ++ct) {
            acc[ct] = (f32x4){0.f, 0.f, 0.f, 0.f};
#pragma unroll
            for (int ks = 0; ks < 4; ++ks) {
                if (ks < 2 || wave >= 4) { const bf16x8 vf = *(const LAS bf16x8*)(lds + (ct * 16 + fr) * VPB + ks * 64 + quad * 16); acc[ct] = __builtin_amdgcn_mfma_f32_16x16x32_bf16(vf, wf[ks], acc[ct], 0, 0, 0); }
            }
        }
        const size_t t = (size_t)tbase + irow; const float sbv = a.in[I_SGB][g * 128 + irow];
#pragma unroll
        for (int ct = 0; ct < 8; ++ct) {
            const int col = g * 128 + ct * 16 + 4 * quad;
            const u32x2 uu = *(const u32x2*)(P1 + t * N3 + col), gg = *(const u32x2*)(P1 + t * N3 + 2048 + col);
            u32x2 w; w.x = pk2(bflo(uu.x) * (acc[ct][0] + sbv) * bflo(gg.x), bfhi(uu.x) * (acc[ct][1] + sbv) * bfhi(gg.x));
            w.y = pk2(bflo(uu.y) * (acc[ct][2] + sbv) * bflo(gg.y), bfhi(uu.y) * (acc[ct][3] + sbv) * bfhi(gg.y));
            *(u32x2*)(Y2 + t * 1024 + col) = w;
        }
        __syncthreads();
    }
}

__device__ __forceinline__ void phase_final(const Args& a) {
    const int tid = threadIdx.x, lane = tid & 63, wave = tid >> 6;
    const float* rs2 = (const float*)(a.ws + WS_RS2); const float* fg = a.in[I_FG];
    const int gw = blockIdx.x * 8 + wave, NGW = gridDim.x * 8;
    f32x4 g4[4];
#pragma unroll
    for (int j = 0; j < 4; ++j) g4[j] = ((const f32x4*)fg)[lane + 64 * j];
    for (int m = gw; m < M; m += NGW) {
        const float rinv = rsqrtf(rs2[m] * (1.0f / DM) + RMS_EPS);
        f32x4* p = (f32x4*)(a.out + (size_t)m * DM) + lane;
#pragma unroll
        for (int j = 0; j < 4; ++j) { f32x4 v = p[64 * j]; v = v * rinv * g4[j]; p[64 * j] = v; }
    }
}

template <int PHM> __global__ void __launch_bounds__(NTHR, 2) mega(Args a) {
    extern __shared__ __attribute__((aligned(16))) unsigned char lds[];
    unsigned char* ws = a.ws;
    const int lo = a.lo, hi = a.hi;
#define IN(k) (((PHM >> (k)) & 1) && lo <= (k) && (k) < hi)
#define SEAM(k) do { if (IN(k) && IN((k) + 1)) { cg::this_grid().sync(); } } while (0)
    if (IN(0)) { phase_prologue(a, lds); }
    SEAM(0);
    if (IN(1)) { EpiG1 f{(const float*)(ws + WS_RS0), (bf16_t*)(ws + WS_PA), (bf16_t*)(ws + WS_PB)};
        gemm_any(lds, (const bf16_t*)(ws + WS_XN), (const bf16_t*)(ws + WS_W1T), M, N1, DM, f); }
    SEAM(1);
    if (IN(2)) { phase_prep(a, lds); }
    SEAM(2);
    #if PROBE & 1
    phase_prep(a, lds); cg::this_grid().sync();
#endif
#if USE_NAIVE_MIX
    if (IN(3)) { phase_scan_naive(a); phase_attn_naive(a); }
#else
    if (IN(3)) { phase_mix(a, (LAS unsigned char*)lds); }
#endif
    SEAM(3);
#if PROBE & 2
    phase_prep(a, lds); cg::this_grid().sync(); phase_mix(a, (LAS unsigned char*)lds); cg::this_grid().sync();
#endif
#if PROBE & 64
    phase_prep(a, lds); cg::this_grid().sync(); phase_mix(a, (LAS unsigned char*)lds, true, false); cg::this_grid().sync();
#endif
#if PROBE & 32
    if (blockIdx.x == 0 && threadIdx.x == 0) *(unsigned*)(ws + WS_CTR) = 0u;
    cg::this_grid().sync(); phase_mix(a, (LAS unsigned char*)lds, false); cg::this_grid().sync();
#endif
#if PROBE & 4
    phase_prologue(a, lds); cg::this_grid().sync();
#endif
#if PROBE & 16
    { EpiG1 f{(const float*)(ws + WS_RS0), (bf16_t*)(ws + WS_PA), (bf16_t*)(ws + WS_PB)};
        gemm_any(lds, (const bf16_t*)(ws + WS_XN), (const bf16_t*)(ws + WS_W1T), M, N1, DM, f); cg::this_grid().sync(); }
#endif
    if (IN(4)) { EpiG2 f{a.in[I_X], a.out, (bf16_t*)(ws + WS_XN), (float*)(ws + WS_RS1)};
        gemm_any(lds, (const bf16_t*)(ws + WS_YMIX), (const bf16_t*)(ws + WS_W2T), M, DM, DM, f); }
    SEAM(4);
#if PROBE & 128
    { EpiG2 f{a.in[I_X], a.out, (bf16_t*)(ws + WS_XN), (float*)(ws + 640 * 1024)};
        gemm_any(lds, (const bf16_t*)(ws + WS_YMIX), (const bf16_t*)(ws + WS_W2T), M, DM, DM, f); cg::this_grid().sync(); }
#endif
    if (IN(5)) { EpiG3 f{(const float*)(ws + WS_RS1), (bf16_t*)(ws + WS_P1), (float*)(ws + WS_VSUM), (float*)(ws + WS_VSQ)};
        gemm_any(lds, (const bf16_t*)(ws + WS_XN), (const bf16_t*)(ws + WS_W3T), M, N3, DM, f); }
    SEAM(5);
    if (IN(6)) { phase_sg(a, (LAS unsigned char*)lds); }
    SEAM(6);
#if PROBE & 8
    phase_sg(a, (LAS unsigned char*)lds); cg::this_grid().sync();
#endif
    if (IN(7)) { EpiG4 f{a.out, (float*)(ws + WS_RS2)};
        gemm_any(lds, (const bf16_t*)(ws + WS_YMIX), (const bf16_t*)(ws + WS_W4T), M, DM, DM, f); }
    SEAM(7);
    if (IN(8)) { phase_final(a); }
#undef IN
#undef SEAM
}
constexpr int NPHASE = 9;
}
#if defined(__HIP_DEVICE_COMPILE__)
#pragma clang attribute pop
#endif

extern "C" void kernel_launch(void* const* d_in, const int* in_sizes, int n_in, void* d_out, int out_size, void* d_ws, size_t ws_size, hipStream_t stream) {
    using namespace mk;
    static int grid = 0;
    if (grid == 0) {
        if (n_in != 22 || out_size != M * DM || ws_size < WS_END) { fprintf(stderr, "kernel_launch: unexpected shapes (n_in %d out %d ws %zu)\n", n_in, out_size, ws_size); grid = -1; return; }
        int dev = 0, cus = 0, per_cu = 0;
        (void)hipGetDevice(&dev); (void)hipDeviceGetAttribute(&cus, hipDeviceAttributeMultiprocessorCount, dev);
#if N_LAUNCH_MODE == 1
        if (hipFuncSetAttribute((const void*)mega<0x1ff>, hipFuncAttributeMaxDynamicSharedMemorySize, LDS_BYTES) != hipSuccess) { fprintf(stderr, "kernel_launch: hipFuncSetAttribute failed\n"); grid = -1; return; }
        if (hipOccupancyMaxActiveBlocksPerMultiprocessor(&per_cu, (const void*)mega<0x1ff>, NTHR, LDS_BYTES) != hipSuccess || per_cu < 1) { fprintf(stderr, "kernel_launch: occupancy query says %d\n", per_cu); per_cu = 1; }
#else
        if (hipFuncSetAttribute((const void*)mega<0x1f7>, hipFuncAttributeMaxDynamicSharedMemorySize, LDS_BYTES) != hipSuccess || hipFuncSetAttribute((const void*)mega<0x008>, hipFuncAttributeMaxDynamicSharedMemorySize, LDS_BYTES) != hipSuccess) { fprintf(stderr, "kernel_launch: hipFuncSetAttribute failed\n"); grid = -1; return; }
#endif
        (void)hipGetLastError();
        grid = cus * 1;
        if (grid <= 0) grid = 256;
    }
    if (grid < 0) return;
    Args a{};
    for (int i = 0; i < 22; ++i) a.in[i] = (const float*)d_in[i];
    a.out = (float*)d_out; a.ws = (unsigned char*)d_ws;
#if N_LAUNCH_MODE == 2
    {
        void* args[] = {&a};
        a.lo = 0; a.hi = 3;
        hipError_t e = hipLaunchCooperativeKernel((const void*)mega<0x1f7>, dim3(grid), dim3(NTHR), args, LDS_BYTES, stream);
        if (e != hipSuccess) fprintf(stderr, "kernel_launch: cooperative launch A failed: %s (grid %d)\n", hipGetErrorString(e), grid);
        a.lo = 3; a.hi = 4;
        hipLaunchKernelGGL(mega<0x008>, dim3(grid), dim3(NTHR), LDS_BYTES, stream, a);
        a.lo = 4; a.hi = NPHASE;
        e = hipLaunchCooperativeKernel((const void*)mega<0x1f7>, dim3(grid), dim3(NTHR), args, LDS_BYTES, stream);
        if (e != hipSuccess) fprintf(stderr, "kernel_launch: cooperative launch B failed: %s (grid %d)\n", hipGetErrorString(e), grid);
    }
#elif N_LAUNCH_MODE == 1
    a.lo = 0; a.hi = NPHASE;
    void* args[] = {&a};
    hipError_t e = hipLaunchCooperativeKernel((const void*)mega<0x1ff>, dim3(grid), dim3(NTHR), args, LDS_BYTES, stream);
    if (e != hipSuccess) fprintf(stderr, "kernel_launch: cooperative launch failed: %s (grid %d)\n", hipGetErrorString(e), grid);
#else
    for (int ph = 0; ph < NPHASE; ++ph) {
        a.lo = ph; a.hi = ph + 1;
        if (ph == 3) hipLaunchKernelGGL(mega<0x008>, dim3(grid), dim3(NTHR), LDS_BYTES, stream, a);
        else hipLaunchKernelGGL(mega<0x1f7>, dim3(grid), dim3(NTHR), LDS_BYTES, stream, a);
    }
#endif
}
```

```cpp
#if defined(__HIP_DEVICE_COMPILE__)
#pragma clang attribute push(__attribute__((target("no-packed-fp32-ops"))), apply_to = function)
#endif
#include <hip/hip_runtime.h>
#include <hip/hip_cooperative_groups.h>
#include <cstdio>
#include <cstdint>
namespace cg = cooperative_groups;
#ifndef USE_PG8
#define USE_PG8 1
#endif
#ifndef N_LAUNCH_MODE
#define N_LAUNCH_MODE 1
#endif
#ifndef PHMASK
#define PHMASK 0x1ff
#endif
#ifndef USE_NAIVE_MIX
#define USE_NAIVE_MIX 0
#endif
#ifndef PROBE
#define PROBE 0
#endif
namespace pg8 {
#define PG8_LAS __attribute__((address_space(3)))
typedef unsigned short bf16_t;
typedef short bf16x8 __attribute__((ext_vector_type(8)));
typedef float f32x4 __attribute__((ext_vector_type(4)));
typedef unsigned u32x4 __attribute__((ext_vector_type(4)));
constexpr int BM = 256, BK = 64, HALF = 128, HTB = HALF * BK * 2  , STAGE_BYTES = 8 * HTB, NXCD = 8, WGM = 8;

__host__ __device__ __forceinline__ int lds_byte(int r, int c) { const int st = (r >> 4) * 2 + (c >> 5), rr = r & 15, cc = c & 31, ob = rr * 64 + cc * 2; return st * 1024 + (ob ^ (((ob >> 9) & 1) << 5)); }
__host__ __device__ __forceinline__ void stage_rc(int b, int& R, int& C) { const int st = b / 1024, sb = b % 1024, swz = sb ^ (((sb >> 9) & 1) << 5); R = (st >> 1) * 16 + swz / 64; C = (st & 1) * 32 + (swz % 64) / 2; }
__host__ __device__ __forceinline__ int perm32(int rho) { const int n = rho >> 4, i = rho & 15; return 8 * (i >> 2) + 4 * n + (i & 3); }

struct Unit { int pm, pn; };
struct Gemm { const bf16_t* A; const bf16_t* Bt; int M, N, K; };

struct StaticOrder {
    int nM, nN, nwg, G, c;
    __host__ __device__ void init(int M, int N, int G_, int c_) { nM = M / BM; nN = N / BM; nwg = nM * nN; G = G_; c = c_; }
    __host__ __device__ bool next(int i, Unit& u) const {
        const long L = (long)i * G + c; if (L >= nwg) return false;
        int wgid = (int)L; { const int q = nwg / NXCD, r = nwg % NXCD, xcd = wgid % NXCD, off = wgid / NXCD; wgid = (xcd < r ? xcd * (q + 1) : r * (q + 1) + (xcd - r) * q) + off; }
        const int nig = WGM * nN, gid = wgid / nig, fm = gid * WGM, gsz = (nM - fm) < WGM ? (nM - fm) : WGM;
        u.pm = fm + ((wgid % nig) % gsz); u.pn = (wgid % nig) / gsz; return true;
    }
    __device__ __forceinline__ void a_ready(const Unit&) const {}
    __device__ __forceinline__ void done(const Unit&) const {}
};

__device__ __forceinline__ unsigned cvt_pk_bf16(float lo, float hi) { unsigned r; asm volatile("v_cvt_pk_bf16_f32 %0, %1, %2" : "=v"(r) : "v"(lo), "v"(hi)); return r; }
typedef float f32x2 __attribute__((ext_vector_type(2)));
__device__ __forceinline__ f32x2 gelu_pk(f32x2 v) {
    const f32x2 av = __builtin_elementwise_abs(v), d = av * 0.2316418882f + 1.0f;
    f32x2 t; t.x = __builtin_amdgcn_rcpf(d.x); t.y = __builtin_amdgcn_rcpf(d.y);
    f32x2 q = t * 0.5307027145f + (-0.7265760135f); q = q * t + 0.7107068705f; q = q * t + (-0.142248368f); q = q * t + 0.127414796f; q = q * t;
    const f32x2 s = (v * v) * (-0.72134752044f);
    f32x2 e; e.x = __builtin_amdgcn_exp2f(s.x); e.y = __builtin_amdgcn_exp2f(s.y);
    const f32x2 m = v * (q * e), r = v - m;
    f32x2 o; o.x = v.x < 0.f ? m.x : r.x; o.y = v.y < 0.f ? m.y : r.y; return o;
}

template <int ACT  > struct EpiBf16 {
    static constexpr bool PERM = true, AFTER_DRAIN = false; static_assert(ACT == 0 || ACT == 1, "EpiBf16: ACT is 0 (none) or 1 (gelu_pk)");
    bf16_t* O; int ldc; const float* bias; int split_cols; size_t split_stride; float scale0;
    __device__ __forceinline__ void operator()(const f32x4 (&acc)[2][2][4][2], const Unit& u, int wr, int wc, int fr, int fq) const {
        const int row0 = u.pm * BM + wr * 64 + fr; int colt = u.pn * BM; bf16_t* base = O;
        float sc = 1.f; if (split_cols) { const int t = colt / split_cols; base += (size_t)t * split_stride; colt -= t * split_cols; if (t == 0) sc = scale0; }
        const int col0 = colt + wc * 32 + 8 * fq, bcol0 = u.pn * BM + wc * 32 + 8 * fq;
        f32x4 bv[2][2];
#pragma unroll
        for (int bj = 0; bj < 2; ++bj)
#pragma unroll
            for (int n = 0; n < 2; ++n) bv[bj][n] = bias ? *(const f32x4*)(bias + bcol0 + bj * HALF + 4 * n) : (f32x4){0.f, 0.f, 0.f, 0.f};
#pragma unroll
        for (int ai = 0; ai < 2; ++ai)
#pragma unroll
            for (int m = 0; m < 4; ++m) { bf16_t* rowp = base + (size_t)(row0 + ai * HALF + m * 16) * ldc + col0;
#pragma unroll
                for (int bj = 0; bj < 2; ++bj) { f32x4 v0 = acc[ai][bj][m][0] + bv[bj][0], v1 = acc[ai][bj][m][1] + bv[bj][1];
                    if (ACT == 1) { f32x2 a = gelu_pk((f32x2){v0[0], v0[1]}), b = gelu_pk((f32x2){v0[2], v0[3]}), c = gelu_pk((f32x2){v1[0], v1[1]}), d = gelu_pk((f32x2){v1[2], v1[3]});
                        v0 = (f32x4){a.x, a.y, b.x, b.y}; v1 = (f32x4){c.x, c.y, d.x, d.y}; }
                    v0 = v0 * sc; v1 = v1 * sc; u32x4 w; w.x = cvt_pk_bf16(v0[0], v0[1]); w.y = cvt_pk_bf16(v0[2], v0[3]); w.z = cvt_pk_bf16(v1[0], v1[1]); w.w = cvt_pk_bf16(v1[2], v1[3]);
                    *(u32x4*)(rowp + bj * HALF) = w; } }
    }
};
template <class Epi, class Sched, bool ALIGN_EPI = false, bool SP2 = false>
__device__ __forceinline__ void gemm_phase(PG8_LAS unsigned char* lds, const Gemm g, const Sched& S, const Epi& E) {
    const int tid = threadIdx.x, wid = __builtin_amdgcn_readfirstlane(tid >> 6), lane = tid & 63, wr = wid >> 2, wc = wid & 3, fr = lane & 15, fq = lane >> 4;
    const int K = g.K, nt = K / BK;
    unsigned voffA[2], voffB[2];
#pragma unroll
    for (int i = 0; i < 2; ++i) { int R, C; stage_rc(tid * 16 + i * 8192, R, C); const int Rb = Epi::PERM ? ((R & ~31) + perm32(R & 31)) : R;
        voffA[i] = (unsigned)(R * K + C) * 2u; voffB[i] = (unsigned)(Rb * K + C) * 2u; }
    const size_t kstep = (size_t)(BK * 2);
    const size_t hstep = (size_t)HALF * K * 2;
    const size_t tstep = 2 * hstep;
    const unsigned ldsw = (unsigned)wid * 1024u;
    const int aoff = lds_byte(wr * 64 + fr, fq * 8), boff = lds_byte(wc * 32 + fr, fq * 8);
#define PG8_SA(b, h) (((b) * 2 + (h)) * HTB)
#define PG8_SB(b, h) ((4 + (b) * 2 + (h)) * HTB)
#define PG8_STAGE(bufoff, gbase, voff) do { _Pragma("unroll") for (int _i = 0; _i < 2; ++_i) \
        __builtin_amdgcn_global_load_lds((const unsigned*)((const char*)(gbase) + (voff)[_i]), (PG8_LAS unsigned*)(lds + (bufoff) + ldsw + _i * 8192), 16, 0, 0); } while (0)
#define PG8_LDA(dst, b, h) do { _Pragma("unroll") for (int m = 0; m < 4; ++m) _Pragma("unroll") for (int k = 0; k < 2; ++k) dst[m][k] = *(const PG8_LAS bf16x8*)(lds + PG8_SA(b, h) + aoff + m * 2048 + k * 1024); } while (0)
#define PG8_LDB(dst, b, h) do { _Pragma("unroll") for (int n = 0; n < 2; ++n) _Pragma("unroll") for (int k = 0; k < 2; ++k) dst[n][k] = *(const PG8_LAS bf16x8*)(lds + PG8_SB(b, h) + boff + n * 2048 + k * 1024); } while (0)
#define PG8_MMA(ai, bj, At, Bt) do { __builtin_amdgcn_s_setprio(1); _Pragma("unroll") for (int m = 0; m < 4; ++m) _Pragma("unroll") for (int n = 0; n < 2; ++n) _Pragma("unroll") for (int k = 0; k < 2; ++k) \
        acc[ai][bj][m][n] = __builtin_amdgcn_mfma_f32_16x16x32_bf16(Bt[n][k], At[m][k], acc[ai][bj][m][n], 0, 0, 0); __builtin_amdgcn_s_setprio(0); } while (0)
#define PG8_WAIT_V(n) asm volatile("s_waitcnt vmcnt(" #n ")" ::: "memory")
#define PG8_WAIT_L(n) asm volatile("s_waitcnt lgkmcnt(" #n ")" ::: "memory")
#define PG8_BAR __builtin_amdgcn_s_barrier()
#define PG8_SCHED __builtin_amdgcn_sched_barrier(0)
    Unit cur, nxt; int ui = 0;
    if (!S.next(0, cur)) return;
    f32x4 acc[2][2][4][2];
#pragma unroll
    for (int a = 0; a < 2; ++a)
#pragma unroll
        for (int b = 0; b < 2; ++b)
#pragma unroll
            for (int m = 0; m < 4; ++m)
#pragma unroll
                for (int n = 0; n < 2; ++n) acc[a][b][m][n] = (f32x4){0.f, 0.f, 0.f, 0.f};
    bf16x8 At[4][2], B0[2][2], B1[2][2];
    const char* cA = (const char*)g.A + (size_t)cur.pm * tstep; const char* cB = (const char*)g.Bt + (size_t)cur.pn * tstep;
    S.a_ready(cur);
    if constexpr (SP2) {
        PG8_STAGE(PG8_SB(0, 0), cB, voffB); PG8_STAGE(PG8_SB(0, 1), cB + hstep, voffB); PG8_STAGE(PG8_SA(0, 0), cA, voffA); PG8_STAGE(PG8_SA(0, 1), cA + hstep, voffA);
        if (wr == 1) PG8_BAR;
        PG8_WAIT_V(2); PG8_BAR;
        PG8_STAGE(PG8_SB(1, 0), cB + kstep, voffB); PG8_STAGE(PG8_SA(1, 0), cA + kstep, voffA); PG8_STAGE(PG8_SB(1, 1), cB + hstep + kstep, voffB);
        PG8_WAIT_V(6); PG8_BAR;
    } else {
        PG8_STAGE(PG8_SB(0, 0), cB, voffB); PG8_STAGE(PG8_SA(0, 0), cA, voffA); PG8_STAGE(PG8_SB(0, 1), cB + hstep, voffB); PG8_STAGE(PG8_SA(0, 1), cA + hstep, voffA);
        if (wr == 1) PG8_BAR;
        PG8_WAIT_V(4); PG8_BAR;
        PG8_STAGE(PG8_SB(1, 0), cB + kstep, voffB); PG8_STAGE(PG8_SA(1, 0), cA + kstep, voffA); PG8_STAGE(PG8_SB(1, 1), cB + hstep + kstep, voffB);
        PG8_WAIT_V(6); PG8_BAR;
    }
    for (;;) {
        const bool has_next = S.next(ui + 1, nxt);
        const char* nA = has_next ? (const char*)g.A + (size_t)nxt.pm * tstep : cA; const char* nB = has_next ? (const char*)g.Bt + (size_t)nxt.pn * tstep : cB;
        for (int t = 0; t < nt; t += 2) {
            const bool last = (t == nt - 2);
            const char* a1 = cA + (size_t)(t + 1) * kstep;
            const char* a2 = last ? nA : cA + (size_t)(t + 2) * kstep; const char* b2 = last ? nB : cB + (size_t)(t + 2) * kstep;
            const char* a3 = a2 + kstep; const char* b3 = b2 + kstep;
            if (last && has_next) S.a_ready(nxt);
            if constexpr (SP2) {
            PG8_LDB(B0, 0, 0); PG8_LDB(B1, 0, 1); PG8_SCHED; PG8_LDA(At, 0, 0); PG8_STAGE(PG8_SA(1, 1), a1 + hstep, voffA);
            PG8_WAIT_V(8); PG8_WAIT_L(0); PG8_BAR; PG8_MMA(0, 0, At, B0); PG8_MMA(0, 1, At, B1); PG8_BAR; PG8_SCHED;
            PG8_LDA(At, 0, 1); PG8_STAGE(PG8_SB(0, 0), b2, voffB); PG8_STAGE(PG8_SB(0, 1), b2 + hstep, voffB); PG8_STAGE(PG8_SA(0, 0), a2, voffA);
            PG8_WAIT_V(8); PG8_WAIT_L(0); PG8_BAR; PG8_MMA(1, 0, At, B0); PG8_MMA(1, 1, At, B1); PG8_BAR; PG8_SCHED;
            PG8_LDB(B0, 1, 0); PG8_LDB(B1, 1, 1); PG8_SCHED; PG8_LDA(At, 1, 0); PG8_STAGE(PG8_SA(0, 1), a2 + hstep, voffA);
            PG8_WAIT_V(8); PG8_WAIT_L(0); PG8_BAR; PG8_MMA(0, 0, At, B0); PG8_MMA(0, 1, At, B1); PG8_BAR; PG8_SCHED;
            PG8_LDA(At, 1, 1); PG8_STAGE(PG8_SB(1, 0), b3, voffB); PG8_STAGE(PG8_SB(1, 1), b3 + hstep, voffB); PG8_STAGE(PG8_SA(1, 0), a3, voffA);
            PG8_WAIT_V(8); PG8_WAIT_L(0); PG8_BAR; PG8_MMA(1, 0, At, B0); PG8_MMA(1, 1, At, B1); PG8_BAR; PG8_SCHED;
            } else {
            PG8_LDB(B0, 0, 0); PG8_SCHED; PG8_LDA(At, 0, 0); PG8_STAGE(PG8_SA(1, 1), a1 + hstep, voffA);
            PG8_WAIT_L(8); PG8_BAR; PG8_WAIT_L(0); PG8_MMA(0, 0, At, B0); PG8_BAR; PG8_SCHED;
            PG8_LDB(B1, 0, 1); PG8_STAGE(PG8_SB(0, 0), b2, voffB);
            PG8_BAR; PG8_WAIT_L(0); PG8_MMA(0, 1, At, B1); PG8_BAR;
            PG8_LDA(At, 0, 1); PG8_STAGE(PG8_SA(0, 0), a2, voffA);
            PG8_BAR; PG8_WAIT_L(0); PG8_MMA(1, 0, At, B0); PG8_BAR; PG8_SCHED;
            PG8_STAGE(PG8_SB(0, 1), b2 + hstep, voffB);
            PG8_WAIT_V(6); PG8_BAR; PG8_MMA(1, 1, At, B1); PG8_BAR;
            PG8_LDB(B0, 1, 0); PG8_SCHED; PG8_LDA(At, 1, 0); PG8_STAGE(PG8_SA(0, 1), a2 + hstep, voffA);
            PG8_WAIT_L(8); PG8_BAR; PG8_WAIT_L(0); PG8_MMA(0, 0, At, B0); PG8_BAR; PG8_SCHED;
            PG8_LDB(B1, 1, 1); PG8_STAGE(PG8_SB(1, 0), b3, voffB);
            PG8_BAR; PG8_WAIT_L(0); PG8_MMA(0, 1, At, B1); PG8_BAR;
            PG8_LDA(At, 1, 1); PG8_STAGE(PG8_SA(1, 0), a3, voffA);
            PG8_BAR; PG8_WAIT_L(0); PG8_MMA(1, 0, At, B0); PG8_BAR; PG8_SCHED;
            PG8_STAGE(PG8_SB(1, 1), b3 + hstep, voffB);
            PG8_WAIT_V(6); PG8_BAR; PG8_MMA(1, 1, At, B1); PG8_BAR;
            }
        }
        if constexpr (ALIGN_EPI) { if (wr == 0) PG8_BAR; }
        if constexpr (!Epi::AFTER_DRAIN) { E(acc, cur, wr, wc, fr, fq); S.done(cur); }
        if (!has_next) break;
#pragma unroll
        for (int a = 0; a < 2; ++a)
#pragma unroll
            for (int b = 0; b < 2; ++b)
#pragma unroll
                for (int m = 0; m < 4; ++m)
#pragma unroll
                    for (int n = 0; n < 2; ++n) acc[a][b][m][n] = (f32x4){0.f, 0.f, 0.f, 0.f};
        cur = nxt; cA = nA; cB = nB; ++ui;
        if constexpr (ALIGN_EPI) { if (wr == 1) PG8_BAR; }
    }
    PG8_WAIT_V(0);
    if constexpr (!ALIGN_EPI) { if (wr == 0) PG8_BAR; }
    PG8_BAR;
    if constexpr (Epi::AFTER_DRAIN) { E.fused(acc, cur, wr, wc, fr, fq, lds, wid, lane); S.done(cur); }
#undef PG8_SA
#undef PG8_SB
#undef PG8_STAGE
#undef PG8_LDA
#undef PG8_LDB
#undef PG8_MMA
#undef PG8_WAIT_V
#undef PG8_WAIT_L
#undef PG8_BAR
#undef PG8_SCHED
}
}

namespace mk {
typedef unsigned short bf16_t;
typedef float f32x4 __attribute__((ext_vector_type(4)));
typedef unsigned u32x4 __attribute__((ext_vector_type(4)));
typedef unsigned u32x2 __attribute__((ext_vector_type(2)));
typedef float f32x2 __attribute__((ext_vector_type(2)));
#define LAS __attribute__((address_space(3)))

constexpr int BATCH = 16, SEQ = 2048, DM = 1024, M = BATCH * SEQ;
constexpr int NA = 1792, NB = 2560, N1 = NA + NB;
constexpr int N3 = 3072;
constexpr int EVEN_IN = 4224, SHIFT_W = 1664;
constexpr float RMS_EPS = 1e-6f, LN_EPS = 1e-5f, GN_EPS = 64e-5f;
constexpr int NTHR = 512;

constexpr size_t MiB = 1u << 20;
constexpr size_t WS_CTR = 768 * 1024;
constexpr size_t WS_LW = 23 * MiB + 512 * 1024;
constexpr size_t WS_SGW = 23 * MiB;
constexpr size_t WS_RS0 = 0, WS_RS1 = 128 * 1024, WS_RS2 = 256 * 1024, WS_VSUM = 384 * 1024, WS_VSQ = 512 * 1024, WS_BON = 1 * MiB;
constexpr size_t WS_W1T = 4 * MiB, WS_W2T = 13 * MiB, WS_W3T = 15 * MiB, WS_W4T = 21 * MiB;
constexpr size_t WS_XN = 24 * MiB;
constexpr size_t WS_PA = 88 * MiB;
constexpr size_t WS_PB = 200 * MiB;
constexpr size_t WS_YMIX = 360 * MiB;
constexpr size_t WS_TAIL = 424 * MiB;
constexpr size_t WS_VRAW = 448 * MiB;
constexpr size_t WS_END = 480 * MiB;
constexpr int RSZ = 12544;
constexpr size_t WS_P1 = WS_PA;
constexpr int LDS_BYTES = 147456;

struct Args {
    const float* in[22];
    float* out; unsigned char* ws;
    int lo, hi;
};
enum { I_X = 0, I_NORMG, I_WINE, I_SHMU, I_W0, I_W2, I_A0, I_A2, I_KK, I_KA, I_RK, I_LNXG, I_LNXB, I_ABIAS, I_WOUTE, I_WINO, I_SGLNG, I_SGLNB, I_SGW, I_SGB, I_WOUTO, I_FG };

__device__ __forceinline__ unsigned short f2bf(float f) { unsigned u = __float_as_uint(f); return (unsigned short)((u + 0x7fffu + ((u >> 16) & 1u)) >> 16); }
__device__ __forceinline__ float bf2f(unsigned short h) { return __uint_as_float((unsigned)h << 16); }
typedef __bf16 bf2_t __attribute__((ext_vector_type(2)));
__device__ __forceinline__ unsigned pk2(float lo, float hi) { const f32x2 v = {lo, hi}; const bf2_t b = __builtin_convertvector(v, bf2_t); return __builtin_bit_cast(unsigned, b); }
__device__ __forceinline__ float bflo(unsigned w) { return __uint_as_float(w << 16); }
__device__ __forceinline__ float bfhi(unsigned w) { return __uint_as_float(w & 0xffff0000u); }
__device__ __forceinline__ float wave_sum(float v) {
#pragma unroll
    for (int o = 1; o < 64; o <<= 1) v += __shfl_xor(v, o);
    return v;
}
__device__ __forceinline__ float sigmoidf_(float x) { return 1.0f / (1.0f + __expf(-x)); }
__device__ __forceinline__ float siluf_(float x) { return x * sigmoidf_(x); }
__device__ __forceinline__ float gelu_tanh(float x) { const float y = 0.7978845608028654f * (x + 0.044715f * x * x * x); return x * sigmoidf_(2.0f * y); }

__device__ __forceinline__ void phase_prologue(const Args& a, unsigned char* ldsb) {
    const int tid = threadIdx.x, lane = tid & 63, wave = tid >> 6;
    unsigned char* ws = a.ws;
    const int gtid = blockIdx.x * NTHR + tid, nthr = gridDim.x * NTHR;
    {
        LAS float* scr = (LAS float*)((LAS unsigned char*)ldsb + wave * 8448);
        constexpr int NB1 = N1 / 32, NB2 = 32, NB3 = N3 / 32, NB4 = 32, NITEM = (NB1 + NB2 + NB3 + NB4) * 16;
        for (int it = blockIdx.x * 8 + wave; it < NITEM; it += gridDim.x * 8) {
            int nb = it >> 4; const int k0 = (it & 15) * 64;
            const float* src; const float* g; int N, col0; bf16_t* dst; bool zero = false;
            if (nb < NB1) { const int n0 = nb * 32; src = a.in[I_WINE]; g = a.in[I_NORMG]; N = EVEN_IN; dst = (bf16_t*)(ws + WS_W1T) + (size_t)n0 * 1024;
                if (n0 < SHIFT_W) col0 = n0; else if (n0 < NA) { col0 = 0; zero = true; } else col0 = n0 - (NA - SHIFT_W); }
            else if ((nb -= NB1) < NB2) { src = a.in[I_WOUTE]; g = nullptr; N = 1024; col0 = nb * 32; dst = (bf16_t*)(ws + WS_W2T) + (size_t)col0 * 1024; }
            else if ((nb -= NB2) < NB3) { src = a.in[I_WINO]; g = a.in[I_NORMG] + 1024; N = N3; col0 = nb * 32; dst = (bf16_t*)(ws + WS_W3T) + (size_t)col0 * 1024; }
            else { nb -= NB3; src = a.in[I_WOUTO]; g = nullptr; N = 1024; col0 = nb * 32; dst = (bf16_t*)(ws + WS_W4T) + (size_t)col0 * 1024; }
#pragma unroll 8
            for (int i = 0; i < 32; ++i) { const int kk = 2 * i + (lane >> 5); float x = zero ? 0.f : src[(size_t)(k0 + kk) * N + col0 + (lane & 31)]; if (g) x *= g[k0 + kk]; scr[kk * 33 + (lane & 31)] = x; }
            asm volatile("s_waitcnt lgkmcnt(0)" ::: "memory");
            const int c8 = lane & 7;
#pragma unroll
            for (int j = 0; j < 4; ++j) { const int n = (lane >> 3) + 8 * j; const LAS float* sp = scr + (8 * c8) * 33 + n;
                u32x4 o; o.x = pk2(sp[0 * 33], sp[1 * 33]); o.y = pk2(sp[2 * 33], sp[3 * 33]); o.z = pk2(sp[4 * 33], sp[5 * 33]); o.w = pk2(sp[6 * 33], sp[7 * 33]);
                *(u32x4*)(dst + (size_t)n * 1024 + k0 + 8 * c8) = o; }
            asm volatile("s_waitcnt lgkmcnt(0)" ::: "memory");
        }
    }
    const float* x = a.in[I_X]; bf16_t* XN = (bf16_t*)(ws + WS_XN); float* rs0 = (float*)(ws + WS_RS0);
    const int gw = blockIdx.x * 8 + wave, NGW = gridDim.x * 8;
    for (int m = gw; m < M; m += NGW) {
        const f32x4* xr = (const f32x4*)(x + (size_t)m * DM) + lane; float s = 0.f; f32x4 v[4];
#pragma unroll
        for (int j = 0; j < 4; ++j) { v[j] = xr[64 * j]; s += (v[j].x * v[j].x + v[j].y * v[j].y) + (v[j].z * v[j].z + v[j].w * v[j].w); }
        s = wave_sum(s);
        u32x2* o = (u32x2*)(XN + (size_t)m * DM) + lane;
#pragma unroll
        for (int j = 0; j < 4; ++j) { u32x2 w; w.x = pk2(v[j].x, v[j].y); w.y = pk2(v[j].z, v[j].w); o[64 * j] = w; }
        if (lane == 0) rs0[m] = s;
    }
    float* rs1 = (float*)(ws + WS_RS1); float* rs2 = (float*)(ws + WS_RS2); float* vsum = (float*)(ws + WS_VSUM); float* vsq = (float*)(ws + WS_VSQ);
    for (int i = gtid; i < M; i += nthr) { rs1[i] = 0.f; rs2[i] = 0.f; vsum[i] = 0.f; vsq[i] = 0.f; }
    { bf16_t* LW = (bf16_t*)(ws + WS_LW); const float* w2 = a.in[I_W2]; const float* a2 = a.in[I_A2];
      for (int i = gtid; i < 2 * 512 * 64; i += nthr) { const int j = i & 63, cc = (i >> 6) & 511, mat = i >> 15; LW[i] = f2bf((mat ? a2 : w2)[j * 512 + cc]); } }
    { bf16_t* SGW = (bf16_t*)(ws + WS_SGW); const float* sgw = a.in[I_SGW];
      for (int i = gtid; i < 8 * 128 * 128; i += nthr) { const int jj = i & 127, ii = (i >> 7) & 127; SGW[i] = f2bf(((jj >> 6) <= (ii >> 6)) ? sgw[i] : 0.f); } }
}

struct EpiG1 {
    const float* rs0; bf16_t* PA; bf16_t* PB;
    static constexpr int NSTAT = 0;
    __device__ __forceinline__ void commit(int, float, float) const {}
    __device__ __forceinline__ f32x2 operator()(int row, int col, f32x4 v0, f32x4 v1) const {
        const float rinv = rsqrtf(rs0[row] * (1.0f / DM) + RMS_EPS);
        v0 = v0 * rinv; v1 = v1 * rinv;
        u32x4 w; w.x = pk2(v0[0], v0[1]); w.y = pk2(v0[2], v0[3]); w.z = pk2(v1[0], v1[1]); w.w = pk2(v1[2], v1[3]);
        bf16_t* dst = col < NA ? PA + (size_t)row * NA + col : PB + (size_t)row * NB + (col - NA);
        *(u32x4*)dst = w;
        return (f32x2){0.f, 0.f};
    }
};
struct EpiG2 {
    const float* x; float* out; bf16_t* HB; float* rs1;
    static constexpr int NSTAT = 1;
    __device__ __forceinline__ void commit(int row, float s0, float) const { unsafeAtomicAdd(rs1 + row, s0); }
    __device__ __forceinline__ f32x2 operator()(int row, int col, f32x4 v0, f32x4 v1) const {
        const size_t off = (size_t)row * DM + col;
        v0 = v0 + *(const f32x4*)(x + off); v1 = v1 + *(const f32x4*)(x + off + 4);
        *(f32x4*)(out + off) = v0; *(f32x4*)(out + off + 4) = v1;
        u32x4 w; w.x = pk2(v0[0], v0[1]); w.y = pk2(v0[2], v0[3]); w.z = pk2(v1[0], v1[1]); w.w = pk2(v1[2], v1[3]);
        *(u32x4*)(HB + off) = w;
        const float s = (v0[0] * v0[0] + v0[1] * v0[1]) + (v0[2] * v0[2] + v0[3] * v0[3]) + (v1[0] * v1[0] + v1[1] * v1[1]) + (v1[2] * v1[2] + v1[3] * v1[3]);
        return (f32x2){s, 0.f};
    }
};
struct EpiG3 {
    const float* rs1; bf16_t* P1; float* vsum; float* vsq;
    static constexpr int NSTAT = 2;
    __device__ __forceinline__ void commit(int row, float s0, float s1) const { if (s1 != 0.f) { unsafeAtomicAdd(vsum + row, s0); unsafeAtomicAdd(vsq + row, s1); } }
    __device__ __forceinline__ f32x2 operator()(int row, int col, f32x4 v0, f32x4 v1) const {
        f32x2 ret = (f32x2){0.f, 0.f};
        const float rinv = rsqrtf(rs1[row] * (1.0f / DM) + RMS_EPS);
        float v[8];
#pragma unroll
        for (int j = 0; j < 4; ++j) { v[j] = v0[j] * rinv; v[4 + j] = v1[j] * rinv; }
        if (col < 2048) {
#pragma unroll
            for (int j = 0; j < 8; ++j) v[j] = gelu_tanh(v[j]);
            if (col >= 1024) {
                float s = 0.f, q = 0.f;
#pragma unroll
                for (int j = 0; j < 8; ++j) { s += v[j]; q += v[j] * v[j]; }
                ret = (f32x2){s, q};
            }
        } else {
#pragma unroll
            for (int j = 0; j < 8; ++j) v[j] = siluf_(v[j]);
        }
        u32x4 w; w.x = pk2(v[0], v[1]); w.y = pk2(v[2], v[3]); w.z = pk2(v[4], v[5]); w.w = pk2(v[6], v[7]);
        *(u32x4*)(P1 + (size_t)row * N3 + col) = w;
        return ret;
    }
};
struct EpiG4 {
    float* out; float* rs2;
    static constexpr int NSTAT = 1;
    __device__ __forceinline__ void commit(int row, float s0, float) const { unsafeAtomicAdd(rs2 + row, s0); }
    __device__ __forceinline__ f32x2 operator()(int row, int col, f32x4 v0, f32x4 v1) const {
        const size_t off = (size_t)row * DM + col;
        v0 = v0 + *(const f32x4*)(out + off); v1 = v1 + *(const f32x4*)(out + off + 4);
        *(f32x4*)(out + off) = v0; *(f32x4*)(out + off + 4) = v1;
        const float s = (v0[0] * v0[0] + v0[1] * v0[1]) + (v0[2] * v0[2] + v0[3] * v0[3]) + (v1[0] * v1[0] + v1[1] * v1[1]) + (v1[2] * v1[2] + v1[3] * v1[3]);
        return (f32x2){s, 0.f};
    }
};

template <class F> struct EpiAdapt {
    static constexpr bool PERM = true, AFTER_DRAIN = false;
    F f;
    __device__ __forceinline__ void operator()(const pg8::f32x4 (&acc)[2][2][4][2], const pg8::Unit& u, int wr, int wc, int fr, int fq) const {
#pragma unroll
        for (int ai = 0; ai < 2; ++ai)
#pragma unroll
            for (int m = 0; m < 4; ++m) {
                const int row = u.pm * 256 + ai * 128 + wr * 64 + m * 16 + fr;
                f32x2 st = (f32x2){0.f, 0.f};
#pragma unroll
                for (int bj = 0; bj < 2; ++bj) { const int col = u.pn * 256 + bj * 128 + wc * 32 + 8 * fq; const f32x2 r = f(row, col, acc[ai][bj][m][0], acc[ai][bj][m][1]); st = st + r; }
                if (F::NSTAT >= 1) { st.x += __shfl_xor(st.x, 16); st.x += __shfl_xor(st.x, 32); }
                if (F::NSTAT >= 2) { st.y += __shfl_xor(st.y, 16); st.y += __shfl_xor(st.y, 32); }
                if (F::NSTAT >= 1 && fq == 0) f.commit(row, st.x, st.y);
            }
    }
};

template <class F> __device__ __forceinline__ void gemm_naive(float* lds, const bf16_t* A, const bf16_t* Bt, int Mm, int N, int K, const F& f) {
    const int tid = threadIdx.x, ty = tid >> 4, tx = tid & 15;
    float* As = lds; float* Bs = lds + 32 * 132;
    const int ntn = N / 128, ntiles = (Mm / 128) * ntn;
    for (int tile = blockIdx.x; tile < ntiles; tile += gridDim.x) {
        const int tm = tile / ntn, tn = tile % ntn;
        float acc[4][8];
#pragma unroll
        for (int i = 0; i < 4; ++i)
#pragma unroll
            for (int j = 0; j < 8; ++j) acc[i][j] = 0.f;
        for (int k0 = 0; k0 < K; k0 += 32) {
            { const int row = tid >> 2, kc = (tid & 3) * 8;
              const u32x4 va = *(const u32x4*)(A + (size_t)(tm * 128 + row) * K + k0 + kc);
              const u32x4 vb = *(const u32x4*)(Bt + (size_t)(tn * 128 + row) * K + k0 + kc);
              As[(kc + 0) * 132 + row] = bflo(va.x); As[(kc + 1) * 132 + row] = bfhi(va.x); As[(kc + 2) * 132 + row] = bflo(va.y); As[(kc + 3) * 132 + row] = bfhi(va.y);
              As[(kc + 4) * 132 + row] = bflo(va.z); As[(kc + 5) * 132 + row] = bfhi(va.z); As[(kc + 6) * 132 + row] = bflo(va.w); As[(kc + 7) * 132 + row] = bfhi(va.w);
              Bs[(kc + 0) * 132 + row] = bflo(vb.x); Bs[(kc + 1) * 132 + row] = bfhi(vb.x); Bs[(kc + 2) * 132 + row] = bflo(vb.y); Bs[(kc + 3) * 132 + row] = bfhi(vb.y);
              Bs[(kc + 4) * 132 + row] = bflo(vb.z); Bs[(kc + 5) * 132 + row] = bfhi(vb.z); Bs[(kc + 6) * 132 + row] = bflo(vb.w); Bs[(kc + 7) * 132 + row] = bfhi(vb.w); }
            __syncthreads();
#pragma unroll 8
            for (int kk = 0; kk < 32; ++kk) {
                const f32x4 a4 = *(const f32x4*)(As + kk * 132 + ty * 4);
                const f32x4 b0 = *(const f32x4*)(Bs + kk * 132 + tx * 8), b1 = *(const f32x4*)(Bs + kk * 132 + tx * 8 + 4);
#pragma unroll
                for (int i = 0; i < 4; ++i) {
#pragma unroll
                    for (int j = 0; j < 4; ++j) { acc[i][j] += a4[i] * b0[j]; acc[i][4 + j] += a4[i] * b1[j]; }
                }
            }
            __syncthreads();
        }
#pragma unroll
        for (int i = 0; i < 4; ++i) { const f32x2 r = f(tm * 128 + ty * 4 + i, tn * 128 + tx * 8, (f32x4){acc[i][0], acc[i][1], acc[i][2], acc[i][3]}, (f32x4){acc[i][4], acc[i][5], acc[i][6], acc[i][7]}); if (F::NSTAT >= 1) f.commit(tm * 128 + ty * 4 + i, r.x, r.y); }
    }
}

template <class F> __device__ __forceinline__ void gemm_any(unsigned char* lds, const bf16_t* A, const bf16_t* Bt, int Mm, int N, int K, const F& f) {
#if USE_PG8
    pg8::Gemm g{A, Bt, Mm, N, K}; pg8::StaticOrder S; S.init(Mm, N, (int)gridDim.x, (int)blockIdx.x);
    EpiAdapt<F> E{f};
    pg8::gemm_phase<EpiAdapt<F>, pg8::StaticOrder, true, true>((PG8_LAS unsigned char*)lds, g, S, E);
#else
    gemm_naive((float*)lds, A, Bt, Mm, N, K, f);
#endif
}

typedef short pbf16x8 __attribute__((ext_vector_type(8)));
template <int CTRL> __device__ __forceinline__ float pdpp_add(float x) { return x + __uint_as_float(__builtin_amdgcn_update_dpp(0, __float_as_uint(x), CTRL, 0xf, 0xf, true)); }
__device__ __forceinline__ float wave_sum_dpp(float x) {
    x = pdpp_add<0x128>(x); x = pdpp_add<0x124>(x); x = pdpp_add<0x122>(x); x = pdpp_add<0x121>(x);
    const unsigned u = __float_as_uint(x);
    return (__uint_as_float(__builtin_amdgcn_readlane(u, 0)) + __uint_as_float(__builtin_amdgcn_readlane(u, 16))) + (__uint_as_float(__builtin_amdgcn_readlane(u, 32)) + __uint_as_float(__builtin_amdgcn_readlane(u, 48)));
}
__device__ __forceinline__ unsigned char* rec_base(const Args& a, int u) {
    if (u < 80) return (unsigned char*)a.out + (size_t)u * 128 * RSZ;
    if (u < 118) return a.ws + WS_XN + (size_t)(u - 80) * 128 * RSZ;
    return a.ws + WS_TAIL + (size_t)(u - 118) * 128 * RSZ;
}
__device__ __forceinline__ void phase_prep(const Args& a, unsigned char* ldsb) {
    const int tid = threadIdx.x, lane = tid & 63, wave = tid >> 6, fr = lane & 15, quad = lane >> 4;
    unsigned char* ws = a.ws;
    const bf16_t* PA = (const bf16_t*)(ws + WS_PA);
    bf16_t* VR = (bf16_t*)(ws + WS_VRAW); float* BON = (float*)(ws + WS_BON);
    const float* mu = a.in[I_SHMU];
    LAS unsigned char* lds = (LAS unsigned char*)ldsb;
    constexpr int HAT_OFF = 69888;
    constexpr int XPB = 272;
    constexpr int RES_OFF = 4352;
    if (blockIdx.x == 0 && tid == 0) *(unsigned*)(ws + WS_CTR) = 0u;
    const int c = tid;
    const float w0 = a.in[I_W0][c], a0 = a.in[I_A0][c], kkc = a.in[I_KK][c], kac = a.in[I_KA][c], rkc = a.in[I_RK][c];
    const float mur = mu[c], muk = mu[512 + c], muv = mu[1024 + c];
    const bf16_t* LW = (const bf16_t*)(ws + WS_LW);
    pbf16x8 wf[2][4][2];
#pragma unroll
    for (int mat = 0; mat < 2; ++mat)
#pragma unroll
        for (int mt = 0; mt < 4; ++mt)
#pragma unroll
            for (int ks = 0; ks < 2; ++ks) wf[mat][mt][ks] = *(const pbf16x8*)(LW + (size_t)(mat * 512 + wave * 64 + mt * 16 + fr) * 64 + ks * 32 + 8 * quad);
    const int stok = tid >> 5, sj4 = (tid & 31) * 4;
    const f32x4 smu = *(const f32x4*)(mu + 1536 + sj4);
    for (int u = blockIdx.x; u < M / 16; u += gridDim.x) {
        const int t0 = u * 16;
        {   const int t = t0 + stok; const bool first = (t % SEQ) == 0;
            const u32x2 pw = *(const u32x2*)(PA + (size_t)t * NA + 1536 + sj4);
            u32x2 qw = pw; if (!first) qw = *(const u32x2*)(PA + (size_t)(t - 1) * NA + 1536 + sj4);
            float x0 = bflo(pw.x), x1 = bfhi(pw.x), x2 = bflo(pw.y), x3 = bfhi(pw.y);
            const float y0 = first ? 0.f : bflo(qw.x), y1 = first ? 0.f : bfhi(qw.x), y2 = first ? 0.f : bflo(qw.y), y3 = first ? 0.f : bfhi(qw.y);
            x0 += (y0 - x0) * smu.x; x1 += (y1 - x1) * smu.y; x2 += (y2 - x2) * smu.z; x3 += (y3 - x3) * smu.w;
            if (sj4 < 64) { x0 = 1.0f - 2.0f / (__expf(2.0f * x0) + 1.0f); x1 = 1.0f - 2.0f / (__expf(2.0f * x1) + 1.0f); x2 = 1.0f - 2.0f / (__expf(2.0f * x2) + 1.0f); x3 = 1.0f - 2.0f / (__expf(2.0f * x3) + 1.0f); }
            u32x2 o; o.x = pk2(x0, x1); o.y = pk2(x2, x3);
            *(LAS u32x2*)(lds + stok * XPB + sj4 * 2) = o; }
        __syncthreads();
#pragma unroll
        for (int mat = 0; mat < 2; ++mat)
#pragma unroll
            for (int mt = 0; mt < 4; ++mt) {
                f32x4 acc = (f32x4){0.f, 0.f, 0.f, 0.f};
#pragma unroll
                for (int ks = 0; ks < 2; ++ks) { const pbf16x8 xf = *(const LAS pbf16x8*)(lds + fr * XPB + (mat * 64 + ks * 32 + 8 * quad) * 2); acc = __builtin_amdgcn_mfma_f32_16x16x32_bf16(wf[mat][mt][ks], xf, acc, 0, 0, 0); }
                *(LAS f32x4*)(lds + RES_OFF + ((mat * 16 + fr) * 512 + wave * 64 + mt * 16 + 4 * quad) * 4) = acc;
            }
        __syncthreads();
        float rp, kp_, vp;
        { const bool first = (t0 % SEQ) == 0; const bf16_t* q = PA + (size_t)(t0 - 1) * NA;
          rp = first ? 0.f : bf2f(q[c]); kp_ = first ? 0.f : bf2f(q[512 + c]); vp = first ? 0.f : bf2f(q[1024 + c]); }
        unsigned char* rec = rec_base(a, (t0 / SEQ) * 8 + wave) + (size_t)((t0 % SEQ) / 16) * RSZ;
        LAS unsigned char* hb = lds + HAT_OFF + wave * 9216;
        float Pprev = 1.0f;
#pragma unroll 4
        for (int i = 0; i < 16; ++i) {
            const int t = t0 + i;
            const bf16_t* p = PA + (size_t)t * NA;
            const float rc = bf2f(p[c]), kc = bf2f(p[512 + c]), vc = bf2f(p[1024 + c]);
            const float r = rc + (rp - rc) * mur, k = kc + (kp_ - kc) * muk, v = vc + (vp - vc) * muv;
            rp = rc; kp_ = kc; vp = vc;
            const float z = *(const LAS float*)(lds + RES_OFF + (i * 512 + c) * 4) + w0;
            const float za = *(const LAS float*)(lds + RES_OFF + ((16 + i) * 512 + c) * 4) + a0;
            const float sp = fmaxf(-z, 0.f) + __logf(1.0f + __expf(-fabsf(z)));
            const float w = -sp - 0.5f;
            const float dec = __expf(-__expf(w));
            const float av = __builtin_amdgcn_rcpf(1.0f + __expf(-za));
            float kk = k * kkc; const float ss = wave_sum_dpp(kk * kk); kk = kk * __builtin_amdgcn_rcpf(fmaxf(__builtin_amdgcn_sqrtf(ss), 1e-12f));
            const float kn = k * (1.0f + (av - 1.0f) * kac);
            const float bon = wave_sum_dpp(r * kn * rkc);
            const float P = Pprev * dec, iP = __builtin_amdgcn_rcpf(P);
            LAS unsigned short* hat = (LAS unsigned short*)hb + i * 72 + lane;
            hat[0] = f2bf(-kk * Pprev); hat[1152] = f2bf(r * P); hat[2304] = f2bf(kk * av * iP); hat[3456] = f2bf(kn * iP);
            Pprev = P;
            const unsigned short vb16 = f2bf(v);
            VR[(size_t)t * 512 + c] = vb16;
            *(unsigned short*)(rec + 8192 + (lane >> 4) * 512 + ((i >> 2) * 16 + (lane & 15)) * 8 + (i & 3) * 2) = vb16;
            if (lane == 0) BON[t * 8 + wave] = bon;
        }
        *(float*)(rec + 12288 + lane * 4) = Pprev;
        asm volatile("s_waitcnt lgkmcnt(0)" ::: "memory");
        {
            pbf16x8 fa[2], fr2[2], fb[2], fk[2];
#pragma unroll
            for (int ks = 0; ks < 2; ++ks) { const int off = fr * 144 + (ks * 32 + 8 * quad) * 2;
                fa[ks] = *(const LAS pbf16x8*)(hb + off); fr2[ks] = *(const LAS pbf16x8*)(hb + 2304 + off); fb[ks] = *(const LAS pbf16x8*)(hb + 4608 + off); fk[ks] = *(const LAS pbf16x8*)(hb + 6912 + off); }
            f32x4 cba = (f32x4){0.f, 0.f, 0.f, 0.f}, cka = cba, cbr = cba, ckr = cba;
#pragma unroll
            for (int ks = 0; ks < 2; ++ks) { cba = __builtin_amdgcn_mfma_f32_16x16x32_bf16(fb[ks], fa[ks], cba, 0, 0, 0); cka = __builtin_amdgcn_mfma_f32_16x16x32_bf16(fk[ks], fa[ks], cka, 0, 0, 0);
                                             cbr = __builtin_amdgcn_mfma_f32_16x16x32_bf16(fb[ks], fr2[ks], cbr, 0, 0, 0); ckr = __builtin_amdgcn_mfma_f32_16x16x32_bf16(fk[ks], fr2[ks], ckr, 0, 0, 0); }
            float nn[4];
            {   float x0[4], x1[4], x2[4];
#pragma unroll
                for (int e = 0; e < 4; ++e) { const int j = 4 * quad + e; x0[e] = (j < fr) ? cka[e] : 0.f; x1[e] = (j <= fr) ? ckr[e] : 0.f; x2[e] = (j <= fr) ? cbr[e] : 0.f; nn[e] = (j < fr) ? cba[e] : 0.f; }
                u32x2 w; w.x = pk2(x0[0], x0[1]); w.y = pk2(x0[2], x0[3]); *(u32x2*)(rec + 10240 + lane * 8) = w;
                w.x = pk2(x1[0], x1[1]); w.y = pk2(x1[2], x1[3]); *(u32x2*)(rec + 10752 + lane * 8) = w;
                w.x = pk2(x2[0], x2[1]); w.y = pk2(x2[2], x2[3]); *(u32x2*)(rec + 11776 + lane * 8) = w; }
#pragma unroll
            for (int ks = 0; ks < 2; ++ks) {
                const u32x2 alo = *(const LAS u32x2*)(hb + fr * 144 + (32 * ks + 4 * quad) * 2), ahi = *(const LAS u32x2*)(hb + fr * 144 + (32 * ks + 16 + 4 * quad) * 2);
                const u32x2 rlo = *(const LAS u32x2*)(hb + 2304 + fr * 144 + (32 * ks + 4 * quad) * 2), rhi = *(const LAS u32x2*)(hb + 2304 + fr * 144 + (32 * ks + 16 + 4 * quad) * 2);
                *(u32x4*)(rec + ks * 1024 + lane * 16) = (u32x4){alo.x, alo.y, ahi.x, ahi.y};
                *(u32x4*)(rec + 2048 + ks * 1024 + lane * 16) = (u32x4){rlo.x, rlo.y, rhi.x, rhi.y};
            }
#pragma unroll
            for (int mt = 0; mt < 4; ++mt) {
                const LAS unsigned short* hB = (const LAS unsigned short*)(hb + 4608) + (4 * quad) * 72 + 16 * mt + fr;
                const LAS unsigned short* hK = (const LAS unsigned short*)(hb + 6912) + (4 * quad) * 72 + 16 * mt + fr;
                u32x4 o; o.x = (unsigned)hB[0] | ((unsigned)hB[72] << 16); o.y = (unsigned)hB[144] | ((unsigned)hB[216] << 16); o.z = (unsigned)hK[0] | ((unsigned)hK[72] << 16); o.w = (unsigned)hK[144] | ((unsigned)hK[216] << 16);
                *(u32x4*)(rec + 4096 + mt * 1024 + lane * 16) = o;
            }
            asm volatile("s_waitcnt lgkmcnt(0)" ::: "memory");
            LAS float* NL = (LAS float*)hb;
#pragma unroll
            for (int e = 0; e < 4; ++e) NL[(4 * quad + e) * 16 + fr] = nn[e];
            asm volatile("s_waitcnt lgkmcnt(0)" ::: "memory");
            float X[16];
#pragma unroll
            for (int l = 0; l < 16; ++l) X[l] = (l == fr) ? 1.0f : 0.f;
#pragma unroll
            for (int j = 14; j >= 0; --j) {
                const f32x4 n0 = ((const LAS f32x4*)NL)[j * 4], n1 = ((const LAS f32x4*)NL)[j * 4 + 1], n2 = ((const LAS f32x4*)NL)[j * 4 + 2], n3 = ((const LAS f32x4*)NL)[j * 4 + 3];
                const float nr[16] = {n0.x, n0.y, n0.z, n0.w, n1.x, n1.y, n1.z, n1.w, n2.x, n2.y, n2.z, n2.w, n3.x, n3.y, n3.z, n3.w};
                float acc = X[j];
#pragma unroll
                for (int l = j + 1; l < 16; ++l) acc = __builtin_fmaf(nr[l], X[l], acc);
                X[j] = acc;
            }
            float mv[4];
#pragma unroll
            for (int e = 0; e < 4; ++e) mv[e] = quad == 0 ? X[e] : (quad == 1 ? X[4 + e] : (quad == 2 ? X[8 + e] : X[12 + e]));
            u32x2 w; w.x = pk2(mv[0], mv[1]); w.y = pk2(mv[2], mv[3]); *(u32x2*)(rec + 11264 + lane * 8) = w;
            asm volatile("s_waitcnt lgkmcnt(0)" ::: "memory");
        }
    }
}

__device__ __forceinline__ float rdlane(float x, int k) { return __uint_as_float(__builtin_amdgcn_readlane(__float_as_uint(x), k)); }
__device__ __forceinline__ void phase_scan_naive(const Args& a) {
    const int tid = threadIdx.x, lane = tid & 63, wave = tid >> 6;
    if (wave != 0) return;
    unsigned char* ws = a.ws;
    const bf16_t* R = (const bf16_t*)a.out; const bf16_t* KP = R + (size_t)M * 512; const bf16_t* V = KP + (size_t)M * 512; const bf16_t* AN = V + (size_t)M * 512;
    bf16_t* YM = (bf16_t*)(ws + WS_YMIX); const float* DEC = (const float*)(ws + WS_XN); const float* BON = (const float*)(ws + WS_BON);
    const bf16_t* PB = (const bf16_t*)(ws + WS_PB);
    for (int u = blockIdx.x; u < BATCH * 8; u += gridDim.x) {
        const int b = u >> 3, h = u & 7;
        const float lg = a.in[I_LNXG][h * 64 + lane], lb = a.in[I_LNXB][h * 64 + lane];
        float s[64];
#pragma unroll
        for (int k = 0; k < 64; ++k) s[k] = 0.f;
        for (int t = 0; t < SEQ; ++t) {
            const int tok = b * SEQ + t; const size_t o = (size_t)tok * 512 + h * 64 + lane;
            const float ca = bf2f(AN[o]), cw = DEC[o], cb = bf2f(YM[(size_t)tok * 1024 + h * 64 + lane]), ck = bf2f(KP[o]), cr = bf2f(R[o]), vv = bf2f(V[o]);
            float sa = 0.f;
#pragma unroll
            for (int k = 0; k < 64; ++k) sa += s[k] * rdlane(ca, k);
            float y = 0.f;
#pragma unroll
            for (int k = 0; k < 64; ++k) { s[k] = s[k] * rdlane(cw, k) + sa * rdlane(cb, k) + vv * rdlane(ck, k); y += s[k] * rdlane(cr, k); }
            const float mean = wave_sum(y) * (1.0f / 64.0f); const float d = y - mean; const float var = wave_sum(d * d) * (1.0f / 64.0f);
            float yn = d * rsqrtf(var + GN_EPS) * lg + lb;
            yn += BON[tok * 8 + h] * vv;
            const float g = bf2f(PB[(size_t)tok * NB + h * 64 + lane]);
            YM[(size_t)tok * 1024 + h * 64 + lane] = f2bf(yn * siluf_(g));
        }
    }
}

__device__ __forceinline__ void phase_attn_naive(const Args& a) {
    const int tid = threadIdx.x, lane = tid & 63, wave = tid >> 6;
    unsigned char* ws = a.ws;
    const bf16_t* PB = (const bf16_t*)(ws + WS_PB); bf16_t* YM = (bf16_t*)(ws + WS_YMIX);
    for (int u = blockIdx.x * 8 + wave; u < BATCH * 8 * 32; u += gridDim.x * 8) {
        const int c = u & 31, h = (u >> 5) & 7, b = u >> 8;
        const int t = b * SEQ + c * 64 + lane;
        float q[64], acc[64];
        { const u32x4* qp = (const u32x4*)(PB + (size_t)t * NB + 512 + h * 64);
#pragma unroll
          for (int i = 0; i < 8; ++i) { const u32x4 w = qp[i]; q[8 * i] = bflo(w.x) * 0.125f; q[8 * i + 1] = bfhi(w.x) * 0.125f; q[8 * i + 2] = bflo(w.y) * 0.125f; q[8 * i + 3] = bfhi(w.y) * 0.125f;
              q[8 * i + 4] = bflo(w.z) * 0.125f; q[8 * i + 5] = bfhi(w.z) * 0.125f; q[8 * i + 6] = bflo(w.w) * 0.125f; q[8 * i + 7] = bfhi(w.w) * 0.125f; } }
#pragma unroll
        for (int d = 0; d < 64; ++d) acc[d] = 0.f;
        float m = -1e30f, l = 0.f;
        const float* bt = a.in[I_ABIAS] + h * 257;
        const int k0 = (c - 8 > 0 ? c - 8 : 0) * 64, k1 = (c + 1) * 64;
        for (int kj = k0; kj < k1; ++kj) {
            const bf16_t* kr = PB + (size_t)(b * SEQ + kj) * NB + 1024 + h * 64;
            float s = 0.f;
#pragma unroll
            for (int i = 0; i < 8; ++i) { const u32x4 w = ((const u32x4*)kr)[i];
                s += q[8 * i] * bflo(w.x) + q[8 * i + 1] * bfhi(w.x) + q[8 * i + 2] * bflo(w.y) + q[8 * i + 3] * bfhi(w.y) + q[8 * i + 4] * bflo(w.z) + q[8 * i + 5] * bfhi(w.z) + q[8 * i + 6] * bflo(w.w) + q[8 * i + 7] * bfhi(w.w); }
            int rel = c * 64 + lane - kj; rel = rel < -128 ? -128 : (rel > 128 ? 128 : rel);
            s += bt[rel + 128];
            const float mn = fmaxf(m, s), al = __expf(m - mn), p = __expf(s - mn);
            l = l * al + p; m = mn;
            const bf16_t* vr = kr + 512;
#pragma unroll
            for (int i = 0; i < 8; ++i) { const u32x4 w = ((const u32x4*)vr)[i];
                acc[8 * i] = acc[8 * i] * al + p * bflo(w.x); acc[8 * i + 1] = acc[8 * i + 1] * al + p * bfhi(w.x); acc[8 * i + 2] = acc[8 * i + 2] * al + p * bflo(w.y); acc[8 * i + 3] = acc[8 * i + 3] * al + p * bfhi(w.y);
                acc[8 * i + 4] = acc[8 * i + 4] * al + p * bflo(w.z); acc[8 * i + 5] = acc[8 * i + 5] * al + p * bfhi(w.z); acc[8 * i + 6] = acc[8 * i + 6] * al + p * bflo(w.w); acc[8 * i + 7] = acc[8 * i + 7] * al + p * bfhi(w.w); }
        }
        const float il = 1.0f / l;
        const u32x4* gp = (const u32x4*)(PB + (size_t)t * NB + 2048 + h * 64);
        u32x4* op = (u32x4*)(YM + (size_t)t * 1024 + 512 + h * 64);
#pragma unroll
        for (int i = 0; i < 8; ++i) { const u32x4 g = gp[i]; u32x4 o;
            o.x = pk2(acc[8 * i] * il * siluf_(bflo(g.x)), acc[8 * i + 1] * il * siluf_(bfhi(g.x))); o.y = pk2(acc[8 * i + 2] * il * siluf_(bflo(g.y)), acc[8 * i + 3] * il * siluf_(bfhi(g.y)));
            o.z = pk2(acc[8 * i + 4] * il * siluf_(bflo(g.z)), acc[8 * i + 5] * il * siluf_(bfhi(g.z))); o.w = pk2(acc[8 * i + 6] * il * siluf_(bflo(g.w)), acc[8 * i + 7] * il * siluf_(bfhi(g.w)));
            op[i] = o; }
    }
}


typedef _Float16 h8 __attribute__((ext_vector_type(8)));
typedef _Float16 h4 __attribute__((ext_vector_type(4)));
typedef short bf16x8 __attribute__((ext_vector_type(8)));
template <int CTRL> __device__ __forceinline__ float dpp_add(float x) { return x + __uint_as_float(__builtin_amdgcn_update_dpp(0, __float_as_uint(x), CTRL, 0xf, 0xf, true)); }
__device__ __forceinline__ float red8(float x) { x = dpp_add<0xB1>(x); x = dpp_add<0x4E>(x); x = dpp_add<0x141>(x); return x; }
__device__ __forceinline__ float red16(float x) { x = dpp_add<0x128>(x); x = dpp_add<0x124>(x); x = dpp_add<0x122>(x); x = dpp_add<0x121>(x); return x; }
constexpr int SC_PH = 0, SC_VV = 40960, SC_SC = 57344, SC_YY = 57856;
constexpr int TC = 32;

__device__ __forceinline__ void scan_unit(const Args& a, LAS unsigned char* lds, int u) {
    const int tid = threadIdx.x, lane = tid & 63, wave = tid >> 6;
    const int b = u >> 3, h = u & 7;
    unsigned char* ws = a.ws;
    const bf16_t* R = (const bf16_t*)a.out; const bf16_t* KP = R + (size_t)M * 512; const bf16_t* V = KP + (size_t)M * 512; const bf16_t* AN = V + (size_t)M * 512;
    bf16_t* YM = (bf16_t*)(ws + WS_YMIX); const float* DEC = (const float*)(ws + WS_XN); const float* BON = (const float*)(ws + WS_BON);
    const bf16_t* PB = (const bf16_t*)(ws + WS_PB);
    const int st = tid >> 4, sq = tid & 15;
    const int row = wave * 8 + (lane >> 3), cg = lane & 7;
    const int colbase = h * 64 + 4 * sq;
    const f32x4 lg = *(const f32x4*)(a.in[I_LNXG] + colbase), lb = *(const f32x4*)(a.in[I_LNXB] + colbase);
    float s[8];
#pragma unroll
    for (int j = 0; j < 8; ++j) s[j] = 0.f;
    u32x2 gR, gK, gV, gA, gB; f32x4 gD;
#define SC_GLOAD(c) do { const size_t tok_ = (size_t)b * SEQ + (c) * TC + st; const size_t o_ = tok_ * 512 + colbase; \
        gR = *(const u32x2*)(R + o_); gK = *(const u32x2*)(KP + o_); gV = *(const u32x2*)(V + o_); gA = *(const u32x2*)(AN + o_); \
        gB = *(const u32x2*)(YM + tok_ * 1024 + colbase); gD = *(const f32x4*)(DEC + o_); } while (0)
#define SC_STAGE(buf) do { \
        const float r0 = bflo(gR.x), r1 = bfhi(gR.x), r2 = bflo(gR.y), r3 = bfhi(gR.y); \
        const float k0 = bflo(gK.x), k1 = bfhi(gK.x), k2 = bflo(gK.y), k3 = bfhi(gK.y); \
        const float b0 = bflo(gB.x), b1 = bfhi(gB.x), b2 = bflo(gB.y), b3 = bfhi(gB.y); \
        LAS h4* ph4 = (LAS h4*)(lds + SC_PH) + (size_t)(((buf) * TC + st) * 5) * 16 + sq; \
        ph4[0]  = (h4){(_Float16)bflo(gA.x), (_Float16)bfhi(gA.x), (_Float16)bflo(gA.y), (_Float16)bfhi(gA.y)}; \
        ph4[16] = (h4){(_Float16)(1.0f - gD.x), (_Float16)(1.0f - gD.y), (_Float16)(1.0f - gD.z), (_Float16)(1.0f - gD.w)}; \
        ph4[32] = (h4){(_Float16)b0, (_Float16)b1, (_Float16)b2, (_Float16)b3}; \
        ph4[48] = (h4){(_Float16)k0, (_Float16)k1, (_Float16)k2, (_Float16)k3}; \
        ph4[64] = (h4){(_Float16)(gD.x * r0), (_Float16)(gD.y * r1), (_Float16)(gD.z * r2), (_Float16)(gD.w * r3)}; \
        *((LAS f32x4*)(lds + SC_VV) + ((buf) * TC + st) * 16 + sq) = (f32x4){bflo(gV.x), bfhi(gV.x), bflo(gV.y), bfhi(gV.y)}; \
        float br_ = (b0 * r0 + b1 * r1) + (b2 * r2 + b3 * r3), kr_ = (k0 * r0 + k1 * r1) + (k2 * r2 + k3 * r3); \
        br_ = red16(br_); kr_ = red16(kr_); \
        if (sq == 0) *((LAS f32x2*)(lds + SC_SC) + (buf) * TC + st) = (f32x2){br_, kr_}; } while (0)
    SC_GLOAD(0); SC_STAGE(0);
    __syncthreads();
    for (int c = 0; c < SEQ / TC; ++c) {
        const int buf = c & 1;
        if (c + 1 < SEQ / TC) SC_GLOAD(c + 1);
        const size_t tokE = (size_t)b * SEQ + c * TC + st;
        const u32x2 gG = *(const u32x2*)(PB + tokE * NB + colbase);
        const float bon = BON[tokE * 8 + h];
        {
            const LAS h8* ph8 = (const LAS h8*)(lds + SC_PH) + buf * TC * 40 + cg;
            const LAS float* vvp = (const LAS float*)(lds + SC_VV) + buf * TC * 64 + row;
            const LAS f32x2* scp = (const LAS f32x2*)(lds + SC_SC) + buf * TC;
            LAS float* yyp = (LAS float*)(lds + SC_YY) + row;
            h8 cA = ph8[0], cE = ph8[8], cB = ph8[16], cK = ph8[24], cW = ph8[32]; float cv = vvp[0]; f32x2 cs = scp[0];
#pragma unroll 2
            for (int t = 0; t < TC; ++t) {
                const int tn = (t + 1 < TC) ? t + 1 : t;
                const h8 nA = ph8[tn * 40], nE = ph8[tn * 40 + 8], nB = ph8[tn * 40 + 16], nK = ph8[tn * 40 + 24], nW = ph8[tn * 40 + 32]; const float nv = vvp[tn * 64]; const f32x2 ns = scp[tn];
                float sa0 = 0.f, sa1 = 0.f, yw0 = 0.f, yw1 = 0.f;
#pragma unroll
                for (int j = 0; j < 4; ++j) { sa0 = __builtin_fmaf(s[j], (float)cA[j], sa0); sa1 = __builtin_fmaf(s[4 + j], (float)cA[4 + j], sa1);
                                              yw0 = __builtin_fmaf(s[j], (float)cW[j], yw0); yw1 = __builtin_fmaf(s[4 + j], (float)cW[4 + j], yw1); }
                float sa = red8(sa0 + sa1), yw = red8(yw0 + yw1);
#pragma unroll
                for (int j = 0; j < 8; ++j) { float uu = __builtin_fmaf(sa, (float)cB[j], s[j]); uu = __builtin_fmaf(cv, (float)cK[j], uu); s[j] = __builtin_fmaf(-(float)cE[j], s[j], uu); }
                const float y = yw + sa * cs.x + cv * cs.y;
                yyp[t * 64] = y;
                cA = nA; cE = nE; cB = nB; cK = nK; cW = nW; cv = nv; cs = ns;
            }
        }
        __syncthreads();
        {
            const f32x4 y4 = *((const LAS f32x4*)(lds + SC_YY) + st * 16 + sq);
            const f32x4 v4 = *((const LAS f32x4*)(lds + SC_VV) + (buf * TC + st) * 16 + sq);
            const float mean = red16((y4.x + y4.y) + (y4.z + y4.w)) * (1.0f / 64.0f);
            const f32x4 d = y4 - mean;
            const float var = red16((d.x * d.x + d.y * d.y) + (d.z * d.z + d.w * d.w)) * (1.0f / 64.0f);
            const float rstd = rsqrtf(var + GN_EPS);
            f32x4 o = d * rstd * lg + lb + v4 * bon;
            o.x *= siluf_(bflo(gG.x)); o.y *= siluf_(bfhi(gG.x)); o.z *= siluf_(bflo(gG.y)); o.w *= siluf_(bfhi(gG.y));
            u32x2 w; w.x = pk2(o.x, o.y); w.y = pk2(o.z, o.w);
            *(u32x2*)(YM + tokE * 1024 + colbase) = w;
        }
        if (c + 1 < SEQ / TC) SC_STAGE(buf ^ 1);
        __syncthreads();
    }
#undef SC_GLOAD
#undef SC_STAGE
}


struct ChOps { u32x4 Aa[2], Ar[2], Abk[4]; u32x2 Acka, Ackr, Aminv, Acbr, Vb; f32x4 P[4]; };
__device__ __forceinline__ void ch_load(ChOps& o, const unsigned char* rec, int nt, int lane, int quad) {
#pragma unroll
    for (int ks = 0; ks < 2; ++ks) { o.Aa[ks] = *(const u32x4*)(rec + ks * 1024 + lane * 16); o.Ar[ks] = *(const u32x4*)(rec + 2048 + ks * 1024 + lane * 16); }
#pragma unroll
    for (int mt = 0; mt < 4; ++mt) { o.Abk[mt] = *(const u32x4*)(rec + 4096 + mt * 1024 + lane * 16); o.P[mt] = *(const f32x4*)(rec + 12288 + (16 * mt + 4 * quad) * 4); }
    o.Vb = *(const u32x2*)(rec + 8192 + nt * 512 + lane * 8);
    o.Acka = *(const u32x2*)(rec + 10240 + lane * 8); o.Ackr = *(const u32x2*)(rec + 10752 + lane * 8); o.Aminv = *(const u32x2*)(rec + 11264 + lane * 8); o.Acbr = *(const u32x2*)(rec + 11776 + lane * 8);
}
__device__ __forceinline__ bf16x8 asbf(u32x4 v) { return __builtin_bit_cast(bf16x8, v); }
__device__ __forceinline__ void scan_unit_chunked(const Args& a, LAS unsigned char* lds, int u) {
    const int tid = threadIdx.x, lane = tid & 63, wave = tid >> 6, fr = lane & 15, quad = lane >> 4;
    const int b = u >> 3, h = u & 7;
    unsigned char* ws = a.ws;
    const bf16_t* VR = (const bf16_t*)(ws + WS_VRAW); bf16_t* YM = (bf16_t*)(ws + WS_YMIX); const float* BON = (const float*)(ws + WS_BON);
    const bf16_t* PB = (const bf16_t*)(ws + WS_PB);
    const unsigned char* recs = rec_base(a, u);
    LAS float* YY = (LAS float*)lds;
    const int etok = tid >> 3, er8 = (tid & 7) * 8;
    const f32x4 lg0 = *(const f32x4*)(a.in[I_LNXG] + h * 64 + er8), lg1 = *(const f32x4*)(a.in[I_LNXG] + h * 64 + er8 + 4);
    const f32x4 lb0 = *(const f32x4*)(a.in[I_LNXB] + h * 64 + er8), lb1 = *(const f32x4*)(a.in[I_LNXB] + h * 64 + er8 + 4);
    f32x4 S[4];
#pragma unroll
    for (int mt = 0; mt < 4; ++mt) S[mt] = (f32x4){0.f, 0.f, 0.f, 0.f};
    ChOps cur;
    if (wave < 4) ch_load(cur, recs, wave, lane, quad);
    for (int g = 0; g < SEQ / 64; ++g) {
        const size_t tokE = (size_t)b * SEQ + g * 64 + etok;
        const u32x4 ev = *(const u32x4*)(VR + tokE * 512 + h * 64 + er8);
        const u32x4 eg = *(const u32x4*)(PB + tokE * NB + h * 64 + er8);
        const float bon = BON[tokE * 8 + h];
        if (wave < 4) {
#pragma unroll
            for (int cc = 0; cc < 4; ++cc) {
                const int cidx = g * 4 + cc;
                ChOps nxt;
                ch_load(nxt, recs + (size_t)(cidx + 1 < SEQ / 16 ? cidx + 1 : cidx) * RSZ, wave, lane, quad);
                u32x4 sb[2];
#pragma unroll
                for (int ks = 0; ks < 2; ++ks) { sb[ks].x = pk2(S[2 * ks][0], S[2 * ks][1]); sb[ks].y = pk2(S[2 * ks][2], S[2 * ks][3]);
                                                 sb[ks].z = pk2(S[2 * ks + 1][0], S[2 * ks + 1][1]); sb[ks].w = pk2(S[2 * ks + 1][2], S[2 * ks + 1][3]); }
                const u32x4 vb = (u32x4){cur.Vb.x, cur.Vb.y, 0u, 0u};
                f32x4 rhs = (f32x4){0.f, 0.f, 0.f, 0.f}, hv = rhs;
#pragma unroll
                for (int ks = 0; ks < 2; ++ks) { rhs = __builtin_amdgcn_mfma_f32_16x16x32_bf16(asbf(cur.Aa[ks]), asbf(sb[ks]), rhs, 0, 0, 0); hv = __builtin_amdgcn_mfma_f32_16x16x32_bf16(asbf(cur.Ar[ks]), asbf(sb[ks]), hv, 0, 0, 0); }
                rhs = __builtin_amdgcn_mfma_f32_16x16x32_bf16(asbf((u32x4){cur.Acka.x, cur.Acka.y, 0u, 0u}), asbf(vb), rhs, 0, 0, 0);
                hv = __builtin_amdgcn_mfma_f32_16x16x32_bf16(asbf((u32x4){cur.Ackr.x, cur.Ackr.y, 0u, 0u}), asbf(vb), hv, 0, 0, 0);
                const u32x4 rb = (u32x4){pk2(rhs[0], rhs[1]), pk2(rhs[2], rhs[3]), 0u, 0u};
                const f32x4 sa = __builtin_amdgcn_mfma_f32_16x16x32_bf16(asbf((u32x4){cur.Aminv.x, cur.Aminv.y, 0u, 0u}), asbf(rb), (f32x4){0.f, 0.f, 0.f, 0.f}, 0, 0, 0);
                const u32x4 svb = (u32x4){pk2(sa[0], sa[1]), pk2(sa[2], sa[3]), cur.Vb.x, cur.Vb.y};
                const f32x4 y = __builtin_amdgcn_mfma_f32_16x16x32_bf16(asbf((u32x4){cur.Acbr.x, cur.Acbr.y, 0u, 0u}), asbf(svb), hv, 0, 0, 0);
#pragma unroll
                for (int mt = 0; mt < 4; ++mt) { S[mt] = __builtin_amdgcn_mfma_f32_16x16x32_bf16(asbf(cur.Abk[mt]), asbf(svb), S[mt], 0, 0, 0); S[mt] = S[mt] * cur.P[mt]; }
#pragma unroll
                for (int jj = 0; jj < 4; ++jj) YY[(cc * 16 + 4 * quad + jj) * 64 + 16 * wave + fr] = y[jj];
                cur = nxt;
            }
        }
        __syncthreads();
        {
            const f32x4 y0 = *(const LAS f32x4*)(YY + etok * 64 + er8), y1 = *(const LAS f32x4*)(YY + etok * 64 + er8 + 4);
            const float mean = red8(((y0.x + y0.y) + (y0.z + y0.w)) + ((y1.x + y1.y) + (y1.z + y1.w))) * (1.0f / 64.0f);
            const f32x4 d0 = y0 - mean, d1 = y1 - mean;
            const float var = red8(((d0.x * d0.x + d0.y * d0.y) + (d0.z * d0.z + d0.w * d0.w)) + ((d1.x * d1.x + d1.y * d1.y) + (d1.z * d1.z + d1.w * d1.w))) * (1.0f / 64.0f);
            const float rstd = rsqrtf(var + GN_EPS);
            const f32x4 v0 = (f32x4){bflo(ev.x), bfhi(ev.x), bflo(ev.y), bfhi(ev.y)}, v1 = (f32x4){bflo(ev.z), bfhi(ev.z), bflo(ev.w), bfhi(ev.w)};
            f32x4 o0 = d0 * rstd * lg0 + lb0 + v0 * bon, o1 = d1 * rstd * lg1 + lb1 + v1 * bon;
            o0.x *= siluf_(bflo(eg.x)); o0.y *= siluf_(bfhi(eg.x)); o0.z *= siluf_(bflo(eg.y)); o0.w *= siluf_(bfhi(eg.y));
            o1.x *= siluf_(bflo(eg.z)); o1.y *= siluf_(bfhi(eg.z)); o1.z *= siluf_(bflo(eg.w)); o1.w *= siluf_(bfhi(eg.w));
            u32x4 w; w.x = pk2(o0.x, o0.y); w.y = pk2(o0.z, o0.w); w.z = pk2(o1.x, o1.y); w.w = pk2(o1.z, o1.w);
            *(u32x4*)(YM + tokE * 1024 + h * 64 + er8) = w;
        }
        __syncthreads();
    }
}

constexpr int AT_KS = 0, AT_VT = 18432, AT_BT = 36864, AT_PITCH = 144;
__device__ __forceinline__ void attn_unit(const Args& a, LAS unsigned char* lds, int u) {
    const int tid = threadIdx.x, lane = tid & 63, wave = tid >> 6, fr = lane & 15, quad = lane >> 4;
    const int cp = u & 15, h = (u >> 4) & 7, b = u >> 7;
    unsigned char* ws = a.ws;
    const bf16_t* PB = (const bf16_t*)(ws + WS_PB); bf16_t* YM = (bf16_t*)(ws + WS_YMIX);
    const int c0 = 2 * cp, cq = c0 + (wave >> 2), qrow = (wave & 3) * 16 + fr;
    const size_t tq = (size_t)b * SEQ + cq * 64 + qrow;
    constexpr float LOG2E = 1.4426950408889634f;
    if (tid < 257) ((LAS float*)(lds + AT_BT))[tid] = a.in[I_ABIAS][h * 257 + tid] * LOG2E;
    bf16x8 qf[2];
    qf[0] = *(const bf16x8*)(PB + tq * NB + 512 + h * 64 + 8 * quad); qf[1] = *(const bf16x8*)(PB + tq * NB + 512 + h * 64 + 32 + 8 * quad);
    f32x4 O[4];
#pragma unroll
    for (int i = 0; i < 4; ++i) O[i] = (f32x4){0.f, 0.f, 0.f, 0.f};
    float m = -1e30f, l = 0.f;
    const int kfirst = c0 - 8 > 0 ? c0 - 8 : 0, klast = c0 + 1;
    const int kkey = tid >> 3, kdch = tid & 7;
    const int vkey = tid & 63, vdch = tid >> 6;
    const int vpos = (vkey & 32) + 8 * ((vkey >> 2) & 3) + 4 * ((vkey >> 4) & 1) + (vkey & 3);
    u32x4 gk, gv;
#define AT_GLD(kc) do { gk = *(const u32x4*)(PB + ((size_t)b * SEQ + (kc) * 64 + kkey) * NB + 1024 + h * 64 + kdch * 8); \
                        gv = *(const u32x4*)(PB + ((size_t)b * SEQ + (kc) * 64 + vkey) * NB + 1536 + h * 64 + vdch * 8); } while (0)
#define AT_SST(buf) do { *(LAS u32x4*)(lds + AT_KS + (buf) * 9216 + kkey * AT_PITCH + kdch * 16) = gk; \
        LAS unsigned short* vt_ = (LAS unsigned short*)(lds + AT_VT + (buf) * 9216) + (vdch * 8) * (AT_PITCH / 2) + vpos; \
        vt_[0 * 72] = (unsigned short)(gv.x & 0xffffu); vt_[1 * 72] = (unsigned short)(gv.x >> 16); vt_[2 * 72] = (unsigned short)(gv.y & 0xffffu); vt_[3 * 72] = (unsigned short)(gv.y >> 16); \
        vt_[4 * 72] = (unsigned short)(gv.z & 0xffffu); vt_[5 * 72] = (unsigned short)(gv.z >> 16); vt_[6 * 72] = (unsigned short)(gv.w & 0xffffu); vt_[7 * 72] = (unsigned short)(gv.w >> 16); } while (0)
    AT_GLD(kfirst); AT_SST(0);
    __syncthreads();
    for (int kc = kfirst; kc <= klast; ++kc) {
        const int buf = (kc - kfirst) & 1;
        if (kc < klast) AT_GLD(kc + 1);
        if (kc <= cq && kc >= cq - 8) {
            const LAS unsigned char* ks = lds + AT_KS + buf * 9216 + fr * AT_PITCH + quad * 16;
            const LAS unsigned char* vt = lds + AT_VT + buf * 9216 + fr * AT_PITCH + quad * 16;
            f32x4 sc[4];
#pragma unroll
            for (int kt = 0; kt < 4; ++kt) {
                sc[kt] = (f32x4){0.f, 0.f, 0.f, 0.f};
#pragma unroll
                for (int k2 = 0; k2 < 2; ++k2) { const bf16x8 kf = *(const LAS bf16x8*)(ks + kt * 16 * AT_PITCH + k2 * 64); sc[kt] = __builtin_amdgcn_mfma_f32_16x16x32_bf16(kf, qf[k2], sc[kt], 0, 0, 0); }
            }
            const int dch = cq - kc;
            const LAS float* bt = (const LAS float*)(lds + AT_BT);
            float mx = -1e30f;
            if (dch >= 3) {
                const float bc = bt[256];
#pragma unroll
                for (int kt = 0; kt < 4; ++kt)
#pragma unroll
                    for (int j = 0; j < 4; ++j) { sc[kt][j] = __builtin_fmaf(sc[kt][j], 0.125f * LOG2E, bc); mx = fmaxf(mx, sc[kt][j]); }
            } else {
                const int base = dch * 64 + qrow + 128 - 4 * quad;
#pragma unroll
                for (int kt = 0; kt < 4; ++kt)
#pragma unroll
                    for (int j = 0; j < 4; ++j) { int idx = base - kt * 16 - j; idx = idx > 256 ? 256 : idx; sc[kt][j] = __builtin_fmaf(sc[kt][j], 0.125f * LOG2E, bt[idx]); mx = fmaxf(mx, sc[kt][j]); }
            }
            mx = fmaxf(mx, __shfl_xor(mx, 16)); mx = fmaxf(mx, __shfl_xor(mx, 32));
            const float mn = fmaxf(m, mx), al = __builtin_amdgcn_exp2f(m - mn); m = mn;
            float ps = 0.f;
#pragma unroll
            for (int kt = 0; kt < 4; ++kt)
#pragma unroll
                for (int j = 0; j < 4; ++j) { sc[kt][j] = __builtin_amdgcn_exp2f(sc[kt][j] - mn); ps += sc[kt][j]; }
            l = l * al + ps;
#pragma unroll
            for (int i = 0; i < 4; ++i) O[i] = O[i] * al;
#pragma unroll
            for (int s2 = 0; s2 < 2; ++s2) {
                u32x4 pw; pw.x = pk2(sc[2 * s2][0], sc[2 * s2][1]); pw.y = pk2(sc[2 * s2][2], sc[2 * s2][3]); pw.z = pk2(sc[2 * s2 + 1][0], sc[2 * s2 + 1][1]); pw.w = pk2(sc[2 * s2 + 1][2], sc[2 * s2 + 1][3]);
                const bf16x8 pf = __builtin_bit_cast(bf16x8, pw);
#pragma unroll
                for (int dt = 0; dt < 4; ++dt) { const bf16x8 vf = *(const LAS bf16x8*)(vt + dt * 16 * AT_PITCH + s2 * 64); O[dt] = __builtin_amdgcn_mfma_f32_16x16x32_bf16(vf, pf, O[dt], 0, 0, 0); }
            }
        }
        if (kc < klast) AT_SST(buf ^ 1);
        __syncthreads();
    }
#undef AT_GLD
#undef AT_SST
    l += __shfl_xor(l, 16); l += __shfl_xor(l, 32);
    const float il = 1.0f / l;
#pragma unroll
    for (int dt = 0; dt < 4; ++dt) {
        const int dcol = h * 64 + dt * 16 + 4 * quad;
        const u32x2 g = *(const u32x2*)(PB + tq * NB + 2048 + dcol);
        const f32x4 o = O[dt] * il;
        u32x2 w; w.x = pk2(o[0] * siluf_(bflo(g.x)), o[1] * siluf_(bfhi(g.x))); w.y = pk2(o[2] * siluf_(bflo(g.y)), o[3] * siluf_(bfhi(g.y)));
        *(u32x2*)(YM + tq * 1024 + 512 + dcol) = w;
    }
}

__device__ __forceinline__ void phase_mix(const Args& a, LAS unsigned char* lds, bool do_scan = true, bool do_attn = true) {
    unsigned* ctr = (unsigned*)(a.ws + WS_CTR);
    if (do_scan) for (int u = blockIdx.x; u < BATCH * 8; u += gridDim.x) scan_unit_chunked(a, lds, u);
    LAS int* uw = (LAS int*)(lds + 40000);
    if (do_attn) for (;;) {
        __syncthreads();
        if (threadIdx.x == 0) *uw = (int)atomicAdd(ctr, 1u);
        __syncthreads();
        const int u = *uw;
        if (u >= BATCH * 8 * 16) break;
        attn_unit(a, lds, u);
    }
}

__device__ __forceinline__ void phase_sg_naive(const Args& a, unsigned char* ldsb) {
    const int tid = threadIdx.x;
    unsigned char* ws = a.ws;
    const bf16_t* P1 = (const bf16_t*)(ws + WS_P1); bf16_t* Y2 = (bf16_t*)(ws + WS_YMIX);
    const float* vsum = (const float*)(ws + WS_VSUM); const float* vsq = (const float*)(ws + WS_VSQ);
    float* vn = (float*)ldsb;
    const int c = tid & 127, i0 = tid >> 7;
    for (int u = blockIdx.x; u < BATCH * 16 * 8; u += gridDim.x) {
        const int g = u & 7, nb = (u >> 3) & 15, b = u >> 7;
        const int tbase = b * SEQ + nb * 128;
        const float lg = a.in[I_SGLNG][g * 128 + c], lb = a.in[I_SGLNB][g * 128 + c];
        for (int j = i0; j < 128; j += 4) {
            const int t = tbase + j; const float mean = vsum[t] * (1.0f / 1024.0f); const float var = vsq[t] * (1.0f / 1024.0f) - mean * mean;
            const float rstd = rsqrtf(fmaxf(var, 0.f) + LN_EPS);
            vn[j * 128 + c] = (bf2f(P1[(size_t)t * N3 + 1024 + g * 128 + c]) - mean) * rstd * lg + lb;
        }
        __syncthreads();
        const float* wg = a.in[I_SGW] + (size_t)g * 128 * 128; const float* sb = a.in[I_SGB] + g * 128;
        for (int i = i0; i < 128; i += 4) {
            const int jend = (i < 64) ? 64 : 128;
            float acc = 0.f;
            for (int j = 0; j < jend; ++j) acc += wg[i * 128 + j] * vn[j * 128 + c];
            const int t = tbase + i;
            const float uu = bf2f(P1[(size_t)t * N3 + g * 128 + c]), gt = bf2f(P1[(size_t)t * N3 + 2048 + g * 128 + c]);
            Y2[(size_t)t * 1024 + g * 128 + c] = f2bf(uu * (acc + sb[i]) * gt);
        }
        __syncthreads();
    }
}


__device__ __forceinline__ void phase_sg(const Args& a, LAS unsigned char* lds) {
    const int tid = threadIdx.x, lane = tid & 63, wave = tid >> 6, fr = lane & 15, quad = lane >> 4;
    unsigned char* ws = a.ws;
    const bf16_t* P1 = (const bf16_t*)(ws + WS_P1); bf16_t* Y2 = (bf16_t*)(ws + WS_YMIX); const bf16_t* SGW = (const bf16_t*)(ws + WS_SGW);
    const float* vsum = (const float*)(ws + WS_VSUM); const float* vsq = (const float*)(ws + WS_VSQ);
    constexpr int VPB = 272;
    const int sj = tid & 127, scc = tid >> 7;
    constexpr int NUN = BATCH * 16 * 8;
    const int per = (NUN + (int)gridDim.x - 1) / (int)gridDim.x;
    const int u0 = blockIdx.x * per, u1 = (u0 + per < NUN) ? u0 + per : NUN;
    for (int u = u0; u < u1; ++u) {
        const int g = u >> 8, b = (u >> 4) & 15, nb = u & 15;
        const int tbase = b * SEQ + nb * 128;
        {
            const int t = tbase + sj; const float mean = vsum[t] * (1.0f / 1024.0f); const float var = vsq[t] * (1.0f / 1024.0f) - mean * mean;
            const float rstd = rsqrtf(fmaxf(var, 0.f) + LN_EPS);
#pragma unroll
            for (int q = 0; q < 4; ++q) {
                const int c8 = (scc + 4 * q) * 8;
                const u32x4 w = *(const u32x4*)(P1 + (size_t)t * N3 + 1024 + g * 128 + c8);
                const f32x4 g0 = *(const f32x4*)(a.in[I_SGLNG] + g * 128 + c8), g1 = *(const f32x4*)(a.in[I_SGLNG] + g * 128 + c8 + 4);
                const f32x4 b0 = *(const f32x4*)(a.in[I_SGLNB] + g * 128 + c8), b1 = *(const f32x4*)(a.in[I_SGLNB] + g * 128 + c8 + 4);
                LAS unsigned short* vt = (LAS unsigned short*)lds + c8 * (VPB / 2) + sj;
                vt[0 * (VPB / 2)] = f2bf((bflo(w.x) - mean) * rstd * g0.x + b0.x); vt[1 * (VPB / 2)] = f2bf((bfhi(w.x) - mean) * rstd * g0.y + b0.y);
                vt[2 * (VPB / 2)] = f2bf((bflo(w.y) - mean) * rstd * g0.z + b0.z); vt[3 * (VPB / 2)] = f2bf((bfhi(w.y) - mean) * rstd * g0.w + b0.w);
                vt[4 * (VPB / 2)] = f2bf((bflo(w.z) - mean) * rstd * g1.x + b1.x); vt[5 * (VPB / 2)] = f2bf((bfhi(w.z) - mean) * rstd * g1.y + b1.y);
                vt[6 * (VPB / 2)] = f2bf((bflo(w.w) - mean) * rstd * g1.z + b1.z); vt[7 * (VPB / 2)] = f2bf((bfhi(w.w) - mean) * rstd * g1.w + b1.w);
            }
        }
        const int irow = 16 * wave + fr;
        bf16x8 wf[4];
#pragma unroll
        for (int ks = 0; ks < 4; ++ks) wf[ks] = *(const bf16x8*)(SGW + (size_t)(g * 128 + irow) * 128 + ks * 32 + 8 * quad);
        __syncthreads();
        f32x4 acc[8];
#pragma unroll
        for (int ct = 0; ct < 8; ++ct) {
            acc[ct] = (f32x4){0.f, 0.f, 0.f, 0.f};
#pragma unroll
            for (int ks = 0; ks < 4; ++ks) {
                if (ks < 2 || wave >= 4) { const bf16x8 vf = *(const LAS bf16x8*)(lds + (ct * 16 + fr) * VPB + ks * 64 + quad * 16); acc[ct] = __builtin_amdgcn_mfma_f32_16x16x32_bf16(vf, wf[ks], acc[ct], 0, 0, 0); }
            }
        }
        const size_t t = (size_t)tbase + irow; const float sbv = a.in[I_SGB][g * 128 + irow];
#pragma unroll
        for (int ct = 0; ct < 8; ++ct) {
            const int col = g * 128 + ct * 16 + 4 * quad;
            const u32x2 uu = *(const u32x2*)(P1 + t * N3 + col), gg = *(const u32x2*)(P1 + t * N3 + 2048 + col);
            u32x2 w; w.x = pk2(bflo(uu.x) * (acc[ct][0] + sbv) * bflo(gg.x), bfhi(uu.x) * (acc[ct][1] + sbv) * bfhi(gg.x));
            w.y = pk2(bflo(uu.y) * (acc[ct][2] + sbv) * bflo(gg.y), bfhi(uu.y) * (acc[ct][3] + sbv) * bfhi(gg.y));
            *(u32x2*)(Y2 + t * 1024 + col) = w;
        }
        __syncthreads();
    }
}

__device__ __forceinline__ void phase_final(const Args& a) {
    const int tid = threadIdx.x, lane = tid & 63, wave = tid >> 6;
    const float* rs2 = (const float*)(a.ws + WS_RS2); const float* fg = a.in[I_FG];
    const int gw = blockIdx.x * 8 + wave, NGW = gridDim.x * 8;
    f32x4 g4[4];
#pragma unroll
    for (int j = 0; j < 4; ++j) g4[j] = ((const f32x4*)fg)[lane + 64 * j];
    for (int m = gw; m < M; m += NGW) {
        const float rinv = rsqrtf(rs2[m] * (1.0f / DM) + RMS_EPS);
        f32x4* p = (f32x4*)(a.out + (size_t)m * DM) + lane;
#pragma unroll
        for (int j = 0; j < 4; ++j) { f32x4 v = p[64 * j]; v = v * rinv * g4[j]; p[64 * j] = v; }
    }
}

template <int PHM> __global__ void __launch_bounds__(NTHR, 2) mega(Args a) {
    extern __shared__ __attribute__((aligned(16))) unsigned char lds[];
    unsigned char* ws = a.ws;
    const int lo = a.lo, hi = a.hi;
#define IN(k) (((PHM >> (k)) & 1) && lo <= (k) && (k) < hi)
#define SEAM(k) do { if (IN(k) && IN((k) + 1)) { cg::this_grid().sync(); } } while (0)
    if (IN(0)) { phase_prologue(a, lds); }
    SEAM(0);
    if (IN(1)) { EpiG1 f{(const float*)(ws + WS_RS0), (bf16_t*)(ws + WS_PA), (bf16_t*)(ws + WS_PB)};
        gemm_any(lds, (const bf16_t*)(ws + WS_XN), (const bf16_t*)(ws + WS_W1T), M, N1, DM, f); }
    SEAM(1);
    if (IN(2)) { phase_prep(a, lds); }
    SEAM(2);
    #if PROBE & 1
    phase_prep(a, lds); cg::this_grid().sync();
#endif
#if USE_NAIVE_MIX
    if (IN(3)) { phase_scan_naive(a); phase_attn_naive(a); }
#else
    if (IN(3)) { phase_mix(a, (LAS unsigned char*)lds); }
#endif
    SEAM(3);
#if PROBE & 2
    phase_prep(a, lds); cg::this_grid().sync(); phase_mix(a, (LAS unsigned char*)lds); cg::this_grid().sync();
#endif
#if PROBE & 64
    phase_prep(a, lds); cg::this_grid().sync(); phase_mix(a, (LAS unsigned char*)lds, true, false); cg::this_grid().sync();
#endif
#if PROBE & 32
    if (blockIdx.x == 0 && threadIdx.x == 0) *(unsigned*)(ws + WS_CTR) = 0u;
    cg::this_grid().sync(); phase_mix(a, (LAS unsigned char*)lds, false); cg::this_grid().sync();
#endif
#if PROBE & 4
    phase_prologue(a, lds); cg::this_grid().sync();
#endif
#if PROBE & 16
    { EpiG1 f{(const float*)(ws + WS_RS0), (bf16_t*)(ws + WS_PA), (bf16_t*)(ws + WS_PB)};
        gemm_any(lds, (const bf16_t*)(ws + WS_XN), (const bf16_t*)(ws + WS_W1T), M, N1, DM, f); cg::this_grid().sync(); }
#endif
    if (IN(4)) { EpiG2 f{a.in[I_X], a.out, (bf16_t*)(ws + WS_XN), (float*)(ws + WS_RS1)};
        gemm_any(lds, (const bf16_t*)(ws + WS_YMIX), (const bf16_t*)(ws + WS_W2T), M, DM, DM, f); }
    SEAM(4);
#if PROBE & 128
    { EpiG2 f{a.in[I_X], a.out, (bf16_t*)(ws + WS_XN), (float*)(ws + 640 * 1024)};
        gemm_any(lds, (const bf16_t*)(ws + WS_YMIX), (const bf16_t*)(ws + WS_W2T), M, DM, DM, f); cg::this_grid().sync(); }
#endif
    if (IN(5)) { EpiG3 f{(const float*)(ws + WS_RS1), (bf16_t*)(ws + WS_P1), (float*)(ws + WS_VSUM), (float*)(ws + WS_VSQ)};
        gemm_any(lds, (const bf16_t*)(ws + WS_XN), (const bf16_t*)(ws + WS_W3T), M, N3, DM, f); }
    SEAM(5);
    if (IN(6)) { phase_sg(a, (LAS unsigned char*)lds); }
    SEAM(6);
#if PROBE & 8
    phase_sg(a, (LAS unsigned char*)lds); cg::this_grid().sync();
#endif
    if (IN(7)) { EpiG4 f{a.out, (float*)(ws + WS_RS2)};
        gemm_any(lds, (const bf16_t*)(ws + WS_YMIX), (const bf16_t*)(ws + WS_W4T), M, DM, DM, f); }
    SEAM(7);
    if (IN(8)) { phase_final(a); }
#undef IN
#undef SEAM
}
constexpr int NPHASE = 9;
}
#if defined(__HIP_DEVICE_COMPILE__)
#pragma clang attribute pop
#endif

extern "C" void kernel_launch(void* const* d_in, const int* in_sizes, int n_in, void* d_out, int out_size, void* d_ws, size_t ws_size, hipStream_t stream) {
    using namespace mk;
    static int grid = 0;
    if (grid == 0) {
        if (n_in != 22 || out_size != M * DM || ws_size < WS_END) { fprintf(stderr, "kernel_launch: unexpected shapes (n_in %d out %d ws %zu)\n", n_in, out_size, ws_size); grid = -1; return; }
        int dev = 0, cus = 0, per_cu = 0;
        (void)hipGetDevice(&dev); (void)hipDeviceGetAttribute(&cus, hipDeviceAttributeMultiprocessorCount, dev);
#if N_LAUNCH_MODE == 1
        if (hipFuncSetAttribute((const void*)mega<0x1ff>, hipFuncAttributeMaxDynamicSharedMemorySize, LDS_BYTES) != hipSuccess) { fprintf(stderr, "kernel_launch: hipFuncSetAttribute failed\n"); grid = -1; return; }
        if (hipOccupancyMaxActiveBlocksPerMultiprocessor(&per_cu, (const void*)mega<0x1ff>, NTHR, LDS_BYTES) != hipSuccess || per_cu < 1) { fprintf(stderr, "kernel_launch: occupancy query says %d\n", per_cu); per_cu = 1; }
#else
        if (hipFuncSetAttribute((const void*)mega<0x1f7>, hipFuncAttributeMaxDynamicSharedMemorySize, LDS_BYTES) != hipSuccess || hipFuncSetAttribute((const void*)mega<0x008>, hipFuncAttributeMaxDynamicSharedMemorySize, LDS_BYTES) != hipSuccess) { fprintf(stderr, "kernel_launch: hipFuncSetAttribute failed\n"); grid = -1; return; }
#endif
        (void)hipGetLastError();
        grid = cus * 1;
        if (grid <= 0) grid = 256;
    }
    if (grid < 0) return;
    Args a{};
    for (int i = 0; i < 22; ++i) a.in[i] = (const float*)d_in[i];
    a.out = (float*)d_out; a.ws = (unsigned char*)d_ws;
#if N_LAUNCH_MODE == 2
    {
        void* args[] = {&a};
        a.lo = 0; a.hi = 3;
        hipError_t e = hipLaunchCooperativeKernel((const void*)mega<0x1f7>, dim3(grid), dim3(NTHR), args, LDS_BYTES, stream);
        if (e != hipSuccess) fprintf(stderr, "kernel_launch: cooperative launch A failed: %s (grid %d)\n", hipGetErrorString(e), grid);
        a.lo = 3; a.hi = 4;
        hipLaunchKernelGGL(mega<0x008>, dim3(grid), dim3(NTHR), LDS_BYTES, stream, a);
        a.lo = 4; a.hi = NPHASE;
        e = hipLaunchCooperativeKernel((const void*)mega<0x1f7>, dim3(grid), dim3(NTHR), args, LDS_BYTES, stream);
        if (e != hipSuccess) fprintf(stderr, "kernel_launch: cooperative launch B failed: %s (grid %d)\n", hipGetErrorString(e), grid);
    }
#elif N_LAUNCH_MODE == 1
    a.lo = 0; a.hi = NPHASE;
    void* args[] = {&a};
    hipError_t e = hipLaunchCooperativeKernel((const void*)mega<0x1ff>, dim3(grid), dim3(NTHR), args, LDS_BYTES, stream);
    if (e != hipSuccess) fprintf(stderr, "kernel_launch: cooperative launch failed: %s (grid %d)\n", hipGetErrorString(e), grid);
#else
    for (int ph = 0; ph < NPHASE; ++ph) {
        a.lo = ph; a.hi = ph + 1;
        if (ph == 3) hipLaunchKernelGGL(mega<0x008>, dim3(grid), dim3(NTHR), LDS_BYTES, stream, a);
        else hipLaunchKernelGGL(mega<0x1f7>, dim3(grid), dim3(NTHR), LDS_BYTES, stream, a);
    }
#endif
}
```

```cpp
#if defined(__HIP_DEVICE_COMPILE__)
#pragma clang attribute push(__attribute__((target("no-packed-fp32-ops"))), apply_to = function)
#endif
#include <hip/hip_runtime.h>
#include <hip/hip_cooperative_groups.h>
#include <cstdio>
#include <cstdint>
namespace cg = cooperative_groups;
#ifndef USE_PG8
#define USE_PG8 1
#endif
#ifndef N_LAUNCH_MODE
#define N_LAUNCH_MODE 1
#endif
#ifndef PHMASK
#define PHMASK 0x1ff
#endif
#ifndef USE_NAIVE_MIX
#define USE_NAIVE_MIX 0
#endif
#ifndef PROBE
#define PROBE 0
#endif
#ifndef USE_XBAR
#define USE_XBAR 1
#endif
namespace pg8 {
#define PG8_LAS __attribute__((address_space(3)))
typedef unsigned short bf16_t;
typedef short bf16x8 __attribute__((ext_vector_type(8)));
typedef float f32x4 __attribute__((ext_vector_type(4)));
typedef unsigned u32x4 __attribute__((ext_vector_type(4)));
constexpr int BM = 256, BK = 64, HALF = 128, HTB = HALF * BK * 2  , STAGE_BYTES = 8 * HTB, NXCD = 8, WGM = 8;

__host__ __device__ __forceinline__ int lds_byte(int r, int c) { const int st = (r >> 4) * 2 + (c >> 5), rr = r & 15, cc = c & 31, ob = rr * 64 + cc * 2; return st * 1024 + (ob ^ (((ob >> 9) & 1) << 5)); }
__host__ __device__ __forceinline__ void stage_rc(int b, int& R, int& C) { const int st = b / 1024, sb = b % 1024, swz = sb ^ (((sb >> 9) & 1) << 5); R = (st >> 1) * 16 + swz / 64; C = (st & 1) * 32 + (swz % 64) / 2; }
__host__ __device__ __forceinline__ int perm32(int rho) { const int n = rho >> 4, i = rho & 15; return 8 * (i >> 2) + 4 * n + (i & 3); }

struct Unit { int pm, pn; };
struct Gemm { const bf16_t* A; const bf16_t* Bt; int M, N, K; };

struct StaticOrder {
    int nM, nN, nwg, G, c;
    __host__ __device__ void init(int M, int N, int G_, int c_) { nM = M / BM; nN = N / BM; nwg = nM * nN; G = G_; c = c_; }
    __host__ __device__ bool next(int i, Unit& u) const {
        const long L = (long)i * G + c; if (L >= nwg) return false;
        int wgid = (int)L; { const int q = nwg / NXCD, r = nwg % NXCD, xcd = wgid % NXCD, off = wgid / NXCD; wgid = (xcd < r ? xcd * (q + 1) : r * (q + 1) + (xcd - r) * q) + off; }
        const int nig = WGM * nN, gid = wgid / nig, fm = gid * WGM, gsz = (nM - fm) < WGM ? (nM - fm) : WGM;
        u.pm = fm + ((wgid % nig) % gsz); u.pn = (wgid % nig) / gsz; return true;
    }
    __device__ __forceinline__ void a_ready(const Unit&) const {}
    __device__ __forceinline__ void done(const Unit&) const {}
};

__device__ __forceinline__ unsigned cvt_pk_bf16(float lo, float hi) { unsigned r; asm volatile("v_cvt_pk_bf16_f32 %0, %1, %2" : "=v"(r) : "v"(lo), "v"(hi)); return r; }
typedef float f32x2 __attribute__((ext_vector_type(2)));
__device__ __forceinline__ f32x2 gelu_pk(f32x2 v) {
    const f32x2 av = __builtin_elementwise_abs(v), d = av * 0.2316418882f + 1.0f;
    f32x2 t; t.x = __builtin_amdgcn_rcpf(d.x); t.y = __builtin_amdgcn_rcpf(d.y);
    f32x2 q = t * 0.5307027145f + (-0.7265760135f); q = q * t + 0.7107068705f; q = q * t + (-0.142248368f); q = q * t + 0.127414796f; q = q * t;
    const f32x2 s = (v * v) * (-0.72134752044f);
    f32x2 e; e.x = __builtin_amdgcn_exp2f(s.x); e.y = __builtin_amdgcn_exp2f(s.y);
    const f32x2 m = v * (q * e), r = v - m;
    f32x2 o; o.x = v.x < 0.f ? m.x : r.x; o.y = v.y < 0.f ? m.y : r.y; return o;
}

template <int ACT  > struct EpiBf16 {
    static constexpr bool PERM = true, AFTER_DRAIN = false; static_assert(ACT == 0 || ACT == 1, "EpiBf16: ACT is 0 (none) or 1 (gelu_pk)");
    bf16_t* O; int ldc; const float* bias; int split_cols; size_t split_stride; float scale0;
    __device__ __forceinline__ void operator()(const f32x4 (&acc)[2][2][4][2], const Unit& u, int wr, int wc, int fr, int fq) const {
        const int row0 = u.pm * BM + wr * 64 + fr; int colt = u.pn * BM; bf16_t* base = O;
        float sc = 1.f; if (split_cols) { const int t = colt / split_cols; base += (size_t)t * split_stride; colt -= t * split_cols; if (t == 0) sc = scale0; }
        const int col0 = colt + wc * 32 + 8 * fq, bcol0 = u.pn * BM + wc * 32 + 8 * fq;
        f32x4 bv[2][2];
#pragma unroll
        for (int bj = 0; bj < 2; ++bj)
#pragma unroll
            for (int n = 0; n < 2; ++n) bv[bj][n] = bias ? *(const f32x4*)(bias + bcol0 + bj * HALF + 4 * n) : (f32x4){0.f, 0.f, 0.f, 0.f};
#pragma unroll
        for (int ai = 0; ai < 2; ++ai)
#pragma unroll
            for (int m = 0; m < 4; ++m) { bf16_t* rowp = base + (size_t)(row0 + ai * HALF + m * 16) * ldc + col0;
#pragma unroll
                for (int bj = 0; bj < 2; ++bj) { f32x4 v0 = acc[ai][bj][m][0] + bv[bj][0], v1 = acc[ai][bj][m][1] + bv[bj][1];
                    if (ACT == 1) { f32x2 a = gelu_pk((f32x2){v0[0], v0[1]}), b = gelu_pk((f32x2){v0[2], v0[3]}), c = gelu_pk((f32x2){v1[0], v1[1]}), d = gelu_pk((f32x2){v1[2], v1[3]});
                        v0 = (f32x4){a.x, a.y, b.x, b.y}; v1 = (f32x4){c.x, c.y, d.x, d.y}; }
                    v0 = v0 * sc; v1 = v1 * sc; u32x4 w; w.x = cvt_pk_bf16(v0[0], v0[1]); w.y = cvt_pk_bf16(v0[2], v0[3]); w.z = cvt_pk_bf16(v1[0], v1[1]); w.w = cvt_pk_bf16(v1[2], v1[3]);
                    *(u32x4*)(rowp + bj * HALF) = w; } }
    }
};
template <class Epi, class Sched, bool ALIGN_EPI = false, bool SP2 = false>
__device__ __forceinline__ void gemm_phase(PG8_LAS unsigned char* lds, const Gemm g, const Sched& S, const Epi& E) {
    const int tid = threadIdx.x, wid = __builtin_amdgcn_readfirstlane(tid >> 6), lane = tid & 63, wr = wid >> 2, wc = wid & 3, fr = lane & 15, fq = lane >> 4;
    const int K = g.K, nt = K / BK;
    unsigned voffA[2], voffB[2];
#pragma unroll
    for (int i = 0; i < 2; ++i) { int R, C; stage_rc(tid * 16 + i * 8192, R, C); const int Rb = Epi::PERM ? ((R & ~31) + perm32(R & 31)) : R;
        voffA[i] = (unsigned)(R * K + C) * 2u; voffB[i] = (unsigned)(Rb * K + C) * 2u; }
    const size_t kstep = (size_t)(BK * 2);
    const size_t hstep = (size_t)HALF * K * 2;
    const size_t tstep = 2 * hstep;
    const unsigned ldsw = (unsigned)wid * 1024u;
    const int aoff = lds_byte(wr * 64 + fr, fq * 8), boff = lds_byte(wc * 32 + fr, fq * 8);
#define PG8_SA(b, h) (((b) * 2 + (h)) * HTB)
#define PG8_SB(b, h) ((4 + (b) * 2 + (h)) * HTB)
#define PG8_STAGE(bufoff, gbase, voff) do { _Pragma("unroll") for (int _i = 0; _i < 2; ++_i) \
        __builtin_amdgcn_global_load_lds((const unsigned*)((const char*)(gbase) + (voff)[_i]), (PG8_LAS unsigned*)(lds + (bufoff) + ldsw + _i * 8192), 16, 0, 0); } while (0)
#define PG8_LDA(dst, b, h) do { _Pragma("unroll") for (int m = 0; m < 4; ++m) _Pragma("unroll") for (int k = 0; k < 2; ++k) dst[m][k] = *(const PG8_LAS bf16x8*)(lds + PG8_SA(b, h) + aoff + m * 2048 + k * 1024); } while (0)
#define PG8_LDB(dst, b, h) do { _Pragma("unroll") for (int n = 0; n < 2; ++n) _Pragma("unroll") for (int k = 0; k < 2; ++k) dst[n][k] = *(const PG8_LAS bf16x8*)(lds + PG8_SB(b, h) + boff + n * 2048 + k * 1024); } while (0)
#define PG8_MMA(ai, bj, At, Bt) do { __builtin_amdgcn_s_setprio(1); _Pragma("unroll") for (int m = 0; m < 4; ++m) _Pragma("unroll") for (int n = 0; n < 2; ++n) _Pragma("unroll") for (int k = 0; k < 2; ++k) \
        acc[ai][bj][m][n] = __builtin_amdgcn_mfma_f32_16x16x32_bf16(Bt[n][k], At[m][k], acc[ai][bj][m][n], 0, 0, 0); __builtin_amdgcn_s_setprio(0); } while (0)
#define PG8_WAIT_V(n) asm volatile("s_waitcnt vmcnt(" #n ")" ::: "memory")
#define PG8_WAIT_L(n) asm volatile("s_waitcnt lgkmcnt(" #n ")" ::: "memory")
#define PG8_BAR __builtin_amdgcn_s_barrier()
#define PG8_SCHED __builtin_amdgcn_sched_barrier(0)
    Unit cur, nxt; int ui = 0;
    if (!S.next(0, cur)) return;
    f32x4 acc[2][2][4][2];
#pragma unroll
    for (int a = 0; a < 2; ++a)
#pragma unroll
        for (int b = 0; b < 2; ++b)
#pragma unroll
            for (int m = 0; m < 4; ++m)
#pragma unroll
                for (int n = 0; n < 2; ++n) acc[a][b][m][n] = (f32x4){0.f, 0.f, 0.f, 0.f};
    bf16x8 At[4][2], B0[2][2], B1[2][2];
    const char* cA = (const char*)g.A + (size_t)cur.pm * tstep; const char* cB = (const char*)g.Bt + (size_t)cur.pn * tstep;
    S.a_ready(cur);
    if constexpr (SP2) {
        PG8_STAGE(PG8_SB(0, 0), cB, voffB); PG8_STAGE(PG8_SB(0, 1), cB + hstep, voffB); PG8_STAGE(PG8_SA(0, 0), cA, voffA); PG8_STAGE(PG8_SA(0, 1), cA + hstep, voffA);
        if (wr == 1) PG8_BAR;
        PG8_WAIT_V(2); PG8_BAR;
        PG8_STAGE(PG8_SB(1, 0), cB + kstep, voffB); PG8_STAGE(PG8_SA(1, 0), cA + kstep, voffA); PG8_STAGE(PG8_SB(1, 1), cB + hstep + kstep, voffB);
        PG8_WAIT_V(6); PG8_BAR;
    } else {
        PG8_STAGE(PG8_SB(0, 0), cB, voffB); PG8_STAGE(PG8_SA(0, 0), cA, voffA); PG8_STAGE(PG8_SB(0, 1), cB + hstep, voffB); PG8_STAGE(PG8_SA(0, 1), cA + hstep, voffA);
        if (wr == 1) PG8_BAR;
        PG8_WAIT_V(4); PG8_BAR;
        PG8_STAGE(PG8_SB(1, 0), cB + kstep, voffB); PG8_STAGE(PG8_SA(1, 0), cA + kstep, voffA); PG8_STAGE(PG8_SB(1, 1), cB + hstep + kstep, voffB);
        PG8_WAIT_V(6); PG8_BAR;
    }
    for (;;) {
        const bool has_next = S.next(ui + 1, nxt);
        const char* nA = has_next ? (const char*)g.A + (size_t)nxt.pm * tstep : cA; const char* nB = has_next ? (const char*)g.Bt + (size_t)nxt.pn * tstep : cB;
        for (int t = 0; t < nt; t += 2) {
            const bool last = (t == nt - 2);
            const char* a1 = cA + (size_t)(t + 1) * kstep;
            const char* a2 = last ? nA : cA + (size_t)(t + 2) * kstep; const char* b2 = last ? nB : cB + (size_t)(t + 2) * kstep;
            const char* a3 = a2 + kstep; const char* b3 = b2 + kstep;
            if (last && has_next) S.a_ready(nxt);
            if constexpr (SP2) {
            PG8_LDB(B0, 0, 0); PG8_LDB(B1, 0, 1); PG8_SCHED; PG8_LDA(At, 0, 0); PG8_STAGE(PG8_SA(1, 1), a1 + hstep, voffA);
            PG8_WAIT_V(8); PG8_WAIT_L(0); PG8_BAR; PG8_MMA(0, 0, At, B0); PG8_MMA(0, 1, At, B1); PG8_BAR; PG8_SCHED;
            PG8_LDA(At, 0, 1); PG8_STAGE(PG8_SB(0, 0), b2, voffB); PG8_STAGE(PG8_SB(0, 1), b2 + hstep, voffB); PG8_STAGE(PG8_SA(0, 0), a2, voffA);
            PG8_WAIT_V(8); PG8_WAIT_L(0); PG8_BAR; PG8_MMA(1, 0, At, B0); PG8_MMA(1, 1, At, B1); PG8_BAR; PG8_SCHED;
            PG8_LDB(B0, 1, 0); PG8_LDB(B1, 1, 1); PG8_SCHED; PG8_LDA(At, 1, 0); PG8_STAGE(PG8_SA(0, 1), a2 + hstep, voffA);
            PG8_WAIT_V(8); PG8_WAIT_L(0); PG8_BAR; PG8_MMA(0, 0, At, B0); PG8_MMA(0, 1, At, B1); PG8_BAR; PG8_SCHED;
            PG8_LDA(At, 1, 1); PG8_STAGE(PG8_SB(1, 0), b3, voffB); PG8_STAGE(PG8_SB(1, 1), b3 + hstep, voffB); PG8_STAGE(PG8_SA(1, 0), a3, voffA);
            PG8_WAIT_V(8); PG8_WAIT_L(0); PG8_BAR; PG8_MMA(1, 0, At, B0); PG8_MMA(1, 1, At, B1); PG8_BAR; PG8_SCHED;
            } else {
            PG8_LDB(B0, 0, 0); PG8_SCHED; PG8_LDA(At, 0, 0); PG8_STAGE(PG8_SA(1, 1), a1 + hstep, voffA);
            PG8_WAIT_L(8); PG8_BAR; PG8_WAIT_L(0); PG8_MMA(0, 0, At, B0); PG8_BAR; PG8_SCHED;
            PG8_LDB(B1, 0, 1); PG8_STAGE(PG8_SB(0, 0), b2, voffB);
            PG8_BAR; PG8_WAIT_L(0); PG8_MMA(0, 1, At, B1); PG8_BAR;
            PG8_LDA(At, 0, 1); PG8_STAGE(PG8_SA(0, 0), a2, voffA);
            PG8_BAR; PG8_WAIT_L(0); PG8_MMA(1, 0, At, B0); PG8_BAR; PG8_SCHED;
            PG8_STAGE(PG8_SB(0, 1), b2 + hstep, voffB);
            PG8_WAIT_V(6); PG8_BAR; PG8_MMA(1, 1, At, B1); PG8_BAR;
            PG8_LDB(B0, 1, 0); PG8_SCHED; PG8_LDA(At, 1, 0); PG8_STAGE(PG8_SA(0, 1), a2 + hstep, voffA);
            PG8_WAIT_L(8); PG8_BAR; PG8_WAIT_L(0); PG8_MMA(0, 0, At, B0); PG8_BAR; PG8_SCHED;
            PG8_LDB(B1, 1, 1); PG8_STAGE(PG8_SB(1, 0), b3, voffB);
            PG8_BAR; PG8_WAIT_L(0); PG8_MMA(0, 1, At, B1); PG8_BAR;
            PG8_LDA(At, 1, 1); PG8_STAGE(PG8_SA(1, 0), a3, voffA);
            PG8_BAR; PG8_WAIT_L(0); PG8_MMA(1, 0, At, B0); PG8_BAR; PG8_SCHED;
            PG8_STAGE(PG8_SB(1, 1), b3 + hstep, voffB);
            PG8_WAIT_V(6); PG8_BAR; PG8_MMA(1, 1, At, B1); PG8_BAR;
            }
        }
        if constexpr (ALIGN_EPI) { if (wr == 0) PG8_BAR; }
        if constexpr (!Epi::AFTER_DRAIN) { E(acc, cur, wr, wc, fr, fq); S.done(cur); }
        if (!has_next) break;
#pragma unroll
        for (int a = 0; a < 2; ++a)
#pragma unroll
            for (int b = 0; b < 2; ++b)
#pragma unroll
                for (int m = 0; m < 4; ++m)
#pragma unroll
                    for (int n = 0; n < 2; ++n) acc[a][b][m][n] = (f32x4){0.f, 0.f, 0.f, 0.f};
        cur = nxt; cA = nA; cB = nB; ++ui;
        if constexpr (ALIGN_EPI) { if (wr == 1) PG8_BAR; }
    }
    PG8_WAIT_V(0);
    if constexpr (!ALIGN_EPI) { if (wr == 0) PG8_BAR; }
    PG8_BAR;
    if constexpr (Epi::AFTER_DRAIN) { E.fused(acc, cur, wr, wc, fr, fq, lds, wid, lane); S.done(cur); }
#undef PG8_SA
#undef PG8_SB
#undef PG8_STAGE
#undef PG8_LDA
#undef PG8_LDB
#undef PG8_MMA
#undef PG8_WAIT_V
#undef PG8_WAIT_L
#undef PG8_BAR
#undef PG8_SCHED
}
}

namespace mk {
typedef unsigned short bf16_t;
typedef float f32x4 __attribute__((ext_vector_type(4)));
typedef unsigned u32x4 __attribute__((ext_vector_type(4)));
typedef unsigned u32x2 __attribute__((ext_vector_type(2)));
typedef float f32x2 __attribute__((ext_vector_type(2)));
#define LAS __attribute__((address_space(3)))

constexpr int BATCH = 16, SEQ = 2048, DM = 1024, M = BATCH * SEQ;
constexpr int NA = 1792, NB = 2560, N1 = NA + NB;
constexpr int N3 = 3072;
constexpr int EVEN_IN = 4224, SHIFT_W = 1664;
constexpr float RMS_EPS = 1e-6f, LN_EPS = 1e-5f, GN_EPS = 64e-5f;
constexpr int NTHR = 512;

constexpr size_t MiB = 1u << 20;
constexpr size_t WS_CTR = 768 * 1024;
constexpr size_t WS_LW = 23 * MiB + 512 * 1024;
constexpr size_t WS_SGW = 23 * MiB;
constexpr size_t WS_RS0 = 0, WS_RS1 = 128 * 1024, WS_RS2 = 256 * 1024, WS_VSUM = 384 * 1024, WS_VSQ = 512 * 1024, WS_BON = 1 * MiB;
constexpr size_t WS_BAR = 2 * MiB;
constexpr size_t WS_W1T = 4 * MiB, WS_W2T = 13 * MiB, WS_W3T = 15 * MiB, WS_W4T = 21 * MiB;
constexpr size_t WS_XN = 24 * MiB;
constexpr size_t WS_PA = 88 * MiB;
constexpr size_t WS_PB = 200 * MiB;
constexpr size_t WS_YMIX = 360 * MiB;
constexpr size_t WS_TAIL = 424 * MiB;
constexpr size_t WS_VRAW = 448 * MiB;
constexpr size_t WS_END = 480 * MiB;
constexpr int RSZ = 12544;
constexpr size_t WS_P1 = WS_PA;
constexpr int LDS_BYTES = 147456;

struct Args {
    const float* in[22];
    float* out; unsigned char* ws;
    int lo, hi;
};
enum { I_X = 0, I_NORMG, I_WINE, I_SHMU, I_W0, I_W2, I_A0, I_A2, I_KK, I_KA, I_RK, I_LNXG, I_LNXB, I_ABIAS, I_WOUTE, I_WINO, I_SGLNG, I_SGLNB, I_SGW, I_SGB, I_WOUTO, I_FG };

__device__ __forceinline__ unsigned short f2bf(float f) { unsigned u = __float_as_uint(f); return (unsigned short)((u + 0x7fffu + ((u >> 16) & 1u)) >> 16); }
__device__ __forceinline__ float bf2f(unsigned short h) { return __uint_as_float((unsigned)h << 16); }
typedef __bf16 bf2_t __attribute__((ext_vector_type(2)));
__device__ __forceinline__ unsigned pk2(float lo, float hi) { const f32x2 v = {lo, hi}; const bf2_t b = __builtin_convertvector(v, bf2_t); return __builtin_bit_cast(unsigned, b); }
__device__ __forceinline__ float bflo(unsigned w) { return __uint_as_float(w << 16); }
__device__ __forceinline__ float bfhi(unsigned w) { return __uint_as_float(w & 0xffff0000u); }
__device__ __forceinline__ float wave_sum(float v) {
#pragma unroll
    for (int o = 1; o < 64; o <<= 1) v += __shfl_xor(v, o);
    return v;
}
__device__ __forceinline__ float sigmoidf_(float x) { return 1.0f / (1.0f + __expf(-x)); }
__device__ __forceinline__ float siluf_(float x) { return x * sigmoidf_(x); }
__device__ __forceinline__ float gelu_tanh(float x) { const float y = 0.7978845608028654f * (x + 0.044715f * x * x * x); return x * sigmoidf_(2.0f * y); }

__device__ __forceinline__ void phase_prologue(const Args& a, unsigned char* ldsb) {
    const int tid = threadIdx.x, lane = tid & 63, wave = tid >> 6;
    unsigned char* ws = a.ws;
    const int gtid = blockIdx.x * NTHR + tid, nthr = gridDim.x * NTHR;
    {
        LAS float* scr = (LAS float*)((LAS unsigned char*)ldsb + wave * 8448);
        constexpr int NB1 = N1 / 32, NB2 = 32, NB3 = N3 / 32, NB4 = 32, NITEM = (NB1 + NB2 + NB3 + NB4) * 16;
        for (int it = blockIdx.x * 8 + wave; it < NITEM; it += gridDim.x * 8) {
            int nb = it >> 4; const int k0 = (it & 15) * 64;
            const float* src; const float* g; int N, col0; bf16_t* dst; bool zero = false;
            if (nb < NB1) { const int n0 = nb * 32; src = a.in[I_WINE]; g = a.in[I_NORMG]; N = EVEN_IN; dst = (bf16_t*)(ws + WS_W1T) + (size_t)n0 * 1024;
                if (n0 < SHIFT_W) col0 = n0; else if (n0 < NA) { col0 = 0; zero = true; } else col0 = n0 - (NA - SHIFT_W); }
            else if ((nb -= NB1) < NB2) { src = a.in[I_WOUTE]; g = nullptr; N = 1024; col0 = nb * 32; dst = (bf16_t*)(ws + WS_W2T) + (size_t)col0 * 1024; }
            else if ((nb -= NB2) < NB3) { src = a.in[I_WINO]; g = a.in[I_NORMG] + 1024; N = N3; col0 = nb * 32; dst = (bf16_t*)(ws + WS_W3T) + (size_t)col0 * 1024; }
            else { nb -= NB3; src = a.in[I_WOUTO]; g = nullptr; N = 1024; col0 = nb * 32; dst = (bf16_t*)(ws + WS_W4T) + (size_t)col0 * 1024; }
#pragma unroll 8
            for (int i = 0; i < 32; ++i) { const int kk = 2 * i + (lane >> 5); float x = zero ? 0.f : src[(size_t)(k0 + kk) * N + col0 + (lane & 31)]; if (g) x *= g[k0 + kk]; scr[kk * 33 + (lane & 31)] = x; }
            asm volatile("s_waitcnt lgkmcnt(0)" ::: "memory");
            const int c8 = lane & 7;
#pragma unroll
            for (int j = 0; j < 4; ++j) { const int n = (lane >> 3) + 8 * j; const LAS float* sp = scr + (8 * c8) * 33 + n;
                u32x4 o; o.x = pk2(sp[0 * 33], sp[1 * 33]); o.y = pk2(sp[2 * 33], sp[3 * 33]); o.z = pk2(sp[4 * 33], sp[5 * 33]); o.w = pk2(sp[6 * 33], sp[7 * 33]);
                *(u32x4*)(dst + (size_t)n * 1024 + k0 + 8 * c8) = o; }
            asm volatile("s_waitcnt lgkmcnt(0)" ::: "memory");
        }
    }
    const float* x = a.in[I_X]; bf16_t* XN = (bf16_t*)(ws + WS_XN); float* rs0 = (float*)(ws + WS_RS0);
    const int gw = blockIdx.x * 8 + wave, NGW = gridDim.x * 8;
    for (int m = gw; m < M; m += NGW) {
        const f32x4* xr = (const f32x4*)(x + (size_t)m * DM) + lane; float s = 0.f; f32x4 v[4];
#pragma unroll
        for (int j = 0; j < 4; ++j) { v[j] = xr[64 * j]; s += (v[j].x * v[j].x + v[j].y * v[j].y) + (v[j].z * v[j].z + v[j].w * v[j].w); }
        s = wave_sum(s);
        u32x2* o = (u32x2*)(XN + (size_t)m * DM) + lane;
#pragma unroll
        for (int j = 0; j < 4; ++j) { u32x2 w; w.x = pk2(v[j].x, v[j].y); w.y = pk2(v[j].z, v[j].w); o[64 * j] = w; }
        if (lane == 0) rs0[m] = s;
    }
    float* rs1 = (float*)(ws + WS_RS1); float* rs2 = (float*)(ws + WS_RS2); float* vsum = (float*)(ws + WS_VSUM); float* vsq = (float*)(ws + WS_VSQ);
    for (int i = gtid; i < M; i += nthr) { rs1[i] = 0.f; rs2[i] = 0.f; vsum[i] = 0.f; vsq[i] = 0.f; }
    { bf16_t* LW = (bf16_t*)(ws + WS_LW); const float* w2 = a.in[I_W2]; const float* a2 = a.in[I_A2];
      for (int i = gtid; i < 2 * 512 * 64; i += nthr) { const int j = i & 63, cc = (i >> 6) & 511, mat = i >> 15; LW[i] = f2bf((mat ? a2 : w2)[j * 512 + cc]); } }
    { bf16_t* SGW = (bf16_t*)(ws + WS_SGW); const float* sgw = a.in[I_SGW];
      for (int i = gtid; i < 8 * 128 * 128; i += nthr) { const int jj = i & 127, ii = (i >> 7) & 127; SGW[i] = f2bf(((jj >> 6) <= (ii >> 6)) ? sgw[i] : 0.f); } }
}

struct EpiG1 {
    const float* rs0; bf16_t* PA; bf16_t* PB;
    static constexpr int NSTAT = 0;
    __device__ __forceinline__ void commit(int, float, float) const {}
    __device__ __forceinline__ f32x2 operator()(int row, int col, f32x4 v0, f32x4 v1) const {
        const float rinv = rsqrtf(rs0[row] * (1.0f / DM) + RMS_EPS);
        v0 = v0 * rinv; v1 = v1 * rinv;
        u32x4 w; w.x = pk2(v0[0], v0[1]); w.y = pk2(v0[2], v0[3]); w.z = pk2(v1[0], v1[1]); w.w = pk2(v1[2], v1[3]);
        bf16_t* dst = col < NA ? PA + (size_t)row * NA + col : PB + (size_t)row * NB + (col - NA);
        *(u32x4*)dst = w;
        return (f32x2){0.f, 0.f};
    }
};
struct EpiG2 {
    const float* x; float* out; bf16_t* HB; float* rs1;
    static constexpr int NSTAT = 1;
    __device__ __forceinline__ void commit(int row, float s0, float) const { unsafeAtomicAdd(rs1 + row, s0); }
    __device__ __forceinline__ f32x2 operator()(int row, int col, f32x4 v0, f32x4 v1) const {
        const size_t off = (size_t)row * DM + col;
        v0 = v0 + *(const f32x4*)(x + off); v1 = v1 + *(const f32x4*)(x + off + 4);
        *(f32x4*)(out + off) = v0; *(f32x4*)(out + off + 4) = v1;
        u32x4 w; w.x = pk2(v0[0], v0[1]); w.y = pk2(v0[2], v0[3]); w.z = pk2(v1[0], v1[1]); w.w = pk2(v1[2], v1[3]);
        *(u32x4*)(HB + off) = w;
        const float s = (v0[0] * v0[0] + v0[1] * v0[1]) + (v0[2] * v0[2] + v0[3] * v0[3]) + (v1[0] * v1[0] + v1[1] * v1[1]) + (v1[2] * v1[2] + v1[3] * v1[3]);
        return (f32x2){s, 0.f};
    }
};
struct EpiG3 {
    const float* rs1; bf16_t* P1; float* vsum; float* vsq;
    static constexpr int NSTAT = 2;
    __device__ __forceinline__ void commit(int row, float s0, float s1) const { if (s1 != 0.f) { unsafeAtomicAdd(vsum + row, s0); unsafeAtomicAdd(vsq + row, s1); } }
    __device__ __forceinline__ f32x2 operator()(int row, int col, f32x4 v0, f32x4 v1) const {
        f32x2 ret = (f32x2){0.f, 0.f};
        const float rinv = rsqrtf(rs1[row] * (1.0f / DM) + RMS_EPS);
        float v[8];
#pragma unroll
        for (int j = 0; j < 4; ++j) { v[j] = v0[j] * rinv; v[4 + j] = v1[j] * rinv; }
        if (col < 2048) {
#pragma unroll
            for (int j = 0; j < 8; ++j) v[j] = gelu_tanh(v[j]);
            if (col >= 1024) {
                float s = 0.f, q = 0.f;
#pragma unroll
                for (int j = 0; j < 8; ++j) { s += v[j]; q += v[j] * v[j]; }
                ret = (f32x2){s, q};
            }
        } else {
#pragma unroll
            for (int j = 0; j < 8; ++j) v[j] = siluf_(v[j]);
        }
        u32x4 w; w.x = pk2(v[0], v[1]); w.y = pk2(v[2], v[3]); w.z = pk2(v[4], v[5]); w.w = pk2(v[6], v[7]);
        *(u32x4*)(P1 + (size_t)row * N3 + col) = w;
        return ret;
    }
};
struct EpiG4 {
    float* out; float* rs2;
    static constexpr int NSTAT = 1;
    __device__ __forceinline__ void commit(int row, float s0, float) const { unsafeAtomicAdd(rs2 + row, s0); }
    __device__ __forceinline__ f32x2 operator()(int row, int col, f32x4 v0, f32x4 v1) const {
        const size_t off = (size_t)row * DM + col;
        v0 = v0 + *(const f32x4*)(out + off); v1 = v1 + *(const f32x4*)(out + off + 4);
        *(f32x4*)(out + off) = v0; *(f32x4*)(out + off + 4) = v1;
        const float s = (v0[0] * v0[0] + v0[1] * v0[1]) + (v0[2] * v0[2] + v0[3] * v0[3]) + (v1[0] * v1[0] + v1[1] * v1[1]) + (v1[2] * v1[2] + v1[3] * v1[3]);
        return (f32x2){s, 0.f};
    }
};

template <class F> struct EpiAdapt {
    static constexpr bool PERM = true, AFTER_DRAIN = false;
    F f;
    __device__ __forceinline__ void operator()(const pg8::f32x4 (&acc)[2][2][4][2], const pg8::Unit& u, int wr, int wc, int fr, int fq) const {
#pragma unroll
        for (int ai = 0; ai < 2; ++ai)
#pragma unroll
            for (int m = 0; m < 4; ++m) {
                const int row = u.pm * 256 + ai * 128 + wr * 64 + m * 16 + fr;
                f32x2 st = (f32x2){0.f, 0.f};
#pragma unroll
                for (int bj = 0; bj < 2; ++bj) { const int col = u.pn * 256 + bj * 128 + wc * 32 + 8 * fq; const f32x2 r = f(row, col, acc[ai][bj][m][0], acc[ai][bj][m][1]); st = st + r; }
                if (F::NSTAT >= 1) { st.x += __shfl_xor(st.x, 16); st.x += __shfl_xor(st.x, 32); }
                if (F::NSTAT >= 2) { st.y += __shfl_xor(st.y, 16); st.y += __shfl_xor(st.y, 32); }
                if (F::NSTAT >= 1 && fq == 0) f.commit(row, st.x, st.y);
            }
    }
};

template <class F> __device__ __forceinline__ void gemm_naive(float* lds, const bf16_t* A, const bf16_t* Bt, int Mm, int N, int K, const F& f) {
    const int tid = threadIdx.x, ty = tid >> 4, tx = tid & 15;
    float* As = lds; float* Bs = lds + 32 * 132;
    const int ntn = N / 128, ntiles = (Mm / 128) * ntn;
    for (int tile = blockIdx.x; tile < ntiles; tile += gridDim.x) {
        const int tm = tile / ntn, tn = tile % ntn;
        float acc[4][8];
#pragma unroll
        for (int i = 0; i < 4; ++i)
#pragma unroll
            for (int j = 0; j < 8; ++j) acc[i][j] = 0.f;
        for (int k0 = 0; k0 < K; k0 += 32) {
            { const int row = tid >> 2, kc = (tid & 3) * 8;
              const u32x4 va = *(const u32x4*)(A + (size_t)(tm * 128 + row) * K + k0 + kc);
              const u32x4 vb = *(const u32x4*)(Bt + (size_t)(tn * 128 + row) * K + k0 + kc);
              As[(kc + 0) * 132 + row] = bflo(va.x); As[(kc + 1) * 132 + row] = bfhi(va.x); As[(kc + 2) * 132 + row] = bflo(va.y); As[(kc + 3) * 132 + row] = bfhi(va.y);
              As[(kc + 4) * 132 + row] = bflo(va.z); As[(kc + 5) * 132 + row] = bfhi(va.z); As[(kc + 6) * 132 + row] = bflo(va.w); As[(kc + 7) * 132 + row] = bfhi(va.w);
              Bs[(kc + 0) * 132 + row] = bflo(vb.x); Bs[(kc + 1) * 132 + row] = bfhi(vb.x); Bs[(kc + 2) * 132 + row] = bflo(vb.y); Bs[(kc + 3) * 132 + row] = bfhi(vb.y);
              Bs[(kc + 4) * 132 + row] = bflo(vb.z); Bs[(kc + 5) * 132 + row] = bfhi(vb.z); Bs[(kc + 6) * 132 + row] = bflo(vb.w); Bs[(kc + 7) * 132 + row] = bfhi(vb.w); }
            __syncthreads();
#pragma unroll 8
            for (int kk = 0; kk < 32; ++kk) {
                const f32x4 a4 = *(const f32x4*)(As + kk * 132 + ty * 4);
                const f32x4 b0 = *(const f32x4*)(Bs + kk * 132 + tx * 8), b1 = *(const f32x4*)(Bs + kk * 132 + tx * 8 + 4);
#pragma unroll
                for (int i = 0; i < 4; ++i) {
#pragma unroll
                    for (int j = 0; j < 4; ++j) { acc[i][j] += a4[i] * b0[j]; acc[i][4 + j] += a4[i] * b1[j]; }
                }
            }
            __syncthreads();
        }
#pragma unroll
        for (int i = 0; i < 4; ++i) { const f32x2 r = f(tm * 128 + ty * 4 + i, tn * 128 + tx * 8, (f32x4){acc[i][0], acc[i][1], acc[i][2], acc[i][3]}, (f32x4){acc[i][4], acc[i][5], acc[i][6], acc[i][7]}); if (F::NSTAT >= 1) f.commit(tm * 128 + ty * 4 + i, r.x, r.y); }
    }
}

template <class F> __device__ __forceinline__ void gemm_any(unsigned char* lds, const bf16_t* A, const bf16_t* Bt, int Mm, int N, int K, const F& f) {
#if USE_PG8
    pg8::Gemm g{A, Bt, Mm, N, K}; pg8::StaticOrder S; S.init(Mm, N, (int)gridDim.x, (int)blockIdx.x);
    EpiAdapt<F> E{f};
    pg8::gemm_phase<EpiAdapt<F>, pg8::StaticOrder, true, true>((PG8_LAS unsigned char*)lds, g, S, E);
#else
    gemm_naive((float*)lds, A, Bt, Mm, N, K, f);
#endif
}

typedef short pbf16x8 __attribute__((ext_vector_type(8)));
template <int CTRL> __device__ __forceinline__ float pdpp_add(float x) { return x + __uint_as_float(__builtin_amdgcn_update_dpp(0, __float_as_uint(x), CTRL, 0xf, 0xf, true)); }
__device__ __forceinline__ float wave_sum_dpp(float x) {
    x = pdpp_add<0x128>(x); x = pdpp_add<0x124>(x); x = pdpp_add<0x122>(x); x = pdpp_add<0x121>(x);
    const unsigned u = __float_as_uint(x);
    return (__uint_as_float(__builtin_amdgcn_readlane(u, 0)) + __uint_as_float(__builtin_amdgcn_readlane(u, 16))) + (__uint_as_float(__builtin_amdgcn_readlane(u, 32)) + __uint_as_float(__builtin_amdgcn_readlane(u, 48)));
}
__device__ __forceinline__ unsigned char* rec_base(const Args& a, int u) {
    if (u < 80) return (unsigned char*)a.out + (size_t)u * 128 * RSZ;
    if (u < 118) return a.ws + WS_XN + (size_t)(u - 80) * 128 * RSZ;
    return a.ws + WS_TAIL + (size_t)(u - 118) * 128 * RSZ;
}
__device__ __forceinline__ void phase_prep(const Args& a, unsigned char* ldsb) {
    const int tid = threadIdx.x, lane = tid & 63, wave = tid >> 6, fr = lane & 15, quad = lane >> 4;
    unsigned char* ws = a.ws;
    const bf16_t* PA = (const bf16_t*)(ws + WS_PA);
    bf16_t* VR = (bf16_t*)(ws + WS_VRAW); float* BON = (float*)(ws + WS_BON);
    const float* mu = a.in[I_SHMU];
    LAS unsigned char* lds = (LAS unsigned char*)ldsb;
    constexpr int HAT_OFF = 69888;
    constexpr int XPB = 272;
    constexpr int RES_OFF = 4352;
    if (blockIdx.x == 0 && tid == 0) *(unsigned*)(ws + WS_CTR) = 0u;
    const int c = tid;
    const float w0 = a.in[I_W0][c], a0 = a.in[I_A0][c], kkc = a.in[I_KK][c], kac = a.in[I_KA][c], rkc = a.in[I_RK][c];
    const float mur = mu[c], muk = mu[512 + c], muv = mu[1024 + c];
    const bf16_t* LW = (const bf16_t*)(ws + WS_LW);
    pbf16x8 wf[2][4][2];
#pragma unroll
    for (int mat = 0; mat < 2; ++mat)
#pragma unroll
        for (int mt = 0; mt < 4; ++mt)
#pragma unroll
            for (int ks = 0; ks < 2; ++ks) wf[mat][mt][ks] = *(const pbf16x8*)(LW + (size_t)(mat * 512 + wave * 64 + mt * 16 + fr) * 64 + ks * 32 + 8 * quad);
    const int stok = tid >> 5, sj4 = (tid & 31) * 4;
    const f32x4 smu = *(const f32x4*)(mu + 1536 + sj4);
    for (int u = blockIdx.x; u < M / 16; u += gridDim.x) {
        const int t0 = u * 16;
        {   const int t = t0 + stok; const bool first = (t % SEQ) == 0;
            const u32x2 pw = *(const u32x2*)(PA + (size_t)t * NA + 1536 + sj4);
            u32x2 qw = pw; if (!first) qw = *(const u32x2*)(PA + (size_t)(t - 1) * NA + 1536 + sj4);
            float x0 = bflo(pw.x), x1 = bfhi(pw.x), x2 = bflo(pw.y), x3 = bfhi(pw.y);
            const float y0 = first ? 0.f : bflo(qw.x), y1 = first ? 0.f : bfhi(qw.x), y2 = first ? 0.f : bflo(qw.y), y3 = first ? 0.f : bfhi(qw.y);
            x0 += (y0 - x0) * smu.x; x1 += (y1 - x1) * smu.y; x2 += (y2 - x2) * smu.z; x3 += (y3 - x3) * smu.w;
            if (sj4 < 64) { x0 = 1.0f - 2.0f / (__expf(2.0f * x0) + 1.0f); x1 = 1.0f - 2.0f / (__expf(2.0f * x1) + 1.0f); x2 = 1.0f - 2.0f / (__expf(2.0f * x2) + 1.0f); x3 = 1.0f - 2.0f / (__expf(2.0f * x3) + 1.0f); }
            u32x2 o; o.x = pk2(x0, x1); o.y = pk2(x2, x3);
            *(LAS u32x2*)(lds + stok * XPB + sj4 * 2) = o; }
        __syncthreads();
#pragma unroll
        for (int mat = 0; mat < 2; ++mat)
#pragma unroll
            for (int mt = 0; mt < 4; ++mt) {
                f32x4 acc = (f32x4){0.f, 0.f, 0.f, 0.f};
#pragma unroll
                for (int ks = 0; ks < 2; ++ks) { const pbf16x8 xf = *(const LAS pbf16x8*)(lds + fr * XPB + (mat * 64 + ks * 32 + 8 * quad) * 2); acc = __builtin_amdgcn_mfma_f32_16x16x32_bf16(wf[mat][mt][ks], xf, acc, 0, 0, 0); }
                *(LAS f32x4*)(lds + RES_OFF + ((mat * 16 + fr) * 512 + wave * 64 + mt * 16 + 4 * quad) * 4) = acc;
            }
        __syncthreads();
        float rp, kp_, vp;
        { const bool first = (t0 % SEQ) == 0; const bf16_t* q = PA + (size_t)(t0 - 1) * NA;
          rp = first ? 0.f : bf2f(q[c]); kp_ = first ? 0.f : bf2f(q[512 + c]); vp = first ? 0.f : bf2f(q[1024 + c]); }
        unsigned char* rec = rec_base(a, (t0 / SEQ) * 8 + wave) + (size_t)((t0 % SEQ) / 16) * RSZ;
        LAS unsigned char* hb = lds + HAT_OFF + wave * 9216;
        float Pprev = 1.0f;
#pragma unroll 4
        for (int i = 0; i < 16; ++i) {
            const int t = t0 + i;
            const bf16_t* p = PA + (size_t)t * NA;
            const float rc = bf2f(p[c]), kc = bf2f(p[512 + c]), vc = bf2f(p[1024 + c]);
            const float r = rc + (rp - rc) * mur, k = kc + (kp_ - kc) * muk, v = vc + (vp - vc) * muv;
            rp = rc; kp_ = kc; vp = vc;
            const float z = *(const LAS float*)(lds + RES_OFF + (i * 512 + c) * 4) + w0;
            const float za = *(const LAS float*)(lds + RES_OFF + ((16 + i) * 512 + c) * 4) + a0;
            const float sp = fmaxf(-z, 0.f) + __logf(1.0f + __expf(-fabsf(z)));
            const float w = -sp - 0.5f;
            const float dec = __expf(-__expf(w));
            const float av = __builtin_amdgcn_rcpf(1.0f + __expf(-za));
            float kk = k * kkc; const float ss = wave_sum_dpp(kk * kk); kk = kk * __builtin_amdgcn_rcpf(fmaxf(__builtin_amdgcn_sqrtf(ss), 1e-12f));
            const float kn = k * (1.0f + (av - 1.0f) * kac);
            const float bon = wave_sum_dpp(r * kn * rkc);
            const float P = Pprev * dec, iP = __builtin_amdgcn_rcpf(P);
            LAS unsigned short* hat = (LAS unsigned short*)hb + i * 72 + lane;
            hat[0] = f2bf(-kk * Pprev); hat[1152] = f2bf(r * P); hat[2304] = f2bf(kk * av * iP); hat[3456] = f2bf(kn * iP);
            Pprev = P;
            const unsigned short vb16 = f2bf(v);
            VR[(size_t)t * 512 + c] = vb16;
            *(unsigned short*)(rec + 8192 + (lane >> 4) * 512 + ((i >> 2) * 16 + (lane & 15)) * 8 + (i & 3) * 2) = vb16;
            if (lane == 0) BON[t * 8 + wave] = bon;
        }
        *(float*)(rec + 12288 + lane * 4) = Pprev;
        asm volatile("s_waitcnt lgkmcnt(0)" ::: "memory");
        {
            pbf16x8 fa[2], fr2[2], fb[2], fk[2];
#pragma unroll
            for (int ks = 0; ks < 2; ++ks) { const int off = fr * 144 + (ks * 32 + 8 * quad) * 2;
                fa[ks] = *(const LAS pbf16x8*)(hb + off); fr2[ks] = *(const LAS pbf16x8*)(hb + 2304 + off); fb[ks] = *(const LAS pbf16x8*)(hb + 4608 + off); fk[ks] = *(const LAS pbf16x8*)(hb + 6912 + off); }
            f32x4 cba = (f32x4){0.f, 0.f, 0.f, 0.f}, cka = cba, cbr = cba, ckr = cba;
#pragma unroll
            for (int ks = 0; ks < 2; ++ks) { cba = __builtin_amdgcn_mfma_f32_16x16x32_bf16(fb[ks], fa[ks], cba, 0, 0, 0); cka = __builtin_amdgcn_mfma_f32_16x16x32_bf16(fk[ks], fa[ks], cka, 0, 0, 0);
                                             cbr = __builtin_amdgcn_mfma_f32_16x16x32_bf16(fb[ks], fr2[ks], cbr, 0, 0, 0); ckr = __builtin_amdgcn_mfma_f32_16x16x32_bf16(fk[ks], fr2[ks], ckr, 0, 0, 0); }
            float nn[4];
            {   float x0[4], x1[4], x2[4];
#pragma unroll
                for (int e = 0; e < 4; ++e) { const int j = 4 * quad + e; x0[e] = (j < fr) ? cka[e] : 0.f; x1[e] = (j <= fr) ? ckr[e] : 0.f; x2[e] = (j <= fr) ? cbr[e] : 0.f; nn[e] = (j < fr) ? cba[e] : 0.f; }
                u32x2 w; w.x = pk2(x0[0], x0[1]); w.y = pk2(x0[2], x0[3]); *(u32x2*)(rec + 10240 + lane * 8) = w;
                w.x = pk2(x1[0], x1[1]); w.y = pk2(x1[2], x1[3]); *(u32x2*)(rec + 10752 + lane * 8) = w;
                w.x = pk2(x2[0], x2[1]); w.y = pk2(x2[2], x2[3]); *(u32x2*)(rec + 11776 + lane * 8) = w; }
#pragma unroll
            for (int ks = 0; ks < 2; ++ks) {
                const u32x2 alo = *(const LAS u32x2*)(hb + fr * 144 + (32 * ks + 4 * quad) * 2), ahi = *(const LAS u32x2*)(hb + fr * 144 + (32 * ks + 16 + 4 * quad) * 2);
                const u32x2 rlo = *(const LAS u32x2*)(hb + 2304 + fr * 144 + (32 * ks + 4 * quad) * 2), rhi = *(const LAS u32x2*)(hb + 2304 + fr * 144 + (32 * ks + 16 + 4 * quad) * 2);
                *(u32x4*)(rec + ks * 1024 + lane * 16) = (u32x4){alo.x, alo.y, ahi.x, ahi.y};
                *(u32x4*)(rec + 2048 + ks * 1024 + lane * 16) = (u32x4){rlo.x, rlo.y, rhi.x, rhi.y};
            }
#pragma unroll
            for (int mt = 0; mt < 4; ++mt) {
                const LAS unsigned short* hB = (const LAS unsigned short*)(hb + 4608) + (4 * quad) * 72 + 16 * mt + fr;
                const LAS unsigned short* hK = (const LAS unsigned short*)(hb + 6912) + (4 * quad) * 72 + 16 * mt + fr;
                u32x4 o; o.x = (unsigned)hB[0] | ((unsigned)hB[72] << 16); o.y = (unsigned)hB[144] | ((unsigned)hB[216] << 16); o.z = (unsigned)hK[0] | ((unsigned)hK[72] << 16); o.w = (unsigned)hK[144] | ((unsigned)hK[216] << 16);
                *(u32x4*)(rec + 4096 + mt * 1024 + lane * 16) = o;
            }
            asm volatile("s_waitcnt lgkmcnt(0)" ::: "memory");
            LAS float* NL = (LAS float*)hb;
#pragma unroll
            for (int e = 0; e < 4; ++e) NL[(4 * quad + e) * 16 + fr] = nn[e];
            asm volatile("s_waitcnt lgkmcnt(0)" ::: "memory");
            float X[16];
#pragma unroll
            for (int l = 0; l < 16; ++l) X[l] = (l == fr) ? 1.0f : 0.f;
#pragma unroll
            for (int j = 14; j >= 0; --j) {
                const f32x4 n0 = ((const LAS f32x4*)NL)[j * 4], n1 = ((const LAS f32x4*)NL)[j * 4 + 1], n2 = ((const LAS f32x4*)NL)[j * 4 + 2], n3 = ((const LAS f32x4*)NL)[j * 4 + 3];
                const float nr[16] = {n0.x, n0.y, n0.z, n0.w, n1.x, n1.y, n1.z, n1.w, n2.x, n2.y, n2.z, n2.w, n3.x, n3.y, n3.z, n3.w};
                float acc = X[j];
#pragma unroll
                for (int l = j + 1; l < 16; ++l) acc = __builtin_fmaf(nr[l], X[l], acc);
                X[j] = acc;
            }
            float mv[4];
#pragma unroll
            for (int e = 0; e < 4; ++e) mv[e] = quad == 0 ? X[e] : (quad == 1 ? X[4 + e] : (quad == 2 ? X[8 + e] : X[12 + e]));
            u32x2 w; w.x = pk2(mv[0], mv[1]); w.y = pk2(mv[2], mv[3]); *(u32x2*)(rec + 11264 + lane * 8) = w;
            asm volatile("s_waitcnt lgkmcnt(0)" ::: "memory");
        }
    }
}

__device__ __forceinline__ float rdlane(float x, int k) { return __uint_as_float(__builtin_amdgcn_readlane(__float_as_uint(x), k)); }
__device__ __forceinline__ void phase_scan_naive(const Args& a) {
    const int tid = threadIdx.x, lane = tid & 63, wave = tid >> 6;
    if (wave != 0) return;
    unsigned char* ws = a.ws;
    const bf16_t* R = (const bf16_t*)a.out; const bf16_t* KP = R + (size_t)M * 512; const bf16_t* V = KP + (size_t)M * 512; const bf16_t* AN = V + (size_t)M * 512;
    bf16_t* YM = (bf16_t*)(ws + WS_YMIX); const float* DEC = (const float*)(ws + WS_XN); const float* BON = (const float*)(ws + WS_BON);
    const bf16_t* PB = (const bf16_t*)(ws + WS_PB);
    for (int u = blockIdx.x; u < BATCH * 8; u += gridDim.x) {
        const int b = u >> 3, h = u & 7;
        const float lg = a.in[I_LNXG][h * 64 + lane], lb = a.in[I_LNXB][h * 64 + lane];
        float s[64];
#pragma unroll
        for (int k = 0; k < 64; ++k) s[k] = 0.f;
        for (int t = 0; t < SEQ; ++t) {
            const int tok = b * SEQ + t; const size_t o = (size_t)tok * 512 + h * 64 + lane;
            const float ca = bf2f(AN[o]), cw = DEC[o], cb = bf2f(YM[(size_t)tok * 1024 + h * 64 + lane]), ck = bf2f(KP[o]), cr = bf2f(R[o]), vv = bf2f(V[o]);
            float sa = 0.f;
#pragma unroll
            for (int k = 0; k < 64; ++k) sa += s[k] * rdlane(ca, k);
            float y = 0.f;
#pragma unroll
            for (int k = 0; k < 64; ++k) { s[k] = s[k] * rdlane(cw, k) + sa * rdlane(cb, k) + vv * rdlane(ck, k); y += s[k] * rdlane(cr, k); }
            const float mean = wave_sum(y) * (1.0f / 64.0f); const float d = y - mean; const float var = wave_sum(d * d) * (1.0f / 64.0f);
            float yn = d * rsqrtf(var + GN_EPS) * lg + lb;
            yn += BON[tok * 8 + h] * vv;
            const float g = bf2f(PB[(size_t)tok * NB + h * 64 + lane]);
            YM[(size_t)tok * 1024 + h * 64 + lane] = f2bf(yn * siluf_(g));
        }
    }
}

__device__ __forceinline__ void phase_attn_naive(const Args& a) {
    const int tid = threadIdx.x, lane = tid & 63, wave = tid >> 6;
    unsigned char* ws = a.ws;
    const bf16_t* PB = (const bf16_t*)(ws + WS_PB); bf16_t* YM = (bf16_t*)(ws + WS_YMIX);
    for (int u = blockIdx.x * 8 + wave; u < BATCH * 8 * 32; u += gridDim.x * 8) {
        const int c = u & 31, h = (u >> 5) & 7, b = u >> 8;
        const int t = b * SEQ + c * 64 + lane;
        float q[64], acc[64];
        { const u32x4* qp = (const u32x4*)(PB + (size_t)t * NB + 512 + h * 64);
#pragma unroll
          for (int i = 0; i < 8; ++i) { const u32x4 w = qp[i]; q[8 * i] = bflo(w.x) * 0.125f; q[8 * i + 1] = bfhi(w.x) * 0.125f; q[8 * i + 2] = bflo(w.y) * 0.125f; q[8 * i + 3] = bfhi(w.y) * 0.125f;
              q[8 * i + 4] = bflo(w.z) * 0.125f; q[8 * i + 5] = bfhi(w.z) * 0.125f; q[8 * i + 6] = bflo(w.w) * 0.125f; q[8 * i + 7] = bfhi(w.w) * 0.125f; } }
#pragma unroll
        for (int d = 0; d < 64; ++d) acc[d] = 0.f;
        float m = -1e30f, l = 0.f;
        const float* bt = a.in[I_ABIAS] + h * 257;
        const int k0 = (c - 8 > 0 ? c - 8 : 0) * 64, k1 = (c + 1) * 64;
        for (int kj = k0; kj < k1; ++kj) {
            const bf16_t* kr = PB + (size_t)(b * SEQ + kj) * NB + 1024 + h * 64;
            float s = 0.f;
#pragma unroll
            for (int i = 0; i < 8; ++i) { const u32x4 w = ((const u32x4*)kr)[i];
                s += q[8 * i] * bflo(w.x) + q[8 * i + 1] * bfhi(w.x) + q[8 * i + 2] * bflo(w.y) + q[8 * i + 3] * bfhi(w.y) + q[8 * i + 4] * bflo(w.z) + q[8 * i + 5] * bfhi(w.z) + q[8 * i + 6] * bflo(w.w) + q[8 * i + 7] * bfhi(w.w); }
            int rel = c * 64 + lane - kj; rel = rel < -128 ? -128 : (rel > 128 ? 128 : rel);
            s += bt[rel + 128];
            const float mn = fmaxf(m, s), al = __expf(m - mn), p = __expf(s - mn);
            l = l * al + p; m = mn;
            const bf16_t* vr = kr + 512;
#pragma unroll
            for (int i = 0; i < 8; ++i) { const u32x4 w = ((const u32x4*)vr)[i];
                acc[8 * i] = acc[8 * i] * al + p * bflo(w.x); acc[8 * i + 1] = acc[8 * i + 1] * al + p * bfhi(w.x); acc[8 * i + 2] = acc[8 * i + 2] * al + p * bflo(w.y); acc[8 * i + 3] = acc[8 * i + 3] * al + p * bfhi(w.y);
                acc[8 * i + 4] = acc[8 * i + 4] * al + p * bflo(w.z); acc[8 * i + 5] = acc[8 * i + 5] * al + p * bfhi(w.z); acc[8 * i + 6] = acc[8 * i + 6] * al + p * bflo(w.w); acc[8 * i + 7] = acc[8 * i + 7] * al + p * bfhi(w.w); }
        }
        const float il = 1.0f / l;
        const u32x4* gp = (const u32x4*)(PB + (size_t)t * NB + 2048 + h * 64);
        u32x4* op = (u32x4*)(YM + (size_t)t * 1024 + 512 + h * 64);
#pragma unroll
        for (int i = 0; i < 8; ++i) { const u32x4 g = gp[i]; u32x4 o;
            o.x = pk2(acc[8 * i] * il * siluf_(bflo(g.x)), acc[8 * i + 1] * il * siluf_(bfhi(g.x))); o.y = pk2(acc[8 * i + 2] * il * siluf_(bflo(g.y)), acc[8 * i + 3] * il * siluf_(bfhi(g.y)));
            o.z = pk2(acc[8 * i + 4] * il * siluf_(bflo(g.z)), acc[8 * i + 5] * il * siluf_(bfhi(g.z))); o.w = pk2(acc[8 * i + 6] * il * siluf_(bflo(g.w)), acc[8 * i + 7] * il * siluf_(bfhi(g.w)));
            op[i] = o; }
    }
}


typedef _Float16 h8 __attribute__((ext_vector_type(8)));
typedef _Float16 h4 __attribute__((ext_vector_type(4)));
typedef short bf16x8 __attribute__((ext_vector_type(8)));
template <int CTRL> __device__ __forceinline__ float dpp_add(float x) { return x + __uint_as_float(__builtin_amdgcn_update_dpp(0, __float_as_uint(x), CTRL, 0xf, 0xf, true)); }
__device__ __forceinline__ float red8(float x) { x = dpp_add<0xB1>(x); x = dpp_add<0x4E>(x); x = dpp_add<0x141>(x); return x; }
__device__ __forceinline__ float red16(float x) { x = dpp_add<0x128>(x); x = dpp_add<0x124>(x); x = dpp_add<0x122>(x); x = dpp_add<0x121>(x); return x; }
constexpr int SC_PH = 0, SC_VV = 40960, SC_SC = 57344, SC_YY = 57856;
constexpr int TC = 32;

__device__ __forceinline__ void scan_unit(const Args& a, LAS unsigned char* lds, int u) {
    const int tid = threadIdx.x, lane = tid & 63, wave = tid >> 6;
    const int b = u >> 3, h = u & 7;
    unsigned char* ws = a.ws;
    const bf16_t* R = (const bf16_t*)a.out; const bf16_t* KP = R + (size_t)M * 512; const bf16_t* V = KP + (size_t)M * 512; const bf16_t* AN = V + (size_t)M * 512;
    bf16_t* YM = (bf16_t*)(ws + WS_YMIX); const float* DEC = (const float*)(ws + WS_XN); const float* BON = (const float*)(ws + WS_BON);
    const bf16_t* PB = (const bf16_t*)(ws + WS_PB);
    const int st = tid >> 4, sq = tid & 15;
    const int row = wave * 8 + (lane >> 3), cg = lane & 7;
    const int colbase = h * 64 + 4 * sq;
    const f32x4 lg = *(const f32x4*)(a.in[I_LNXG] + colbase), lb = *(const f32x4*)(a.in[I_LNXB] + colbase);
    float s[8];
#pragma unroll
    for (int j = 0; j < 8; ++j) s[j] = 0.f;
    u32x2 gR, gK, gV, gA, gB; f32x4 gD;
#define SC_GLOAD(c) do { const size_t tok_ = (size_t)b * SEQ + (c) * TC + st; const size_t o_ = tok_ * 512 + colbase; \
        gR = *(const u32x2*)(R + o_); gK = *(const u32x2*)(KP + o_); gV = *(const u32x2*)(V + o_); gA = *(const u32x2*)(AN + o_); \
        gB = *(const u32x2*)(YM + tok_ * 1024 + colbase); gD = *(const f32x4*)(DEC + o_); } while (0)
#define SC_STAGE(buf) do { \
        const float r0 = bflo(gR.x), r1 = bfhi(gR.x), r2 = bflo(gR.y), r3 = bfhi(gR.y); \
        const float k0 = bflo(gK.x), k1 = bfhi(gK.x), k2 = bflo(gK.y), k3 = bfhi(gK.y); \
        const float b0 = bflo(gB.x), b1 = bfhi(gB.x), b2 = bflo(gB.y), b3 = bfhi(gB.y); \
        LAS h4* ph4 = (LAS h4*)(lds + SC_PH) + (size_t)(((buf) * TC + st) * 5) * 16 + sq; \
        ph4[0]  = (h4){(_Float16)bflo(gA.x), (_Float16)bfhi(gA.x), (_Float16)bflo(gA.y), (_Float16)bfhi(gA.y)}; \
        ph4[16] = (h4){(_Float16)(1.0f - gD.x), (_Float16)(1.0f - gD.y), (_Float16)(1.0f - gD.z), (_Float16)(1.0f - gD.w)}; \
        ph4[32] = (h4){(_Float16)b0, (_Float16)b1, (_Float16)b2, (_Float16)b3}; \
        ph4[48] = (h4){(_Float16)k0, (_Float16)k1, (_Float16)k2, (_Float16)k3}; \
        ph4[64] = (h4){(_Float16)(gD.x * r0), (_Float16)(gD.y * r1), (_Float16)(gD.z * r2), (_Float16)(gD.w * r3)}; \
        *((LAS f32x4*)(lds + SC_VV) + ((buf) * TC + st) * 16 + sq) = (f32x4){bflo(gV.x), bfhi(gV.x), bflo(gV.y), bfhi(gV.y)}; \
        float br_ = (b0 * r0 + b1 * r1) + (b2 * r2 + b3 * r3), kr_ = (k0 * r0 + k1 * r1) + (k2 * r2 + k3 * r3); \
        br_ = red16(br_); kr_ = red16(kr_); \
        if (sq == 0) *((LAS f32x2*)(lds + SC_SC) + (buf) * TC + st) = (f32x2){br_, kr_}; } while (0)
    SC_GLOAD(0); SC_STAGE(0);
    __syncthreads();
    for (int c = 0; c < SEQ / TC; ++c) {
        const int buf = c & 1;
        if (c + 1 < SEQ / TC) SC_GLOAD(c + 1);
        const size_t tokE = (size_t)b * SEQ + c * TC + st;
        const u32x2 gG = *(const u32x2*)(PB + tokE * NB + colbase);
        const float bon = BON[tokE * 8 + h];
        {
            const LAS h8* ph8 = (const LAS h8*)(lds + SC_PH) + buf * TC * 40 + cg;
            const LAS float* vvp = (const LAS float*)(lds + SC_VV) + buf * TC * 64 + row;
            const LAS f32x2* scp = (const LAS f32x2*)(lds + SC_SC) + buf * TC;
            LAS float* yyp = (LAS float*)(lds + SC_YY) + row;
            h8 cA = ph8[0], cE = ph8[8], cB = ph8[16], cK = ph8[24], cW = ph8[32]; float cv = vvp[0]; f32x2 cs = scp[0];
#pragma unroll 2
            for (int t = 0; t < TC; ++t) {
                const int tn = (t + 1 < TC) ? t + 1 : t;
                const h8 nA = ph8[tn * 40], nE = ph8[tn * 40 + 8], nB = ph8[tn * 40 + 16], nK = ph8[tn * 40 + 24], nW = ph8[tn * 40 + 32]; const float nv = vvp[tn * 64]; const f32x2 ns = scp[tn];
                float sa0 = 0.f, sa1 = 0.f, yw0 = 0.f, yw1 = 0.f;
#pragma unroll
                for (int j = 0; j < 4; ++j) { sa0 = __builtin_fmaf(s[j], (float)cA[j], sa0); sa1 = __builtin_fmaf(s[4 + j], (float)cA[4 + j], sa1);
                                              yw0 = __builtin_fmaf(s[j], (float)cW[j], yw0); yw1 = __builtin_fmaf(s[4 + j], (float)cW[4 + j], yw1); }
                float sa = red8(sa0 + sa1), yw = red8(yw0 + yw1);
#pragma unroll
                for (int j = 0; j < 8; ++j) { float uu = __builtin_fmaf(sa, (float)cB[j], s[j]); uu = __builtin_fmaf(cv, (float)cK[j], uu); s[j] = __builtin_fmaf(-(float)cE[j], s[j], uu); }
                const float y = yw + sa * cs.x + cv * cs.y;
                yyp[t * 64] = y;
                cA = nA; cE = nE; cB = nB; cK = nK; cW = nW; cv = nv; cs = ns;
            }
        }
        __syncthreads();
        {
            const f32x4 y4 = *((const LAS f32x4*)(lds + SC_YY) + st * 16 + sq);
            const f32x4 v4 = *((const LAS f32x4*)(lds + SC_VV) + (buf * TC + st) * 16 + sq);
            const float mean = red16((y4.x + y4.y) + (y4.z + y4.w)) * (1.0f / 64.0f);
            const f32x4 d = y4 - mean;
            const float var = red16((d.x * d.x + d.y * d.y) + (d.z * d.z + d.w * d.w)) * (1.0f / 64.0f);
            const float rstd = rsqrtf(var + GN_EPS);
            f32x4 o = d * rstd * lg + lb + v4 * bon;
            o.x *= siluf_(bflo(gG.x)); o.y *= siluf_(bfhi(gG.x)); o.z *= siluf_(bflo(gG.y)); o.w *= siluf_(bfhi(gG.y));
            u32x2 w; w.x = pk2(o.x, o.y); w.y = pk2(o.z, o.w);
            *(u32x2*)(YM + tokE * 1024 + colbase) = w;
        }
        if (c + 1 < SEQ / TC) SC_STAGE(buf ^ 1);
        __syncthreads();
    }
#undef SC_GLOAD
#undef SC_STAGE
}


struct ChOps { u32x4 Aa[2], Ar[2], Abk[4]; u32x2 Acka, Ackr, Aminv, Acbr, Vb; f32x4 P[4]; };
__device__ __forceinline__ void ch_load(ChOps& o, const unsigned char* rec, int nt, int lane, int quad) {
#pragma unroll
    for (int ks = 0; ks < 2; ++ks) { o.Aa[ks] = *(const u32x4*)(rec + ks * 1024 + lane * 16); o.Ar[ks] = *(const u32x4*)(rec + 2048 + ks * 1024 + lane * 16); }
#pragma unroll
    for (int mt = 0; mt < 4; ++mt) { o.Abk[mt] = *(const u32x4*)(rec + 4096 + mt * 1024 + lane * 16); o.P[mt] = *(const f32x4*)(rec + 12288 + (16 * mt + 4 * quad) * 4); }
    o.Vb = *(const u32x2*)(rec + 8192 + nt * 512 + lane * 8);
    o.Acka = *(const u32x2*)(rec + 10240 + lane * 8); o.Ackr = *(const u32x2*)(rec + 10752 + lane * 8); o.Aminv = *(const u32x2*)(rec + 11264 + lane * 8); o.Acbr = *(const u32x2*)(rec + 11776 + lane * 8);
}
__device__ __forceinline__ bf16x8 asbf(u32x4 v) { return __builtin_bit_cast(bf16x8, v); }
__device__ __forceinline__ void scan_unit_chunked(const Args& a, LAS unsigned char* lds, int u) {
    const int tid = threadIdx.x, lane = tid & 63, wave = tid >> 6, fr = lane & 15, quad = lane >> 4;
    const int b = u >> 3, h = u & 7;
    unsigned char* ws = a.ws;
    const bf16_t* VR = (const bf16_t*)(ws + WS_VRAW); bf16_t* YM = (bf16_t*)(ws + WS_YMIX); const float* BON = (const float*)(ws + WS_BON);
    const bf16_t* PB = (const bf16_t*)(ws + WS_PB);
    const unsigned char* recs = rec_base(a, u);
    LAS float* YY = (LAS float*)lds;
    const int etok = tid >> 3, er8 = (tid & 7) * 8;
    const f32x4 lg0 = *(const f32x4*)(a.in[I_LNXG] + h * 64 + er8), lg1 = *(const f32x4*)(a.in[I_LNXG] + h * 64 + er8 + 4);
    const f32x4 lb0 = *(const f32x4*)(a.in[I_LNXB] + h * 64 + er8), lb1 = *(const f32x4*)(a.in[I_LNXB] + h * 64 + er8 + 4);
    f32x4 S[4];
#pragma unroll
    for (int mt = 0; mt < 4; ++mt) S[mt] = (f32x4){0.f, 0.f, 0.f, 0.f};
    ChOps cur;
    if (wave < 4) ch_load(cur, recs, wave, lane, quad);
    for (int g = 0; g < SEQ / 64; ++g) {
        const size_t tokE = (size_t)b * SEQ + g * 64 + etok;
        const u32x4 ev = *(const u32x4*)(VR + tokE * 512 + h * 64 + er8);
        const u32x4 eg = *(const u32x4*)(PB + tokE * NB + h * 64 + er8);
        const float bon = BON[tokE * 8 + h];
        if (wave < 4) {
#pragma unroll
            for (int cc = 0; cc < 4; ++cc) {
                const int cidx = g * 4 + cc;
                ChOps nxt;
                ch_load(nxt, recs + (size_t)(cidx + 1 < SEQ / 16 ? cidx + 1 : cidx) * RSZ, wave, lane, quad);
                u32x4 sb[2];
#pragma unroll
                for (int ks = 0; ks < 2; ++ks) { sb[ks].x = pk2(S[2 * ks][0], S[2 * ks][1]); sb[ks].y = pk2(S[2 * ks][2], S[2 * ks][3]);
                                                 sb[ks].z = pk2(S[2 * ks + 1][0], S[2 * ks + 1][1]); sb[ks].w = pk2(S[2 * ks + 1][2], S[2 * ks + 1][3]); }
                const u32x4 vb = (u32x4){cur.Vb.x, cur.Vb.y, 0u, 0u};
                f32x4 rhs = (f32x4){0.f, 0.f, 0.f, 0.f}, hv = rhs;
#pragma unroll
                for (int ks = 0; ks < 2; ++ks) { rhs = __builtin_amdgcn_mfma_f32_16x16x32_bf16(asbf(cur.Aa[ks]), asbf(sb[ks]), rhs, 0, 0, 0); hv = __builtin_amdgcn_mfma_f32_16x16x32_bf16(asbf(cur.Ar[ks]), asbf(sb[ks]), hv, 0, 0, 0); }
                rhs = __builtin_amdgcn_mfma_f32_16x16x32_bf16(asbf((u32x4){cur.Acka.x, cur.Acka.y, 0u, 0u}), asbf(vb), rhs, 0, 0, 0);
                hv = __builtin_amdgcn_mfma_f32_16x16x32_bf16(asbf((u32x4){cur.Ackr.x, cur.Ackr.y, 0u, 0u}), asbf(vb), hv, 0, 0, 0);
                const u32x4 rb = (u32x4){pk2(rhs[0], rhs[1]), pk2(rhs[2], rhs[3]), 0u, 0u};
                const f32x4 sa = __builtin_amdgcn_mfma_f32_16x16x32_bf16(asbf((u32x4){cur.Aminv.x, cur.Aminv.y, 0u, 0u}), asbf(rb), (f32x4){0.f, 0.f, 0.f, 0.f}, 0, 0, 0);
                const u32x4 svb = (u32x4){pk2(sa[0], sa[1]), pk2(sa[2], sa[3]), cur.Vb.x, cur.Vb.y};
                const f32x4 y = __builtin_amdgcn_mfma_f32_16x16x32_bf16(asbf((u32x4){cur.Acbr.x, cur.Acbr.y, 0u, 0u}), asbf(svb), hv, 0, 0, 0);
#pragma unroll
                for (int mt = 0; mt < 4; ++mt) { S[mt] = __builtin_amdgcn_mfma_f32_16x16x32_bf16(asbf(cur.Abk[mt]), asbf(svb), S[mt], 0, 0, 0); S[mt] = S[mt] * cur.P[mt]; }
#pragma unroll
                for (int jj = 0; jj < 4; ++jj) YY[(cc * 16 + 4 * quad + jj) * 64 + 16 * wave + fr] = y[jj];
                cur = nxt;
            }
        }
        __syncthreads();
        {
            const f32x4 y0 = *(const LAS f32x4*)(YY + etok * 64 + er8), y1 = *(const LAS f32x4*)(YY + etok * 64 + er8 + 4);
            const float mean = red8(((y0.x + y0.y) + (y0.z + y0.w)) + ((y1.x + y1.y) + (y1.z + y1.w))) * (1.0f / 64.0f);
            const f32x4 d0 = y0 - mean, d1 = y1 - mean;
            const float var = red8(((d0.x * d0.x + d0.y * d0.y) + (d0.z * d0.z + d0.w * d0.w)) + ((d1.x * d1.x + d1.y * d1.y) + (d1.z * d1.z + d1.w * d1.w))) * (1.0f / 64.0f);
            const float rstd = rsqrtf(var + GN_EPS);
            const f32x4 v0 = (f32x4){bflo(ev.x), bfhi(ev.x), bflo(ev.y), bfhi(ev.y)}, v1 = (f32x4){bflo(ev.z), bfhi(ev.z), bflo(ev.w), bfhi(ev.w)};
            f32x4 o0 = d0 * rstd * lg0 + lb0 + v0 * bon, o1 = d1 * rstd * lg1 + lb1 + v1 * bon;
            o0.x *= siluf_(bflo(eg.x)); o0.y *= siluf_(bfhi(eg.x)); o0.z *= siluf_(bflo(eg.y)); o0.w *= siluf_(bfhi(eg.y));
            o1.x *= siluf_(bflo(eg.z)); o1.y *= siluf_(bfhi(eg.z)); o1.z *= siluf_(bflo(eg.w)); o1.w *= siluf_(bfhi(eg.w));
            u32x4 w; w.x = pk2(o0.x, o0.y); w.y = pk2(o0.z, o0.w); w.z = pk2(o1.x, o1.y); w.w = pk2(o1.z, o1.w);
            *(u32x4*)(YM + tokE * 1024 + h * 64 + er8) = w;
        }
        __syncthreads();
    }
}

constexpr int AT_KS = 0, AT_VT = 18432, AT_BT = 36864, AT_PITCH = 144;
__device__ __forceinline__ void attn_unit(const Args& a, LAS unsigned char* lds, int u) {
    const int tid = threadIdx.x, lane = tid & 63, wave = tid >> 6, fr = lane & 15, quad = lane >> 4;
    const int cp = u & 15, h = (u >> 4) & 7, b = u >> 7;
    unsigned char* ws = a.ws;
    const bf16_t* PB = (const bf16_t*)(ws + WS_PB); bf16_t* YM = (bf16_t*)(ws + WS_YMIX);
    const int c0 = 2 * cp, cq = c0 + (wave >> 2), qrow = (wave & 3) * 16 + fr;
    const size_t tq = (size_t)b * SEQ + cq * 64 + qrow;
    constexpr float LOG2E = 1.4426950408889634f;
    if (tid < 257) ((LAS float*)(lds + AT_BT))[tid] = a.in[I_ABIAS][h * 257 + tid] * LOG2E;
    bf16x8 qf[2];
    qf[0] = *(const bf16x8*)(PB + tq * NB + 512 + h * 64 + 8 * quad); qf[1] = *(const bf16x8*)(PB + tq * NB + 512 + h * 64 + 32 + 8 * quad);
    f32x4 O[4];
#pragma unroll
    for (int i = 0; i < 4; ++i) O[i] = (f32x4){0.f, 0.f, 0.f, 0.f};
    float m = -1e30f, l = 0.f;
    const int kfirst = c0 - 8 > 0 ? c0 - 8 : 0, klast = c0 + 1;
    const int kkey = tid >> 3, kdch = tid & 7;
    const int vkey = tid & 63, vdch = tid >> 6;
    const int vpos = (vkey & 32) + 8 * ((vkey >> 2) & 3) + 4 * ((vkey >> 4) & 1) + (vkey & 3);
    u32x4 gk, gv;
#define AT_GLD(kc) do { gk = *(const u32x4*)(PB + ((size_t)b * SEQ + (kc) * 64 + kkey) * NB + 1024 + h * 64 + kdch * 8); \
                        gv = *(const u32x4*)(PB + ((size_t)b * SEQ + (kc) * 64 + vkey) * NB + 1536 + h * 64 + vdch * 8); } while (0)
#define AT_SST(buf) do { *(LAS u32x4*)(lds + AT_KS + (buf) * 9216 + kkey * AT_PITCH + kdch * 16) = gk; \
        LAS unsigned short* vt_ = (LAS unsigned short*)(lds + AT_VT + (buf) * 9216) + (vdch * 8) * (AT_PITCH / 2) + vpos; \
        vt_[0 * 72] = (unsigned short)(gv.x & 0xffffu); vt_[1 * 72] = (unsigned short)(gv.x >> 16); vt_[2 * 72] = (unsigned short)(gv.y & 0xffffu); vt_[3 * 72] = (unsigned short)(gv.y >> 16); \
        vt_[4 * 72] = (unsigned short)(gv.z & 0xffffu); vt_[5 * 72] = (unsigned short)(gv.z >> 16); vt_[6 * 72] = (unsigned short)(gv.w & 0xffffu); vt_[7 * 72] = (unsigned short)(gv.w >> 16); } while (0)
    AT_GLD(kfirst); AT_SST(0);
    __syncthreads();
    for (int kc = kfirst; kc <= klast; ++kc) {
        const int buf = (kc - kfirst) & 1;
        if (kc < klast) AT_GLD(kc + 1);
        if (kc <= cq && kc >= cq - 8) {
            const LAS unsigned char* ks = lds + AT_KS + buf * 9216 + fr * AT_PITCH + quad * 16;
            const LAS unsigned char* vt = lds + AT_VT + buf * 9216 + fr * AT_PITCH + quad * 16;
            f32x4 sc[4];
#pragma unroll
            for (int kt = 0; kt < 4; ++kt) {
                sc[kt] = (f32x4){0.f, 0.f, 0.f, 0.f};
#pragma unroll
                for (int k2 = 0; k2 < 2; ++k2) { const bf16x8 kf = *(const LAS bf16x8*)(ks + kt * 16 * AT_PITCH + k2 * 64); sc[kt] = __builtin_amdgcn_mfma_f32_16x16x32_bf16(kf, qf[k2], sc[kt], 0, 0, 0); }
            }
            const int dch = cq - kc;
            const LAS float* bt = (const LAS float*)(lds + AT_BT);
            float mx = -1e30f;
            if (dch >= 3) {
                const float bc = bt[256];
#pragma unroll
                for (int kt = 0; kt < 4; ++kt)
#pragma unroll
                    for (int j = 0; j < 4; ++j) { sc[kt][j] = __builtin_fmaf(sc[kt][j], 0.125f * LOG2E, bc); mx = fmaxf(mx, sc[kt][j]); }
            } else {
                const int base = dch * 64 + qrow + 128 - 4 * quad;
#pragma unroll
                for (int kt = 0; kt < 4; ++kt)
#pragma unroll
                    for (int j = 0; j < 4; ++j) { int idx = base - kt * 16 - j; idx = idx > 256 ? 256 : idx; sc[kt][j] = __builtin_fmaf(sc[kt][j], 0.125f * LOG2E, bt[idx]); mx = fmaxf(mx, sc[kt][j]); }
            }
            mx = fmaxf(mx, __shfl_xor(mx, 16)); mx = fmaxf(mx, __shfl_xor(mx, 32));
            const float mn = fmaxf(m, mx), al = __builtin_amdgcn_exp2f(m - mn); m = mn;
            float ps = 0.f;
#pragma unroll
            for (int kt = 0; kt < 4; ++kt)
#pragma unroll
                for (int j = 0; j < 4; ++j) { sc[kt][j] = __builtin_amdgcn_exp2f(sc[kt][j] - mn); ps += sc[kt][j]; }
            l = l * al + ps;
#pragma unroll
            for (int i = 0; i < 4; ++i) O[i] = O[i] * al;
#pragma unroll
            for (int s2 = 0; s2 < 2; ++s2) {
                u32x4 pw; pw.x = pk2(sc[2 * s2][0], sc[2 * s2][1]); pw.y = pk2(sc[2 * s2][2], sc[2 * s2][3]); pw.z = pk2(sc[2 * s2 + 1][0], sc[2 * s2 + 1][1]); pw.w = pk2(sc[2 * s2 + 1][2], sc[2 * s2 + 1][3]);
                const bf16x8 pf = __builtin_bit_cast(bf16x8, pw);
#pragma unroll
                for (int dt = 0; dt < 4; ++dt) { const bf16x8 vf = *(const LAS bf16x8*)(vt + dt * 16 * AT_PITCH + s2 * 64); O[dt] = __builtin_amdgcn_mfma_f32_16x16x32_bf16(vf, pf, O[dt], 0, 0, 0); }
            }
        }
        if (kc < klast) AT_SST(buf ^ 1);
        __syncthreads();
    }
#undef AT_GLD
#undef AT_SST
    l += __shfl_xor(l, 16); l += __shfl_xor(l, 32);
    const float il = 1.0f / l;
#pragma unroll
    for (int dt = 0; dt < 4; ++dt) {
        const int dcol = h * 64 + dt * 16 + 4 * quad;
        const u32x2 g = *(const u32x2*)(PB + tq * NB + 2048 + dcol);
        const f32x4 o = O[dt] * il;
        u32x2 w; w.x = pk2(o[0] * siluf_(bflo(g.x)), o[1] * siluf_(bfhi(g.x))); w.y = pk2(o[2] * siluf_(bflo(g.y)), o[3] * siluf_(bfhi(g.y)));
        *(u32x2*)(YM + tq * 1024 + 512 + dcol) = w;
    }
}

__device__ __forceinline__ void phase_mix(const Args& a, LAS unsigned char* lds, bool do_scan = true, bool do_attn = true) {
    unsigned* ctr = (unsigned*)(a.ws + WS_CTR);
    if (do_scan) for (int u = blockIdx.x; u < BATCH * 8; u += gridDim.x) scan_unit_chunked(a, lds, u);
    LAS int* uw = (LAS int*)(lds + 40000);
    if (do_attn) for (;;) {
        __syncthreads();
        if (threadIdx.x == 0) *uw = (int)atomicAdd(ctr, 1u);
        __syncthreads();
        const int u = *uw;
        if (u >= BATCH * 8 * 16) break;
        attn_unit(a, lds, u);
    }
}

__device__ __forceinline__ void phase_sg_naive(const Args& a, unsigned char* ldsb) {
    const int tid = threadIdx.x;
    unsigned char* ws = a.ws;
    const bf16_t* P1 = (const bf16_t*)(ws + WS_P1); bf16_t* Y2 = (bf16_t*)(ws + WS_YMIX);
    const float* vsum = (const float*)(ws + WS_VSUM); const float* vsq = (const float*)(ws + WS_VSQ);
    float* vn = (float*)ldsb;
    const int c = tid & 127, i0 = tid >> 7;
    for (int u = blockIdx.x; u < BATCH * 16 * 8; u += gridDim.x) {
        const int g = u & 7, nb = (u >> 3) & 15, b = u >> 7;
        const int tbase = b * SEQ + nb * 128;
        const float lg = a.in[I_SGLNG][g * 128 + c], lb = a.in[I_SGLNB][g * 128 + c];
        for (int j = i0; j < 128; j += 4) {
            const int t = tbase + j; const float mean = vsum[t] * (1.0f / 1024.0f); const float var = vsq[t] * (1.0f / 1024.0f) - mean * mean;
            const float rstd = rsqrtf(fmaxf(var, 0.f) + LN_EPS);
            vn[j * 128 + c] = (bf2f(P1[(size_t)t * N3 + 1024 + g * 128 + c]) - mean) * rstd * lg + lb;
        }
        __syncthreads();
        const float* wg = a.in[I_SGW] + (size_t)g * 128 * 128; const float* sb = a.in[I_SGB] + g * 128;
        for (int i = i0; i < 128; i += 4) {
            const int jend = (i < 64) ? 64 : 128;
            float acc = 0.f;
            for (int j = 0; j < jend; ++j) acc += wg[i * 128 + j] * vn[j * 128 + c];
            const int t = tbase + i;
            const float uu = bf2f(P1[(size_t)t * N3 + g * 128 + c]), gt = bf2f(P1[(size_t)t * N3 + 2048 + g * 128 + c]);
            Y2[(size_t)t * 1024 + g * 128 + c] = f2bf(uu * (acc + sb[i]) * gt);
        }
        __syncthreads();
    }
}


__device__ __forceinline__ void phase_sg(const Args& a, LAS unsigned char* lds) {
    const int tid = threadIdx.x, lane = tid & 63, wave = tid >> 6, fr = lane & 15, quad = lane >> 4;
    unsigned char* ws = a.ws;
    const bf16_t* P1 = (const bf16_t*)(ws + WS_P1); bf16_t* Y2 = (bf16_t*)(ws + WS_YMIX); const bf16_t* SGW = (const bf16_t*)(ws + WS_SGW);
    const float* vsum = (const float*)(ws + WS_VSUM); const float* vsq = (const float*)(ws + WS_VSQ);
    constexpr int VPB = 272;
    const int sj = tid & 127, scc = tid >> 7;
    constexpr int NUN = BATCH * 16 * 8;
    const int per = (NUN + (int)gridDim.x - 1) / (int)gridDim.x;
    const int u0 = blockIdx.x * per, u1 = (u0 + per < NUN) ? u0 + per : NUN;
    for (int u = u0; u < u1; ++u) {
        const int g = u >> 8, b = (u >> 4) & 15, nb = u & 15;
        const int tbase = b * SEQ + nb * 128;
        {
            const int t = tbase + sj; const float mean = vsum[t] * (1.0f / 1024.0f); const float var = vsq[t] * (1.0f / 1024.0f) - mean * mean;
            const float rstd = rsqrtf(fmaxf(var, 0.f) + LN_EPS);
#pragma unroll
            for (int q = 0; q < 4; ++q) {
                const int c8 = (scc + 4 * q) * 8;
                const u32x4 w = *(const u32x4*)(P1 + (size_t)t * N3 + 1024 + g * 128 + c8);
                const f32x4 g0 = *(const f32x4*)(a.in[I_SGLNG] + g * 128 + c8), g1 = *(const f32x4*)(a.in[I_SGLNG] + g * 128 + c8 + 4);
                const f32x4 b0 = *(const f32x4*)(a.in[I_SGLNB] + g * 128 + c8), b1 = *(const f32x4*)(a.in[I_SGLNB] + g * 128 + c8 + 4);
                LAS unsigned short* vt = (LAS unsigned short*)lds + c8 * (VPB / 2) + sj;
                vt[0 * (VPB / 2)] = f2bf((bflo(w.x) - mean) * rstd * g0.x + b0.x); vt[1 * (VPB / 2)] = f2bf((bfhi(w.x) - mean) * rstd * g0.y + b0.y);
                vt[2 * (VPB / 2)] = f2bf((bflo(w.y) - mean) * rstd * g0.z + b0.z); vt[3 * (VPB / 2)] = f2bf((bfhi(w.y) - mean) * rstd * g0.w + b0.w);
                vt[4 * (VPB / 2)] = f2bf((bflo(w.z) - mean) * rstd * g1.x + b1.x); vt[5 * (VPB / 2)] = f2bf((bfhi(w.z) - mean) * rstd * g1.y + b1.y);
                vt[6 * (VPB / 2)] = f2bf((bflo(w.w) - mean) * rstd * g1.z + b1.z); vt[7 * (VPB / 2)] = f2bf((bfhi(w.w) - mean) * rstd * g1.w + b1.w);
            }
        }
        const int irow = 16 * wave + fr;
        bf16x8 wf[4];
#pragma unroll
        for (int ks = 0; ks < 4; ++ks) wf[ks] = *(const bf16x8*)(SGW + (size_t)(g * 128 + irow) * 128 + ks * 32 + 8 * quad);
        __syncthreads();
        f32x4 acc[8];
#pragma unroll
        for (int ct = 0; ct < 8; ++ct) {
            acc[ct] = (f32x4){0.f, 0.f, 0.f, 0.f};
#pragma unroll
            for (int ks = 0; ks < 4; ++ks) {
                if (ks < 2 || wave >= 4) { const bf16x8 vf = *(const LAS bf16x8*)(lds + (ct * 16 + fr) * VPB + ks * 64 + quad * 16); acc[ct] = __builtin_amdgcn_mfma_f32_16x16x32_bf16(vf, wf[ks], acc[ct], 0, 0, 0); }
            }
        }
        const size_t t = (size_t)tbase + irow; const float sbv = a.in[I_SGB][g * 128 + irow];
#pragma unroll
        for (int ct = 0; ct < 8; ++ct) {
            const int col = g * 128 + ct * 16 + 4 * quad;
            const u32x2 uu = *(const u32x2*)(P1 + t * N3 + col), gg = *(const u32x2*)(P1 + t * N3 + 2048 + col);
            u32x2 w; w.x = pk2(bflo(uu.x) * (acc[ct][0] + sbv) * bflo(gg.x), bfhi(uu.x) * (acc[ct][1] + sbv) * bfhi(gg.x));
            w.y = pk2(bflo(uu.y) * (acc[ct][2] + sbv) * bflo(gg.y), bfhi(uu.y) * (acc[ct][3] + sbv) * bfhi(gg.y));
            *(u32x2*)(Y2 + t * 1024 + col) = w;
        }
        __syncthreads();
    }
}

__device__ __forceinline__ void phase_final(const Args& a) {
    const int tid = threadIdx.x, lane = tid & 63, wave = tid >> 6;
    const float* rs2 = (const float*)(a.ws + WS_RS2); const float* fg = a.in[I_FG];
    const int gw = blockIdx.x * 8 + wave, NGW = gridDim.x * 8;
    f32x4 g4[4];
#pragma unroll
    for (int j = 0; j < 4; ++j) g4[j] = ((const f32x4*)fg)[lane + 64 * j];
    for (int m = gw; m < M; m += NGW) {
        const float rinv = rsqrtf(rs2[m] * (1.0f / DM) + RMS_EPS);
        f32x4* p = (f32x4*)(a.out + (size_t)m * DM) + lane;
#pragma unroll
        for (int j = 0; j < 4; ++j) { f32x4 v = p[64 * j]; v = v * rinv * g4[j]; p[64 * j] = v; }
    }
}

#define XB_TMO      128
#define XB_XCNT(j)  (256  + 64 * (j))
#define XB_XSUB(j)  (1280 + 64 * (j))
#define XB_XGEN(j)  (2304 + 64 * (j))
#define XB_TOP      3328
#define XB_TOPGEN   3392
#define XCD_BAR_WORDS 3456
#define XB_SPIN_CAP (1u << 18)

__device__ __forceinline__ unsigned xb_ld(unsigned* p)              { return __hip_atomic_load(p, __ATOMIC_RELAXED, __HIP_MEMORY_SCOPE_AGENT); }
__device__ __forceinline__ unsigned xb_add(unsigned* p, unsigned v) { return __hip_atomic_fetch_add(p, v, __ATOMIC_RELAXED, __HIP_MEMORY_SCOPE_AGENT); }
__device__ __forceinline__ unsigned xb_xcc_id() { return (unsigned)__builtin_amdgcn_s_getreg((3 << 11) | 20) & 0xFu; }
#define XB_SPIN(cond, bar) do { unsigned _sp = 0; while (cond) { __builtin_amdgcn_s_sleep(1); \
    if ((++_sp & 255u) == 0u) { if (xb_ld(&(bar)[XB_TMO])) break; if (_sp > XB_SPIN_CAP) { atomicAdd(&(bar)[XB_TMO], 1u); break; } } } } while (0)

struct XcdBarrier {
    unsigned* bar; unsigned x;
    volatile LAS unsigned* st;
};

__device__ __forceinline__ XcdBarrier xcd_barrier_post(unsigned* bar, volatile LAS unsigned* st) {
    XcdBarrier b; b.bar = bar; b.x = xb_xcc_id(); b.st = st;
    if (threadIdx.x == 0) (void)xb_add(&bar[XB_XCNT(b.x)], 1u);
    return b;
}
__device__ __forceinline__ void xcd_barrier_complete(unsigned* bar, unsigned x, unsigned& nloc, unsigned& nx) {
    const unsigned G = gridDim.x * gridDim.y * gridDim.z;
    unsigned sum, cnt, mine, sp = 0u;
    for (;;) {
        sum = 0u; cnt = 0u; mine = 0u;
#pragma unroll
        for (unsigned j = 0; j < 16; ++j) { const unsigned c = xb_ld(&bar[XB_XCNT(j)]); sum += c; cnt += (c > 0u) ? 1u : 0u; mine = (j == x) ? c : mine; }
        if (sum == G) break;
        __builtin_amdgcn_s_sleep(1);
        if ((++sp & 255u) == 0u) { if (xb_ld(&bar[XB_TMO])) break; if (sp > XB_SPIN_CAP) { atomicAdd(&bar[XB_TMO], 1u); break; } }
    }
    nloc = mine > 0u ? mine : 1u; nx = cnt > 0u ? cnt : 1u;
}

__device__ __forceinline__ void xcd_barrier(const XcdBarrier& b) {
    asm volatile("s_waitcnt vmcnt(0)" ::: "memory");
    __syncthreads();
    if (threadIdx.x == 0) {
        unsigned* bar = b.bar;
        __builtin_amdgcn_s_waitcnt(0);
        unsigned nloc = b.st[0], nx = b.st[1];
        if (nloc == 0u) { xcd_barrier_complete(bar, b.x, nloc, nx); b.st[0] = nloc; b.st[1] = nx; }
        const unsigned old = xb_add(&bar[XB_XSUB(b.x)], 1u);
        const unsigned gen = old / nloc;
        if (old + 1u == (gen + 1u) * nloc) {
            __builtin_amdgcn_fence(__ATOMIC_RELEASE, "agent");
            asm volatile("s_waitcnt vmcnt(0)" ::: "memory");
            const unsigned og = xb_add(&bar[XB_TOP], 1u);
            const unsigned tg = og / nx;
            if (og + 1u == (tg + 1u) * nx) xb_add(&bar[XB_TOPGEN], 1u);
            else XB_SPIN(xb_ld(&bar[XB_TOPGEN]) == tg, bar);
            __builtin_amdgcn_fence(__ATOMIC_ACQUIRE, "agent");
            xb_add(&bar[XB_XGEN(b.x)], 1u);
            asm volatile("s_waitcnt vmcnt(0)" ::: "memory");
        } else {
            XB_SPIN(xb_ld(&bar[XB_XGEN(b.x)]) == gen, bar);
            __builtin_amdgcn_fence(__ATOMIC_ACQUIRE, "agent");
            asm volatile("s_waitcnt vmcnt(0)" ::: "memory");
        }
    }
    __syncthreads();
}

template <int PHM> __global__ void __launch_bounds__(NTHR, 2) mega(Args a) {
    extern __shared__ __attribute__((aligned(16))) unsigned char lds[];
    unsigned char* ws = a.ws;
    const int lo = a.lo, hi = a.hi;
    volatile LAS unsigned* bst = (volatile LAS unsigned*)((LAS unsigned char*)lds + (LDS_BYTES - 64));
    if (threadIdx.x < 2) bst[threadIdx.x] = 0u;
    __syncthreads();
    XcdBarrier xbar = xcd_barrier_post((unsigned*)(ws + WS_BAR), bst);
    if (hi > 1000) cg::this_grid().sync();
#define IN(k) (((PHM >> (k)) & 1) && lo <= (k) && (k) < hi)
#if USE_XBAR
#define SEAM(k) do { if (IN(k) && IN((k) + 1)) { xcd_barrier(xbar); } } while (0)
#else
#define SEAM(k) do { if (IN(k) && IN((k) + 1)) { cg::this_grid().sync(); } } while (0)
#endif
    if (IN(0)) { phase_prologue(a, lds); }
    SEAM(0);
    if (IN(1)) { EpiG1 f{(const float*)(ws + WS_RS0), (bf16_t*)(ws + WS_PA), (bf16_t*)(ws + WS_PB)};
        gemm_any(lds, (const bf16_t*)(ws + WS_XN), (const bf16_t*)(ws + WS_W1T), M, N1, DM, f); }
    SEAM(1);
    if (IN(2)) { phase_prep(a, lds); }
    SEAM(2);
    #if PROBE & 1
    phase_prep(a, lds); cg::this_grid().sync();
#endif
#if USE_NAIVE_MIX
    if (IN(3)) { phase_scan_naive(a); phase_attn_naive(a); }
#else
    if (IN(3)) { phase_mix(a, (LAS unsigned char*)lds); }
#endif
    SEAM(3);
#if PROBE & 2
    phase_prep(a, lds); cg::this_grid().sync(); phase_mix(a, (LAS unsigned char*)lds); cg::this_grid().sync();
#endif
#if PROBE & 64
    phase_prep(a, lds); cg::this_grid().sync(); phase_mix(a, (LAS unsigned char*)lds, true, false); cg::this_grid().sync();
#endif
#if PROBE & 32
    if (blockIdx.x == 0 && threadIdx.x == 0) *(unsigned*)(ws + WS_CTR) = 0u;
    cg::this_grid().sync(); phase_mix(a, (LAS unsigned char*)lds, false); cg::this_grid().sync();
#endif
#if PROBE & 4
    phase_prologue(a, lds); cg::this_grid().sync();
#endif
#if PROBE & 16
    { EpiG1 f{(const float*)(ws + WS_RS0), (bf16_t*)(ws + WS_PA), (bf16_t*)(ws + WS_PB)};
        gemm_any(lds, (const bf16_t*)(ws + WS_XN), (const bf16_t*)(ws + WS_W1T), M, N1, DM, f); cg::this_grid().sync(); }
#endif
    if (IN(4)) { EpiG2 f{a.in[I_X], a.out, (bf16_t*)(ws + WS_XN), (float*)(ws + WS_RS1)};
        gemm_any(lds, (const bf16_t*)(ws + WS_YMIX), (const bf16_t*)(ws + WS_W2T), M, DM, DM, f); }
    SEAM(4);
#if PROBE & 128
    { EpiG2 f{a.in[I_X], a.out, (bf16_t*)(ws + WS_XN), (float*)(ws + 640 * 1024)};
        gemm_any(lds, (const bf16_t*)(ws + WS_YMIX), (const bf16_t*)(ws + WS_W2T), M, DM, DM, f); cg::this_grid().sync(); }
#endif
    if (IN(5)) { EpiG3 f{(const float*)(ws + WS_RS1), (bf16_t*)(ws + WS_P1), (float*)(ws + WS_VSUM), (float*)(ws + WS_VSQ)};
        gemm_any(lds, (const bf16_t*)(ws + WS_XN), (const bf16_t*)(ws + WS_W3T), M, N3, DM, f); }
    SEAM(5);
    if (IN(6)) { phase_sg(a, (LAS unsigned char*)lds); }
    SEAM(6);
#if PROBE & 8
    phase_sg(a, (LAS unsigned char*)lds); cg::this_grid().sync();
#endif
    if (IN(7)) { EpiG4 f{a.out, (float*)(ws + WS_RS2)};
        gemm_any(lds, (const bf16_t*)(ws + WS_YMIX), (const bf16_t*)(ws + WS_W4T), M, DM, DM, f); }
    SEAM(7);
#if PROBE & 256
    for (int i_ = 0; i_ < 8; ++i_) cg::this_grid().sync();
#endif
    if (IN(8)) { phase_final(a); }
#undef IN
#undef SEAM
}
constexpr int NPHASE = 9;
}
#if defined(__HIP_DEVICE_COMPILE__)
#pragma clang attribute pop
#endif

extern "C" void kernel_launch(void* const* d_in, const int* in_sizes, int n_in, void* d_out, int out_size, void* d_ws, size_t ws_size, hipStream_t stream) {
    using namespace mk;
    static int grid = 0;
    if (grid == 0) {
        if (n_in != 22 || out_size != M * DM || ws_size < WS_END) { fprintf(stderr, "kernel_launch: unexpected shapes (n_in %d out %d ws %zu)\n", n_in, out_size, ws_size); grid = -1; return; }
        int dev = 0, cus = 0, per_cu = 0;
        (void)hipGetDevice(&dev); (void)hipDeviceGetAttribute(&cus, hipDeviceAttributeMultiprocessorCount, dev);
#if N_LAUNCH_MODE == 1
        if (hipFuncSetAttribute((const void*)mega<0x1ff>, hipFuncAttributeMaxDynamicSharedMemorySize, LDS_BYTES) != hipSuccess) { fprintf(stderr, "kernel_launch: hipFuncSetAttribute failed\n"); grid = -1; return; }
        if (hipOccupancyMaxActiveBlocksPerMultiprocessor(&per_cu, (const void*)mega<0x1ff>, NTHR, LDS_BYTES) != hipSuccess || per_cu < 1) { fprintf(stderr, "kernel_launch: occupancy query says %d\n", per_cu); per_cu = 1; }
#else
        if (hipFuncSetAttribute((const void*)mega<0x1f7>, hipFuncAttributeMaxDynamicSharedMemorySize, LDS_BYTES) != hipSuccess || hipFuncSetAttribute((const void*)mega<0x008>, hipFuncAttributeMaxDynamicSharedMemorySize, LDS_BYTES) != hipSuccess) { fprintf(stderr, "kernel_launch: hipFuncSetAttribute failed\n"); grid = -1; return; }
#endif
        (void)hipGetLastError();
        grid = cus * 1;
        if (grid <= 0) grid = 256;
    }
    if (grid < 0) return;
    Args a{};
    for (int i = 0; i < 22; ++i) a.in[i] = (const float*)d_in[i];
    a.out = (float*)d_out; a.ws = (unsigned char*)d_ws;
    if (hipMemsetAsync((char*)d_ws + WS_BAR, 0, 16384, stream) != hipSuccess) { fprintf(stderr, "kernel_launch: hipMemsetAsync failed\n"); return; }
#if N_LAUNCH_MODE == 2
    {
        void* args[] = {&a};
        a.lo = 0; a.hi = 3;
        hipError_t e = hipLaunchCooperativeKernel((const void*)mega<0x1f7>, dim3(grid), dim3(NTHR), args, LDS_BYTES, stream);
        if (e != hipSuccess) fprintf(stderr, "kernel_launch: cooperative launch A failed: %s (grid %d)\n", hipGetErrorString(e), grid);
        a.lo = 3; a.hi = 4;
        hipLaunchKernelGGL(mega<0x008>, dim3(grid), dim3(NTHR), LDS_BYTES, stream, a);
        a.lo = 4; a.hi = NPHASE;
        e = hipLaunchCooperativeKernel((const void*)mega<0x1f7>, dim3(grid), dim3(NTHR), args, LDS_BYTES, stream);
        if (e != hipSuccess) fprintf(stderr, "kernel_launch: cooperative launch B failed: %s (grid %d)\n", hipGetErrorString(e), grid);
    }
#elif N_LAUNCH_MODE == 1
    a.lo = 0; a.hi = NPHASE;
    void* args[] = {&a};
    hipError_t e = hipLaunchCooperativeKernel((const void*)mega<0x1ff>, dim3(grid), dim3(NTHR), args, LDS_BYTES, stream);
    if (e != hipSuccess) fprintf(stderr, "kernel_launch: cooperative launch failed: %s (grid %d)\n", hipGetErrorString(e), grid);
#else
    for (int ph = 0; ph < NPHASE; ++ph) {
        a.lo = ph; a.hi = ph + 1;
        if (ph == 3) hipLaunchKernelGGL(mega<0x008>, dim3(grid), dim3(NTHR), LDS_BYTES, stream, a);
        else hipLaunchKernelGGL(mega<0x1f7>, dim3(grid), dim3(NTHR), LDS_BYTES, stream, a);
    }
#endif
}
```

```cpp
#if defined(__HIP_DEVICE_COMPILE__)
#pragma clang attribute push(__attribute__((target("no-packed-fp32-ops"))), apply_to = function)
#endif
#include <hip/hip_runtime.h>
#include <hip/hip_cooperative_groups.h>
#include <cstdio>
#include <cstdint>
namespace cg = cooperative_groups;
#ifndef USE_PG8
#define USE_PG8 1
#endif
#ifndef N_LAUNCH_MODE
#define N_LAUNCH_MODE 1
#endif
#ifndef PHMASK
#define PHMASK 0x1ff
#endif
#ifndef USE_NAIVE_MIX
#define USE_NAIVE_MIX 0
#endif
#ifndef PROBE
#define PROBE 0
#endif
#ifndef USE_XBAR
#define USE_XBAR 1
#endif
#ifndef PROBE_REP0
#define PROBE_REP0 0
#define PROBE_REP1 0
#define PROBE_REP2 0
#define PROBE_REP3 0
#endif
#ifndef SCAN_PREFETCH
#define SCAN_PREFETCH 1
#endif
#ifndef PROBE_LOOPS
#define PROBE_LOOPS 0
#endif
#ifndef PROBE_MIXMODE
#define PROBE_MIXMODE 0
#endif
#ifndef PROBE_PHASE
#define PROBE_PHASE 3
#endif
namespace pg8 {
#define PG8_LAS __attribute__((address_space(3)))
typedef unsigned short bf16_t;
typedef short bf16x8 __attribute__((ext_vector_type(8)));
typedef float f32x4 __attribute__((ext_vector_type(4)));
typedef unsigned u32x4 __attribute__((ext_vector_type(4)));
constexpr int BM = 256, BK = 64, HALF = 128, HTB = HALF * BK * 2  , STAGE_BYTES = 8 * HTB, NXCD = 8, WGM = 8;

__host__ __device__ __forceinline__ int lds_byte(int r, int c) { const int st = (r >> 4) * 2 + (c >> 5), rr = r & 15, cc = c & 31, ob = rr * 64 + cc * 2; return st * 1024 + (ob ^ (((ob >> 9) & 1) << 5)); }
__host__ __device__ __forceinline__ void stage_rc(int b, int& R, int& C) { const int st = b / 1024, sb = b % 1024, swz = sb ^ (((sb >> 9) & 1) << 5); R = (st >> 1) * 16 + swz / 64; C = (st & 1) * 32 + (swz % 64) / 2; }
__host__ __device__ __forceinline__ int perm32(int rho) { const int n = rho >> 4, i = rho & 15; return 8 * (i >> 2) + 4 * n + (i & 3); }

struct Unit { int pm, pn; };
struct Gemm { const bf16_t* A; const bf16_t* Bt; int M, N, K; };

struct StaticOrder {
    int nM, nN, nwg, G, c;
    __host__ __device__ void init(int M, int N, int G_, int c_) { nM = M / BM; nN = N / BM; nwg = nM * nN; G = G_; c = c_; }
    __host__ __device__ bool next(int i, Unit& u) const {
        const long L = (long)i * G + c; if (L >= nwg) return false;
        int wgid = (int)L; { const int q = nwg / NXCD, r = nwg % NXCD, xcd = wgid % NXCD, off = wgid / NXCD; wgid = (xcd < r ? xcd * (q + 1) : r * (q + 1) + (xcd - r) * q) + off; }
        const int nig = WGM * nN, gid = wgid / nig, fm = gid * WGM, gsz = (nM - fm) < WGM ? (nM - fm) : WGM;
        u.pm = fm + ((wgid % nig) % gsz); u.pn = (wgid % nig) / gsz; return true;
    }
    __device__ __forceinline__ void a_ready(const Unit&) const {}
    __device__ __forceinline__ void done(const Unit&) const {}
};

__device__ __forceinline__ unsigned cvt_pk_bf16(float lo, float hi) { unsigned r; asm volatile("v_cvt_pk_bf16_f32 %0, %1, %2" : "=v"(r) : "v"(lo), "v"(hi)); return r; }
typedef float f32x2 __attribute__((ext_vector_type(2)));
__device__ __forceinline__ f32x2 gelu_pk(f32x2 v) {
    const f32x2 av = __builtin_elementwise_abs(v), d = av * 0.2316418882f + 1.0f;
    f32x2 t; t.x = __builtin_amdgcn_rcpf(d.x); t.y = __builtin_amdgcn_rcpf(d.y);
    f32x2 q = t * 0.5307027145f + (-0.7265760135f); q = q * t + 0.7107068705f; q = q * t + (-0.142248368f); q = q * t + 0.127414796f; q = q * t;
    const f32x2 s = (v * v) * (-0.72134752044f);
    f32x2 e; e.x = __builtin_amdgcn_exp2f(s.x); e.y = __builtin_amdgcn_exp2f(s.y);
    const f32x2 m = v * (q * e), r = v - m;
    f32x2 o; o.x = v.x < 0.f ? m.x : r.x; o.y = v.y < 0.f ? m.y : r.y; return o;
}

template <int ACT  > struct EpiBf16 {
    static constexpr bool PERM = true, AFTER_DRAIN = false; static_assert(ACT == 0 || ACT == 1, "EpiBf16: ACT is 0 (none) or 1 (gelu_pk)");
    bf16_t* O; int ldc; const float* bias; int split_cols; size_t split_stride; float scale0;
    __device__ __forceinline__ void operator()(const f32x4 (&acc)[2][2][4][2], const Unit& u, int wr, int wc, int fr, int fq) const {
        const int row0 = u.pm * BM + wr * 64 + fr; int colt = u.pn * BM; bf16_t* base = O;
        float sc = 1.f; if (split_cols) { const int t = colt / split_cols; base += (size_t)t * split_stride; colt -= t * split_cols; if (t == 0) sc = scale0; }
        const int col0 = colt + wc * 32 + 8 * fq, bcol0 = u.pn * BM + wc * 32 + 8 * fq;
        f32x4 bv[2][2];
#pragma unroll
        for (int bj = 0; bj < 2; ++bj)
#pragma unroll
            for (int n = 0; n < 2; ++n) bv[bj][n] = bias ? *(const f32x4*)(bias + bcol0 + bj * HALF + 4 * n) : (f32x4){0.f, 0.f, 0.f, 0.f};
#pragma unroll
        for (int ai = 0; ai < 2; ++ai)
#pragma unroll
            for (int m = 0; m < 4; ++m) { bf16_t* rowp = base + (size_t)(row0 + ai * HALF + m * 16) * ldc + col0;
#pragma unroll
                for (int bj = 0; bj < 2; ++bj) { f32x4 v0 = acc[ai][bj][m][0] + bv[bj][0], v1 = acc[ai][bj][m][1] + bv[bj][1];
                    if (ACT == 1) { f32x2 a = gelu_pk((f32x2){v0[0], v0[1]}), b = gelu_pk((f32x2){v0[2], v0[3]}), c = gelu_pk((f32x2){v1[0], v1[1]}), d = gelu_pk((f32x2){v1[2], v1[3]});
                        v0 = (f32x4){a.x, a.y, b.x, b.y}; v1 = (f32x4){c.x, c.y, d.x, d.y}; }
                    v0 = v0 * sc; v1 = v1 * sc; u32x4 w; w.x = cvt_pk_bf16(v0[0], v0[1]); w.y = cvt_pk_bf16(v0[2], v0[3]); w.z = cvt_pk_bf16(v1[0], v1[1]); w.w = cvt_pk_bf16(v1[2], v1[3]);
                    *(u32x4*)(rowp + bj * HALF) = w; } }
    }
};
template <class Epi, class Sched, bool ALIGN_EPI = false, bool SP2 = false>
__device__ __forceinline__ void gemm_phase(PG8_LAS unsigned char* lds, const Gemm g, const Sched& S, const Epi& E) {
    const int tid = threadIdx.x, wid = __builtin_amdgcn_readfirstlane(tid >> 6), lane = tid & 63, wr = wid >> 2, wc = wid & 3, fr = lane & 15, fq = lane >> 4;
    const int K = g.K, nt = K / BK;
    unsigned voffA[2], voffB[2];
#pragma unroll
    for (int i = 0; i < 2; ++i) { int R, C; stage_rc(tid * 16 + i * 8192, R, C); const int Rb = Epi::PERM ? ((R & ~31) + perm32(R & 31)) : R;
        voffA[i] = (unsigned)(R * K + C) * 2u; voffB[i] = (unsigned)(Rb * K + C) * 2u; }
    const size_t kstep = (size_t)(BK * 2);
    const size_t hstep = (size_t)HALF * K * 2;
    const size_t tstep = 2 * hstep;
    const unsigned ldsw = (unsigned)wid * 1024u;
    const int aoff = lds_byte(wr * 64 + fr, fq * 8), boff = lds_byte(wc * 32 + fr, fq * 8);
#define PG8_SA(b, h) (((b) * 2 + (h)) * HTB)
#define PG8_SB(b, h) ((4 + (b) * 2 + (h)) * HTB)
#define PG8_STAGE(bufoff, gbase, voff) do { _Pragma("unroll") for (int _i = 0; _i < 2; ++_i) \
        __builtin_amdgcn_global_load_lds((const unsigned*)((const char*)(gbase) + (voff)[_i]), (PG8_LAS unsigned*)(lds + (bufoff) + ldsw + _i * 8192), 16, 0, 0); } while (0)
#define PG8_LDA(dst, b, h) do { _Pragma("unroll") for (int m = 0; m < 4; ++m) _Pragma("unroll") for (int k = 0; k < 2; ++k) dst[m][k] = *(const PG8_LAS bf16x8*)(lds + PG8_SA(b, h) + aoff + m * 2048 + k * 1024); } while (0)
#define PG8_LDB(dst, b, h) do { _Pragma("unroll") for (int n = 0; n < 2; ++n) _Pragma("unroll") for (int k = 0; k < 2; ++k) dst[n][k] = *(const PG8_LAS bf16x8*)(lds + PG8_SB(b, h) + boff + n * 2048 + k * 1024); } while (0)
#define PG8_MMA(ai, bj, At, Bt) do { __builtin_amdgcn_s_setprio(1); _Pragma("unroll") for (int m = 0; m < 4; ++m) _Pragma("unroll") for (int n = 0; n < 2; ++n) _Pragma("unroll") for (int k = 0; k < 2; ++k) \
        acc[ai][bj][m][n] = __builtin_amdgcn_mfma_f32_16x16x32_bf16(Bt[n][k], At[m][k], acc[ai][bj][m][n], 0, 0, 0); __builtin_amdgcn_s_setprio(0); } while (0)
#define PG8_WAIT_V(n) asm volatile("s_waitcnt vmcnt(" #n ")" ::: "memory")
#define PG8_WAIT_L(n) asm volatile("s_waitcnt lgkmcnt(" #n ")" ::: "memory")
#define PG8_BAR __builtin_amdgcn_s_barrier()
#define PG8_SCHED __builtin_amdgcn_sched_barrier(0)
    Unit cur, nxt; int ui = 0;
    if (!S.next(0, cur)) return;
    f32x4 acc[2][2][4][2];
#pragma unroll
    for (int a = 0; a < 2; ++a)
#pragma unroll
        for (int b = 0; b < 2; ++b)
#pragma unroll
            for (int m = 0; m < 4; ++m)
#pragma unroll
                for (int n = 0; n < 2; ++n) acc[a][b][m][n] = (f32x4){0.f, 0.f, 0.f, 0.f};
    bf16x8 At[4][2], B0[2][2], B1[2][2];
    const char* cA = (const char*)g.A + (size_t)cur.pm * tstep; const char* cB = (const char*)g.Bt + (size_t)cur.pn * tstep;
    S.a_ready(cur);
    if constexpr (SP2) {
        PG8_STAGE(PG8_SB(0, 0), cB, voffB); PG8_STAGE(PG8_SB(0, 1), cB + hstep, voffB); PG8_STAGE(PG8_SA(0, 0), cA, voffA); PG8_STAGE(PG8_SA(0, 1), cA + hstep, voffA);
        if (wr == 1) PG8_BAR;
        PG8_WAIT_V(2); PG8_BAR;
        PG8_STAGE(PG8_SB(1, 0), cB + kstep, voffB); PG8_STAGE(PG8_SA(1, 0), cA + kstep, voffA); PG8_STAGE(PG8_SB(1, 1), cB + hstep + kstep, voffB);
        PG8_WAIT_V(6); PG8_BAR;
    } else {
        PG8_STAGE(PG8_SB(0, 0), cB, voffB); PG8_STAGE(PG8_SA(0, 0), cA, voffA); PG8_STAGE(PG8_SB(0, 1), cB + hstep, voffB); PG8_STAGE(PG8_SA(0, 1), cA + hstep, voffA);
        if (wr == 1) PG8_BAR;
        PG8_WAIT_V(4); PG8_BAR;
        PG8_STAGE(PG8_SB(1, 0), cB + kstep, voffB); PG8_STAGE(PG8_SA(1, 0), cA + kstep, voffA); PG8_STAGE(PG8_SB(1, 1), cB + hstep + kstep, voffB);
        PG8_WAIT_V(6); PG8_BAR;
    }
    for (;;) {
        const bool has_next = S.next(ui + 1, nxt);
        const char* nA = has_next ? (const char*)g.A + (size_t)nxt.pm * tstep : cA; const char* nB = has_next ? (const char*)g.Bt + (size_t)nxt.pn * tstep : cB;
        for (int t = 0; t < nt; t += 2) {
            const bool last = (t == nt - 2);
            const char* a1 = cA + (size_t)(t + 1) * kstep;
            const char* a2 = last ? nA : cA + (size_t)(t + 2) * kstep; const char* b2 = last ? nB : cB + (size_t)(t + 2) * kstep;
            const char* a3 = a2 + kstep; const char* b3 = b2 + kstep;
            if (last && has_next) S.a_ready(nxt);
            if constexpr (SP2) {
            PG8_LDB(B0, 0, 0); PG8_LDB(B1, 0, 1); PG8_SCHED; PG8_LDA(At, 0, 0); PG8_STAGE(PG8_SA(1, 1), a1 + hstep, voffA);
            PG8_WAIT_V(8); PG8_WAIT_L(0); PG8_BAR; PG8_MMA(0, 0, At, B0); PG8_MMA(0, 1, At, B1); PG8_BAR; PG8_SCHED;
            PG8_LDA(At, 0, 1); PG8_STAGE(PG8_SB(0, 0), b2, voffB); PG8_STAGE(PG8_SB(0, 1), b2 + hstep, voffB); PG8_STAGE(PG8_SA(0, 0), a2, voffA);
            PG8_WAIT_V(8); PG8_WAIT_L(0); PG8_BAR; PG8_MMA(1, 0, At, B0); PG8_MMA(1, 1, At, B1); PG8_BAR; PG8_SCHED;
            PG8_LDB(B0, 1, 0); PG8_LDB(B1, 1, 1); PG8_SCHED; PG8_LDA(At, 1, 0); PG8_STAGE(PG8_SA(0, 1), a2 + hstep, voffA);
            PG8_WAIT_V(8); PG8_WAIT_L(0); PG8_BAR; PG8_MMA(0, 0, At, B0); PG8_MMA(0, 1, At, B1); PG8_BAR; PG8_SCHED;
            PG8_LDA(At, 1, 1); PG8_STAGE(PG8_SB(1, 0), b3, voffB); PG8_STAGE(PG8_SB(1, 1), b3 + hstep, voffB); PG8_STAGE(PG8_SA(1, 0), a3, voffA);
            PG8_WAIT_V(8); PG8_WAIT_L(0); PG8_BAR; PG8_MMA(1, 0, At, B0); PG8_MMA(1, 1, At, B1); PG8_BAR; PG8_SCHED;
            } else {
            PG8_LDB(B0, 0, 0); PG8_SCHED; PG8_LDA(At, 0, 0); PG8_STAGE(PG8_SA(1, 1), a1 + hstep, voffA);
            PG8_WAIT_L(8); PG8_BAR; PG8_WAIT_L(0); PG8_MMA(0, 0, At, B0); PG8_BAR; PG8_SCHED;
            PG8_LDB(B1, 0, 1); PG8_STAGE(PG8_SB(0, 0), b2, voffB);
            PG8_BAR; PG8_WAIT_L(0); PG8_MMA(0, 1, At, B1); PG8_BAR;
            PG8_LDA(At, 0, 1); PG8_STAGE(PG8_SA(0, 0), a2, voffA);
            PG8_BAR; PG8_WAIT_L(0); PG8_MMA(1, 0, At, B0); PG8_BAR; PG8_SCHED;
            PG8_STAGE(PG8_SB(0, 1), b2 + hstep, voffB);
            PG8_WAIT_V(6); PG8_BAR; PG8_MMA(1, 1, At, B1); PG8_BAR;
            PG8_LDB(B0, 1, 0); PG8_SCHED; PG8_LDA(At, 1, 0); PG8_STAGE(PG8_SA(0, 1), a2 + hstep, voffA);
            PG8_WAIT_L(8); PG8_BAR; PG8_WAIT_L(0); PG8_MMA(0, 0, At, B0); PG8_BAR; PG8_SCHED;
            PG8_LDB(B1, 1, 1); PG8_STAGE(PG8_SB(1, 0), b3, voffB);
            PG8_BAR; PG8_WAIT_L(0); PG8_MMA(0, 1, At, B1); PG8_BAR;
            PG8_LDA(At, 1, 1); PG8_STAGE(PG8_SA(1, 0), a3, voffA);
            PG8_BAR; PG8_WAIT_L(0); PG8_MMA(1, 0, At, B0); PG8_BAR; PG8_SCHED;
            PG8_STAGE(PG8_SB(1, 1), b3 + hstep, voffB);
            PG8_WAIT_V(6); PG8_BAR; PG8_MMA(1, 1, At, B1); PG8_BAR;
            }
        }
        if constexpr (ALIGN_EPI) { if (wr == 0) PG8_BAR; }
        if constexpr (!Epi::AFTER_DRAIN) { E(acc, cur, wr, wc, fr, fq); S.done(cur); }
        if (!has_next) break;
#pragma unroll
        for (int a = 0; a < 2; ++a)
#pragma unroll
            for (int b = 0; b < 2; ++b)
#pragma unroll
                for (int m = 0; m < 4; ++m)
#pragma unroll
                    for (int n = 0; n < 2; ++n) acc[a][b][m][n] = (f32x4){0.f, 0.f, 0.f, 0.f};
        cur = nxt; cA = nA; cB = nB; ++ui;
        if constexpr (ALIGN_EPI) { if (wr == 1) PG8_BAR; }
    }
    PG8_WAIT_V(0);
    if constexpr (!ALIGN_EPI) { if (wr == 0) PG8_BAR; }
    PG8_BAR;
    if constexpr (Epi::AFTER_DRAIN) { E.fused(acc, cur, wr, wc, fr, fq, lds, wid, lane); S.done(cur); }
#undef PG8_SA
#undef PG8_SB
#undef PG8_STAGE
#undef PG8_LDA
#undef PG8_LDB
#undef PG8_MMA
#undef PG8_WAIT_V
#undef PG8_WAIT_L
#undef PG8_BAR
#undef PG8_SCHED
}
}

namespace mk {
typedef unsigned short bf16_t;
typedef float f32x4 __attribute__((ext_vector_type(4)));
typedef unsigned u32x4 __attribute__((ext_vector_type(4)));
typedef unsigned u32x2 __attribute__((ext_vector_type(2)));
typedef float f32x2 __attribute__((ext_vector_type(2)));
#define LAS __attribute__((address_space(3)))

constexpr int BATCH = 16, SEQ = 2048, DM = 1024, M = BATCH * SEQ;
constexpr int NA = 1792, NB = 2560, N1 = NA + NB;
constexpr int N3 = 3072;
constexpr int EVEN_IN = 4224, SHIFT_W = 1664;
constexpr float RMS_EPS = 1e-6f, LN_EPS = 1e-5f, GN_EPS = 64e-5f;
constexpr int NTHR = 512;

constexpr size_t MiB = 1u << 20;
constexpr size_t WS_CTR = 768 * 1024;
constexpr size_t WS_LW = 23 * MiB + 512 * 1024;
constexpr size_t WS_SGW = 23 * MiB;
constexpr size_t WS_RS0 = 0, WS_RS1 = 128 * 1024, WS_RS2 = 256 * 1024, WS_VSUM = 384 * 1024, WS_VSQ = 512 * 1024, WS_BON = 1 * MiB;
constexpr size_t WS_BAR = 2 * MiB;
constexpr size_t WS_W1T = 4 * MiB, WS_W2T = 13 * MiB, WS_W3T = 15 * MiB, WS_W4T = 21 * MiB;
constexpr size_t WS_XN = 24 * MiB;
constexpr size_t WS_PA = 88 * MiB;
constexpr size_t WS_PB = 200 * MiB;
constexpr size_t WS_YMIX = 360 * MiB;
constexpr size_t WS_TAIL = 424 * MiB;
constexpr size_t WS_VRAW = 448 * MiB;
constexpr size_t WS_END = 480 * MiB;
constexpr int RSZ = 12544;
constexpr size_t WS_P1 = WS_PA;
constexpr int LDS_BYTES = 147456;

struct Args {
    const float* in[22];
    float* out; unsigned char* ws;
    int lo, hi;
    int rep[4];
};
enum { I_X = 0, I_NORMG, I_WINE, I_SHMU, I_W0, I_W2, I_A0, I_A2, I_KK, I_KA, I_RK, I_LNXG, I_LNXB, I_ABIAS, I_WOUTE, I_WINO, I_SGLNG, I_SGLNB, I_SGW, I_SGB, I_WOUTO, I_FG };

__device__ __forceinline__ float bf2f(unsigned short h) { return __uint_as_float((unsigned)h << 16); }
typedef __bf16 bf2_t __attribute__((ext_vector_type(2)));
__device__ __forceinline__ unsigned pk2(float lo, float hi) { const f32x2 v = {lo, hi}; const bf2_t b = __builtin_convertvector(v, bf2_t); return __builtin_bit_cast(unsigned, b); }
__device__ __forceinline__ unsigned short f2bf(float f) { return (unsigned short)(pk2(f, 0.f) & 0xffffu); }
__device__ __forceinline__ float bflo(unsigned w) { return __uint_as_float(w << 16); }
__device__ __forceinline__ float bfhi(unsigned w) { return __uint_as_float(w & 0xffff0000u); }
__device__ __forceinline__ float wave_sum(float v) {
#pragma unroll
    for (int o = 1; o < 64; o <<= 1) v += __shfl_xor(v, o);
    return v;
}
__device__ __forceinline__ float sigmoidf_(float x) { return __builtin_amdgcn_rcpf(1.0f + __expf(-x)); }
__device__ __forceinline__ float siluf_(float x) { return x * sigmoidf_(x); }
__device__ __forceinline__ float gelu_tanh(float x) { const float y = 0.7978845608028654f * (x + 0.044715f * x * x * x); return x * sigmoidf_(2.0f * y); }

__device__ __forceinline__ void phase_prologue(const Args& a, unsigned char* ldsb) {
    const int tid = threadIdx.x, lane = tid & 63, wave = tid >> 6;
    unsigned char* ws = a.ws;
    const int gtid = blockIdx.x * NTHR + tid, nthr = gridDim.x * NTHR;
    {
        LAS float* scr = (LAS float*)((LAS unsigned char*)ldsb + wave * 8448);
        constexpr int NB1 = N1 / 32, NB2 = 32, NB3 = N3 / 32, NB4 = 32, NITEM = (NB1 + NB2 + NB3 + NB4) * 16;
        for (int it = blockIdx.x * 8 + wave; it < NITEM; it += gridDim.x * 8) {
            int nb = it >> 4; const int k0 = (it & 15) * 64;
            const float* src; const float* g; int N, col0; bf16_t* dst; bool zero = false;
            if (nb < NB1) { const int n0 = nb * 32; src = a.in[I_WINE]; g = a.in[I_NORMG]; N = EVEN_IN; dst = (bf16_t*)(ws + WS_W1T) + (size_t)n0 * 1024;
                if (n0 < SHIFT_W) col0 = n0; else if (n0 < NA) { col0 = 0; zero = true; } else col0 = n0 - (NA - SHIFT_W); }
            else if ((nb -= NB1) < NB2) { src = a.in[I_WOUTE]; g = nullptr; N = 1024; col0 = nb * 32; dst = (bf16_t*)(ws + WS_W2T) + (size_t)col0 * 1024; }
            else if ((nb -= NB2) < NB3) { src = a.in[I_WINO]; g = a.in[I_NORMG] + 1024; N = N3; col0 = nb * 32; dst = (bf16_t*)(ws + WS_W3T) + (size_t)col0 * 1024; }
            else { nb -= NB3; src = a.in[I_WOUTO]; g = nullptr; N = 1024; col0 = nb * 32; dst = (bf16_t*)(ws + WS_W4T) + (size_t)col0 * 1024; }
#pragma unroll 8
            for (int i = 0; i < 32; ++i) { const int kk = 2 * i + (lane >> 5); float x = zero ? 0.f : src[(size_t)(k0 + kk) * N + col0 + (lane & 31)]; if (g) x *= g[k0 + kk]; scr[kk * 33 + (lane & 31)] = x; }
            asm volatile("s_waitcnt lgkmcnt(0)" ::: "memory");
            const int c8 = lane & 7;
#pragma unroll
            for (int j = 0; j < 4; ++j) { const int n = (lane >> 3) + 8 * j; const LAS float* sp = scr + (8 * c8) * 33 + n;
                u32x4 o; o.x = pk2(sp[0 * 33], sp[1 * 33]); o.y = pk2(sp[2 * 33], sp[3 * 33]); o.z = pk2(sp[4 * 33], sp[5 * 33]); o.w = pk2(sp[6 * 33], sp[7 * 33]);
                *(u32x4*)(dst + (size_t)n * 1024 + k0 + 8 * c8) = o; }
            asm volatile("s_waitcnt lgkmcnt(0)" ::: "memory");
        }
    }
    const float* x = a.in[I_X]; bf16_t* XN = (bf16_t*)(ws + WS_XN); float* rs0 = (float*)(ws + WS_RS0);
    const int gw = blockIdx.x * 8 + wave, NGW = gridDim.x * 8;
    for (int m = gw; m < M; m += NGW) {
        const f32x4* xr = (const f32x4*)(x + (size_t)m * DM) + lane; float s = 0.f; f32x4 v[4];
#pragma unroll
        for (int j = 0; j < 4; ++j) { v[j] = xr[64 * j]; s += (v[j].x * v[j].x + v[j].y * v[j].y) + (v[j].z * v[j].z + v[j].w * v[j].w); }
        s = wave_sum(s);
        u32x2* o = (u32x2*)(XN + (size_t)m * DM) + lane;
#pragma unroll
        for (int j = 0; j < 4; ++j) { u32x2 w; w.x = pk2(v[j].x, v[j].y); w.y = pk2(v[j].z, v[j].w); o[64 * j] = w; }
        if (lane == 0) rs0[m] = s;
    }
    float* rs1 = (float*)(ws + WS_RS1); float* rs2 = (float*)(ws + WS_RS2); float* vsum = (float*)(ws + WS_VSUM); float* vsq = (float*)(ws + WS_VSQ);
    for (int i = gtid; i < M; i += nthr) { rs1[i] = 0.f; rs2[i] = 0.f; vsum[i] = 0.f; vsq[i] = 0.f; }
    { bf16_t* LW = (bf16_t*)(ws + WS_LW); const float* w2 = a.in[I_W2]; const float* a2 = a.in[I_A2];
      for (int i = gtid; i < 2 * 512 * 64; i += nthr) { const int j = i & 63, cc = (i >> 6) & 511, mat = i >> 15; LW[i] = f2bf((mat ? a2 : w2)[j * 512 + cc]); } }
    { bf16_t* SGW = (bf16_t*)(ws + WS_SGW); const float* sgw = a.in[I_SGW];
      for (int i = gtid; i < 8 * 128 * 128; i += nthr) { const int jj = i & 127, ii = (i >> 7) & 127; SGW[i] = f2bf(((jj >> 6) <= (ii >> 6)) ? sgw[i] : 0.f); } }
}

struct EpiG1 {
    const float* rs0; bf16_t* PA; bf16_t* PB;
    static constexpr int NSTAT = 0;
    __device__ __forceinline__ void commit(int, float, float) const {}
    __device__ __forceinline__ f32x2 operator()(int row, int col, f32x4 v0, f32x4 v1) const {
        const float rinv = rsqrtf(rs0[row] * (1.0f / DM) + RMS_EPS);
        v0 = v0 * rinv; v1 = v1 * rinv;
        u32x4 w; w.x = pk2(v0[0], v0[1]); w.y = pk2(v0[2], v0[3]); w.z = pk2(v1[0], v1[1]); w.w = pk2(v1[2], v1[3]);
        bf16_t* dst = col < NA ? PA + (size_t)row * NA + col : PB + (size_t)row * NB + (col - NA);
        *(u32x4*)dst = w;
        return (f32x2){0.f, 0.f};
    }
};
struct EpiG2 {
    const float* x; float* out; bf16_t* HB; float* rs1;
    static constexpr int NSTAT = 1;
    __device__ __forceinline__ void commit(int row, float s0, float) const { unsafeAtomicAdd(rs1 + row, s0); }
    __device__ __forceinline__ f32x2 operator()(int row, int col, f32x4 v0, f32x4 v1) const {
        const size_t off = (size_t)row * DM + col;
        v0 = v0 + *(const f32x4*)(x + off); v1 = v1 + *(const f32x4*)(x + off + 4);
        *(f32x4*)(out + off) = v0; *(f32x4*)(out + off + 4) = v1;
        u32x4 w; w.x = pk2(v0[0], v0[1]); w.y = pk2(v0[2], v0[3]); w.z = pk2(v1[0], v1[1]); w.w = pk2(v1[2], v1[3]);
        *(u32x4*)(HB + off) = w;
        const float s = (v0[0] * v0[0] + v0[1] * v0[1]) + (v0[2] * v0[2] + v0[3] * v0[3]) + (v1[0] * v1[0] + v1[1] * v1[1]) + (v1[2] * v1[2] + v1[3] * v1[3]);
        return (f32x2){s, 0.f};
    }
};
struct EpiG3 {
    const float* rs1; bf16_t* P1; float* vsum; float* vsq;
    static constexpr int NSTAT = 2;
    __device__ __forceinline__ void commit(int row, float s0, float s1) const { if (s1 != 0.f) { unsafeAtomicAdd(vsum + row, s0); unsafeAtomicAdd(vsq + row, s1); } }
    __device__ __forceinline__ f32x2 operator()(int row, int col, f32x4 v0, f32x4 v1) const {
        f32x2 ret = (f32x2){0.f, 0.f};
        const float rinv = rsqrtf(rs1[row] * (1.0f / DM) + RMS_EPS);
        float v[8];
#pragma unroll
        for (int j = 0; j < 4; ++j) { v[j] = v0[j] * rinv; v[4 + j] = v1[j] * rinv; }
        if (col < 2048) {
#pragma unroll
            for (int j = 0; j < 8; ++j) v[j] = gelu_tanh(v[j]);
            if (col >= 1024) {
                float s = 0.f, q = 0.f;
#pragma unroll
                for (int j = 0; j < 8; ++j) { s += v[j]; q += v[j] * v[j]; }
                ret = (f32x2){s, q};
            }
        } else {
#pragma unroll
            for (int j = 0; j < 8; ++j) v[j] = siluf_(v[j]);
        }
        u32x4 w; w.x = pk2(v[0], v[1]); w.y = pk2(v[2], v[3]); w.z = pk2(v[4], v[5]); w.w = pk2(v[6], v[7]);
        *(u32x4*)(P1 + (size_t)row * N3 + col) = w;
        return ret;
    }
};
struct EpiG4 {
    float* out; float* rs2;
    static constexpr int NSTAT = 1;
    __device__ __forceinline__ void commit(int row, float s0, float) const { unsafeAtomicAdd(rs2 + row, s0); }
    __device__ __forceinline__ f32x2 operator()(int row, int col, f32x4 v0, f32x4 v1) const {
        const size_t off = (size_t)row * DM + col;
        v0 = v0 + *(const f32x4*)(out + off); v1 = v1 + *(const f32x4*)(out + off + 4);
        *(f32x4*)(out + off) = v0; *(f32x4*)(out + off + 4) = v1;
        const float s = (v0[0] * v0[0] + v0[1] * v0[1]) + (v0[2] * v0[2] + v0[3] * v0[3]) + (v1[0] * v1[0] + v1[1] * v1[1]) + (v1[2] * v1[2] + v1[3] * v1[3]);
        return (f32x2){s, 0.f};
    }
};

template <class F> struct EpiAdapt {
    static constexpr bool PERM = true, AFTER_DRAIN = false;
    F f;
    __device__ __forceinline__ void operator()(const pg8::f32x4 (&acc)[2][2][4][2], const pg8::Unit& u, int wr, int wc, int fr, int fq) const {
#pragma unroll
        for (int ai = 0; ai < 2; ++ai)
#pragma unroll
            for (int m = 0; m < 4; ++m) {
                const int row = u.pm * 256 + ai * 128 + wr * 64 + m * 16 + fr;
                f32x2 st = (f32x2){0.f, 0.f};
#pragma unroll
                for (int bj = 0; bj < 2; ++bj) { const int col = u.pn * 256 + bj * 128 + wc * 32 + 8 * fq; const f32x2 r = f(row, col, acc[ai][bj][m][0], acc[ai][bj][m][1]); st = st + r; }
                if (F::NSTAT >= 1) { st.x += __shfl_xor(st.x, 16); st.x += __shfl_xor(st.x, 32); }
                if (F::NSTAT >= 2) { st.y += __shfl_xor(st.y, 16); st.y += __shfl_xor(st.y, 32); }
                if (F::NSTAT >= 1 && fq == 0) f.commit(row, st.x, st.y);
            }
    }
};

template <class F> __device__ __forceinline__ void gemm_naive(float* lds, const bf16_t* A, const bf16_t* Bt, int Mm, int N, int K, const F& f) {
    const int tid = threadIdx.x, ty = tid >> 4, tx = tid & 15;
    float* As = lds; float* Bs = lds + 32 * 132;
    const int ntn = N / 128, ntiles = (Mm / 128) * ntn;
    for (int tile = blockIdx.x; tile < ntiles; tile += gridDim.x) {
        const int tm = tile / ntn, tn = tile % ntn;
        float acc[4][8];
#pragma unroll
        for (int i = 0; i < 4; ++i)
#pragma unroll
            for (int j = 0; j < 8; ++j) acc[i][j] = 0.f;
        for (int k0 = 0; k0 < K; k0 += 32) {
            { const int row = tid >> 2, kc = (tid & 3) * 8;
              const u32x4 va = *(const u32x4*)(A + (size_t)(tm * 128 + row) * K + k0 + kc);
              const u32x4 vb = *(const u32x4*)(Bt + (size_t)(tn * 128 + row) * K + k0 + kc);
              As[(kc + 0) * 132 + row] = bflo(va.x); As[(kc + 1) * 132 + row] = bfhi(va.x); As[(kc + 2) * 132 + row] = bflo(va.y); As[(kc + 3) * 132 + row] = bfhi(va.y);
              As[(kc + 4) * 132 + row] = bflo(va.z); As[(kc + 5) * 132 + row] = bfhi(va.z); As[(kc + 6) * 132 + row] = bflo(va.w); As[(kc + 7) * 132 + row] = bfhi(va.w);
              Bs[(kc + 0) * 132 + row] = bflo(vb.x); Bs[(kc + 1) * 132 + row] = bfhi(vb.x); Bs[(kc + 2) * 132 + row] = bflo(vb.y); Bs[(kc + 3) * 132 + row] = bfhi(vb.y);
              Bs[(kc + 4) * 132 + row] = bflo(vb.z); Bs[(kc + 5) * 132 + row] = bfhi(vb.z); Bs[(kc + 6) * 132 + row] = bflo(vb.w); Bs[(kc + 7) * 132 + row] = bfhi(vb.w); }
            __syncthreads();
#pragma unroll 8
            for (int kk = 0; kk < 32; ++kk) {
                const f32x4 a4 = *(const f32x4*)(As + kk * 132 + ty * 4);
                const f32x4 b0 = *(const f32x4*)(Bs + kk * 132 + tx * 8), b1 = *(const f32x4*)(Bs + kk * 132 + tx * 8 + 4);
#pragma unroll
                for (int i = 0; i < 4; ++i) {
#pragma unroll
                    for (int j = 0; j < 4; ++j) { acc[i][j] += a4[i] * b0[j]; acc[i][4 + j] += a4[i] * b1[j]; }
                }
            }
            __syncthreads();
        }
#pragma unroll
        for (int i = 0; i < 4; ++i) { const f32x2 r = f(tm * 128 + ty * 4 + i, tn * 128 + tx * 8, (f32x4){acc[i][0], acc[i][1], acc[i][2], acc[i][3]}, (f32x4){acc[i][4], acc[i][5], acc[i][6], acc[i][7]}); if (F::NSTAT >= 1) f.commit(tm * 128 + ty * 4 + i, r.x, r.y); }
    }
}

template <class F> __device__ __forceinline__ void gemm_any(unsigned char* lds, const bf16_t* A, const bf16_t* Bt, int Mm, int N, int K, const F& f) {
#if USE_PG8
    pg8::Gemm g{A, Bt, Mm, N, K}; pg8::StaticOrder S; S.init(Mm, N, (int)gridDim.x, (int)blockIdx.x);
    EpiAdapt<F> E{f};
    pg8::gemm_phase<EpiAdapt<F>, pg8::StaticOrder, true, true>((PG8_LAS unsigned char*)lds, g, S, E);
#else
    gemm_naive((float*)lds, A, Bt, Mm, N, K, f);
#endif
}

typedef short pbf16x8 __attribute__((ext_vector_type(8)));
template <int CTRL> __device__ __forceinline__ float pdpp_add(float x) { return x + __uint_as_float(__builtin_amdgcn_update_dpp(0, __float_as_uint(x), CTRL, 0xf, 0xf, true)); }
__device__ __forceinline__ float wave_sum_dpp(float x) {
    x = pdpp_add<0x128>(x); x = pdpp_add<0x124>(x); x = pdpp_add<0x122>(x); x = pdpp_add<0x121>(x);
    const unsigned u = __float_as_uint(x);
    return (__uint_as_float(__builtin_amdgcn_readlane(u, 0)) + __uint_as_float(__builtin_amdgcn_readlane(u, 16))) + (__uint_as_float(__builtin_amdgcn_readlane(u, 32)) + __uint_as_float(__builtin_amdgcn_readlane(u, 48)));
}
__device__ __forceinline__ void lds_barrier() { asm volatile("s_waitcnt lgkmcnt(0)" ::: "memory"); __builtin_amdgcn_s_barrier(); asm volatile("" ::: "memory"); }
__device__ __forceinline__ unsigned char* rec_base(const Args& a, int u) {
    if (u < 80) return (unsigned char*)a.out + (size_t)u * 128 * RSZ;
    if (u < 118) return a.ws + WS_XN + (size_t)(u - 80) * 128 * RSZ;
    return a.ws + WS_TAIL + (size_t)(u - 118) * 128 * RSZ;
}
__device__ __forceinline__ void phase_prep(const Args& a, unsigned char* ldsb) {
    const int tid = threadIdx.x, lane = tid & 63, wave = tid >> 6, fr = lane & 15, quad = lane >> 4;
    unsigned char* ws = a.ws;
    const bf16_t* PA = (const bf16_t*)(ws + WS_PA);
    bf16_t* VR = (bf16_t*)(ws + WS_VRAW); float* BON = (float*)(ws + WS_BON);
    const float* mu = a.in[I_SHMU];
    LAS unsigned char* lds = (LAS unsigned char*)ldsb;
    constexpr int HAT_OFF = 69888;
    constexpr int XPB = 272;
    constexpr int RES_OFF = 4352;
    if (blockIdx.x == 0 && tid == 0) *(unsigned*)(ws + WS_CTR) = 0u;
    const int c = tid;
    const float w0 = a.in[I_W0][c], a0 = a.in[I_A0][c], kkc = a.in[I_KK][c], kac = a.in[I_KA][c], rkc = a.in[I_RK][c];
    const float mur = mu[c], muk = mu[512 + c], muv = mu[1024 + c];
    const bf16_t* LW = (const bf16_t*)(ws + WS_LW);
    pbf16x8 wf[2][4][2];
#pragma unroll
    for (int mat = 0; mat < 2; ++mat)
#pragma unroll
        for (int mt = 0; mt < 4; ++mt)
#pragma unroll
            for (int ks = 0; ks < 2; ++ks) wf[mat][mt][ks] = *(const pbf16x8*)(LW + (size_t)(mat * 512 + wave * 64 + mt * 16 + fr) * 64 + ks * 32 + 8 * quad);
    const int stok = tid >> 5, sj4 = (tid & 31) * 4;
    const f32x4 smu = *(const f32x4*)(mu + 1536 + sj4);
    u32x2 spw, sqw;
#define PREP_SLOAD(uu) do { const int t_ = (uu) * 16 + stok; spw = *(const u32x2*)(PA + (size_t)t_ * NA + 1536 + sj4); sqw = spw; if ((t_ % SEQ) != 0) sqw = *(const u32x2*)(PA + (size_t)(t_ - 1) * NA + 1536 + sj4); } while (0)
    if ((int)blockIdx.x < M / 16) PREP_SLOAD(blockIdx.x);
    for (int u = blockIdx.x; u < M / 16; u += gridDim.x) {
        const int t0 = u * 16;
        unsigned short gr[17], gk[17], gv[17];
        { const bool first0 = (t0 % SEQ) == 0;
          gr[0] = 0; gk[0] = 0; gv[0] = 0;
          if (!first0) { const bf16_t* q = PA + (size_t)(t0 - 1) * NA; gr[0] = q[c]; gk[0] = q[512 + c]; gv[0] = q[1024 + c]; }
#pragma unroll
          for (int i = 0; i < 16; ++i) { const bf16_t* p = PA + (size_t)(t0 + i) * NA; gr[i + 1] = p[c]; gk[i + 1] = p[512 + c]; gv[i + 1] = p[1024 + c]; } }
        {   const int t = t0 + stok; const bool first = (t % SEQ) == 0;
            const u32x2 pw = spw, qw = sqw;
            float x0 = bflo(pw.x), x1 = bfhi(pw.x), x2 = bflo(pw.y), x3 = bfhi(pw.y);
            const float y0 = first ? 0.f : bflo(qw.x), y1 = first ? 0.f : bfhi(qw.x), y2 = first ? 0.f : bflo(qw.y), y3 = first ? 0.f : bfhi(qw.y);
            x0 += (y0 - x0) * smu.x; x1 += (y1 - x1) * smu.y; x2 += (y2 - x2) * smu.z; x3 += (y3 - x3) * smu.w;
            if (sj4 < 64) { x0 = 1.0f - 2.0f / (__expf(2.0f * x0) + 1.0f); x1 = 1.0f - 2.0f / (__expf(2.0f * x1) + 1.0f); x2 = 1.0f - 2.0f / (__expf(2.0f * x2) + 1.0f); x3 = 1.0f - 2.0f / (__expf(2.0f * x3) + 1.0f); }
            u32x2 o; o.x = pk2(x0, x1); o.y = pk2(x2, x3);
            *(LAS u32x2*)(lds + stok * XPB + sj4 * 2) = o; }
        if (u + (int)gridDim.x < M / 16) PREP_SLOAD(u + gridDim.x);
        lds_barrier();
#pragma unroll
        for (int mat = 0; mat < 2; ++mat)
#pragma unroll
            for (int mt = 0; mt < 4; ++mt) {
                f32x4 acc = (f32x4){0.f, 0.f, 0.f, 0.f};
#pragma unroll
                for (int ks = 0; ks < 2; ++ks) { const pbf16x8 xf = *(const LAS pbf16x8*)(lds + fr * XPB + (mat * 64 + ks * 32 + 8 * quad) * 2); acc = __builtin_amdgcn_mfma_f32_16x16x32_bf16(wf[mat][mt][ks], xf, acc, 0, 0, 0); }
                *(LAS f32x4*)(lds + RES_OFF + ((mat * 16 + fr) * 512 + wave * 64 + mt * 16 + 4 * quad) * 4) = acc;
            }
        lds_barrier();
        float rp = bf2f(gr[0]), kp_ = bf2f(gk[0]), vp = bf2f(gv[0]);
        unsigned char* rec = rec_base(a, (t0 / SEQ) * 8 + wave) + (size_t)((t0 % SEQ) / 16) * RSZ;
        LAS unsigned char* hb = lds + HAT_OFF + wave * 9216;
        float Pprev = 1.0f;
#pragma unroll
        for (int i = 0; i < 16; ++i) {
            const int t = t0 + i;
            const float rc = bf2f(gr[i + 1]), kc = bf2f(gk[i + 1]), vc = bf2f(gv[i + 1]);
            const float r = rc + (rp - rc) * mur, k = kc + (kp_ - kc) * muk, v = vc + (vp - vc) * muv;
            rp = rc; kp_ = kc; vp = vc;
            const float z = *(const LAS float*)(lds + RES_OFF + (i * 512 + c) * 4) + w0;
            const float za = *(const LAS float*)(lds + RES_OFF + ((16 + i) * 512 + c) * 4) + a0;
            const float sp = fmaxf(-z, 0.f) + __logf(1.0f + __expf(-fabsf(z)));
            const float w = -sp - 0.5f;
            const float dec = __expf(-__expf(w));
            const float av = __builtin_amdgcn_rcpf(1.0f + __expf(-za));
            float kk = k * kkc; const float ss = wave_sum_dpp(kk * kk); kk = kk * __builtin_amdgcn_rcpf(fmaxf(__builtin_amdgcn_sqrtf(ss), 1e-12f));
            const float kn = k * (1.0f + (av - 1.0f) * kac);
            const float bon = wave_sum_dpp(r * kn * rkc);
            const float P = Pprev * dec, iP = __builtin_amdgcn_rcpf(P);
            LAS unsigned short* hat = (LAS unsigned short*)hb + i * 72 + lane;
            hat[0] = f2bf(-kk * Pprev); hat[1152] = f2bf(r * P); hat[2304] = f2bf(kk * av * iP); hat[3456] = f2bf(kn * iP);
            Pprev = P;
            const unsigned short vb16 = f2bf(v);
            VR[(size_t)t * 512 + c] = vb16;
            *(unsigned short*)(rec + 8192 + (lane >> 4) * 512 + ((i >> 2) * 16 + (lane & 15)) * 8 + (i & 3) * 2) = vb16;
            if (lane == 0) BON[t * 8 + wave] = bon;
        }
        *(float*)(rec + 12288 + lane * 4) = Pprev;
        asm volatile("s_waitcnt lgkmcnt(0)" ::: "memory");
        {
            pbf16x8 fa[2], fr2[2], fb[2], fk[2];
#pragma unroll
            for (int ks = 0; ks < 2; ++ks) { const int off = fr * 144 + (ks * 32 + 8 * quad) * 2;
                fa[ks] = *(const LAS pbf16x8*)(hb + off); fr2[ks] = *(const LAS pbf16x8*)(hb + 2304 + off); fb[ks] = *(const LAS pbf16x8*)(hb + 4608 + off); fk[ks] = *(const LAS pbf16x8*)(hb + 6912 + off); }
            f32x4 cba = (f32x4){0.f, 0.f, 0.f, 0.f}, cka = cba, cbr = cba, ckr = cba;
#pragma unroll
            for (int ks = 0; ks < 2; ++ks) { cba = __builtin_amdgcn_mfma_f32_16x16x32_bf16(fb[ks], fa[ks], cba, 0, 0, 0); cka = __builtin_amdgcn_mfma_f32_16x16x32_bf16(fk[ks], fa[ks], cka, 0, 0, 0);
                                             cbr = __builtin_amdgcn_mfma_f32_16x16x32_bf16(fb[ks], fr2[ks], cbr, 0, 0, 0); ckr = __builtin_amdgcn_mfma_f32_16x16x32_bf16(fk[ks], fr2[ks], ckr, 0, 0, 0); }
            float nn[4];
            {   float x0[4], x1[4], x2[4];
#pragma unroll
                for (int e = 0; e < 4; ++e) { const int j = 4 * quad + e; x0[e] = (j < fr) ? cka[e] : 0.f; x1[e] = (j <= fr) ? ckr[e] : 0.f; x2[e] = (j <= fr) ? cbr[e] : 0.f; nn[e] = (j < fr) ? cba[e] : 0.f; }
                u32x2 w; w.x = pk2(x0[0], x0[1]); w.y = pk2(x0[2], x0[3]); *(u32x2*)(rec + 10240 + lane * 8) = w;
                w.x = pk2(x1[0], x1[1]); w.y = pk2(x1[2], x1[3]); *(u32x2*)(rec + 10752 + lane * 8) = w;
                w.x = pk2(x2[0], x2[1]); w.y = pk2(x2[2], x2[3]); *(u32x2*)(rec + 11776 + lane * 8) = w; }
#pragma unroll
            for (int ks = 0; ks < 2; ++ks) {
                const u32x2 alo = *(const LAS u32x2*)(hb + fr * 144 + (32 * ks + 4 * quad) * 2), ahi = *(const LAS u32x2*)(hb + fr * 144 + (32 * ks + 16 + 4 * quad) * 2);
                const u32x2 rlo = *(const LAS u32x2*)(hb + 2304 + fr * 144 + (32 * ks + 4 * quad) * 2), rhi = *(const LAS u32x2*)(hb + 2304 + fr * 144 + (32 * ks + 16 + 4 * quad) * 2);
                *(u32x4*)(rec + ks * 1024 + lane * 16) = (u32x4){alo.x, alo.y, ahi.x, ahi.y};
                *(u32x4*)(rec + 2048 + ks * 1024 + lane * 16) = (u32x4){rlo.x, rlo.y, rhi.x, rhi.y};
            }
#pragma unroll
            for (int mt = 0; mt < 4; ++mt) {
                const LAS unsigned short* hB = (const LAS unsigned short*)(hb + 4608) + (4 * quad) * 72 + 16 * mt + fr;
                const LAS unsigned short* hK = (const LAS unsigned short*)(hb + 6912) + (4 * quad) * 72 + 16 * mt + fr;
                u32x4 o; o.x = (unsigned)hB[0] | ((unsigned)hB[72] << 16); o.y = (unsigned)hB[144] | ((unsigned)hB[216] << 16); o.z = (unsigned)hK[0] | ((unsigned)hK[72] << 16); o.w = (unsigned)hK[144] | ((unsigned)hK[216] << 16);
                *(u32x4*)(rec + 4096 + mt * 1024 + lane * 16) = o;
            }
            asm volatile("s_waitcnt lgkmcnt(0)" ::: "memory");
            LAS float* NL = (LAS float*)hb;
#pragma unroll
            for (int e = 0; e < 4; ++e) NL[(4 * quad + e) * 16 + fr] = nn[e];
            asm volatile("s_waitcnt lgkmcnt(0)" ::: "memory");
            float X[16];
#pragma unroll
            for (int l = 0; l < 16; ++l) X[l] = (l == fr) ? 1.0f : 0.f;
#pragma unroll
            for (int j = 14; j >= 0; --j) {
                const f32x4 n0 = ((const LAS f32x4*)NL)[j * 4], n1 = ((const LAS f32x4*)NL)[j * 4 + 1], n2 = ((const LAS f32x4*)NL)[j * 4 + 2], n3 = ((const LAS f32x4*)NL)[j * 4 + 3];
                const float nr[16] = {n0.x, n0.y, n0.z, n0.w, n1.x, n1.y, n1.z, n1.w, n2.x, n2.y, n2.z, n2.w, n3.x, n3.y, n3.z, n3.w};
                float acc = X[j];
#pragma unroll
                for (int l = j + 1; l < 16; ++l) acc = __builtin_fmaf(nr[l], X[l], acc);
                X[j] = acc;
            }
            float mv[4];
#pragma unroll
            for (int e = 0; e < 4; ++e) mv[e] = quad == 0 ? X[e] : (quad == 1 ? X[4 + e] : (quad == 2 ? X[8 + e] : X[12 + e]));
            u32x2 w; w.x = pk2(mv[0], mv[1]); w.y = pk2(mv[2], mv[3]); *(u32x2*)(rec + 11264 + lane * 8) = w;
            asm volatile("s_waitcnt lgkmcnt(0)" ::: "memory");
        }
    }
}

__device__ __forceinline__ float rdlane(float x, int k) { return __uint_as_float(__builtin_amdgcn_readlane(__float_as_uint(x), k)); }
__device__ __forceinline__ void phase_scan_naive(const Args& a) {
    const int tid = threadIdx.x, lane = tid & 63, wave = tid >> 6;
    if (wave != 0) return;
    unsigned char* ws = a.ws;
    const bf16_t* R = (const bf16_t*)a.out; const bf16_t* KP = R + (size_t)M * 512; const bf16_t* V = KP + (size_t)M * 512; const bf16_t* AN = V + (size_t)M * 512;
    bf16_t* YM = (bf16_t*)(ws + WS_YMIX); const float* DEC = (const float*)(ws + WS_XN); const float* BON = (const float*)(ws + WS_BON);
    const bf16_t* PB = (const bf16_t*)(ws + WS_PB);
    for (int u = blockIdx.x; u < BATCH * 8; u += gridDim.x) {
        const int b = u >> 3, h = u & 7;
        const float lg = a.in[I_LNXG][h * 64 + lane], lb = a.in[I_LNXB][h * 64 + lane];
        float s[64];
#pragma unroll
        for (int k = 0; k < 64; ++k) s[k] = 0.f;
        for (int t = 0; t < SEQ; ++t) {
            const int tok = b * SEQ + t; const size_t o = (size_t)tok * 512 + h * 64 + lane;
            const float ca = bf2f(AN[o]), cw = DEC[o], cb = bf2f(YM[(size_t)tok * 1024 + h * 64 + lane]), ck = bf2f(KP[o]), cr = bf2f(R[o]), vv = bf2f(V[o]);
            float sa = 0.f;
#pragma unroll
            for (int k = 0; k < 64; ++k) sa += s[k] * rdlane(ca, k);
            float y = 0.f;
#pragma unroll
            for (int k = 0; k < 64; ++k) { s[k] = s[k] * rdlane(cw, k) + sa * rdlane(cb, k) + vv * rdlane(ck, k); y += s[k] * rdlane(cr, k); }
            const float mean = wave_sum(y) * (1.0f / 64.0f); const float d = y - mean; const float var = wave_sum(d * d) * (1.0f / 64.0f);
            float yn = d * rsqrtf(var + GN_EPS) * lg + lb;
            yn += BON[tok * 8 + h] * vv;
            const float g = bf2f(PB[(size_t)tok * NB + h * 64 + lane]);
            YM[(size_t)tok * 1024 + h * 64 + lane] = f2bf(yn * siluf_(g));
        }
    }
}

__device__ __forceinline__ void phase_attn_naive(const Args& a) {
    const int tid = threadIdx.x, lane = tid & 63, wave = tid >> 6;
    unsigned char* ws = a.ws;
    const bf16_t* PB = (const bf16_t*)(ws + WS_PB); bf16_t* YM = (bf16_t*)(ws + WS_YMIX);
    for (int u = blockIdx.x * 8 + wave; u < BATCH * 8 * 32; u += gridDim.x * 8) {
        const int c = u & 31, h = (u >> 5) & 7, b = u >> 8;
        const int t = b * SEQ + c * 64 + lane;
        float q[64], acc[64];
        { const u32x4* qp = (const u32x4*)(PB + (size_t)t * NB + 512 + h * 64);
#pragma unroll
          for (int i = 0; i < 8; ++i) { const u32x4 w = qp[i]; q[8 * i] = bflo(w.x) * 0.125f; q[8 * i + 1] = bfhi(w.x) * 0.125f; q[8 * i + 2] = bflo(w.y) * 0.125f; q[8 * i + 3] = bfhi(w.y) * 0.125f;
              q[8 * i + 4] = bflo(w.z) * 0.125f; q[8 * i + 5] = bfhi(w.z) * 0.125f; q[8 * i + 6] = bflo(w.w) * 0.125f; q[8 * i + 7] = bfhi(w.w) * 0.125f; } }
#pragma unroll
        for (int d = 0; d < 64; ++d) acc[d] = 0.f;
        float m = -1e30f, l = 0.f;
        const float* bt = a.in[I_ABIAS] + h * 257;
        const int k0 = (c - 8 > 0 ? c - 8 : 0) * 64, k1 = (c + 1) * 64;
        for (int kj = k0; kj < k1; ++kj) {
            const bf16_t* kr = PB + (size_t)(b * SEQ + kj) * NB + 1024 + h * 64;
            float s = 0.f;
#pragma unroll
            for (int i = 0; i < 8; ++i) { const u32x4 w = ((const u32x4*)kr)[i];
                s += q[8 * i] * bflo(w.x) + q[8 * i + 1] * bfhi(w.x) + q[8 * i + 2] * bflo(w.y) + q[8 * i + 3] * bfhi(w.y) + q[8 * i + 4] * bflo(w.z) + q[8 * i + 5] * bfhi(w.z) + q[8 * i + 6] * bflo(w.w) + q[8 * i + 7] * bfhi(w.w); }
            int rel = c * 64 + lane - kj; rel = rel < -128 ? -128 : (rel > 128 ? 128 : rel);
            s += bt[rel + 128];
            const float mn = fmaxf(m, s), al = __expf(m - mn), p = __expf(s - mn);
            l = l * al + p; m = mn;
            const bf16_t* vr = kr + 512;
#pragma unroll
            for (int i = 0; i < 8; ++i) { const u32x4 w = ((const u32x4*)vr)[i];
                acc[8 * i] = acc[8 * i] * al + p * bflo(w.x); acc[8 * i + 1] = acc[8 * i + 1] * al + p * bfhi(w.x); acc[8 * i + 2] = acc[8 * i + 2] * al + p * bflo(w.y); acc[8 * i + 3] = acc[8 * i + 3] * al + p * bfhi(w.y);
                acc[8 * i + 4] = acc[8 * i + 4] * al + p * bflo(w.z); acc[8 * i + 5] = acc[8 * i + 5] * al + p * bfhi(w.z); acc[8 * i + 6] = acc[8 * i + 6] * al + p * bflo(w.w); acc[8 * i + 7] = acc[8 * i + 7] * al + p * bfhi(w.w); }
        }
        const float il = 1.0f / l;
        const u32x4* gp = (const u32x4*)(PB + (size_t)t * NB + 2048 + h * 64);
        u32x4* op = (u32x4*)(YM + (size_t)t * 1024 + 512 + h * 64);
#pragma unroll
        for (int i = 0; i < 8; ++i) { const u32x4 g = gp[i]; u32x4 o;
            o.x = pk2(acc[8 * i] * il * siluf_(bflo(g.x)), acc[8 * i + 1] * il * siluf_(bfhi(g.x))); o.y = pk2(acc[8 * i + 2] * il * siluf_(bflo(g.y)), acc[8 * i + 3] * il * siluf_(bfhi(g.y)));
            o.z = pk2(acc[8 * i + 4] * il * siluf_(bflo(g.z)), acc[8 * i + 5] * il * siluf_(bfhi(g.z))); o.w = pk2(acc[8 * i + 6] * il * siluf_(bflo(g.w)), acc[8 * i + 7] * il * siluf_(bfhi(g.w)));
            op[i] = o; }
    }
}


typedef _Float16 h8 __attribute__((ext_vector_type(8)));
typedef _Float16 h4 __attribute__((ext_vector_type(4)));
typedef short bf16x8 __attribute__((ext_vector_type(8)));
template <int CTRL> __device__ __forceinline__ float dpp_add(float x) { return x + __uint_as_float(__builtin_amdgcn_update_dpp(0, __float_as_uint(x), CTRL, 0xf, 0xf, true)); }
__device__ __forceinline__ float red8(float x) { x = dpp_add<0xB1>(x); x = dpp_add<0x4E>(x); x = dpp_add<0x141>(x); return x; }
__device__ __forceinline__ float red16(float x) { x = dpp_add<0x128>(x); x = dpp_add<0x124>(x); x = dpp_add<0x122>(x); x = dpp_add<0x121>(x); return x; }
constexpr int SC_PH = 0, SC_VV = 40960, SC_SC = 57344, SC_YY = 57856;
constexpr int TC = 32;

__device__ __forceinline__ void scan_unit(const Args& a, LAS unsigned char* lds, int u) {
    const int tid = threadIdx.x, lane = tid & 63, wave = tid >> 6;
    const int b = u >> 3, h = u & 7;
    unsigned char* ws = a.ws;
    const bf16_t* R = (const bf16_t*)a.out; const bf16_t* KP = R + (size_t)M * 512; const bf16_t* V = KP + (size_t)M * 512; const bf16_t* AN = V + (size_t)M * 512;
    bf16_t* YM = (bf16_t*)(ws + WS_YMIX); const float* DEC = (const float*)(ws + WS_XN); const float* BON = (const float*)(ws + WS_BON);
    const bf16_t* PB = (const bf16_t*)(ws + WS_PB);
    const int st = tid >> 4, sq = tid & 15;
    const int row = wave * 8 + (lane >> 3), cg = lane & 7;
    const int colbase = h * 64 + 4 * sq;
    const f32x4 lg = *(const f32x4*)(a.in[I_LNXG] + colbase), lb = *(const f32x4*)(a.in[I_LNXB] + colbase);
    float s[8];
#pragma unroll
    for (int j = 0; j < 8; ++j) s[j] = 0.f;
    u32x2 gR, gK, gV, gA, gB; f32x4 gD;
#define SC_GLOAD(c) do { const size_t tok_ = (size_t)b * SEQ + (c) * TC + st; const size_t o_ = tok_ * 512 + colbase; \
        gR = *(const u32x2*)(R + o_); gK = *(const u32x2*)(KP + o_); gV = *(const u32x2*)(V + o_); gA = *(const u32x2*)(AN + o_); \
        gB = *(const u32x2*)(YM + tok_ * 1024 + colbase); gD = *(const f32x4*)(DEC + o_); } while (0)
#define SC_STAGE(buf) do { \
        const float r0 = bflo(gR.x), r1 = bfhi(gR.x), r2 = bflo(gR.y), r3 = bfhi(gR.y); \
        const float k0 = bflo(gK.x), k1 = bfhi(gK.x), k2 = bflo(gK.y), k3 = bfhi(gK.y); \
        const float b0 = bflo(gB.x), b1 = bfhi(gB.x), b2 = bflo(gB.y), b3 = bfhi(gB.y); \
        LAS h4* ph4 = (LAS h4*)(lds + SC_PH) + (size_t)(((buf) * TC + st) * 5) * 16 + sq; \
        ph4[0]  = (h4){(_Float16)bflo(gA.x), (_Float16)bfhi(gA.x), (_Float16)bflo(gA.y), (_Float16)bfhi(gA.y)}; \
        ph4[16] = (h4){(_Float16)(1.0f - gD.x), (_Float16)(1.0f - gD.y), (_Float16)(1.0f - gD.z), (_Float16)(1.0f - gD.w)}; \
        ph4[32] = (h4){(_Float16)b0, (_Float16)b1, (_Float16)b2, (_Float16)b3}; \
        ph4[48] = (h4){(_Float16)k0, (_Float16)k1, (_Float16)k2, (_Float16)k3}; \
        ph4[64] = (h4){(_Float16)(gD.x * r0), (_Float16)(gD.y * r1), (_Float16)(gD.z * r2), (_Float16)(gD.w * r3)}; \
        *((LAS f32x4*)(lds + SC_VV) + ((buf) * TC + st) * 16 + sq) = (f32x4){bflo(gV.x), bfhi(gV.x), bflo(gV.y), bfhi(gV.y)}; \
        float br_ = (b0 * r0 + b1 * r1) + (b2 * r2 + b3 * r3), kr_ = (k0 * r0 + k1 * r1) + (k2 * r2 + k3 * r3); \
        br_ = red16(br_); kr_ = red16(kr_); \
        if (sq == 0) *((LAS f32x2*)(lds + SC_SC) + (buf) * TC + st) = (f32x2){br_, kr_}; } while (0)
    SC_GLOAD(0); SC_STAGE(0);
    __syncthreads();
    for (int c = 0; c < SEQ / TC; ++c) {
        const int buf = c & 1;
        if (c + 1 < SEQ / TC) SC_GLOAD(c + 1);
        const size_t tokE = (size_t)b * SEQ + c * TC + st;
        const u32x2 gG = *(const u32x2*)(PB + tokE * NB + colbase);
        const float bon = BON[tokE * 8 + h];
        {
            const LAS h8* ph8 = (const LAS h8*)(lds + SC_PH) + buf * TC * 40 + cg;
            const LAS float* vvp = (const LAS float*)(lds + SC_VV) + buf * TC * 64 + row;
            const LAS f32x2* scp = (const LAS f32x2*)(lds + SC_SC) + buf * TC;
            LAS float* yyp = (LAS float*)(lds + SC_YY) + row;
            h8 cA = ph8[0], cE = ph8[8], cB = ph8[16], cK = ph8[24], cW = ph8[32]; float cv = vvp[0]; f32x2 cs = scp[0];
#pragma unroll 2
            for (int t = 0; t < TC; ++t) {
                const int tn = (t + 1 < TC) ? t + 1 : t;
                const h8 nA = ph8[tn * 40], nE = ph8[tn * 40 + 8], nB = ph8[tn * 40 + 16], nK = ph8[tn * 40 + 24], nW = ph8[tn * 40 + 32]; const float nv = vvp[tn * 64]; const f32x2 ns = scp[tn];
                float sa0 = 0.f, sa1 = 0.f, yw0 = 0.f, yw1 = 0.f;
#pragma unroll
                for (int j = 0; j < 4; ++j) { sa0 = __builtin_fmaf(s[j], (float)cA[j], sa0); sa1 = __builtin_fmaf(s[4 + j], (float)cA[4 + j], sa1);
                                              yw0 = __builtin_fmaf(s[j], (float)cW[j], yw0); yw1 = __builtin_fmaf(s[4 + j], (float)cW[4 + j], yw1); }
                float sa = red8(sa0 + sa1), yw = red8(yw0 + yw1);
#pragma unroll
                for (int j = 0; j < 8; ++j) { float uu = __builtin_fmaf(sa, (float)cB[j], s[j]); uu = __builtin_fmaf(cv, (float)cK[j], uu); s[j] = __builtin_fmaf(-(float)cE[j], s[j], uu); }
                const float y = yw + sa * cs.x + cv * cs.y;
                yyp[t * 64] = y;
                cA = nA; cE = nE; cB = nB; cK = nK; cW = nW; cv = nv; cs = ns;
            }
        }
        __syncthreads();
        {
            const f32x4 y4 = *((const LAS f32x4*)(lds + SC_YY) + st * 16 + sq);
            const f32x4 v4 = *((const LAS f32x4*)(lds + SC_VV) + (buf * TC + st) * 16 + sq);
            const float mean = red16((y4.x + y4.y) + (y4.z + y4.w)) * (1.0f / 64.0f);
            const f32x4 d = y4 - mean;
            const float var = red16((d.x * d.x + d.y * d.y) + (d.z * d.z + d.w * d.w)) * (1.0f / 64.0f);
            const float rstd = rsqrtf(var + GN_EPS);
            f32x4 o = d * rstd * lg + lb + v4 * bon;
            o.x *= siluf_(bflo(gG.x)); o.y *= siluf_(bfhi(gG.x)); o.z *= siluf_(bflo(gG.y)); o.w *= siluf_(bfhi(gG.y));
            u32x2 w; w.x = pk2(o.x, o.y); w.y = pk2(o.z, o.w);
            *(u32x2*)(YM + tokE * 1024 + colbase) = w;
        }
        if (c + 1 < SEQ / TC) SC_STAGE(buf ^ 1);
        __syncthreads();
    }
#undef SC_GLOAD
#undef SC_STAGE
}


struct ChOps { u32x4 Aa[2], Ar[2], Abk[4]; u32x2 Acka, Ackr, Aminv, Acbr, Vb; f32x4 P[4]; };
__device__ __forceinline__ void ch_load(ChOps& o, const unsigned char* rec, int nt, int lane, int quad) {
#pragma unroll
    for (int ks = 0; ks < 2; ++ks) { o.Aa[ks] = *(const u32x4*)(rec + ks * 1024 + lane * 16); o.Ar[ks] = *(const u32x4*)(rec + 2048 + ks * 1024 + lane * 16); }
#pragma unroll
    for (int mt = 0; mt < 4; ++mt) { o.Abk[mt] = *(const u32x4*)(rec + 4096 + mt * 1024 + lane * 16); o.P[mt] = *(const f32x4*)(rec + 12288 + (16 * mt + 4 * quad) * 4); }
    o.Vb = *(const u32x2*)(rec + 8192 + nt * 512 + lane * 8);
    o.Acka = *(const u32x2*)(rec + 10240 + lane * 8); o.Ackr = *(const u32x2*)(rec + 10752 + lane * 8); o.Aminv = *(const u32x2*)(rec + 11264 + lane * 8); o.Acbr = *(const u32x2*)(rec + 11776 + lane * 8);
}
__device__ __forceinline__ void ch_load_lds(ChOps& o, const LAS unsigned char* rec, int nt, int lane, int quad) {
#pragma unroll
    for (int ks = 0; ks < 2; ++ks) { o.Aa[ks] = *(const LAS u32x4*)(rec + ks * 1024 + lane * 16); o.Ar[ks] = *(const LAS u32x4*)(rec + 2048 + ks * 1024 + lane * 16); }
    o.Vb = *(const LAS u32x2*)(rec + 8192 + nt * 512 + lane * 8);
    o.Acka = *(const LAS u32x2*)(rec + 10240 + lane * 8); o.Ackr = *(const LAS u32x2*)(rec + 10752 + lane * 8); o.Aminv = *(const LAS u32x2*)(rec + 11264 + lane * 8); o.Acbr = *(const LAS u32x2*)(rec + 11776 + lane * 8);
#pragma unroll
    for (int mt = 0; mt < 4; ++mt) { o.Abk[mt] = *(const LAS u32x4*)(rec + 4096 + mt * 1024 + lane * 16); o.P[mt] = *(const LAS f32x4*)(rec + 12288 + (16 * mt + 4 * quad) * 4); }
}
__device__ __forceinline__ bf16x8 asbf(u32x4 v) { return __builtin_bit_cast(bf16x8, v); }
__device__ __forceinline__ void scan_unit_chunked(const Args& a, LAS unsigned char* lds, int u) {
    const int tid = threadIdx.x, lane = tid & 63, wave = tid >> 6, fr = lane & 15, quad = lane >> 4;
    const int b = u >> 3, h = u & 7;
    unsigned char* ws = a.ws;
    const bf16_t* VR = (const bf16_t*)(ws + WS_VRAW); bf16_t* YM = (bf16_t*)(ws + WS_YMIX); const float* BON = (const float*)(ws + WS_BON);
    const bf16_t* PB = (const bf16_t*)(ws + WS_PB);
    const unsigned char* recs = rec_base(a, u);
    LAS float* YY = (LAS float*)lds;
    constexpr int REC_OFF = 16384, GRPB = 4 * RSZ, NPIECE = GRPB / 16;
    const int etok = tid >> 3, er8 = (tid & 7) * 8;
    const f32x4 lg0 = *(const f32x4*)(a.in[I_LNXG] + h * 64 + er8), lg1 = *(const f32x4*)(a.in[I_LNXG] + h * 64 + er8 + 4);
    const f32x4 lb0 = *(const f32x4*)(a.in[I_LNXB] + h * 64 + er8), lb1 = *(const f32x4*)(a.in[I_LNXB] + h * 64 + er8 + 4);
    f32x4 S[4];
#pragma unroll
    for (int mt = 0; mt < 4; ++mt) S[mt] = (f32x4){0.f, 0.f, 0.f, 0.f};
#define SC_LDGROUP(gidx, bufi) do { const unsigned char* src_ = recs + (size_t)(gidx) * GRPB; LAS unsigned char* dst_ = lds + REC_OFF + (bufi) * GRPB; u32x4 tmp_[13]; \
        _Pragma("unroll") for (int k_ = 0; k_ < 13; ++k_) { const int idx_ = (tid - 256) + 256 * k_; if (idx_ < NPIECE) tmp_[k_] = *(const u32x4*)(src_ + (size_t)idx_ * 16); } \
        _Pragma("unroll") for (int k_ = 0; k_ < 13; ++k_) { const int idx_ = (tid - 256) + 256 * k_; if (idx_ < NPIECE) *(LAS u32x4*)(dst_ + idx_ * 16) = tmp_[k_]; } } while (0)
    if (wave >= 4) SC_LDGROUP(0, 0);
    __syncthreads();
    for (int g = 0; g < SEQ / 64; ++g) {
        const int buf = g & 1;
        const size_t tokE = (size_t)b * SEQ + g * 64 + etok;
        const u32x4 ev = *(const u32x4*)(VR + tokE * 512 + h * 64 + er8);
        const u32x4 eg = *(const u32x4*)(PB + tokE * NB + h * 64 + er8);
        const float bon = BON[tokE * 8 + h];
        if (wave < 4) {
#pragma unroll
            for (int cc = 0; cc < 4; ++cc) {
                ChOps cur;
                ch_load_lds(cur, lds + REC_OFF + buf * GRPB + cc * RSZ, wave, lane, quad);
                u32x4 sb[2];
#pragma unroll
                for (int ks = 0; ks < 2; ++ks) { sb[ks].x = pk2(S[2 * ks][0], S[2 * ks][1]); sb[ks].y = pk2(S[2 * ks][2], S[2 * ks][3]);
                                                 sb[ks].z = pk2(S[2 * ks + 1][0], S[2 * ks + 1][1]); sb[ks].w = pk2(S[2 * ks + 1][2], S[2 * ks + 1][3]); }
                const u32x4 vb = (u32x4){cur.Vb.x, cur.Vb.y, 0u, 0u};
                f32x4 rhs = (f32x4){0.f, 0.f, 0.f, 0.f}, hv = rhs;
#pragma unroll
                for (int ks = 0; ks < 2; ++ks) { rhs = __builtin_amdgcn_mfma_f32_16x16x32_bf16(asbf(cur.Aa[ks]), asbf(sb[ks]), rhs, 0, 0, 0); hv = __builtin_amdgcn_mfma_f32_16x16x32_bf16(asbf(cur.Ar[ks]), asbf(sb[ks]), hv, 0, 0, 0); }
                rhs = __builtin_amdgcn_mfma_f32_16x16x32_bf16(asbf((u32x4){cur.Acka.x, cur.Acka.y, 0u, 0u}), asbf(vb), rhs, 0, 0, 0);
                hv = __builtin_amdgcn_mfma_f32_16x16x32_bf16(asbf((u32x4){cur.Ackr.x, cur.Ackr.y, 0u, 0u}), asbf(vb), hv, 0, 0, 0);
                const u32x4 rb = (u32x4){pk2(rhs[0], rhs[1]), pk2(rhs[2], rhs[3]), 0u, 0u};
                const f32x4 sa = __builtin_amdgcn_mfma_f32_16x16x32_bf16(asbf((u32x4){cur.Aminv.x, cur.Aminv.y, 0u, 0u}), asbf(rb), (f32x4){0.f, 0.f, 0.f, 0.f}, 0, 0, 0);
                const u32x4 svb = (u32x4){pk2(sa[0], sa[1]), pk2(sa[2], sa[3]), cur.Vb.x, cur.Vb.y};
                const f32x4 y = __builtin_amdgcn_mfma_f32_16x16x32_bf16(asbf((u32x4){cur.Acbr.x, cur.Acbr.y, 0u, 0u}), asbf(svb), hv, 0, 0, 0);
#pragma unroll
                for (int mt = 0; mt < 4; ++mt) { S[mt] = __builtin_amdgcn_mfma_f32_16x16x32_bf16(asbf(cur.Abk[mt]), asbf(svb), S[mt], 0, 0, 0); S[mt] = S[mt] * cur.P[mt]; }
#pragma unroll
                for (int jj = 0; jj < 4; ++jj) YY[(cc * 16 + 4 * quad + jj) * 64 + 16 * wave + fr] = y[jj];
            }
        } else if (g + 1 < SEQ / 64) {
            SC_LDGROUP(g + 1, buf ^ 1);
        }
        __syncthreads();
        {
            const f32x4 y0 = *(const LAS f32x4*)(YY + etok * 64 + er8), y1 = *(const LAS f32x4*)(YY + etok * 64 + er8 + 4);
            const float mean = red8(((y0.x + y0.y) + (y0.z + y0.w)) + ((y1.x + y1.y) + (y1.z + y1.w))) * (1.0f / 64.0f);
            const f32x4 d0 = y0 - mean, d1 = y1 - mean;
            const float var = red8(((d0.x * d0.x + d0.y * d0.y) + (d0.z * d0.z + d0.w * d0.w)) + ((d1.x * d1.x + d1.y * d1.y) + (d1.z * d1.z + d1.w * d1.w))) * (1.0f / 64.0f);
            const float rstd = rsqrtf(var + GN_EPS);
            const f32x4 v0 = (f32x4){bflo(ev.x), bfhi(ev.x), bflo(ev.y), bfhi(ev.y)}, v1 = (f32x4){bflo(ev.z), bfhi(ev.z), bflo(ev.w), bfhi(ev.w)};
            f32x4 o0 = d0 * rstd * lg0 + lb0 + v0 * bon, o1 = d1 * rstd * lg1 + lb1 + v1 * bon;
            o0.x *= siluf_(bflo(eg.x)); o0.y *= siluf_(bfhi(eg.x)); o0.z *= siluf_(bflo(eg.y)); o0.w *= siluf_(bfhi(eg.y));
            o1.x *= siluf_(bflo(eg.z)); o1.y *= siluf_(bfhi(eg.z)); o1.z *= siluf_(bflo(eg.w)); o1.w *= siluf_(bfhi(eg.w));
            u32x4 w; w.x = pk2(o0.x, o0.y); w.y = pk2(o0.z, o0.w); w.z = pk2(o1.x, o1.y); w.w = pk2(o1.z, o1.w);
            *(u32x4*)(YM + tokE * 1024 + h * 64 + er8) = w;
        }
        __syncthreads();
    }
#undef SC_LDGROUP
}


constexpr int AT_KS = 0, AT_VT = 18432, AT_BT = 36864, AT_PITCH = 144;
__device__ __forceinline__ void attn_unit(const Args& a, LAS unsigned char* lds, int u) {
    const int tid = threadIdx.x, lane = tid & 63, wave = tid >> 6, fr = lane & 15, quad = lane >> 4;
    const int cp = u & 15, h = (u >> 4) & 7, b = u >> 7;
    unsigned char* ws = a.ws;
    const bf16_t* PB = (const bf16_t*)(ws + WS_PB); bf16_t* YM = (bf16_t*)(ws + WS_YMIX);
    const int c0 = 2 * cp, cq = c0 + (wave >> 2), qrow = (wave & 3) * 16 + fr;
    const size_t tq = (size_t)b * SEQ + cq * 64 + qrow;
    constexpr float LOG2E = 1.4426950408889634f;
    if (tid < 257) ((LAS float*)(lds + AT_BT))[tid] = a.in[I_ABIAS][h * 257 + tid] * LOG2E;
    bf16x8 qf[2];
    qf[0] = *(const bf16x8*)(PB + tq * NB + 512 + h * 64 + 8 * quad); qf[1] = *(const bf16x8*)(PB + tq * NB + 512 + h * 64 + 32 + 8 * quad);
    f32x4 O[4];
#pragma unroll
    for (int i = 0; i < 4; ++i) O[i] = (f32x4){0.f, 0.f, 0.f, 0.f};
    float m = -1e30f, l = 0.f;
    const int kfirst = c0 - 8 > 0 ? c0 - 8 : 0, klast = c0 + 1;
    const int kkey = tid >> 3, kdch = tid & 7;
    const int vkey = tid & 63, vdch = tid >> 6;
    const int vpos = (vkey & 32) + 8 * ((vkey >> 2) & 3) + 4 * ((vkey >> 4) & 1) + (vkey & 3);
    u32x4 gk, gv, gk1, gv1, gk2, gv2;
#define AT_GLD(kc, K_, V_) do { if ((kc) <= klast) { K_ = *(const u32x4*)(PB + ((size_t)b * SEQ + (kc) * 64 + kkey) * NB + 1024 + h * 64 + kdch * 8); \
                        V_ = *(const u32x4*)(PB + ((size_t)b * SEQ + (kc) * 64 + vkey) * NB + 1536 + h * 64 + vdch * 8); } } while (0)
#define AT_SST(buf, gk, gv) do { *(LAS u32x4*)(lds + AT_KS + (buf) * 9216 + kkey * AT_PITCH + kdch * 16) = gk; \
        LAS unsigned short* vt_ = (LAS unsigned short*)(lds + AT_VT + (buf) * 9216) + (vdch * 8) * (AT_PITCH / 2) + vpos; \
        vt_[0 * 72] = (unsigned short)(gv.x & 0xffffu); vt_[1 * 72] = (unsigned short)(gv.x >> 16); vt_[2 * 72] = (unsigned short)(gv.y & 0xffffu); vt_[3 * 72] = (unsigned short)(gv.y >> 16); \
        vt_[4 * 72] = (unsigned short)(gv.z & 0xffffu); vt_[5 * 72] = (unsigned short)(gv.z >> 16); vt_[6 * 72] = (unsigned short)(gv.w & 0xffffu); vt_[7 * 72] = (unsigned short)(gv.w >> 16); } while (0)
    gk = gv = gk1 = gv1 = gk2 = gv2 = (u32x4){0u, 0u, 0u, 0u};
    AT_GLD(kfirst, gk2, gv2); AT_GLD(kfirst + 1, gk, gv); AT_GLD(kfirst + 2, gk1, gv1);
    AT_SST(0, gk2, gv2);
    lds_barrier();
    for (int kc = kfirst; kc <= klast; ++kc) {
        const int buf = (kc - kfirst) & 1;
        AT_GLD(kc + 3, gk2, gv2);
        if (kc <= cq && kc >= cq - 8) {
            const LAS unsigned char* ks = lds + AT_KS + buf * 9216 + fr * AT_PITCH + quad * 16;
            const LAS unsigned char* vt = lds + AT_VT + buf * 9216 + fr * AT_PITCH + quad * 16;
            f32x4 sc[4];
#pragma unroll
            for (int kt = 0; kt < 4; ++kt) {
                sc[kt] = (f32x4){0.f, 0.f, 0.f, 0.f};
#pragma unroll
                for (int k2 = 0; k2 < 2; ++k2) { const bf16x8 kf = *(const LAS bf16x8*)(ks + kt * 16 * AT_PITCH + k2 * 64); sc[kt] = __builtin_amdgcn_mfma_f32_16x16x32_bf16(kf, qf[k2], sc[kt], 0, 0, 0); }
            }
            const int dch = cq - kc;
            const LAS float* bt = (const LAS float*)(lds + AT_BT);
            float mx = -1e30f;
            if (dch >= 3) {
                const float bc = bt[256];
#pragma unroll
                for (int kt = 0; kt < 4; ++kt)
#pragma unroll
                    for (int j = 0; j < 4; ++j) { sc[kt][j] = __builtin_fmaf(sc[kt][j], 0.125f * LOG2E, bc); mx = fmaxf(mx, sc[kt][j]); }
            } else {
                const int base = dch * 64 + qrow + 128 - 4 * quad;
#pragma unroll
                for (int kt = 0; kt < 4; ++kt)
#pragma unroll
                    for (int j = 0; j < 4; ++j) { int idx = base - kt * 16 - j; idx = idx > 256 ? 256 : idx; sc[kt][j] = __builtin_fmaf(sc[kt][j], 0.125f * LOG2E, bt[idx]); mx = fmaxf(mx, sc[kt][j]); }
            }
            mx = fmaxf(mx, __shfl_xor(mx, 16)); mx = fmaxf(mx, __shfl_xor(mx, 32));
            const float mn = fmaxf(m, mx), al = __builtin_amdgcn_exp2f(m - mn); m = mn;
            float ps = 0.f;
#pragma unroll
            for (int kt = 0; kt < 4; ++kt)
#pragma unroll
                for (int j = 0; j < 4; ++j) { sc[kt][j] = __builtin_amdgcn_exp2f(sc[kt][j] - mn); ps += sc[kt][j]; }
            l = l * al + ps;
#pragma unroll
            for (int i = 0; i < 4; ++i) O[i] = O[i] * al;
#pragma unroll
            for (int s2 = 0; s2 < 2; ++s2) {
                u32x4 pw; pw.x = pk2(sc[2 * s2][0], sc[2 * s2][1]); pw.y = pk2(sc[2 * s2][2], sc[2 * s2][3]); pw.z = pk2(sc[2 * s2 + 1][0], sc[2 * s2 + 1][1]); pw.w = pk2(sc[2 * s2 + 1][2], sc[2 * s2 + 1][3]);
                const bf16x8 pf = __builtin_bit_cast(bf16x8, pw);
#pragma unroll
                for (int dt = 0; dt < 4; ++dt) { const bf16x8 vf = *(const LAS bf16x8*)(vt + dt * 16 * AT_PITCH + s2 * 64); O[dt] = __builtin_amdgcn_mfma_f32_16x16x32_bf16(vf, pf, O[dt], 0, 0, 0); }
            }
        }
        if (kc < klast) AT_SST(buf ^ 1, gk, gv);
        gk = gk1; gv = gv1; gk1 = gk2; gv1 = gv2;
        lds_barrier();
    }
#undef AT_GLD
#undef AT_SST
    l += __shfl_xor(l, 16); l += __shfl_xor(l, 32);
    const float il = 1.0f / l;
#pragma unroll
    for (int dt = 0; dt < 4; ++dt) {
        const int dcol = h * 64 + dt * 16 + 4 * quad;
        const u32x2 g = *(const u32x2*)(PB + tq * NB + 2048 + dcol);
        const f32x4 o = O[dt] * il;
        u32x2 w; w.x = pk2(o[0] * siluf_(bflo(g.x)), o[1] * siluf_(bfhi(g.x))); w.y = pk2(o[2] * siluf_(bflo(g.y)), o[3] * siluf_(bfhi(g.y)));
        *(u32x2*)(YM + tq * 1024 + 512 + dcol) = w;
    }
}

__device__ __forceinline__ void phase_mix(const Args& a, LAS unsigned char* lds, bool do_scan = true, bool do_attn = true) {
    unsigned* ctr = (unsigned*)(a.ws + WS_CTR);
    if (do_scan) for (int u = blockIdx.x; u < BATCH * 8; u += gridDim.x) scan_unit_chunked(a, lds, u);
    LAS int* uw = (LAS int*)(lds + 40000);
    if (do_attn) for (;;) {
        __syncthreads();
        if (threadIdx.x == 0) *uw = (int)atomicAdd(ctr, 1u);
        __syncthreads();
        const int u = *uw;
        if (u >= BATCH * 8 * 16) break;
        attn_unit(a, lds, u);
    }
}

__device__ __forceinline__ void phase_sg_naive(const Args& a, unsigned char* ldsb) {
    const int tid = threadIdx.x;
    unsigned char* ws = a.ws;
    const bf16_t* P1 = (const bf16_t*)(ws + WS_P1); bf16_t* Y2 = (bf16_t*)(ws + WS_YMIX);
    const float* vsum = (const float*)(ws + WS_VSUM); const float* vsq = (const float*)(ws + WS_VSQ);
    float* vn = (float*)ldsb;
    const int c = tid & 127, i0 = tid >> 7;
    for (int u = blockIdx.x; u < BATCH * 16 * 8; u += gridDim.x) {
        const int g = u & 7, nb = (u >> 3) & 15, b = u >> 7;
        const int tbase = b * SEQ + nb * 128;
        const float lg = a.in[I_SGLNG][g * 128 + c], lb = a.in[I_SGLNB][g * 128 + c];
        for (int j = i0; j < 128; j += 4) {
            const int t = tbase + j; const float mean = vsum[t] * (1.0f / 1024.0f); const float var = vsq[t] * (1.0f / 1024.0f) - mean * mean;
            const float rstd = rsqrtf(fmaxf(var, 0.f) + LN_EPS);
            vn[j * 128 + c] = (bf2f(P1[(size_t)t * N3 + 1024 + g * 128 + c]) - mean) * rstd * lg + lb;
        }
        __syncthreads();
        const float* wg = a.in[I_SGW] + (size_t)g * 128 * 128; const float* sb = a.in[I_SGB] + g * 128;
        for (int i = i0; i < 128; i += 4) {
            const int jend = (i < 64) ? 64 : 128;
            float acc = 0.f;
            for (int j = 0; j < jend; ++j) acc += wg[i * 128 + j] * vn[j * 128 + c];
            const int t = tbase + i;
            const float uu = bf2f(P1[(size_t)t * N3 + g * 128 + c]), gt = bf2f(P1[(size_t)t * N3 + 2048 + g * 128 + c]);
            Y2[(size_t)t * 1024 + g * 128 + c] = f2bf(uu * (acc + sb[i]) * gt);
        }
        __syncthreads();
    }
}


__device__ __forceinline__ void phase_sg(const Args& a, LAS unsigned char* lds, int variant = 0) {
    const int tid = threadIdx.x, lane = tid & 63, wave = tid >> 6, fr = lane & 15, quad = lane >> 4;
    unsigned char* ws = a.ws;
    const bf16_t* P1 = (const bf16_t*)(ws + WS_P1); bf16_t* Y2 = (bf16_t*)(ws + WS_YMIX); const bf16_t* SGW = (const bf16_t*)(ws + WS_SGW);
    const float* vsum = (const float*)(ws + WS_VSUM); const float* vsq = (const float*)(ws + WS_VSQ);
    constexpr int VPB = 272;
    constexpr int NUN = BATCH * 16 * 8;
    const int per = (NUN + (int)gridDim.x - 1) / (int)gridDim.x;
    const int u0 = blockIdx.x * per, u1 = (u0 + per < NUN) ? u0 + per : NUN;
    u32x4 vw[4]; float vmean[4], vrstd[4];
    const int lpc = tid & 15, lrb = tid >> 4;
#define SG_VLOAD(uu_) do { const int g_ = (uu_) >> 8, tb_ = (((uu_) >> 4) & 15) * SEQ + ((uu_) & 15) * 128; \
        _Pragma("unroll") for (int q_ = 0; q_ < 4; ++q_) { const int t_ = tb_ + lrb + 32 * q_; \
            const float m_ = vsum[t_] * (1.0f / 1024.0f); const float var_ = vsq[t_] * (1.0f / 1024.0f) - m_ * m_; vmean[q_] = m_; vrstd[q_] = rsqrtf(fmaxf(var_, 0.f) + LN_EPS); \
            vw[q_] = *(const u32x4*)(P1 + (size_t)t_ * N3 + 1024 + g_ * 128 + lpc * 8); } } while (0)
    if (u0 < u1) SG_VLOAD(u0);
    for (int u = u0; u < u1; ++u) {
        const int g = u >> 8, b = (u >> 4) & 15, nb = u & 15;
        const int tbase = b * SEQ + nb * 128;
        const int irow = 16 * wave + fr;
        const int epc = tid & 15, erb = tid >> 4;
        u32x4 uu[4], gg[4];
#pragma unroll
        for (int q = 0; q < 4; ++q) { const size_t te = (size_t)tbase + erb + 32 * q; uu[q] = *(const u32x4*)(P1 + te * N3 + g * 128 + epc * 8); gg[q] = *(const u32x4*)(P1 + te * N3 + 2048 + g * 128 + epc * 8); }
        bf16x8 wf[4];
#pragma unroll
        for (int ks = 0; ks < 4; ++ks) wf[ks] = *(const bf16x8*)(SGW + (size_t)(g * 128 + irow) * 128 + ks * 32 + 8 * quad);
        if (variant != 2) {
            const int c8 = lpc * 8;
            const f32x4 g0 = *(const f32x4*)(a.in[I_SGLNG] + g * 128 + c8), g1 = *(const f32x4*)(a.in[I_SGLNG] + g * 128 + c8 + 4);
            const f32x4 b0 = *(const f32x4*)(a.in[I_SGLNB] + g * 128 + c8), b1 = *(const f32x4*)(a.in[I_SGLNB] + g * 128 + c8 + 4);
#pragma unroll
            for (int q = 0; q < 4; ++q) {
                const int j = lrb + 32 * q; const float mean = vmean[q], rstd = vrstd[q];
                const u32x4 w = vw[q];
                LAS unsigned short* vt = (LAS unsigned short*)(lds + c8 * VPB + (((j >> 3) ^ lpc) * 16) + (j & 7) * 2);
                vt[0 * (VPB / 2)] = f2bf((bflo(w.x) - mean) * rstd * g0.x + b0.x); vt[1 * (VPB / 2)] = f2bf((bfhi(w.x) - mean) * rstd * g0.y + b0.y);
                vt[2 * (VPB / 2)] = f2bf((bflo(w.y) - mean) * rstd * g0.z + b0.z); vt[3 * (VPB / 2)] = f2bf((bfhi(w.y) - mean) * rstd * g0.w + b0.w);
                vt[4 * (VPB / 2)] = f2bf((bflo(w.z) - mean) * rstd * g1.x + b1.x); vt[5 * (VPB / 2)] = f2bf((bfhi(w.z) - mean) * rstd * g1.y + b1.y);
                vt[6 * (VPB / 2)] = f2bf((bflo(w.w) - mean) * rstd * g1.z + b1.z); vt[7 * (VPB / 2)] = f2bf((bfhi(w.w) - mean) * rstd * g1.w + b1.w);
            }
        }
        if (u + 1 < u1) SG_VLOAD(u + 1);
        lds_barrier();
        if (variant == 1) { lds_barrier(); continue; }
        f32x4 acc[8];
#pragma unroll
        for (int ct = 0; ct < 8; ++ct) {
            acc[ct] = (f32x4){0.f, 0.f, 0.f, 0.f};
#pragma unroll
            for (int ks = 0; ks < 4; ++ks) {
                if (ks < 2 || wave >= 4) { const bf16x8 vf = *(const LAS bf16x8*)(lds + (ct * 16 + fr) * VPB + (((ks * 4 + quad) ^ (ct * 2 + (fr >> 3))) * 16)); acc[ct] = __builtin_amdgcn_mfma_f32_16x16x32_bf16(vf, wf[ks], acc[ct], 0, 0, 0); }
            }
        }
        {
            LAS float* ot = (LAS float*)(lds + 36864);
#pragma unroll
            for (int ct = 0; ct < 8; ++ct) *(LAS f32x4*)(ot + irow * 132 + ct * 16 + 4 * quad) = acc[ct];
            lds_barrier();
#pragma unroll
            for (int q = 0; q < 4; ++q) {
                const int i = erb + 32 * q; const size_t te = (size_t)tbase + i; const float sbv = a.in[I_SGB][g * 128 + i];
                const f32x4 s0 = *(const LAS f32x4*)(ot + i * 132 + epc * 8), s1 = *(const LAS f32x4*)(ot + i * 132 + epc * 8 + 4);
                u32x4 w;
                w.x = pk2(bflo(uu[q].x) * (s0[0] + sbv) * bflo(gg[q].x), bfhi(uu[q].x) * (s0[1] + sbv) * bfhi(gg[q].x));
                w.y = pk2(bflo(uu[q].y) * (s0[2] + sbv) * bflo(gg[q].y), bfhi(uu[q].y) * (s0[3] + sbv) * bfhi(gg[q].y));
                w.z = pk2(bflo(uu[q].z) * (s1[0] + sbv) * bflo(gg[q].z), bfhi(uu[q].z) * (s1[1] + sbv) * bfhi(gg[q].z));
                w.w = pk2(bflo(uu[q].w) * (s1[2] + sbv) * bflo(gg[q].w), bfhi(uu[q].w) * (s1[3] + sbv) * bfhi(gg[q].w));
                *(u32x4*)(Y2 + te * 1024 + g * 128 + epc * 8) = w;
            }
        }
        lds_barrier();
    }
#undef SG_VLOAD
}

__device__ __forceinline__ void phase_final(const Args& a) {
    const int tid = threadIdx.x, lane = tid & 63, wave = tid >> 6;
    const float* rs2 = (const float*)(a.ws + WS_RS2); const float* fg = a.in[I_FG];
    const int gw = blockIdx.x * 8 + wave, NGW = gridDim.x * 8;
    f32x4 g4[4];
#pragma unroll
    for (int j = 0; j < 4; ++j) g4[j] = ((const f32x4*)fg)[lane + 64 * j];
    for (int m = gw; m < M; m += NGW) {
        const float rinv = rsqrtf(rs2[m] * (1.0f / DM) + RMS_EPS);
        f32x4* p = (f32x4*)(a.out + (size_t)m * DM) + lane;
#pragma unroll
        for (int j = 0; j < 4; ++j) { f32x4 v = p[64 * j]; v = v * rinv * g4[j]; p[64 * j] = v; }
    }
}

#define XB_TMO      128
#define XB_XCNT(j)  (256  + 64 * (j))
#define XB_XSUB(j)  (1280 + 64 * (j))
#define XB_XGEN(j)  (2304 + 64 * (j))
#define XB_TOP      3328
#define XB_TOPGEN   3392
#define XCD_BAR_WORDS 3456
#define XB_SPIN_CAP (1u << 18)

__device__ __forceinline__ unsigned xb_ld(unsigned* p)              { return __hip_atomic_load(p, __ATOMIC_RELAXED, __HIP_MEMORY_SCOPE_AGENT); }
__device__ __forceinline__ unsigned xb_add(unsigned* p, unsigned v) { return __hip_atomic_fetch_add(p, v, __ATOMIC_RELAXED, __HIP_MEMORY_SCOPE_AGENT); }
__device__ __forceinline__ unsigned xb_xcc_id() { return (unsigned)__builtin_amdgcn_s_getreg((3 << 11) | 20) & 0xFu; }
#define XB_SPIN(cond, bar) do { unsigned _sp = 0; while (cond) { __builtin_amdgcn_s_sleep(1); \
    if ((++_sp & 255u) == 0u) { if (xb_ld(&(bar)[XB_TMO])) break; if (_sp > XB_SPIN_CAP) { atomicAdd(&(bar)[XB_TMO], 1u); break; } } } } while (0)

struct XcdBarrier {
    unsigned* bar; unsigned x;
    volatile LAS unsigned* st;
};

__device__ __forceinline__ XcdBarrier xcd_barrier_post(unsigned* bar, volatile LAS unsigned* st) {
    XcdBarrier b; b.bar = bar; b.x = xb_xcc_id(); b.st = st;
    if (threadIdx.x == 0) (void)xb_add(&bar[XB_XCNT(b.x)], 1u);
    return b;
}
__device__ __forceinline__ void xcd_barrier_complete(unsigned* bar, unsigned x, unsigned& nloc, unsigned& nx) {
    const unsigned G = gridDim.x * gridDim.y * gridDim.z;
    unsigned sum, cnt, mine, sp = 0u;
    for (;;) {
        sum = 0u; cnt = 0u; mine = 0u;
#pragma unroll
        for (unsigned j = 0; j < 16; ++j) { const unsigned c = xb_ld(&bar[XB_XCNT(j)]); sum += c; cnt += (c > 0u) ? 1u : 0u; mine = (j == x) ? c : mine; }
        if (sum == G) break;
        __builtin_amdgcn_s_sleep(1);
        if ((++sp & 255u) == 0u) { if (xb_ld(&bar[XB_TMO])) break; if (sp > XB_SPIN_CAP) { atomicAdd(&bar[XB_TMO], 1u); break; } }
    }
    nloc = mine > 0u ? mine : 1u; nx = cnt > 0u ? cnt : 1u;
}

__device__ __forceinline__ void xcd_barrier(const XcdBarrier& b) {
    asm volatile("s_waitcnt vmcnt(0)" ::: "memory");
    __syncthreads();
    if (threadIdx.x == 0) {
        unsigned* bar = b.bar;
        __builtin_amdgcn_s_waitcnt(0);
        unsigned nloc = b.st[0], nx = b.st[1];
        if (nloc == 0u) { xcd_barrier_complete(bar, b.x, nloc, nx); b.st[0] = nloc; b.st[1] = nx; }
        const unsigned old = xb_add(&bar[XB_XSUB(b.x)], 1u);
        const unsigned gen = old / nloc;
        if (old + 1u == (gen + 1u) * nloc) {
            __builtin_amdgcn_fence(__ATOMIC_RELEASE, "agent");
            asm volatile("s_waitcnt vmcnt(0)" ::: "memory");
            const unsigned og = xb_add(&bar[XB_TOP], 1u);
            const unsigned tg = og / nx;
            if (og + 1u == (tg + 1u) * nx) xb_add(&bar[XB_TOPGEN], 1u);
            else XB_SPIN(xb_ld(&bar[XB_TOPGEN]) == tg, bar);
            __builtin_amdgcn_fence(__ATOMIC_ACQUIRE, "agent");
            xb_add(&bar[XB_XGEN(b.x)], 1u);
            asm volatile("s_waitcnt vmcnt(0)" ::: "memory");
        } else {
            XB_SPIN(xb_ld(&bar[XB_XGEN(b.x)]) == gen, bar);
            __builtin_amdgcn_fence(__ATOMIC_ACQUIRE, "agent");
            asm volatile("s_waitcnt vmcnt(0)" ::: "memory");
        }
    }
    __syncthreads();
}

template <int PHM> __global__ void __launch_bounds__(NTHR, 2) mega(Args a) {
    extern __shared__ __attribute__((aligned(16))) unsigned char lds[];
    unsigned char* ws = a.ws;
    const int lo = a.lo, hi = a.hi;
    volatile LAS unsigned* bst = (volatile LAS unsigned*)((LAS unsigned char*)lds + (LDS_BYTES - 64));
    if (threadIdx.x < 2) bst[threadIdx.x] = 0u;
    __syncthreads();
    XcdBarrier xbar = xcd_barrier_post((unsigned*)(ws + WS_BAR), bst);
    if (hi > 1000) cg::this_grid().sync();
#define IN(k) (((PHM >> (k)) & 1) && lo <= (k) && (k) < hi)
#if PROBE_LOOPS
#define REPS(i) a.rep[i]
#else
#define REPS(i) 0
#endif
#if USE_XBAR
#define SEAM(k) do { if (IN(k) && IN((k) + 1)) { xcd_barrier(xbar); } } while (0)
#else
#define SEAM(k) do { if (IN(k) && IN((k) + 1)) { cg::this_grid().sync(); } } while (0)
#endif
    if (IN(0)) for (int r_ = 0; r_ <= REPS(0); ++r_) { phase_prologue(a, lds); if (r_ < REPS(0)) xcd_barrier(xbar); }
    SEAM(0);
    if (IN(1)) { EpiG1 f{(const float*)(ws + WS_RS0), (bf16_t*)(ws + WS_PA), (bf16_t*)(ws + WS_PB)};
        gemm_any(lds, (const bf16_t*)(ws + WS_XN), (const bf16_t*)(ws + WS_W1T), M, N1, DM, f); }
    SEAM(1);
    if (IN(2)) for (int r_ = 0; r_ <= REPS(1); ++r_) { phase_prep(a, lds); if (r_ < REPS(1)) xcd_barrier(xbar); }
    SEAM(2);
    #if PROBE & 1
    phase_prep(a, lds); cg::this_grid().sync();
#endif
#if USE_NAIVE_MIX
    if (IN(3)) { phase_scan_naive(a); phase_attn_naive(a); }
#else
    if (IN(3)) for (int r_ = 0; r_ <= REPS(2); ++r_) { phase_mix(a, (LAS unsigned char*)lds, a.rep[0] != 2, a.rep[0] != 1); if (r_ < REPS(2)) { xcd_barrier(xbar); if (blockIdx.x == 0 && threadIdx.x == 0) *(unsigned*)(ws + WS_CTR) = 0u; xcd_barrier(xbar); } }
#endif
    SEAM(3);
#if PROBE & 2
    phase_prep(a, lds); cg::this_grid().sync(); phase_mix(a, (LAS unsigned char*)lds); cg::this_grid().sync();
#endif
#if PROBE & 64
    phase_prep(a, lds); cg::this_grid().sync(); phase_mix(a, (LAS unsigned char*)lds, true, false); cg::this_grid().sync();
#endif
#if PROBE & 32
    if (blockIdx.x == 0 && threadIdx.x == 0) *(unsigned*)(ws + WS_CTR) = 0u;
    cg::this_grid().sync(); phase_mix(a, (LAS unsigned char*)lds, false); cg::this_grid().sync();
#endif
#if PROBE & 4
    phase_prologue(a, lds); cg::this_grid().sync();
#endif
#if PROBE & 16
    { EpiG1 f{(const float*)(ws + WS_RS0), (bf16_t*)(ws + WS_PA), (bf16_t*)(ws + WS_PB)};
        gemm_any(lds, (const bf16_t*)(ws + WS_XN), (const bf16_t*)(ws + WS_W1T), M, N1, DM, f); cg::this_grid().sync(); }
#endif
    if (IN(4)) { EpiG2 f{a.in[I_X], a.out, (bf16_t*)(ws + WS_XN), (float*)(ws + WS_RS1)};
        gemm_any(lds, (const bf16_t*)(ws + WS_YMIX), (const bf16_t*)(ws + WS_W2T), M, DM, DM, f); }
    SEAM(4);
#if PROBE & 128
    { EpiG2 f{a.in[I_X], a.out, (bf16_t*)(ws + WS_XN), (float*)(ws + 640 * 1024)};
        gemm_any(lds, (const bf16_t*)(ws + WS_YMIX), (const bf16_t*)(ws + WS_W2T), M, DM, DM, f); cg::this_grid().sync(); }
#endif
    if (IN(5)) { EpiG3 f{(const float*)(ws + WS_RS1), (bf16_t*)(ws + WS_P1), (float*)(ws + WS_VSUM), (float*)(ws + WS_VSQ)};
        gemm_any(lds, (const bf16_t*)(ws + WS_XN), (const bf16_t*)(ws + WS_W3T), M, N3, DM, f); }
    SEAM(5);
    if (IN(6)) for (int r_ = 0; r_ <= REPS(3); ++r_) { phase_sg(a, (LAS unsigned char*)lds, (PROBE_LOOPS || N_LAUNCH_MODE == 3) ? a.rep[0] : 0); if (r_ < REPS(3)) xcd_barrier(xbar); }
    SEAM(6);
#if PROBE & 8
    phase_sg(a, (LAS unsigned char*)lds); cg::this_grid().sync();
#endif
    if (IN(7)) { EpiG4 f{a.out, (float*)(ws + WS_RS2)};
        gemm_any(lds, (const bf16_t*)(ws + WS_YMIX), (const bf16_t*)(ws + WS_W4T), M, DM, DM, f); }
    SEAM(7);
#if PROBE & 256
    for (int i_ = 0; i_ < 8; ++i_) cg::this_grid().sync();
#endif
    if (IN(8)) { phase_final(a); }
#undef IN
#undef SEAM
}
constexpr int NPHASE = 9;
}
#if defined(__HIP_DEVICE_COMPILE__)
#pragma clang attribute pop
#endif

extern "C" void kernel_launch(void* const* d_in, const int* in_sizes, int n_in, void* d_out, int out_size, void* d_ws, size_t ws_size, hipStream_t stream) {
    using namespace mk;
    static int grid = 0;
    if (grid == 0) {
        if (n_in != 22 || out_size != M * DM || ws_size < WS_END) { fprintf(stderr, "kernel_launch: unexpected shapes (n_in %d out %d ws %zu)\n", n_in, out_size, ws_size); grid = -1; return; }
        int dev = 0, cus = 0, per_cu = 0;
        (void)hipGetDevice(&dev); (void)hipDeviceGetAttribute(&cus, hipDeviceAttributeMultiprocessorCount, dev);
#if N_LAUNCH_MODE == 1 || N_LAUNCH_MODE == 3
        if (hipFuncSetAttribute((const void*)mega<0x1ff>, hipFuncAttributeMaxDynamicSharedMemorySize, LDS_BYTES) != hipSuccess) { fprintf(stderr, "kernel_launch: hipFuncSetAttribute failed\n"); grid = -1; return; }
        if (hipOccupancyMaxActiveBlocksPerMultiprocessor(&per_cu, (const void*)mega<0x1ff>, NTHR, LDS_BYTES) != hipSuccess || per_cu < 1) { fprintf(stderr, "kernel_launch: occupancy query says %d\n", per_cu); per_cu = 1; }
#else
        if (hipFuncSetAttribute((const void*)mega<0x1f7>, hipFuncAttributeMaxDynamicSharedMemorySize, LDS_BYTES) != hipSuccess || hipFuncSetAttribute((const void*)mega<0x008>, hipFuncAttributeMaxDynamicSharedMemorySize, LDS_BYTES) != hipSuccess) { fprintf(stderr, "kernel_launch: hipFuncSetAttribute failed\n"); grid = -1; return; }
#endif
        (void)hipGetLastError();
        grid = cus * 1;
        if (grid <= 0) grid = 256;
    }
    if (grid < 0) return;
    Args a{};
    for (int i = 0; i < 22; ++i) a.in[i] = (const float*)d_in[i];
    a.out = (float*)d_out; a.ws = (unsigned char*)d_ws;
    a.rep[0] = PROBE_REP0; a.rep[1] = PROBE_REP1; a.rep[2] = PROBE_REP2; a.rep[3] = PROBE_REP3;
    if (hipMemsetAsync((char*)d_ws + WS_BAR, 0, 16384, stream) != hipSuccess) { fprintf(stderr, "kernel_launch: hipMemsetAsync failed\n"); return; }
#if N_LAUNCH_MODE == 3
    {
        constexpr int P = PROBE_PHASE; constexpr int MLO = (1 << P) - 1, MP = 1 << P, MHI = 0x1ff & ~((1 << (P + 1)) - 1);
        void* args[] = {&a};
        (void)hipFuncSetAttribute((const void*)mega<MP>, hipFuncAttributeMaxDynamicSharedMemorySize, LDS_BYTES);
        (void)hipFuncSetAttribute((const void*)mega<MHI>, hipFuncAttributeMaxDynamicSharedMemorySize, LDS_BYTES);
        if (P > 0) { (void)hipFuncSetAttribute((const void*)mega<MLO>, hipFuncAttributeMaxDynamicSharedMemorySize, LDS_BYTES);
            a.lo = 0; a.hi = P; (void)hipLaunchCooperativeKernel((const void*)mega<MLO>, dim3(grid), dim3(NTHR), args, LDS_BYTES, stream); }
        for (int r = 0; r <= PROBE_REP2; ++r) {
            a.lo = P; a.hi = P + 1; a.rep[0] = (r == PROBE_REP2) ? 0 : PROBE_MIXMODE;
            (void)hipMemsetAsync((char*)d_ws + WS_CTR, 0, 4, stream);
            (void)hipMemsetAsync((char*)d_ws + WS_BAR, 0, 16384, stream);
            hipLaunchKernelGGL(mega<MP>, dim3(grid), dim3(NTHR), LDS_BYTES, stream, a);
        }
        a.rep[0] = 0;
        (void)hipMemsetAsync((char*)d_ws + WS_BAR, 0, 16384, stream);
        a.lo = P + 1; a.hi = NPHASE;
        (void)hipLaunchCooperativeKernel((const void*)mega<MHI>, dim3(grid), dim3(NTHR), args, LDS_BYTES, stream);
    }
#elif N_LAUNCH_MODE == 2
    {
        void* args[] = {&a};
        a.lo = 0; a.hi = 3;
        hipError_t e = hipLaunchCooperativeKernel((const void*)mega<0x1f7>, dim3(grid), dim3(NTHR), args, LDS_BYTES, stream);
        if (e != hipSuccess) fprintf(stderr, "kernel_launch: cooperative launch A failed: %s (grid %d)\n", hipGetErrorString(e), grid);
        a.lo = 3; a.hi = 4;
        hipLaunchKernelGGL(mega<0x008>, dim3(grid), dim3(NTHR), LDS_BYTES, stream, a);
        a.lo = 4; a.hi = NPHASE;
        e = hipLaunchCooperativeKernel((const void*)mega<0x1f7>, dim3(grid), dim3(NTHR), args, LDS_BYTES, stream);
        if (e != hipSuccess) fprintf(stderr, "kernel_launch: cooperative launch B failed: %s (grid %d)\n", hipGetErrorString(e), grid);
    }
#elif N_LAUNCH_MODE == 1
    a.lo = 0; a.hi = NPHASE;
    void* args[] = {&a};
    hipError_t e = hipLaunchCooperativeKernel((const void*)mega<0x1ff>, dim3(grid), dim3(NTHR), args, LDS_BYTES, stream);
    if (e != hipSuccess) fprintf(stderr, "kernel_launch: cooperative launch failed: %s (grid %d)\n", hipGetErrorString(e), grid);
#else
    for (int ph = 0; ph < NPHASE; ++ph) {
        a.lo = ph; a.hi = ph + 1;
        if (ph == 3) hipLaunchKernelGGL(mega<0x008>, dim3(grid), dim3(NTHR), LDS_BYTES, stream, a);
        else hipLaunchKernelGGL(mega<0x1f7>, dim3(grid), dim3(NTHR), LDS_BYTES, stream, a);
    }
#endif
}
```

```cpp
#if defined(__HIP_DEVICE_COMPILE__)
#pragma clang attribute push(__attribute__((target("no-packed-fp32-ops"))), apply_to = function)
#endif
#include <hip/hip_runtime.h>
#include <hip/hip_cooperative_groups.h>
#include <cstdio>
#include <cstdint>
namespace cg = cooperative_groups;
#ifndef USE_PG8
#define USE_PG8 1
#endif
#ifndef N_LAUNCH_MODE
#define N_LAUNCH_MODE 1
#endif
#ifndef PHMASK
#define PHMASK 0x1ff
#endif
#ifndef USE_NAIVE_MIX
#define USE_NAIVE_MIX 0
#endif
#ifndef PROBE
#define PROBE 0
#endif
#ifndef USE_XBAR
#define USE_XBAR 1
#endif
#ifndef PROBE_REP0
#define PROBE_REP0 0
#define PROBE_REP1 0
#define PROBE_REP2 0
#define PROBE_REP3 0
#endif
#ifndef SCAN_PREFETCH
#define SCAN_PREFETCH 1
#endif
#ifndef PROBE_LOOPS
#define PROBE_LOOPS 0
#endif
#ifndef PROBE_MIXMODE
#define PROBE_MIXMODE 0
#endif
#ifndef PROBE_PHASE
#define PROBE_PHASE 3
#endif
namespace pg8 {
#define PG8_LAS __attribute__((address_space(3)))
typedef unsigned short bf16_t;
typedef short bf16x8 __attribute__((ext_vector_type(8)));
typedef float f32x4 __attribute__((ext_vector_type(4)));
typedef unsigned u32x4 __attribute__((ext_vector_type(4)));
constexpr int BM = 256, BK = 64, HALF = 128, HTB = HALF * BK * 2  , STAGE_BYTES = 8 * HTB, NXCD = 8, WGM = 8;

__host__ __device__ __forceinline__ int lds_byte(int r, int c) { const int st = (r >> 4) * 2 + (c >> 5), rr = r & 15, cc = c & 31, ob = rr * 64 + cc * 2; return st * 1024 + (ob ^ (((ob >> 9) & 1) << 5)); }
__host__ __device__ __forceinline__ void stage_rc(int b, int& R, int& C) { const int st = b / 1024, sb = b % 1024, swz = sb ^ (((sb >> 9) & 1) << 5); R = (st >> 1) * 16 + swz / 64; C = (st & 1) * 32 + (swz % 64) / 2; }
__host__ __device__ __forceinline__ int perm32(int rho) { const int n = rho >> 4, i = rho & 15; return 8 * (i >> 2) + 4 * n + (i & 3); }

struct Unit { int pm, pn; };
struct Gemm { const bf16_t* A; const bf16_t* Bt; int M, N, K; };

struct StaticOrder {
    int nM, nN, nwg, G, c;
    __host__ __device__ void init(int M, int N, int G_, int c_) { nM = M / BM; nN = N / BM; nwg = nM * nN; G = G_; c = c_; }
    __host__ __device__ bool next(int i, Unit& u) const {
        const long L = (long)i * G + c; if (L >= nwg) return false;
        int wgid = (int)L; { const int q = nwg / NXCD, r = nwg % NXCD, xcd = wgid % NXCD, off = wgid / NXCD; wgid = (xcd < r ? xcd * (q + 1) : r * (q + 1) + (xcd - r) * q) + off; }
        const int nig = WGM * nN, gid = wgid / nig, fm = gid * WGM, gsz = (nM - fm) < WGM ? (nM - fm) : WGM;
        u.pm = fm + ((wgid % nig) % gsz); u.pn = (wgid % nig) / gsz; return true;
    }
    __device__ __forceinline__ void a_ready(const Unit&) const {}
    __device__ __forceinline__ void done(const Unit&) const {}
};

__device__ __forceinline__ unsigned cvt_pk_bf16(float lo, float hi) { unsigned r; asm volatile("v_cvt_pk_bf16_f32 %0, %1, %2" : "=v"(r) : "v"(lo), "v"(hi)); return r; }
typedef float f32x2 __attribute__((ext_vector_type(2)));
__device__ __forceinline__ f32x2 gelu_pk(f32x2 v) {
    const f32x2 av = __builtin_elementwise_abs(v), d = av * 0.2316418882f + 1.0f;
    f32x2 t; t.x = __builtin_amdgcn_rcpf(d.x); t.y = __builtin_amdgcn_rcpf(d.y);
    f32x2 q = t * 0.5307027145f + (-0.7265760135f); q = q * t + 0.7107068705f; q = q * t + (-0.142248368f); q = q * t + 0.127414796f; q = q * t;
    const f32x2 s = (v * v) * (-0.72134752044f);
    f32x2 e; e.x = __builtin_amdgcn_exp2f(s.x); e.y = __builtin_amdgcn_exp2f(s.y);
    const f32x2 m = v * (q * e), r = v - m;
    f32x2 o; o.x = v.x < 0.f ? m.x : r.x; o.y = v.y < 0.f ? m.y : r.y; return o;
}

template <int ACT  > struct EpiBf16 {
    static constexpr bool PERM = true, AFTER_DRAIN = false; static_assert(ACT == 0 || ACT == 1, "EpiBf16: ACT is 0 (none) or 1 (gelu_pk)");
    bf16_t* O; int ldc; const float* bias; int split_cols; size_t split_stride; float scale0;
    __device__ __forceinline__ void operator()(const f32x4 (&acc)[2][2][4][2], const Unit& u, int wr, int wc, int fr, int fq) const {
        const int row0 = u.pm * BM + wr * 64 + fr; int colt = u.pn * BM; bf16_t* base = O;
        float sc = 1.f; if (split_cols) { const int t = colt / split_cols; base += (size_t)t * split_stride; colt -= t * split_cols; if (t == 0) sc = scale0; }
        const int col0 = colt + wc * 32 + 8 * fq, bcol0 = u.pn * BM + wc * 32 + 8 * fq;
        f32x4 bv[2][2];
#pragma unroll
        for (int bj = 0; bj < 2; ++bj)
#pragma unroll
            for (int n = 0; n < 2; ++n) bv[bj][n] = bias ? *(const f32x4*)(bias + bcol0 + bj * HALF + 4 * n) : (f32x4){0.f, 0.f, 0.f, 0.f};
#pragma unroll
        for (int ai = 0; ai < 2; ++ai)
#pragma unroll
            for (int m = 0; m < 4; ++m) { bf16_t* rowp = base + (size_t)(row0 + ai * HALF + m * 16) * ldc + col0;
#pragma unroll
                for (int bj = 0; bj < 2; ++bj) { f32x4 v0 = acc[ai][bj][m][0] + bv[bj][0], v1 = acc[ai][bj][m][1] + bv[bj][1];
                    if (ACT == 1) { f32x2 a = gelu_pk((f32x2){v0[0], v0[1]}), b = gelu_pk((f32x2){v0[2], v0[3]}), c = gelu_pk((f32x2){v1[0], v1[1]}), d = gelu_pk((f32x2){v1[2], v1[3]});
                        v0 = (f32x4){a.x, a.y, b.x, b.y}; v1 = (f32x4){c.x, c.y, d.x, d.y}; }
                    v0 = v0 * sc; v1 = v1 * sc; u32x4 w; w.x = cvt_pk_bf16(v0[0], v0[1]); w.y = cvt_pk_bf16(v0[2], v0[3]); w.z = cvt_pk_bf16(v1[0], v1[1]); w.w = cvt_pk_bf16(v1[2], v1[3]);
                    *(u32x4*)(rowp + bj * HALF) = w; } }
    }
};
template <class Epi, class Sched, bool ALIGN_EPI = false, bool SP2 = false>
__device__ __forceinline__ void gemm_phase(PG8_LAS unsigned char* lds, const Gemm g, const Sched& S, const Epi& E) {
    const int tid = threadIdx.x, wid = __builtin_amdgcn_readfirstlane(tid >> 6), lane = tid & 63, wr = wid >> 2, wc = wid & 3, fr = lane & 15, fq = lane >> 4;
    const int K = g.K, nt = K / BK;
    unsigned voffA[2], voffB[2];
#pragma unroll
    for (int i = 0; i < 2; ++i) { int R, C; stage_rc(tid * 16 + i * 8192, R, C); const int Rb = Epi::PERM ? ((R & ~31) + perm32(R & 31)) : R;
        voffA[i] = (unsigned)(R * K + C) * 2u; voffB[i] = (unsigned)(Rb * K + C) * 2u; }
    const size_t kstep = (size_t)(BK * 2);
    const size_t hstep = (size_t)HALF * K * 2;
    const size_t tstep = 2 * hstep;
    const unsigned ldsw = (unsigned)wid * 1024u;
    const int aoff = lds_byte(wr * 64 + fr, fq * 8), boff = lds_byte(wc * 32 + fr, fq * 8);
#define PG8_SA(b, h) (((b) * 2 + (h)) * HTB)
#define PG8_SB(b, h) ((4 + (b) * 2 + (h)) * HTB)
#define PG8_STAGE(bufoff, gbase, voff) do { _Pragma("unroll") for (int _i = 0; _i < 2; ++_i) \
        __builtin_amdgcn_global_load_lds((const unsigned*)((const char*)(gbase) + (voff)[_i]), (PG8_LAS unsigned*)(lds + (bufoff) + ldsw + _i * 8192), 16, 0, 0); } while (0)
#define PG8_LDA(dst, b, h) do { _Pragma("unroll") for (int m = 0; m < 4; ++m) _Pragma("unroll") for (int k = 0; k < 2; ++k) dst[m][k] = *(const PG8_LAS bf16x8*)(lds + PG8_SA(b, h) + aoff + m * 2048 + k * 1024); } while (0)
#define PG8_LDB(dst, b, h) do { _Pragma("unroll") for (int n = 0; n < 2; ++n) _Pragma("unroll") for (int k = 0; k < 2; ++k) dst[n][k] = *(const PG8_LAS bf16x8*)(lds + PG8_SB(b, h) + boff + n * 2048 + k * 1024); } while (0)
#define PG8_MMA(ai, bj, At, Bt) do { __builtin_amdgcn_s_setprio(1); _Pragma("unroll") for (int m = 0; m < 4; ++m) _Pragma("unroll") for (int n = 0; n < 2; ++n) _Pragma("unroll") for (int k = 0; k < 2; ++k) \
        acc[ai][bj][m][n] = __builtin_amdgcn_mfma_f32_16x16x32_bf16(Bt[n][k], At[m][k], acc[ai][bj][m][n], 0, 0, 0); __builtin_amdgcn_s_setprio(0); } while (0)
#define PG8_WAIT_V(n) asm volatile("s_waitcnt vmcnt(" #n ")" ::: "memory")
#define PG8_WAIT_L(n) asm volatile("s_waitcnt lgkmcnt(" #n ")" ::: "memory")
#define PG8_BAR __builtin_amdgcn_s_barrier()
#define PG8_SCHED __builtin_amdgcn_sched_barrier(0)
    Unit cur, nxt; int ui = 0;
    if (!S.next(0, cur)) return;
    f32x4 acc[2][2][4][2];
#pragma unroll
    for (int a = 0; a < 2; ++a)
#pragma unroll
        for (int b = 0; b < 2; ++b)
#pragma unroll
            for (int m = 0; m < 4; ++m)
#pragma unroll
                for (int n = 0; n < 2; ++n) acc[a][b][m][n] = (f32x4){0.f, 0.f, 0.f, 0.f};
    bf16x8 At[4][2], B0[2][2], B1[2][2];
    const char* cA = (const char*)g.A + (size_t)cur.pm * tstep; const char* cB = (const char*)g.Bt + (size_t)cur.pn * tstep;
    S.a_ready(cur);
    if constexpr (SP2) {
        PG8_STAGE(PG8_SB(0, 0), cB, voffB); PG8_STAGE(PG8_SB(0, 1), cB + hstep, voffB); PG8_STAGE(PG8_SA(0, 0), cA, voffA); PG8_STAGE(PG8_SA(0, 1), cA + hstep, voffA);
        if (wr == 1) PG8_BAR;
        PG8_WAIT_V(2); PG8_BAR;
        PG8_STAGE(PG8_SB(1, 0), cB + kstep, voffB); PG8_STAGE(PG8_SA(1, 0), cA + kstep, voffA); PG8_STAGE(PG8_SB(1, 1), cB + hstep + kstep, voffB);
        PG8_WAIT_V(6); PG8_BAR;
    } else {
        PG8_STAGE(PG8_SB(0, 0), cB, voffB); PG8_STAGE(PG8_SA(0, 0), cA, voffA); PG8_STAGE(PG8_SB(0, 1), cB + hstep, voffB); PG8_STAGE(PG8_SA(0, 1), cA + hstep, voffA);
        if (wr == 1) PG8_BAR;
        PG8_WAIT_V(4); PG8_BAR;
        PG8_STAGE(PG8_SB(1, 0), cB + kstep, voffB); PG8_STAGE(PG8_SA(1, 0), cA + kstep, voffA); PG8_STAGE(PG8_SB(1, 1), cB + hstep + kstep, voffB);
        PG8_WAIT_V(6); PG8_BAR;
    }
    for (;;) {
        const bool has_next = S.next(ui + 1, nxt);
        const char* nA = has_next ? (const char*)g.A + (size_t)nxt.pm * tstep : cA; const char* nB = has_next ? (const char*)g.Bt + (size_t)nxt.pn * tstep : cB;
        for (int t = 0; t < nt; t += 2) {
            const bool last = (t == nt - 2);
            const char* a1 = cA + (size_t)(t + 1) * kstep;
            const char* a2 = last ? nA : cA + (size_t)(t + 2) * kstep; const char* b2 = last ? nB : cB + (size_t)(t + 2) * kstep;
            const char* a3 = a2 + kstep; const char* b3 = b2 + kstep;
            if (last && has_next) S.a_ready(nxt);
            if constexpr (SP2) {
            PG8_LDB(B0, 0, 0); PG8_LDB(B1, 0, 1); PG8_SCHED; PG8_LDA(At, 0, 0); PG8_STAGE(PG8_SA(1, 1), a1 + hstep, voffA);
            PG8_WAIT_V(8); PG8_WAIT_L(0); PG8_BAR; PG8_MMA(0, 0, At, B0); PG8_MMA(0, 1, At, B1); PG8_BAR; PG8_SCHED;
            PG8_LDA(At, 0, 1); PG8_STAGE(PG8_SB(0, 0), b2, voffB); PG8_STAGE(PG8_SB(0, 1), b2 + hstep, voffB); PG8_STAGE(PG8_SA(0, 0), a2, voffA);
            PG8_WAIT_V(8); PG8_WAIT_L(0); PG8_BAR; PG8_MMA(1, 0, At, B0); PG8_MMA(1, 1, At, B1); PG8_BAR; PG8_SCHED;
            PG8_LDB(B0, 1, 0); PG8_LDB(B1, 1, 1); PG8_SCHED; PG8_LDA(At, 1, 0); PG8_STAGE(PG8_SA(0, 1), a2 + hstep, voffA);
            PG8_WAIT_V(8); PG8_WAIT_L(0); PG8_BAR; PG8_MMA(0, 0, At, B0); PG8_MMA(0, 1, At, B1); PG8_BAR; PG8_SCHED;
            PG8_LDA(At, 1, 1); PG8_STAGE(PG8_SB(1, 0), b3, voffB); PG8_STAGE(PG8_SB(1, 1), b3 + hstep, voffB); PG8_STAGE(PG8_SA(1, 0), a3, voffA);
            PG8_WAIT_V(8); PG8_WAIT_L(0); PG8_BAR; PG8_MMA(1, 0, At, B0); PG8_MMA(1, 1, At, B1); PG8_BAR; PG8_SCHED;
            } else {
            PG8_LDB(B0, 0, 0); PG8_SCHED; PG8_LDA(At, 0, 0); PG8_STAGE(PG8_SA(1, 1), a1 + hstep, voffA);
            PG8_WAIT_L(8); PG8_BAR; PG8_WAIT_L(0); PG8_MMA(0, 0, At, B0); PG8_BAR; PG8_SCHED;
            PG8_LDB(B1, 0, 1); PG8_STAGE(PG8_SB(0, 0), b2, voffB);
            PG8_BAR; PG8_WAIT_L(0); PG8_MMA(0, 1, At, B1); PG8_BAR;
            PG8_LDA(At, 0, 1); PG8_STAGE(PG8_SA(0, 0), a2, voffA);
            PG8_BAR; PG8_WAIT_L(0); PG8_MMA(1, 0, At, B0); PG8_BAR; PG8_SCHED;
            PG8_STAGE(PG8_SB(0, 1), b2 + hstep, voffB);
            PG8_WAIT_V(6); PG8_BAR; PG8_MMA(1, 1, At, B1); PG8_BAR;
            PG8_LDB(B0, 1, 0); PG8_SCHED; PG8_LDA(At, 1, 0); PG8_STAGE(PG8_SA(0, 1), a2 + hstep, voffA);
            PG8_WAIT_L(8); PG8_BAR; PG8_WAIT_L(0); PG8_MMA(0, 0, At, B0); PG8_BAR; PG8_SCHED;
            PG8_LDB(B1, 1, 1); PG8_STAGE(PG8_SB(1, 0), b3, voffB);
            PG8_BAR; PG8_WAIT_L(0); PG8_MMA(0, 1, At, B1); PG8_BAR;
            PG8_LDA(At, 1, 1); PG8_STAGE(PG8_SA(1, 0), a3, voffA);
            PG8_BAR; PG8_WAIT_L(0); PG8_MMA(1, 0, At, B0); PG8_BAR; PG8_SCHED;
            PG8_STAGE(PG8_SB(1, 1), b3 + hstep, voffB);
            PG8_WAIT_V(6); PG8_BAR; PG8_MMA(1, 1, At, B1); PG8_BAR;
            }
        }
        if constexpr (ALIGN_EPI) { if (wr == 0) PG8_BAR; }
        if constexpr (!Epi::AFTER_DRAIN) { E(acc, cur, wr, wc, fr, fq); S.done(cur); }
        if (!has_next) break;
#pragma unroll
        for (int a = 0; a < 2; ++a)
#pragma unroll
            for (int b = 0; b < 2; ++b)
#pragma unroll
                for (int m = 0; m < 4; ++m)
#pragma unroll
                    for (int n = 0; n < 2; ++n) acc[a][b][m][n] = (f32x4){0.f, 0.f, 0.f, 0.f};
        cur = nxt; cA = nA; cB = nB; ++ui;
        if constexpr (ALIGN_EPI) { if (wr == 1) PG8_BAR; }
    }
    PG8_WAIT_V(0);
    if constexpr (!ALIGN_EPI) { if (wr == 0) PG8_BAR; }
    PG8_BAR;
    if constexpr (Epi::AFTER_DRAIN) { E.fused(acc, cur, wr, wc, fr, fq, lds, wid, lane); S.done(cur); }
#undef PG8_SA
#undef PG8_SB
#undef PG8_STAGE
#undef PG8_LDA
#undef PG8_LDB
#undef PG8_MMA
#undef PG8_WAIT_V
#undef PG8_WAIT_L
#undef PG8_BAR
#undef PG8_SCHED
}
}

namespace mk {
typedef unsigned short bf16_t;
typedef float f32x4 __attribute__((ext_vector_type(4)));
typedef unsigned u32x4 __attribute__((ext_vector_type(4)));
typedef unsigned u32x2 __attribute__((ext_vector_type(2)));
typedef float f32x2 __attribute__((ext_vector_type(2)));
#define LAS __attribute__((address_space(3)))

constexpr int BATCH = 16, SEQ = 2048, DM = 1024, M = BATCH * SEQ;
constexpr int NA = 1792, NB = 2560, N1 = NA + NB;
constexpr int N3 = 3072;
constexpr int EVEN_IN = 4224, SHIFT_W = 1664;
constexpr float RMS_EPS = 1e-6f, LN_EPS = 1e-5f, GN_EPS = 64e-5f;
constexpr int NTHR = 512;

constexpr size_t MiB = 1u << 20;
constexpr size_t WS_CTR = 768 * 1024;
constexpr size_t WS_LW = 23 * MiB + 512 * 1024;
constexpr size_t WS_SGW = 23 * MiB;
constexpr size_t WS_RS0 = 0, WS_RS1 = 128 * 1024, WS_RS2 = 256 * 1024, WS_VSUM = 384 * 1024, WS_VSQ = 512 * 1024, WS_BON = 1 * MiB;
constexpr size_t WS_BAR = 2 * MiB;
constexpr size_t WS_W1T = 4 * MiB, WS_W2T = 13 * MiB, WS_W3T = 15 * MiB, WS_W4T = 21 * MiB;
constexpr size_t WS_XN = 24 * MiB;
constexpr size_t WS_PA = 88 * MiB;
constexpr size_t WS_PB = 200 * MiB;
constexpr size_t WS_YMIX = 360 * MiB;
constexpr size_t WS_TAIL = 424 * MiB;
constexpr size_t WS_VRAW = 448 * MiB;
constexpr size_t WS_END = 480 * MiB;
constexpr int RSZ = 12544;
constexpr size_t WS_P1 = WS_PA;
constexpr int LDS_BYTES = 147456;

struct Args {
    const float* in[22];
    float* out; unsigned char* ws;
    int lo, hi;
    int rep[4];
};
enum { I_X = 0, I_NORMG, I_WINE, I_SHMU, I_W0, I_W2, I_A0, I_A2, I_KK, I_KA, I_RK, I_LNXG, I_LNXB, I_ABIAS, I_WOUTE, I_WINO, I_SGLNG, I_SGLNB, I_SGW, I_SGB, I_WOUTO, I_FG };

__device__ __forceinline__ float bf2f(unsigned short h) { return __uint_as_float((unsigned)h << 16); }
typedef __bf16 bf2_t __attribute__((ext_vector_type(2)));
__device__ __forceinline__ unsigned pk2(float lo, float hi) { const f32x2 v = {lo, hi}; const bf2_t b = __builtin_convertvector(v, bf2_t); return __builtin_bit_cast(unsigned, b); }
__device__ __forceinline__ unsigned short f2bf(float f) { return (unsigned short)(pk2(f, 0.f) & 0xffffu); }
__device__ __forceinline__ float bflo(unsigned w) { return __uint_as_float(w << 16); }
__device__ __forceinline__ float bfhi(unsigned w) { return __uint_as_float(w & 0xffff0000u); }
__device__ __forceinline__ float wave_sum(float v) {
#pragma unroll
    for (int o = 1; o < 64; o <<= 1) v += __shfl_xor(v, o);
    return v;
}
__device__ __forceinline__ float sigmoidf_(float x) { return __builtin_amdgcn_rcpf(1.0f + __expf(-x)); }
__device__ __forceinline__ float siluf_(float x) { return x * sigmoidf_(x); }
__device__ __forceinline__ float gelu_tanh(float x) { const float y = 0.7978845608028654f * (x + 0.044715f * x * x * x); return x * sigmoidf_(2.0f * y); }

__device__ __forceinline__ void phase_prologue(const Args& a, unsigned char* ldsb) {
    const int tid = threadIdx.x, lane = tid & 63, wave = tid >> 6;
    unsigned char* ws = a.ws;
    const int gtid = blockIdx.x * NTHR + tid, nthr = gridDim.x * NTHR;
    {
        LAS float* scr = (LAS float*)((LAS unsigned char*)ldsb + wave * 8448);
        constexpr int NB1 = N1 / 32, NB2 = 32, NB3 = N3 / 32, NB4 = 32, NITEM = (NB1 + NB2 + NB3 + NB4) * 16;
        for (int it = blockIdx.x * 8 + wave; it < NITEM; it += gridDim.x * 8) {
            int nb = it >> 4; const int k0 = (it & 15) * 64;
            const float* src; const float* g; int N, col0; bf16_t* dst; bool zero = false;
            if (nb < NB1) { const int n0 = nb * 32; src = a.in[I_WINE]; g = a.in[I_NORMG]; N = EVEN_IN; dst = (bf16_t*)(ws + WS_W1T) + (size_t)n0 * 1024;
                if (n0 < SHIFT_W) col0 = n0; else if (n0 < NA) { col0 = 0; zero = true; } else col0 = n0 - (NA - SHIFT_W); }
            else if ((nb -= NB1) < NB2) { src = a.in[I_WOUTE]; g = nullptr; N = 1024; col0 = nb * 32; dst = (bf16_t*)(ws + WS_W2T) + (size_t)col0 * 1024; }
            else if ((nb -= NB2) < NB3) { src = a.in[I_WINO]; g = a.in[I_NORMG] + 1024; N = N3; col0 = nb * 32; dst = (bf16_t*)(ws + WS_W3T) + (size_t)col0 * 1024; }
            else { nb -= NB3; src = a.in[I_WOUTO]; g = nullptr; N = 1024; col0 = nb * 32; dst = (bf16_t*)(ws + WS_W4T) + (size_t)col0 * 1024; }
#pragma unroll 8
            for (int i = 0; i < 32; ++i) { const int kk = 2 * i + (lane >> 5); float x = zero ? 0.f : src[(size_t)(k0 + kk) * N + col0 + (lane & 31)]; if (g) x *= g[k0 + kk]; scr[kk * 33 + (lane & 31)] = x; }
            asm volatile("s_waitcnt lgkmcnt(0)" ::: "memory");
            const int c8 = lane & 7;
#pragma unroll
            for (int j = 0; j < 4; ++j) { const int n = (lane >> 3) + 8 * j; const LAS float* sp = scr + (8 * c8) * 33 + n;
                u32x4 o; o.x = pk2(sp[0 * 33], sp[1 * 33]); o.y = pk2(sp[2 * 33], sp[3 * 33]); o.z = pk2(sp[4 * 33], sp[5 * 33]); o.w = pk2(sp[6 * 33], sp[7 * 33]);
                *(u32x4*)(dst + (size_t)n * 1024 + k0 + 8 * c8) = o; }
            asm volatile("s_waitcnt lgkmcnt(0)" ::: "memory");
        }
    }
    const float* x = a.in[I_X]; bf16_t* XN = (bf16_t*)(ws + WS_XN); float* rs0 = (float*)(ws + WS_RS0);
    const int gw = blockIdx.x * 8 + wave, NGW = gridDim.x * 8;
    for (int m = gw; m < M; m += NGW) {
        const f32x4* xr = (const f32x4*)(x + (size_t)m * DM) + lane; float s = 0.f; f32x4 v[4];
#pragma unroll
        for (int j = 0; j < 4; ++j) { v[j] = xr[64 * j]; s += (v[j].x * v[j].x + v[j].y * v[j].y) + (v[j].z * v[j].z + v[j].w * v[j].w); }
        s = wave_sum(s);
        u32x2* o = (u32x2*)(XN + (size_t)m * DM) + lane;
#pragma unroll
        for (int j = 0; j < 4; ++j) { u32x2 w; w.x = pk2(v[j].x, v[j].y); w.y = pk2(v[j].z, v[j].w); o[64 * j] = w; }
        if (lane == 0) rs0[m] = s;
    }
    float* rs1 = (float*)(ws + WS_RS1); float* rs2 = (float*)(ws + WS_RS2); float* vsum = (float*)(ws + WS_VSUM); float* vsq = (float*)(ws + WS_VSQ);
    for (int i = gtid; i < M; i += nthr) { rs1[i] = 0.f; rs2[i] = 0.f; vsum[i] = 0.f; vsq[i] = 0.f; }
    { bf16_t* LW = (bf16_t*)(ws + WS_LW); const float* w2 = a.in[I_W2]; const float* a2 = a.in[I_A2];
      for (int i = gtid; i < 2 * 512 * 64; i += nthr) { const int j = i & 63, cc = (i >> 6) & 511, mat = i >> 15; LW[i] = f2bf((mat ? a2 : w2)[j * 512 + cc]); } }
    { bf16_t* SGW = (bf16_t*)(ws + WS_SGW); const float* sgw = a.in[I_SGW];
      for (int i = gtid; i < 8 * 128 * 128; i += nthr) { const int jj = i & 127, ii = (i >> 7) & 127; SGW[i] = f2bf(((jj >> 6) <= (ii >> 6)) ? sgw[i] : 0.f); } }
}

struct EpiG1 {
    const float* rs0; bf16_t* PA; bf16_t* PB;
    static constexpr int NSTAT = 0;
    __device__ __forceinline__ void commit(int, float, float) const {}
    __device__ __forceinline__ f32x2 operator()(int row, int col, f32x4 v0, f32x4 v1) const {
        const float rinv = rsqrtf(rs0[row] * (1.0f / DM) + RMS_EPS);
        v0 = v0 * rinv; v1 = v1 * rinv;
        u32x4 w; w.x = pk2(v0[0], v0[1]); w.y = pk2(v0[2], v0[3]); w.z = pk2(v1[0], v1[1]); w.w = pk2(v1[2], v1[3]);
        bf16_t* dst = col < NA ? PA + (size_t)row * NA + col : PB + (size_t)row * NB + (col - NA);
        *(u32x4*)dst = w;
        return (f32x2){0.f, 0.f};
    }
};
struct EpiG2 {
    const float* x; float* out; bf16_t* HB; float* rs1;
    static constexpr int NSTAT = 1;
    __device__ __forceinline__ void commit(int row, float s0, float) const { unsafeAtomicAdd(rs1 + row, s0); }
    __device__ __forceinline__ f32x2 operator()(int row, int col, f32x4 v0, f32x4 v1) const {
        const size_t off = (size_t)row * DM + col;
        v0 = v0 + *(const f32x4*)(x + off); v1 = v1 + *(const f32x4*)(x + off + 4);
        *(f32x4*)(out + off) = v0; *(f32x4*)(out + off + 4) = v1;
        u32x4 w; w.x = pk2(v0[0], v0[1]); w.y = pk2(v0[2], v0[3]); w.z = pk2(v1[0], v1[1]); w.w = pk2(v1[2], v1[3]);
        *(u32x4*)(HB + off) = w;
        const float s = (v0[0] * v0[0] + v0[1] * v0[1]) + (v0[2] * v0[2] + v0[3] * v0[3]) + (v1[0] * v1[0] + v1[1] * v1[1]) + (v1[2] * v1[2] + v1[3] * v1[3]);
        return (f32x2){s, 0.f};
    }
};
struct EpiG3 {
    const float* rs1; bf16_t* P1; float* vsum; float* vsq;
    static constexpr int NSTAT = 2;
    __device__ __forceinline__ void commit(int row, float s0, float s1) const { if (s1 != 0.f) { unsafeAtomicAdd(vsum + row, s0); unsafeAtomicAdd(vsq + row, s1); } }
    __device__ __forceinline__ f32x2 operator()(int row, int col, f32x4 v0, f32x4 v1) const {
        f32x2 ret = (f32x2){0.f, 0.f};
        const float rinv = rsqrtf(rs1[row] * (1.0f / DM) + RMS_EPS);
        float v[8];
#pragma unroll
        for (int j = 0; j < 4; ++j) { v[j] = v0[j] * rinv; v[4 + j] = v1[j] * rinv; }
        if (col < 2048) {
#pragma unroll
            for (int j = 0; j < 8; ++j) v[j] = gelu_tanh(v[j]);
            if (col >= 1024) {
                float s = 0.f, q = 0.f;
#pragma unroll
                for (int j = 0; j < 8; ++j) { s += v[j]; q += v[j] * v[j]; }
                ret = (f32x2){s, q};
            }
        } else {
#pragma unroll
            for (int j = 0; j < 8; ++j) v[j] = siluf_(v[j]);
        }
        u32x4 w; w.x = pk2(v[0], v[1]); w.y = pk2(v[2], v[3]); w.z = pk2(v[4], v[5]); w.w = pk2(v[6], v[7]);
        *(u32x4*)(P1 + (size_t)row * N3 + col) = w;
        return ret;
    }
};
struct EpiG4 {
    float* out; float* rs2;
    static constexpr int NSTAT = 1;
    __device__ __forceinline__ void commit(int row, float s0, float) const { unsafeAtomicAdd(rs2 + row, s0); }
    __device__ __forceinline__ f32x2 operator()(int row, int col, f32x4 v0, f32x4 v1) const {
        const size_t off = (size_t)row * DM + col;
        v0 = v0 + *(const f32x4*)(out + off); v1 = v1 + *(const f32x4*)(out + off + 4);
        *(f32x4*)(out + off) = v0; *(f32x4*)(out + off + 4) = v1;
        const float s = (v0[0] * v0[0] + v0[1] * v0[1]) + (v0[2] * v0[2] + v0[3] * v0[3]) + (v1[0] * v1[0] + v1[1] * v1[1]) + (v1[2] * v1[2] + v1[3] * v1[3]);
        return (f32x2){s, 0.f};
    }
};

template <class F> struct EpiAdapt {
    static constexpr bool PERM = true, AFTER_DRAIN = false;
    F f;
    __device__ __forceinline__ void operator()(const pg8::f32x4 (&acc)[2][2][4][2], const pg8::Unit& u, int wr, int wc, int fr, int fq) const {
#pragma unroll
        for (int ai = 0; ai < 2; ++ai)
#pragma unroll
            for (int m = 0; m < 4; ++m) {
                const int row = u.pm * 256 + ai * 128 + wr * 64 + m * 16 + fr;
                f32x2 st = (f32x2){0.f, 0.f};
#pragma unroll
                for (int bj = 0; bj < 2; ++bj) { const int col = u.pn * 256 + bj * 128 + wc * 32 + 8 * fq; const f32x2 r = f(row, col, acc[ai][bj][m][0], acc[ai][bj][m][1]); st = st + r; }
                if (F::NSTAT >= 1) { st.x += __shfl_xor(st.x, 16); st.x += __shfl_xor(st.x, 32); }
                if (F::NSTAT >= 2) { st.y += __shfl_xor(st.y, 16); st.y += __shfl_xor(st.y, 32); }
                if (F::NSTAT >= 1 && fq == 0) f.commit(row, st.x, st.y);
            }
    }
};

template <class F> __device__ __forceinline__ void gemm_naive(float* lds, const bf16_t* A, const bf16_t* Bt, int Mm, int N, int K, const F& f) {
    const int tid = threadIdx.x, ty = tid >> 4, tx = tid & 15;
    float* As = lds; float* Bs = lds + 32 * 132;
    const int ntn = N / 128, ntiles = (Mm / 128) * ntn;
    for (int tile = blockIdx.x; tile < ntiles; tile += gridDim.x) {
        const int tm = tile / ntn, tn = tile % ntn;
        float acc[4][8];
#pragma unroll
        for (int i = 0; i < 4; ++i)
#pragma unroll
            for (int j = 0; j < 8; ++j) acc[i][j] = 0.f;
        for (int k0 = 0; k0 < K; k0 += 32) {
            { const int row = tid >> 2, kc = (tid & 3) * 8;
              const u32x4 va = *(const u32x4*)(A + (size_t)(tm * 128 + row) * K + k0 + kc);
              const u32x4 vb = *(const u32x4*)(Bt + (size_t)(tn * 128 + row) * K + k0 + kc);
              As[(kc + 0) * 132 + row] = bflo(va.x); As[(kc + 1) * 132 + row] = bfhi(va.x); As[(kc + 2) * 132 + row] = bflo(va.y); As[(kc + 3) * 132 + row] = bfhi(va.y);
              As[(kc + 4) * 132 + row] = bflo(va.z); As[(kc + 5) * 132 + row] = bfhi(va.z); As[(kc + 6) * 132 + row] = bflo(va.w); As[(kc + 7) * 132 + row] = bfhi(va.w);
              Bs[(kc + 0) * 132 + row] = bflo(vb.x); Bs[(kc + 1) * 132 + row] = bfhi(vb.x); Bs[(kc + 2) * 132 + row] = bflo(vb.y); Bs[(kc + 3) * 132 + row] = bfhi(vb.y);
              Bs[(kc + 4) * 132 + row] = bflo(vb.z); Bs[(kc + 5) * 132 + row] = bfhi(vb.z); Bs[(kc + 6) * 132 + row] = bflo(vb.w); Bs[(kc + 7) * 132 + row] = bfhi(vb.w); }
            __syncthreads();
#pragma unroll 8
            for (int kk = 0; kk < 32; ++kk) {
                const f32x4 a4 = *(const f32x4*)(As + kk * 132 + ty * 4);
                const f32x4 b0 = *(const f32x4*)(Bs + kk * 132 + tx * 8), b1 = *(const f32x4*)(Bs + kk * 132 + tx * 8 + 4);
#pragma unroll
                for (int i = 0; i < 4; ++i) {
#pragma unroll
                    for (int j = 0; j < 4; ++j) { acc[i][j] += a4[i] * b0[j]; acc[i][4 + j] += a4[i] * b1[j]; }
                }
            }
            __syncthreads();
        }
#pragma unroll
        for (int i = 0; i < 4; ++i) { const f32x2 r = f(tm * 128 + ty * 4 + i, tn * 128 + tx * 8, (f32x4){acc[i][0], acc[i][1], acc[i][2], acc[i][3]}, (f32x4){acc[i][4], acc[i][5], acc[i][6], acc[i][7]}); if (F::NSTAT >= 1) f.commit(tm * 128 + ty * 4 + i, r.x, r.y); }
    }
}

template <class F> __device__ __forceinline__ void gemm_any(unsigned char* lds, const bf16_t* A, const bf16_t* Bt, int Mm, int N, int K, const F& f) {
#if USE_PG8
    pg8::Gemm g{A, Bt, Mm, N, K}; pg8::StaticOrder S; S.init(Mm, N, (int)gridDim.x, (int)blockIdx.x);
    EpiAdapt<F> E{f};
    pg8::gemm_phase<EpiAdapt<F>, pg8::StaticOrder, true, true>((PG8_LAS unsigned char*)lds, g, S, E);
#else
    gemm_naive((float*)lds, A, Bt, Mm, N, K, f);
#endif
}

typedef short pbf16x8 __attribute__((ext_vector_type(8)));
template <int CTRL> __device__ __forceinline__ float pdpp_add(float x) { return x + __uint_as_float(__builtin_amdgcn_update_dpp(0, __float_as_uint(x), CTRL, 0xf, 0xf, true)); }
__device__ __forceinline__ float wave_sum_dpp(float x) {
    x = pdpp_add<0x128>(x); x = pdpp_add<0x124>(x); x = pdpp_add<0x122>(x); x = pdpp_add<0x121>(x);
    const unsigned u = __float_as_uint(x);
    return (__uint_as_float(__builtin_amdgcn_readlane(u, 0)) + __uint_as_float(__builtin_amdgcn_readlane(u, 16))) + (__uint_as_float(__builtin_amdgcn_readlane(u, 32)) + __uint_as_float(__builtin_amdgcn_readlane(u, 48)));
}
__device__ __forceinline__ void lds_barrier() { asm volatile("s_waitcnt lgkmcnt(0)" ::: "memory"); __builtin_amdgcn_s_barrier(); asm volatile("" ::: "memory"); }
__device__ __forceinline__ unsigned char* rec_base(const Args& a, int u) {
    if (u < 80) return (unsigned char*)a.out + (size_t)u * 128 * RSZ;
    if (u < 118) return a.ws + WS_XN + (size_t)(u - 80) * 128 * RSZ;
    return a.ws + WS_TAIL + (size_t)(u - 118) * 128 * RSZ;
}
__device__ __forceinline__ void phase_prep(const Args& a, unsigned char* ldsb, int variant = 0) {
    const int tid = threadIdx.x, lane = tid & 63, wave = tid >> 6, fr = lane & 15, quad = lane >> 4;
    unsigned char* ws = a.ws;
    const bf16_t* PA = (const bf16_t*)(ws + WS_PA);
    bf16_t* VR = (bf16_t*)(ws + WS_VRAW); float* BON = (float*)(ws + WS_BON);
    const float* mu = a.in[I_SHMU];
    LAS unsigned char* lds = (LAS unsigned char*)ldsb;
    constexpr int HAT_OFF = 69888;
    constexpr int XPB = 272;
    constexpr int RES_OFF = 4352;
    if (blockIdx.x == 0 && tid == 0) *(unsigned*)(ws + WS_CTR) = 0u;
    const int c = tid;
    const float w0 = a.in[I_W0][c], a0 = a.in[I_A0][c], kkc = a.in[I_KK][c], kac = a.in[I_KA][c], rkc = a.in[I_RK][c];
    const float mur = mu[c], muk = mu[512 + c], muv = mu[1024 + c];
    const bf16_t* LW = (const bf16_t*)(ws + WS_LW);
    pbf16x8 wf[2][4][2];
#pragma unroll
    for (int mat = 0; mat < 2; ++mat)
#pragma unroll
        for (int mt = 0; mt < 4; ++mt)
#pragma unroll
            for (int ks = 0; ks < 2; ++ks) wf[mat][mt][ks] = *(const pbf16x8*)(LW + (size_t)(mat * 512 + wave * 64 + mt * 16 + fr) * 64 + ks * 32 + 8 * quad);
    const int stok = tid >> 5, sj4 = (tid & 31) * 4;
    const f32x4 smu = *(const f32x4*)(mu + 1536 + sj4);
    u32x2 spw, sqw;
#define PREP_SLOAD(uu) do { const int t_ = (uu) * 16 + stok; spw = *(const u32x2*)(PA + (size_t)t_ * NA + 1536 + sj4); sqw = spw; if ((t_ % SEQ) != 0) sqw = *(const u32x2*)(PA + (size_t)(t_ - 1) * NA + 1536 + sj4); } while (0)
    if ((int)blockIdx.x < M / 16) PREP_SLOAD(blockIdx.x);
    for (int u = blockIdx.x; u < M / 16; u += gridDim.x) {
        const int t0 = u * 16;
        unsigned short gr[17], gk[17], gv[17];
        { const bool first0 = (t0 % SEQ) == 0;
          gr[0] = 0; gk[0] = 0; gv[0] = 0;
          if (!first0) { const bf16_t* q = PA + (size_t)(t0 - 1) * NA; gr[0] = q[c]; gk[0] = q[512 + c]; gv[0] = q[1024 + c]; }
#pragma unroll
          for (int i = 0; i < 16; ++i) { const bf16_t* p = PA + (size_t)(t0 + i) * NA; gr[i + 1] = p[c]; gk[i + 1] = p[512 + c]; gv[i + 1] = p[1024 + c]; } }
        {   const int t = t0 + stok; const bool first = (t % SEQ) == 0;
            const u32x2 pw = spw, qw = sqw;
            float x0 = bflo(pw.x), x1 = bfhi(pw.x), x2 = bflo(pw.y), x3 = bfhi(pw.y);
            const float y0 = first ? 0.f : bflo(qw.x), y1 = first ? 0.f : bfhi(qw.x), y2 = first ? 0.f : bflo(qw.y), y3 = first ? 0.f : bfhi(qw.y);
            x0 += (y0 - x0) * smu.x; x1 += (y1 - x1) * smu.y; x2 += (y2 - x2) * smu.z; x3 += (y3 - x3) * smu.w;
            if (sj4 < 64) { x0 = 1.0f - 2.0f / (__expf(2.0f * x0) + 1.0f); x1 = 1.0f - 2.0f / (__expf(2.0f * x1) + 1.0f); x2 = 1.0f - 2.0f / (__expf(2.0f * x2) + 1.0f); x3 = 1.0f - 2.0f / (__expf(2.0f * x3) + 1.0f); }
            u32x2 o; o.x = pk2(x0, x1); o.y = pk2(x2, x3);
            *(LAS u32x2*)(lds + stok * XPB + sj4 * 2) = o; }
        if (u + (int)gridDim.x < M / 16) PREP_SLOAD(u + gridDim.x);
        lds_barrier();
#pragma unroll
        for (int mat = 0; mat < 2; ++mat)
#pragma unroll
            for (int mt = 0; mt < 4; ++mt) {
                f32x4 acc = (f32x4){0.f, 0.f, 0.f, 0.f};
#pragma unroll
                for (int ks = 0; ks < 2; ++ks) { const pbf16x8 xf = *(const LAS pbf16x8*)(lds + fr * XPB + (mat * 64 + ks * 32 + 8 * quad) * 2); acc = __builtin_amdgcn_mfma_f32_16x16x32_bf16(wf[mat][mt][ks], xf, acc, 0, 0, 0); }
                *(LAS f32x4*)(lds + RES_OFF + ((mat * 16 + fr) * 512 + wave * 64 + mt * 16 + 4 * quad) * 4) = acc;
            }
        lds_barrier();
        float rp = bf2f(gr[0]), kp_ = bf2f(gk[0]), vp = bf2f(gv[0]);
        unsigned char* rec = rec_base(a, (t0 / SEQ) * 8 + wave) + (size_t)((t0 % SEQ) / 16) * RSZ;
        LAS unsigned char* hb = lds + HAT_OFF + wave * 9216;
        float Pprev = 1.0f;
        if (variant != 2)
#pragma unroll
        for (int i = 0; i < 16; ++i) {
            const int t = t0 + i;
            const float rc = bf2f(gr[i + 1]), kc = bf2f(gk[i + 1]), vc = bf2f(gv[i + 1]);
            const float r = rc + (rp - rc) * mur, k = kc + (kp_ - kc) * muk, v = vc + (vp - vc) * muv;
            rp = rc; kp_ = kc; vp = vc;
            const float z = *(const LAS float*)(lds + RES_OFF + (i * 512 + c) * 4) + w0;
            const float za = *(const LAS float*)(lds + RES_OFF + ((16 + i) * 512 + c) * 4) + a0;
            const float sp = fmaxf(-z, 0.f) + __logf(1.0f + __expf(-fabsf(z)));
            const float w = -sp - 0.5f;
            const float dec = __expf(-__expf(w));
            const float av = __builtin_amdgcn_rcpf(1.0f + __expf(-za));
            float kk = k * kkc; const float ss = wave_sum_dpp(kk * kk); kk = kk * __builtin_amdgcn_rcpf(fmaxf(__builtin_amdgcn_sqrtf(ss), 1e-12f));
            const float kn = k * (1.0f + (av - 1.0f) * kac);
            const float bon = wave_sum_dpp(r * kn * rkc);
            const float P = Pprev * dec, iP = __builtin_amdgcn_rcpf(P);
            LAS unsigned short* hat = (LAS unsigned short*)hb + i * 72 + lane;
            hat[0] = f2bf(-kk * Pprev); hat[1152] = f2bf(r * P); hat[2304] = f2bf(kk * av * iP); hat[3456] = f2bf(kn * iP);
            Pprev = P;
            const unsigned short vb16 = f2bf(v);
            VR[(size_t)t * 512 + c] = vb16;
            *(unsigned short*)(rec + 8192 + (lane >> 4) * 512 + ((i >> 2) * 16 + (lane & 15)) * 8 + (i & 3) * 2) = vb16;
            if (lane == 0) BON[t * 8 + wave] = bon;
        }
        *(float*)(rec + 12288 + lane * 4) = Pprev;
        asm volatile("s_waitcnt lgkmcnt(0)" ::: "memory");
        if (variant != 1) {
            pbf16x8 fa[2], fr2[2], fb[2], fk[2];
#pragma unroll
            for (int ks = 0; ks < 2; ++ks) { const int off = fr * 144 + (ks * 32 + 8 * quad) * 2;
                fa[ks] = *(const LAS pbf16x8*)(hb + off); fr2[ks] = *(const LAS pbf16x8*)(hb + 2304 + off); fb[ks] = *(const LAS pbf16x8*)(hb + 4608 + off); fk[ks] = *(const LAS pbf16x8*)(hb + 6912 + off); }
            f32x4 cba = (f32x4){0.f, 0.f, 0.f, 0.f}, cka = cba, cbr = cba, ckr = cba;
#pragma unroll
            for (int ks = 0; ks < 2; ++ks) { cba = __builtin_amdgcn_mfma_f32_16x16x32_bf16(fb[ks], fa[ks], cba, 0, 0, 0); cka = __builtin_amdgcn_mfma_f32_16x16x32_bf16(fk[ks], fa[ks], cka, 0, 0, 0);
                                             cbr = __builtin_amdgcn_mfma_f32_16x16x32_bf16(fb[ks], fr2[ks], cbr, 0, 0, 0); ckr = __builtin_amdgcn_mfma_f32_16x16x32_bf16(fk[ks], fr2[ks], ckr, 0, 0, 0); }
            float nn[4];
            {   float x0[4], x1[4], x2[4];
#pragma unroll
                for (int e = 0; e < 4; ++e) { const int j = 4 * quad + e; x0[e] = (j < fr) ? cka[e] : 0.f; x1[e] = (j <= fr) ? ckr[e] : 0.f; x2[e] = (j <= fr) ? cbr[e] : 0.f; nn[e] = (j < fr) ? cba[e] : 0.f; }
                u32x2 w; w.x = pk2(x0[0], x0[1]); w.y = pk2(x0[2], x0[3]); *(u32x2*)(rec + 10240 + lane * 8) = w;
                w.x = pk2(x1[0], x1[1]); w.y = pk2(x1[2], x1[3]); *(u32x2*)(rec + 10752 + lane * 8) = w;
                w.x = pk2(x2[0], x2[1]); w.y = pk2(x2[2], x2[3]); *(u32x2*)(rec + 11776 + lane * 8) = w; }
#pragma unroll
            for (int ks = 0; ks < 2; ++ks) {
                const u32x2 alo = *(const LAS u32x2*)(hb + fr * 144 + (32 * ks + 4 * quad) * 2), ahi = *(const LAS u32x2*)(hb + fr * 144 + (32 * ks + 16 + 4 * quad) * 2);
                const u32x2 rlo = *(const LAS u32x2*)(hb + 2304 + fr * 144 + (32 * ks + 4 * quad) * 2), rhi = *(const LAS u32x2*)(hb + 2304 + fr * 144 + (32 * ks + 16 + 4 * quad) * 2);
                *(u32x4*)(rec + ks * 1024 + lane * 16) = (u32x4){alo.x, alo.y, ahi.x, ahi.y};
                *(u32x4*)(rec + 2048 + ks * 1024 + lane * 16) = (u32x4){rlo.x, rlo.y, rhi.x, rhi.y};
            }
#pragma unroll
            for (int mt = 0; mt < 4; ++mt) {
                const LAS unsigned short* hB = (const LAS unsigned short*)(hb + 4608) + (4 * quad) * 72 + 16 * mt + fr;
                const LAS unsigned short* hK = (const LAS unsigned short*)(hb + 6912) + (4 * quad) * 72 + 16 * mt + fr;
                u32x4 o; o.x = (unsigned)hB[0] | ((unsigned)hB[72] << 16); o.y = (unsigned)hB[144] | ((unsigned)hB[216] << 16); o.z = (unsigned)hK[0] | ((unsigned)hK[72] << 16); o.w = (unsigned)hK[144] | ((unsigned)hK[216] << 16);
                *(u32x4*)(rec + 4096 + mt * 1024 + lane * 16) = o;
            }
            asm volatile("s_waitcnt lgkmcnt(0)" ::: "memory");
            LAS float* NL = (LAS float*)hb;
#pragma unroll
            for (int e = 0; e < 4; ++e) NL[(4 * quad + e) * 16 + fr] = nn[e];
            asm volatile("s_waitcnt lgkmcnt(0)" ::: "memory");
            float X[16];
#pragma unroll
            for (int l = 0; l < 16; ++l) X[l] = (l == fr) ? 1.0f : 0.f;
#pragma unroll
            for (int j = 14; j >= 0; --j) {
                const f32x4 n0 = ((const LAS f32x4*)NL)[j * 4], n1 = ((const LAS f32x4*)NL)[j * 4 + 1], n2 = ((const LAS f32x4*)NL)[j * 4 + 2], n3 = ((const LAS f32x4*)NL)[j * 4 + 3];
                const float nr[16] = {n0.x, n0.y, n0.z, n0.w, n1.x, n1.y, n1.z, n1.w, n2.x, n2.y, n2.z, n2.w, n3.x, n3.y, n3.z, n3.w};
                float acc = X[j];
#pragma unroll
                for (int l = j + 1; l < 16; ++l) acc = __builtin_fmaf(nr[l], X[l], acc);
                X[j] = acc;
            }
            float mv[4];
#pragma unroll
            for (int e = 0; e < 4; ++e) mv[e] = quad == 0 ? X[e] : (quad == 1 ? X[4 + e] : (quad == 2 ? X[8 + e] : X[12 + e]));
            u32x2 w; w.x = pk2(mv[0], mv[1]); w.y = pk2(mv[2], mv[3]); *(u32x2*)(rec + 11264 + lane * 8) = w;
            asm volatile("s_waitcnt lgkmcnt(0)" ::: "memory");
        }
    }
}

__device__ __forceinline__ float rdlane(float x, int k) { return __uint_as_float(__builtin_amdgcn_readlane(__float_as_uint(x), k)); }
__device__ __forceinline__ void phase_scan_naive(const Args& a) {
    const int tid = threadIdx.x, lane = tid & 63, wave = tid >> 6;
    if (wave != 0) return;
    unsigned char* ws = a.ws;
    const bf16_t* R = (const bf16_t*)a.out; const bf16_t* KP = R + (size_t)M * 512; const bf16_t* V = KP + (size_t)M * 512; const bf16_t* AN = V + (size_t)M * 512;
    bf16_t* YM = (bf16_t*)(ws + WS_YMIX); const float* DEC = (const float*)(ws + WS_XN); const float* BON = (const float*)(ws + WS_BON);
    const bf16_t* PB = (const bf16_t*)(ws + WS_PB);
    for (int u = blockIdx.x; u < BATCH * 8; u += gridDim.x) {
        const int b = u >> 3, h = u & 7;
        const float lg = a.in[I_LNXG][h * 64 + lane], lb = a.in[I_LNXB][h * 64 + lane];
        float s[64];
#pragma unroll
        for (int k = 0; k < 64; ++k) s[k] = 0.f;
        for (int t = 0; t < SEQ; ++t) {
            const int tok = b * SEQ + t; const size_t o = (size_t)tok * 512 + h * 64 + lane;
            const float ca = bf2f(AN[o]), cw = DEC[o], cb = bf2f(YM[(size_t)tok * 1024 + h * 64 + lane]), ck = bf2f(KP[o]), cr = bf2f(R[o]), vv = bf2f(V[o]);
            float sa = 0.f;
#pragma unroll
            for (int k = 0; k < 64; ++k) sa += s[k] * rdlane(ca, k);
            float y = 0.f;
#pragma unroll
            for (int k = 0; k < 64; ++k) { s[k] = s[k] * rdlane(cw, k) + sa * rdlane(cb, k) + vv * rdlane(ck, k); y += s[k] * rdlane(cr, k); }
            const float mean = wave_sum(y) * (1.0f / 64.0f); const float d = y - mean; const float var = wave_sum(d * d) * (1.0f / 64.0f);
            float yn = d * rsqrtf(var + GN_EPS) * lg + lb;
            yn += BON[tok * 8 + h] * vv;
            const float g = bf2f(PB[(size_t)tok * NB + h * 64 + lane]);
            YM[(size_t)tok * 1024 + h * 64 + lane] = f2bf(yn * siluf_(g));
        }
    }
}

__device__ __forceinline__ void phase_attn_naive(const Args& a) {
    const int tid = threadIdx.x, lane = tid & 63, wave = tid >> 6;
    unsigned char* ws = a.ws;
    const bf16_t* PB = (const bf16_t*)(ws + WS_PB); bf16_t* YM = (bf16_t*)(ws + WS_YMIX);
    for (int u = blockIdx.x * 8 + wave; u < BATCH * 8 * 32; u += gridDim.x * 8) {
        const int c = u & 31, h = (u >> 5) & 7, b = u >> 8;
        const int t = b * SEQ + c * 64 + lane;
        float q[64], acc[64];
        { const u32x4* qp = (const u32x4*)(PB + (size_t)t * NB + 512 + h * 64);
#pragma unroll
          for (int i = 0; i < 8; ++i) { const u32x4 w = qp[i]; q[8 * i] = bflo(w.x) * 0.125f; q[8 * i + 1] = bfhi(w.x) * 0.125f; q[8 * i + 2] = bflo(w.y) * 0.125f; q[8 * i + 3] = bfhi(w.y) * 0.125f;
              q[8 * i + 4] = bflo(w.z) * 0.125f; q[8 * i + 5] = bfhi(w.z) * 0.125f; q[8 * i + 6] = bflo(w.w) * 0.125f; q[8 * i + 7] = bfhi(w.w) * 0.125f; } }
#pragma unroll
        for (int d = 0; d < 64; ++d) acc[d] = 0.f;
        float m = -1e30f, l = 0.f;
        const float* bt = a.in[I_ABIAS] + h * 257;
        const int k0 = (c - 8 > 0 ? c - 8 : 0) * 64, k1 = (c + 1) * 64;
        for (int kj = k0; kj < k1; ++kj) {
            const bf16_t* kr = PB + (size_t)(b * SEQ + kj) * NB + 1024 + h * 64;
            float s = 0.f;
#pragma unroll
            for (int i = 0; i < 8; ++i) { const u32x4 w = ((const u32x4*)kr)[i];
                s += q[8 * i] * bflo(w.x) + q[8 * i + 1] * bfhi(w.x) + q[8 * i + 2] * bflo(w.y) + q[8 * i + 3] * bfhi(w.y) + q[8 * i + 4] * bflo(w.z) + q[8 * i + 5] * bfhi(w.z) + q[8 * i + 6] * bflo(w.w) + q[8 * i + 7] * bfhi(w.w); }
            int rel = c * 64 + lane - kj; rel = rel < -128 ? -128 : (rel > 128 ? 128 : rel);
            s += bt[rel + 128];
            const float mn = fmaxf(m, s), al = __expf(m - mn), p = __expf(s - mn);
            l = l * al + p; m = mn;
            const bf16_t* vr = kr + 512;
#pragma unroll
            for (int i = 0; i < 8; ++i) { const u32x4 w = ((const u32x4*)vr)[i];
                acc[8 * i] = acc[8 * i] * al + p * bflo(w.x); acc[8 * i + 1] = acc[8 * i + 1] * al + p * bfhi(w.x); acc[8 * i + 2] = acc[8 * i + 2] * al + p * bflo(w.y); acc[8 * i + 3] = acc[8 * i + 3] * al + p * bfhi(w.y);
                acc[8 * i + 4] = acc[8 * i + 4] * al + p * bflo(w.z); acc[8 * i + 5] = acc[8 * i + 5] * al + p * bfhi(w.z); acc[8 * i + 6] = acc[8 * i + 6] * al + p * bflo(w.w); acc[8 * i + 7] = acc[8 * i + 7] * al + p * bfhi(w.w); }
        }
        const float il = 1.0f / l;
        const u32x4* gp = (const u32x4*)(PB + (size_t)t * NB + 2048 + h * 64);
        u32x4* op = (u32x4*)(YM + (size_t)t * 1024 + 512 + h * 64);
#pragma unroll
        for (int i = 0; i < 8; ++i) { const u32x4 g = gp[i]; u32x4 o;
            o.x = pk2(acc[8 * i] * il * siluf_(bflo(g.x)), acc[8 * i + 1] * il * siluf_(bfhi(g.x))); o.y = pk2(acc[8 * i + 2] * il * siluf_(bflo(g.y)), acc[8 * i + 3] * il * siluf_(bfhi(g.y)));
            o.z = pk2(acc[8 * i + 4] * il * siluf_(bflo(g.z)), acc[8 * i + 5] * il * siluf_(bfhi(g.z))); o.w = pk2(acc[8 * i + 6] * il * siluf_(bflo(g.w)), acc[8 * i + 7] * il * siluf_(bfhi(g.w)));
            op[i] = o; }
    }
}


typedef _Float16 h8 __attribute__((ext_vector_type(8)));
typedef _Float16 h4 __attribute__((ext_vector_type(4)));
typedef short bf16x8 __attribute__((ext_vector_type(8)));
template <int CTRL> __device__ __forceinline__ float dpp_add(float x) { return x + __uint_as_float(__builtin_amdgcn_update_dpp(0, __float_as_uint(x), CTRL, 0xf, 0xf, true)); }
__device__ __forceinline__ float red8(float x) { x = dpp_add<0xB1>(x); x = dpp_add<0x4E>(x); x = dpp_add<0x141>(x); return x; }
__device__ __forceinline__ float red16(float x) { x = dpp_add<0x128>(x); x = dpp_add<0x124>(x); x = dpp_add<0x122>(x); x = dpp_add<0x121>(x); return x; }
constexpr int SC_PH = 0, SC_VV = 40960, SC_SC = 57344, SC_YY = 57856;
constexpr int TC = 32;

__device__ __forceinline__ void scan_unit(const Args& a, LAS unsigned char* lds, int u) {
    const int tid = threadIdx.x, lane = tid & 63, wave = tid >> 6;
    const int b = u >> 3, h = u & 7;
    unsigned char* ws = a.ws;
    const bf16_t* R = (const bf16_t*)a.out; const bf16_t* KP = R + (size_t)M * 512; const bf16_t* V = KP + (size_t)M * 512; const bf16_t* AN = V + (size_t)M * 512;
    bf16_t* YM = (bf16_t*)(ws + WS_YMIX); const float* DEC = (const float*)(ws + WS_XN); const float* BON = (const float*)(ws + WS_BON);
    const bf16_t* PB = (const bf16_t*)(ws + WS_PB);
    const int st = tid >> 4, sq = tid & 15;
    const int row = wave * 8 + (lane >> 3), cg = lane & 7;
    const int colbase = h * 64 + 4 * sq;
    const f32x4 lg = *(const f32x4*)(a.in[I_LNXG] + colbase), lb = *(const f32x4*)(a.in[I_LNXB] + colbase);
    float s[8];
#pragma unroll
    for (int j = 0; j < 8; ++j) s[j] = 0.f;
    u32x2 gR, gK, gV, gA, gB; f32x4 gD;
#define SC_GLOAD(c) do { const size_t tok_ = (size_t)b * SEQ + (c) * TC + st; const size_t o_ = tok_ * 512 + colbase; \
        gR = *(const u32x2*)(R + o_); gK = *(const u32x2*)(KP + o_); gV = *(const u32x2*)(V + o_); gA = *(const u32x2*)(AN + o_); \
        gB = *(const u32x2*)(YM + tok_ * 1024 + colbase); gD = *(const f32x4*)(DEC + o_); } while (0)
#define SC_STAGE(buf) do { \
        const float r0 = bflo(gR.x), r1 = bfhi(gR.x), r2 = bflo(gR.y), r3 = bfhi(gR.y); \
        const float k0 = bflo(gK.x), k1 = bfhi(gK.x), k2 = bflo(gK.y), k3 = bfhi(gK.y); \
        const float b0 = bflo(gB.x), b1 = bfhi(gB.x), b2 = bflo(gB.y), b3 = bfhi(gB.y); \
        LAS h4* ph4 = (LAS h4*)(lds + SC_PH) + (size_t)(((buf) * TC + st) * 5) * 16 + sq; \
        ph4[0]  = (h4){(_Float16)bflo(gA.x), (_Float16)bfhi(gA.x), (_Float16)bflo(gA.y), (_Float16)bfhi(gA.y)}; \
        ph4[16] = (h4){(_Float16)(1.0f - gD.x), (_Float16)(1.0f - gD.y), (_Float16)(1.0f - gD.z), (_Float16)(1.0f - gD.w)}; \
        ph4[32] = (h4){(_Float16)b0, (_Float16)b1, (_Float16)b2, (_Float16)b3}; \
        ph4[48] = (h4){(_Float16)k0, (_Float16)k1, (_Float16)k2, (_Float16)k3}; \
        ph4[64] = (h4){(_Float16)(gD.x * r0), (_Float16)(gD.y * r1), (_Float16)(gD.z * r2), (_Float16)(gD.w * r3)}; \
        *((LAS f32x4*)(lds + SC_VV) + ((buf) * TC + st) * 16 + sq) = (f32x4){bflo(gV.x), bfhi(gV.x), bflo(gV.y), bfhi(gV.y)}; \
        float br_ = (b0 * r0 + b1 * r1) + (b2 * r2 + b3 * r3), kr_ = (k0 * r0 + k1 * r1) + (k2 * r2 + k3 * r3); \
        br_ = red16(br_); kr_ = red16(kr_); \
        if (sq == 0) *((LAS f32x2*)(lds + SC_SC) + (buf) * TC + st) = (f32x2){br_, kr_}; } while (0)
    SC_GLOAD(0); SC_STAGE(0);
    __syncthreads();
    for (int c = 0; c < SEQ / TC; ++c) {
        const int buf = c & 1;
        if (c + 1 < SEQ / TC) SC_GLOAD(c + 1);
        const size_t tokE = (size_t)b * SEQ + c * TC + st;
        const u32x2 gG = *(const u32x2*)(PB + tokE * NB + colbase);
        const float bon = BON[tokE * 8 + h];
        {
            const LAS h8* ph8 = (const LAS h8*)(lds + SC_PH) + buf * TC * 40 + cg;
            const LAS float* vvp = (const LAS float*)(lds + SC_VV) + buf * TC * 64 + row;
            const LAS f32x2* scp = (const LAS f32x2*)(lds + SC_SC) + buf * TC;
            LAS float* yyp = (LAS float*)(lds + SC_YY) + row;
            h8 cA = ph8[0], cE = ph8[8], cB = ph8[16], cK = ph8[24], cW = ph8[32]; float cv = vvp[0]; f32x2 cs = scp[0];
#pragma unroll 2
            for (int t = 0; t < TC; ++t) {
                const int tn = (t + 1 < TC) ? t + 1 : t;
                const h8 nA = ph8[tn * 40], nE = ph8[tn * 40 + 8], nB = ph8[tn * 40 + 16], nK = ph8[tn * 40 + 24], nW = ph8[tn * 40 + 32]; const float nv = vvp[tn * 64]; const f32x2 ns = scp[tn];
                float sa0 = 0.f, sa1 = 0.f, yw0 = 0.f, yw1 = 0.f;
#pragma unroll
                for (int j = 0; j < 4; ++j) { sa0 = __builtin_fmaf(s[j], (float)cA[j], sa0); sa1 = __builtin_fmaf(s[4 + j], (float)cA[4 + j], sa1);
                                              yw0 = __builtin_fmaf(s[j], (float)cW[j], yw0); yw1 = __builtin_fmaf(s[4 + j], (float)cW[4 + j], yw1); }
                float sa = red8(sa0 + sa1), yw = red8(yw0 + yw1);
#pragma unroll
                for (int j = 0; j < 8; ++j) { float uu = __builtin_fmaf(sa, (float)cB[j], s[j]); uu = __builtin_fmaf(cv, (float)cK[j], uu); s[j] = __builtin_fmaf(-(float)cE[j], s[j], uu); }
                const float y = yw + sa * cs.x + cv * cs.y;
                yyp[t * 64] = y;
                cA = nA; cE = nE; cB = nB; cK = nK; cW = nW; cv = nv; cs = ns;
            }
        }
        __syncthreads();
        {
            const f32x4 y4 = *((const LAS f32x4*)(lds + SC_YY) + st * 16 + sq);
            const f32x4 v4 = *((const LAS f32x4*)(lds + SC_VV) + (buf * TC + st) * 16 + sq);
            const float mean = red16((y4.x + y4.y) + (y4.z + y4.w)) * (1.0f / 64.0f);
            const f32x4 d = y4 - mean;
            const float var = red16((d.x * d.x + d.y * d.y) + (d.z * d.z + d.w * d.w)) * (1.0f / 64.0f);
            const float rstd = rsqrtf(var + GN_EPS);
            f32x4 o = d * rstd * lg + lb + v4 * bon;
            o.x *= siluf_(bflo(gG.x)); o.y *= siluf_(bfhi(gG.x)); o.z *= siluf_(bflo(gG.y)); o.w *= siluf_(bfhi(gG.y));
            u32x2 w; w.x = pk2(o.x, o.y); w.y = pk2(o.z, o.w);
            *(u32x2*)(YM + tokE * 1024 + colbase) = w;
        }
        if (c + 1 < SEQ / TC) SC_STAGE(buf ^ 1);
        __syncthreads();
    }
#undef SC_GLOAD
#undef SC_STAGE
}


struct ChOps { u32x4 Aa[2], Ar[2], Abk[4]; u32x2 Acka, Ackr, Aminv, Acbr, Vb; f32x4 P[4]; };
__device__ __forceinline__ void ch_load(ChOps& o, const unsigned char* rec, int nt, int lane, int quad) {
#pragma unroll
    for (int ks = 0; ks < 2; ++ks) { o.Aa[ks] = *(const u32x4*)(rec + ks * 1024 + lane * 16); o.Ar[ks] = *(const u32x4*)(rec + 2048 + ks * 1024 + lane * 16); }
#pragma unroll
    for (int mt = 0; mt < 4; ++mt) { o.Abk[mt] = *(const u32x4*)(rec + 4096 + mt * 1024 + lane * 16); o.P[mt] = *(const f32x4*)(rec + 12288 + (16 * mt + 4 * quad) * 4); }
    o.Vb = *(const u32x2*)(rec + 8192 + nt * 512 + lane * 8);
    o.Acka = *(const u32x2*)(rec + 10240 + lane * 8); o.Ackr = *(const u32x2*)(rec + 10752 + lane * 8); o.Aminv = *(const u32x2*)(rec + 11264 + lane * 8); o.Acbr = *(const u32x2*)(rec + 11776 + lane * 8);
}
__device__ __forceinline__ void ch_load_lds(ChOps& o, const LAS unsigned char* rec, int nt, int lane, int quad) {
#pragma unroll
    for (int ks = 0; ks < 2; ++ks) { o.Aa[ks] = *(const LAS u32x4*)(rec + ks * 1024 + lane * 16); o.Ar[ks] = *(const LAS u32x4*)(rec + 2048 + ks * 1024 + lane * 16); }
    o.Vb = *(const LAS u32x2*)(rec + 8192 + nt * 512 + lane * 8);
    o.Acka = *(const LAS u32x2*)(rec + 10240 + lane * 8); o.Ackr = *(const LAS u32x2*)(rec + 10752 + lane * 8); o.Aminv = *(const LAS u32x2*)(rec + 11264 + lane * 8); o.Acbr = *(const LAS u32x2*)(rec + 11776 + lane * 8);
#pragma unroll
    for (int mt = 0; mt < 4; ++mt) { o.Abk[mt] = *(const LAS u32x4*)(rec + 4096 + mt * 1024 + lane * 16); o.P[mt] = *(const LAS f32x4*)(rec + 12288 + (16 * mt + 4 * quad) * 4); }
}
__device__ __forceinline__ bf16x8 asbf(u32x4 v) { return __builtin_bit_cast(bf16x8, v); }
__device__ __forceinline__ void scan_unit_chunked(const Args& a, LAS unsigned char* lds, int u) {
    const int tid = threadIdx.x, lane = tid & 63, wave = tid >> 6, fr = lane & 15, quad = lane >> 4;
    const int b = u >> 3, h = u & 7;
    unsigned char* ws = a.ws;
    const bf16_t* VR = (const bf16_t*)(ws + WS_VRAW); bf16_t* YM = (bf16_t*)(ws + WS_YMIX); const float* BON = (const float*)(ws + WS_BON);
    const bf16_t* PB = (const bf16_t*)(ws + WS_PB);
    const unsigned char* recs = rec_base(a, u);
    LAS float* YY = (LAS float*)lds;
    constexpr int REC_OFF = 16384, GRPB = 4 * RSZ, NPIECE = GRPB / 16;
    const int etok = tid >> 3, er8 = (tid & 7) * 8;
    const f32x4 lg0 = *(const f32x4*)(a.in[I_LNXG] + h * 64 + er8), lg1 = *(const f32x4*)(a.in[I_LNXG] + h * 64 + er8 + 4);
    const f32x4 lb0 = *(const f32x4*)(a.in[I_LNXB] + h * 64 + er8), lb1 = *(const f32x4*)(a.in[I_LNXB] + h * 64 + er8 + 4);
    f32x4 S[4];
#pragma unroll
    for (int mt = 0; mt < 4; ++mt) S[mt] = (f32x4){0.f, 0.f, 0.f, 0.f};
#define SC_LDGROUP(gidx, bufi) do { const unsigned char* src_ = recs + (size_t)(gidx) * GRPB; LAS unsigned char* dst_ = lds + REC_OFF + (bufi) * GRPB; u32x4 tmp_[13]; \
        _Pragma("unroll") for (int k_ = 0; k_ < 13; ++k_) { const int idx_ = (tid - 256) + 256 * k_; if (idx_ < NPIECE) tmp_[k_] = *(const u32x4*)(src_ + (size_t)idx_ * 16); } \
        _Pragma("unroll") for (int k_ = 0; k_ < 13; ++k_) { const int idx_ = (tid - 256) + 256 * k_; if (idx_ < NPIECE) *(LAS u32x4*)(dst_ + idx_ * 16) = tmp_[k_]; } } while (0)
    if (wave >= 4) SC_LDGROUP(0, 0);
    __syncthreads();
    for (int g = 0; g < SEQ / 64; ++g) {
        const int buf = g & 1;
        const size_t tokE = (size_t)b * SEQ + g * 64 + etok;
        const u32x4 ev = *(const u32x4*)(VR + tokE * 512 + h * 64 + er8);
        const u32x4 eg = *(const u32x4*)(PB + tokE * NB + h * 64 + er8);
        const float bon = BON[tokE * 8 + h];
        if (wave < 4) {
#pragma unroll
            for (int cc = 0; cc < 4; ++cc) {
                ChOps cur;
                ch_load_lds(cur, lds + REC_OFF + buf * GRPB + cc * RSZ, wave, lane, quad);
                u32x4 sb[2];
#pragma unroll
                for (int ks = 0; ks < 2; ++ks) { sb[ks].x = pk2(S[2 * ks][0], S[2 * ks][1]); sb[ks].y = pk2(S[2 * ks][2], S[2 * ks][3]);
                                                 sb[ks].z = pk2(S[2 * ks + 1][0], S[2 * ks + 1][1]); sb[ks].w = pk2(S[2 * ks + 1][2], S[2 * ks + 1][3]); }
                const u32x4 vb = (u32x4){cur.Vb.x, cur.Vb.y, 0u, 0u};
                f32x4 rhs = (f32x4){0.f, 0.f, 0.f, 0.f}, hv = rhs;
#pragma unroll
                for (int ks = 0; ks < 2; ++ks) { rhs = __builtin_amdgcn_mfma_f32_16x16x32_bf16(asbf(cur.Aa[ks]), asbf(sb[ks]), rhs, 0, 0, 0); hv = __builtin_amdgcn_mfma_f32_16x16x32_bf16(asbf(cur.Ar[ks]), asbf(sb[ks]), hv, 0, 0, 0); }
                rhs = __builtin_amdgcn_mfma_f32_16x16x32_bf16(asbf((u32x4){cur.Acka.x, cur.Acka.y, 0u, 0u}), asbf(vb), rhs, 0, 0, 0);
                hv = __builtin_amdgcn_mfma_f32_16x16x32_bf16(asbf((u32x4){cur.Ackr.x, cur.Ackr.y, 0u, 0u}), asbf(vb), hv, 0, 0, 0);
                const u32x4 rb = (u32x4){pk2(rhs[0], rhs[1]), pk2(rhs[2], rhs[3]), 0u, 0u};
                const f32x4 sa = __builtin_amdgcn_mfma_f32_16x16x32_bf16(asbf((u32x4){cur.Aminv.x, cur.Aminv.y, 0u, 0u}), asbf(rb), (f32x4){0.f, 0.f, 0.f, 0.f}, 0, 0, 0);
                const u32x4 svb = (u32x4){pk2(sa[0], sa[1]), pk2(sa[2], sa[3]), cur.Vb.x, cur.Vb.y};
                const f32x4 y = __builtin_amdgcn_mfma_f32_16x16x32_bf16(asbf((u32x4){cur.Acbr.x, cur.Acbr.y, 0u, 0u}), asbf(svb), hv, 0, 0, 0);
#pragma unroll
                for (int mt = 0; mt < 4; ++mt) { S[mt] = __builtin_amdgcn_mfma_f32_16x16x32_bf16(asbf(cur.Abk[mt]), asbf(svb), S[mt], 0, 0, 0); S[mt] = S[mt] * cur.P[mt]; }
#pragma unroll
                for (int jj = 0; jj < 4; ++jj) YY[(cc * 16 + 4 * quad + jj) * 64 + 16 * wave + fr] = y[jj];
            }
        } else if (g + 1 < SEQ / 64) {
            SC_LDGROUP(g + 1, buf ^ 1);
        }
        __syncthreads();
        {
            const f32x4 y0 = *(const LAS f32x4*)(YY + etok * 64 + er8), y1 = *(const LAS f32x4*)(YY + etok * 64 + er8 + 4);
            const float mean = red8(((y0.x + y0.y) + (y0.z + y0.w)) + ((y1.x + y1.y) + (y1.z + y1.w))) * (1.0f / 64.0f);
            const f32x4 d0 = y0 - mean, d1 = y1 - mean;
            const float var = red8(((d0.x * d0.x + d0.y * d0.y) + (d0.z * d0.z + d0.w * d0.w)) + ((d1.x * d1.x + d1.y * d1.y) + (d1.z * d1.z + d1.w * d1.w))) * (1.0f / 64.0f);
            const float rstd = rsqrtf(var + GN_EPS);
            const f32x4 v0 = (f32x4){bflo(ev.x), bfhi(ev.x), bflo(ev.y), bfhi(ev.y)}, v1 = (f32x4){bflo(ev.z), bfhi(ev.z), bflo(ev.w), bfhi(ev.w)};
            f32x4 o0 = d0 * rstd * lg0 + lb0 + v0 * bon, o1 = d1 * rstd * lg1 + lb1 + v1 * bon;
            o0.x *= siluf_(bflo(eg.x)); o0.y *= siluf_(bfhi(eg.x)); o0.z *= siluf_(bflo(eg.y)); o0.w *= siluf_(bfhi(eg.y));
            o1.x *= siluf_(bflo(eg.z)); o1.y *= siluf_(bfhi(eg.z)); o1.z *= siluf_(bflo(eg.w)); o1.w *= siluf_(bfhi(eg.w));
            u32x4 w; w.x = pk2(o0.x, o0.y); w.y = pk2(o0.z, o0.w); w.z = pk2(o1.x, o1.y); w.w = pk2(o1.z, o1.w);
            *(u32x4*)(YM + tokE * 1024 + h * 64 + er8) = w;
        }
        __syncthreads();
    }
#undef SC_LDGROUP
}


constexpr int AT_KS = 0, AT_VT = 18432, AT_BT = 36864, AT_PITCH = 144;
__device__ __forceinline__ void attn_unit(const Args& a, LAS unsigned char* lds, int u, int variant = 0) {
    const int tid = threadIdx.x, lane = tid & 63, wave = tid >> 6, fr = lane & 15, quad = lane >> 4;
    const int cp = u & 15, h = (u >> 4) & 7, b = u >> 7;
    unsigned char* ws = a.ws;
    const bf16_t* PB = (const bf16_t*)(ws + WS_PB); bf16_t* YM = (bf16_t*)(ws + WS_YMIX);
    const int c0 = 2 * cp, cq = c0 + (wave >> 2), qrow = (wave & 3) * 16 + fr;
    const size_t tq = (size_t)b * SEQ + cq * 64 + qrow;
    constexpr float LOG2E = 1.4426950408889634f;
    if (tid < 257) ((LAS float*)(lds + AT_BT))[tid] = a.in[I_ABIAS][h * 257 + tid] * LOG2E;
    bf16x8 qf[2];
    qf[0] = *(const bf16x8*)(PB + tq * NB + 512 + h * 64 + 8 * quad); qf[1] = *(const bf16x8*)(PB + tq * NB + 512 + h * 64 + 32 + 8 * quad);
    f32x4 O[4];
#pragma unroll
    for (int i = 0; i < 4; ++i) O[i] = (f32x4){0.f, 0.f, 0.f, 0.f};
    f32x4 Lacc = (f32x4){0.f, 0.f, 0.f, 0.f};
    const unsigned onev = (fr == 0) ? 0x3f803f80u : 0u; const bf16x8 ones = __builtin_bit_cast(bf16x8, (u32x4){onev, onev, onev, onev});
    const int kfirst = c0 - 8 > 0 ? c0 - 8 : 0, klast = c0 + 1;
    const int kkey = tid >> 3, kdch = tid & 7;
    const int vkey = tid & 63, vdch = tid >> 6;
    const int vpos = (vkey & 32) + 8 * ((vkey >> 2) & 3) + 4 * ((vkey >> 4) & 1) + (vkey & 3);
    u32x4 gk, gv, gk1, gv1, gk2, gv2;
#define AT_GLD(kc, K_, V_) do { if ((kc) <= klast) { K_ = *(const u32x4*)(PB + ((size_t)b * SEQ + (kc) * 64 + kkey) * NB + 1024 + h * 64 + kdch * 8); \
                        V_ = *(const u32x4*)(PB + ((size_t)b * SEQ + (kc) * 64 + vkey) * NB + 1536 + h * 64 + vdch * 8); } } while (0)
#define AT_SST(buf, gk, gv) do { *(LAS u32x4*)(lds + AT_KS + (buf) * 9216 + kkey * AT_PITCH + kdch * 16) = gk; \
        LAS unsigned short* vt_ = (LAS unsigned short*)(lds + AT_VT + (buf) * 9216) + (vdch * 8) * (AT_PITCH / 2) + vpos; \
        vt_[0 * 72] = (unsigned short)(gv.x & 0xffffu); vt_[1 * 72] = (unsigned short)(gv.x >> 16); vt_[2 * 72] = (unsigned short)(gv.y & 0xffffu); vt_[3 * 72] = (unsigned short)(gv.y >> 16); \
        vt_[4 * 72] = (unsigned short)(gv.z & 0xffffu); vt_[5 * 72] = (unsigned short)(gv.z >> 16); vt_[6 * 72] = (unsigned short)(gv.w & 0xffffu); vt_[7 * 72] = (unsigned short)(gv.w >> 16); } while (0)
    gk = gv = gk1 = gv1 = gk2 = gv2 = (u32x4){0u, 0u, 0u, 0u};
    AT_GLD(kfirst, gk2, gv2); AT_GLD(kfirst + 1, gk, gv); AT_GLD(kfirst + 2, gk1, gv1);
    AT_SST(0, gk2, gv2);
    lds_barrier();
    for (int kc = kfirst; kc <= klast; ++kc) {
        const int buf = (kc - kfirst) & 1;
        if (variant != 4) AT_GLD(kc + 3, gk2, gv2);
        if (variant != 3 && kc <= cq && kc >= cq - 8) {
            const LAS unsigned char* ks = lds + AT_KS + buf * 9216 + fr * AT_PITCH + quad * 16;
            const LAS unsigned char* vt = lds + AT_VT + buf * 9216 + fr * AT_PITCH + quad * 16;
            f32x4 sc[4];
#pragma unroll
            for (int kt = 0; kt < 4; ++kt) {
                sc[kt] = (f32x4){0.f, 0.f, 0.f, 0.f};
#pragma unroll
                for (int k2 = 0; k2 < 2; ++k2) { const bf16x8 kf = *(const LAS bf16x8*)(ks + kt * 16 * AT_PITCH + k2 * 64); sc[kt] = __builtin_amdgcn_mfma_f32_16x16x32_bf16(kf, qf[k2], sc[kt], 0, 0, 0); }
            }
            const int dch = cq - kc;
            const LAS float* bt = (const LAS float*)(lds + AT_BT);
            if (dch >= 3) {
                const float bc = bt[256];
#pragma unroll
                for (int kt = 0; kt < 4; ++kt)
#pragma unroll
                    for (int j = 0; j < 4; ++j) sc[kt][j] = __builtin_amdgcn_exp2f(__builtin_amdgcn_fmed3f(__builtin_fmaf(sc[kt][j], 0.125f * LOG2E, bc), -100.0f, 100.0f));
            } else {
                const int base = dch * 64 + qrow + 128 - 4 * quad;
#pragma unroll
                for (int kt = 0; kt < 4; ++kt)
#pragma unroll
                    for (int j = 0; j < 4; ++j) { int idx = base - kt * 16 - j; idx = idx > 256 ? 256 : idx; sc[kt][j] = __builtin_amdgcn_exp2f(__builtin_amdgcn_fmed3f(__builtin_fmaf(sc[kt][j], 0.125f * LOG2E, bt[idx]), -100.0f, 100.0f)); }
            }
#pragma unroll
            for (int s2 = 0; s2 < 2; ++s2) {
                u32x4 pw; pw.x = pk2(sc[2 * s2][0], sc[2 * s2][1]); pw.y = pk2(sc[2 * s2][2], sc[2 * s2][3]); pw.z = pk2(sc[2 * s2 + 1][0], sc[2 * s2 + 1][1]); pw.w = pk2(sc[2 * s2 + 1][2], sc[2 * s2 + 1][3]);
                const bf16x8 pf = __builtin_bit_cast(bf16x8, pw);
#pragma unroll
                for (int dt = 0; dt < 4; ++dt) { const bf16x8 vf = *(const LAS bf16x8*)(vt + dt * 16 * AT_PITCH + s2 * 64); O[dt] = __builtin_amdgcn_mfma_f32_16x16x32_bf16(vf, pf, O[dt], 0, 0, 0); }
                Lacc = __builtin_amdgcn_mfma_f32_16x16x32_bf16(ones, pf, Lacc, 0, 0, 0);
            }
        }
        if (variant != 4 && kc < klast) AT_SST(buf ^ 1, gk, gv);
        gk = gk1; gv = gv1; gk1 = gk2; gv1 = gv2;
        lds_barrier();
    }
#undef AT_GLD
#undef AT_SST
    const float l = __shfl(Lacc[0], fr);
    const float il = 1.0f / l;
#pragma unroll
    for (int dt = 0; dt < 4; ++dt) {
        const int dcol = h * 64 + dt * 16 + 4 * quad;
        const u32x2 g = *(const u32x2*)(PB + tq * NB + 2048 + dcol);
        const f32x4 o = O[dt] * il;
        u32x2 w; w.x = pk2(o[0] * siluf_(bflo(g.x)), o[1] * siluf_(bfhi(g.x))); w.y = pk2(o[2] * siluf_(bflo(g.y)), o[3] * siluf_(bfhi(g.y)));
        *(u32x2*)(YM + tq * 1024 + 512 + dcol) = w;
    }
}

__device__ __forceinline__ void phase_mix(const Args& a, LAS unsigned char* lds, bool do_scan = true, bool do_attn = true) {
    unsigned* ctr = (unsigned*)(a.ws + WS_CTR);
    if (do_scan) for (int u = blockIdx.x; u < BATCH * 8; u += gridDim.x) scan_unit_chunked(a, lds, u);
    LAS int* uw = (LAS int*)(lds + 40000);
    if (do_attn) for (;;) {
        __syncthreads();
        if (threadIdx.x == 0) *uw = (int)atomicAdd(ctr, 1u);
        __syncthreads();
        const int u = *uw;
        if (u >= BATCH * 8 * 16) break;
        attn_unit(a, lds, u, (PROBE_LOOPS || N_LAUNCH_MODE == 3) ? a.rep[0] : 0);
    }
}

__device__ __forceinline__ void phase_sg_naive(const Args& a, unsigned char* ldsb) {
    const int tid = threadIdx.x;
    unsigned char* ws = a.ws;
    const bf16_t* P1 = (const bf16_t*)(ws + WS_P1); bf16_t* Y2 = (bf16_t*)(ws + WS_YMIX);
    const float* vsum = (const float*)(ws + WS_VSUM); const float* vsq = (const float*)(ws + WS_VSQ);
    float* vn = (float*)ldsb;
    const int c = tid & 127, i0 = tid >> 7;
    for (int u = blockIdx.x; u < BATCH * 16 * 8; u += gridDim.x) {
        const int g = u & 7, nb = (u >> 3) & 15, b = u >> 7;
        const int tbase = b * SEQ + nb * 128;
        const float lg = a.in[I_SGLNG][g * 128 + c], lb = a.in[I_SGLNB][g * 128 + c];
        for (int j = i0; j < 128; j += 4) {
            const int t = tbase + j; const float mean = vsum[t] * (1.0f / 1024.0f); const float var = vsq[t] * (1.0f / 1024.0f) - mean * mean;
            const float rstd = rsqrtf(fmaxf(var, 0.f) + LN_EPS);
            vn[j * 128 + c] = (bf2f(P1[(size_t)t * N3 + 1024 + g * 128 + c]) - mean) * rstd * lg + lb;
        }
        __syncthreads();
        const float* wg = a.in[I_SGW] + (size_t)g * 128 * 128; const float* sb = a.in[I_SGB] + g * 128;
        for (int i = i0; i < 128; i += 4) {
            const int jend = (i < 64) ? 64 : 128;
            float acc = 0.f;
            for (int j = 0; j < jend; ++j) acc += wg[i * 128 + j] * vn[j * 128 + c];
            const int t = tbase + i;
            const float uu = bf2f(P1[(size_t)t * N3 + g * 128 + c]), gt = bf2f(P1[(size_t)t * N3 + 2048 + g * 128 + c]);
            Y2[(size_t)t * 1024 + g * 128 + c] = f2bf(uu * (acc + sb[i]) * gt);
        }
        __syncthreads();
    }
}


__device__ __forceinline__ void phase_sg(const Args& a, LAS unsigned char* lds, int variant = 0) {
    const int tid = threadIdx.x, lane = tid & 63, wave = tid >> 6, fr = lane & 15, quad = lane >> 4;
    unsigned char* ws = a.ws;
    const bf16_t* P1 = (const bf16_t*)(ws + WS_P1); bf16_t* Y2 = (bf16_t*)(ws + WS_YMIX); const bf16_t* SGW = (const bf16_t*)(ws + WS_SGW);
    const float* vsum = (const float*)(ws + WS_VSUM); const float* vsq = (const float*)(ws + WS_VSQ);
    constexpr int VPB = 272;
    constexpr int NUN = BATCH * 16 * 8;
    const int per = (NUN + (int)gridDim.x - 1) / (int)gridDim.x;
    const int u0 = blockIdx.x * per, u1 = (u0 + per < NUN) ? u0 + per : NUN;
    u32x4 vw[4]; float vmean[4], vrstd[4];
    const int lpc = tid & 15, lrb = tid >> 4;
#define SG_VLOAD(uu_) do { const int g_ = (uu_) >> 8, tb_ = (((uu_) >> 4) & 15) * SEQ + ((uu_) & 15) * 128; \
        _Pragma("unroll") for (int q_ = 0; q_ < 4; ++q_) { const int t_ = tb_ + lrb + 32 * q_; \
            const float m_ = vsum[t_] * (1.0f / 1024.0f); const float var_ = vsq[t_] * (1.0f / 1024.0f) - m_ * m_; vmean[q_] = m_; vrstd[q_] = rsqrtf(fmaxf(var_, 0.f) + LN_EPS); \
            vw[q_] = *(const u32x4*)(P1 + (size_t)t_ * N3 + 1024 + g_ * 128 + lpc * 8); } } while (0)
    if (u0 < u1) SG_VLOAD(u0);
    for (int u = u0; u < u1; ++u) {
        const int g = u >> 8, b = (u >> 4) & 15, nb = u & 15;
        const int tbase = b * SEQ + nb * 128;
        const int irow = 16 * wave + fr;
        const int epc = tid & 15, erb = tid >> 4;
        u32x4 uu[4], gg[4];
#pragma unroll
        for (int q = 0; q < 4; ++q) { const size_t te = (size_t)tbase + erb + 32 * q; uu[q] = *(const u32x4*)(P1 + te * N3 + g * 128 + epc * 8); gg[q] = *(const u32x4*)(P1 + te * N3 + 2048 + g * 128 + epc * 8); }
        bf16x8 wf[4];
#pragma unroll
        for (int ks = 0; ks < 4; ++ks) wf[ks] = *(const bf16x8*)(SGW + (size_t)(g * 128 + irow) * 128 + ks * 32 + 8 * quad);
        if (variant != 2) {
            const int c8 = lpc * 8;
            const f32x4 g0 = *(const f32x4*)(a.in[I_SGLNG] + g * 128 + c8), g1 = *(const f32x4*)(a.in[I_SGLNG] + g * 128 + c8 + 4);
            const f32x4 b0 = *(const f32x4*)(a.in[I_SGLNB] + g * 128 + c8), b1 = *(const f32x4*)(a.in[I_SGLNB] + g * 128 + c8 + 4);
#pragma unroll
            for (int q = 0; q < 4; ++q) {
                const int j = lrb + 32 * q; const float mean = vmean[q], rstd = vrstd[q];
                const u32x4 w = vw[q];
                LAS unsigned short* vt = (LAS unsigned short*)(lds + c8 * VPB + (((j >> 3) ^ lpc) * 16) + (j & 7) * 2);
                vt[0 * (VPB / 2)] = f2bf((bflo(w.x) - mean) * rstd * g0.x + b0.x); vt[1 * (VPB / 2)] = f2bf((bfhi(w.x) - mean) * rstd * g0.y + b0.y);
                vt[2 * (VPB / 2)] = f2bf((bflo(w.y) - mean) * rstd * g0.z + b0.z); vt[3 * (VPB / 2)] = f2bf((bfhi(w.y) - mean) * rstd * g0.w + b0.w);
                vt[4 * (VPB / 2)] = f2bf((bflo(w.z) - mean) * rstd * g1.x + b1.x); vt[5 * (VPB / 2)] = f2bf((bfhi(w.z) - mean) * rstd * g1.y + b1.y);
                vt[6 * (VPB / 2)] = f2bf((bflo(w.w) - mean) * rstd * g1.z + b1.z); vt[7 * (VPB / 2)] = f2bf((bfhi(w.w) - mean) * rstd * g1.w + b1.w);
            }
        }
        if (u + 1 < u1) SG_VLOAD(u + 1);
        lds_barrier();
        if (variant == 1) { lds_barrier(); continue; }
        f32x4 acc[8];
#pragma unroll
        for (int ct = 0; ct < 8; ++ct) {
            acc[ct] = (f32x4){0.f, 0.f, 0.f, 0.f};
#pragma unroll
            for (int ks = 0; ks < 4; ++ks) {
                if (ks < 2 || wave >= 4) { const bf16x8 vf = *(const LAS bf16x8*)(lds + (ct * 16 + fr) * VPB + (((ks * 4 + quad) ^ (ct * 2 + (fr >> 3))) * 16)); acc[ct] = __builtin_amdgcn_mfma_f32_16x16x32_bf16(vf, wf[ks], acc[ct], 0, 0, 0); }
            }
        }
        {
            LAS float* ot = (LAS float*)(lds + 36864);
#pragma unroll
            for (int ct = 0; ct < 8; ++ct) *(LAS f32x4*)(ot + irow * 132 + ct * 16 + 4 * quad) = acc[ct];
            lds_barrier();
#pragma unroll
            for (int q = 0; q < 4; ++q) {
                const int i = erb + 32 * q; const size_t te = (size_t)tbase + i; const float sbv = a.in[I_SGB][g * 128 + i];
                const f32x4 s0 = *(const LAS f32x4*)(ot + i * 132 + epc * 8), s1 = *(const LAS f32x4*)(ot + i * 132 + epc * 8 + 4);
                u32x4 w;
                w.x = pk2(bflo(uu[q].x) * (s0[0] + sbv) * bflo(gg[q].x), bfhi(uu[q].x) * (s0[1] + sbv) * bfhi(gg[q].x));
                w.y = pk2(bflo(uu[q].y) * (s0[2] + sbv) * bflo(gg[q].y), bfhi(uu[q].y) * (s0[3] + sbv) * bfhi(gg[q].y));
                w.z = pk2(bflo(uu[q].z) * (s1[0] + sbv) * bflo(gg[q].z), bfhi(uu[q].z) * (s1[1] + sbv) * bfhi(gg[q].z));
                w.w = pk2(bflo(uu[q].w) * (s1[2] + sbv) * bflo(gg[q].w), bfhi(uu[q].w) * (s1[3] + sbv) * bfhi(gg[q].w));
                *(u32x4*)(Y2 + te * 1024 + g * 128 + epc * 8) = w;
            }
        }
        lds_barrier();
    }
#undef SG_VLOAD
}

__device__ __forceinline__ void phase_final(const Args& a) {
    const int tid = threadIdx.x, lane = tid & 63, wave = tid >> 6;
    const float* rs2 = (const float*)(a.ws + WS_RS2); const float* fg = a.in[I_FG];
    const int gw = blockIdx.x * 8 + wave, NGW = gridDim.x * 8;
    f32x4 g4[4];
#pragma unroll
    for (int j = 0; j < 4; ++j) g4[j] = ((const f32x4*)fg)[lane + 64 * j];
    for (int m = gw; m < M; m += NGW) {
        const float rinv = rsqrtf(rs2[m] * (1.0f / DM) + RMS_EPS);
        f32x4* p = (f32x4*)(a.out + (size_t)m * DM) + lane;
#pragma unroll
        for (int j = 0; j < 4; ++j) { f32x4 v = p[64 * j]; v = v * rinv * g4[j]; p[64 * j] = v; }
    }
}

#define XB_TMO      128
#define XB_XCNT(j)  (256  + 64 * (j))
#define XB_XSUB(j)  (1280 + 64 * (j))
#define XB_XGEN(j)  (2304 + 64 * (j))
#define XB_TOP      3328
#define XB_TOPGEN   3392
#define XCD_BAR_WORDS 3456
#define XB_SPIN_CAP (1u << 18)

__device__ __forceinline__ unsigned xb_ld(unsigned* p)              { return __hip_atomic_load(p, __ATOMIC_RELAXED, __HIP_MEMORY_SCOPE_AGENT); }
__device__ __forceinline__ unsigned xb_add(unsigned* p, unsigned v) { return __hip_atomic_fetch_add(p, v, __ATOMIC_RELAXED, __HIP_MEMORY_SCOPE_AGENT); }
__device__ __forceinline__ unsigned xb_xcc_id() { return (unsigned)__builtin_amdgcn_s_getreg((3 << 11) | 20) & 0xFu; }
#define XB_SPIN(cond, bar) do { unsigned _sp = 0; while (cond) { __builtin_amdgcn_s_sleep(1); \
    if ((++_sp & 255u) == 0u) { if (xb_ld(&(bar)[XB_TMO])) break; if (_sp > XB_SPIN_CAP) { atomicAdd(&(bar)[XB_TMO], 1u); break; } } } } while (0)

struct XcdBarrier {
    unsigned* bar; unsigned x;
    volatile LAS unsigned* st;
};

__device__ __forceinline__ XcdBarrier xcd_barrier_post(unsigned* bar, volatile LAS unsigned* st) {
    XcdBarrier b; b.bar = bar; b.x = xb_xcc_id(); b.st = st;
    if (threadIdx.x == 0) (void)xb_add(&bar[XB_XCNT(b.x)], 1u);
    return b;
}
__device__ __forceinline__ void xcd_barrier_complete(unsigned* bar, unsigned x, unsigned& nloc, unsigned& nx) {
    const unsigned G = gridDim.x * gridDim.y * gridDim.z;
    unsigned sum, cnt, mine, sp = 0u;
    for (;;) {
        sum = 0u; cnt = 0u; mine = 0u;
#pragma unroll
        for (unsigned j = 0; j < 16; ++j) { const unsigned c = xb_ld(&bar[XB_XCNT(j)]); sum += c; cnt += (c > 0u) ? 1u : 0u; mine = (j == x) ? c : mine; }
        if (sum == G) break;
        __builtin_amdgcn_s_sleep(1);
        if ((++sp & 255u) == 0u) { if (xb_ld(&bar[XB_TMO])) break; if (sp > XB_SPIN_CAP) { atomicAdd(&bar[XB_TMO], 1u); break; } }
    }
    nloc = mine > 0u ? mine : 1u; nx = cnt > 0u ? cnt : 1u;
}

__device__ __forceinline__ void xcd_barrier(const XcdBarrier& b) {
    asm volatile("s_waitcnt vmcnt(0)" ::: "memory");
    __syncthreads();
    if (threadIdx.x == 0) {
        unsigned* bar = b.bar;
        __builtin_amdgcn_s_waitcnt(0);
        unsigned nloc = b.st[0], nx = b.st[1];
        if (nloc == 0u) { xcd_barrier_complete(bar, b.x, nloc, nx); b.st[0] = nloc; b.st[1] = nx; }
        const unsigned old = xb_add(&bar[XB_XSUB(b.x)], 1u);
        const unsigned gen = old / nloc;
        if (old + 1u == (gen + 1u) * nloc) {
            __builtin_amdgcn_fence(__ATOMIC_RELEASE, "agent");
            asm volatile("s_waitcnt vmcnt(0)" ::: "memory");
            const unsigned og = xb_add(&bar[XB_TOP], 1u);
            const unsigned tg = og / nx;
            if (og + 1u == (tg + 1u) * nx) xb_add(&bar[XB_TOPGEN], 1u);
            else XB_SPIN(xb_ld(&bar[XB_TOPGEN]) == tg, bar);
            __builtin_amdgcn_fence(__ATOMIC_ACQUIRE, "agent");
            xb_add(&bar[XB_XGEN(b.x)], 1u);
            asm volatile("s_waitcnt vmcnt(0)" ::: "memory");
        } else {
            XB_SPIN(xb_ld(&bar[XB_XGEN(b.x)]) == gen, bar);
            __builtin_amdgcn_fence(__ATOMIC_ACQUIRE, "agent");
            asm volatile("s_waitcnt vmcnt(0)" ::: "memory");
        }
    }
    __syncthreads();
}

template <int PHM> __global__ void __launch_bounds__(NTHR, 2) mega(Args a) {
    extern __shared__ __attribute__((aligned(16))) unsigned char lds[];
    unsigned char* ws = a.ws;
    const int lo = a.lo, hi = a.hi;
    volatile LAS unsigned* bst = (volatile LAS unsigned*)((LAS unsigned char*)lds + (LDS_BYTES - 64));
    if (threadIdx.x < 2) bst[threadIdx.x] = 0u;
    __syncthreads();
    XcdBarrier xbar = xcd_barrier_post((unsigned*)(ws + WS_BAR), bst);
    if (hi > 1000) cg::this_grid().sync();
#define IN(k) (((PHM >> (k)) & 1) && lo <= (k) && (k) < hi)
#if PROBE_LOOPS
#define REPS(i) a.rep[i]
#else
#define REPS(i) 0
#endif
#if USE_XBAR
#define SEAM(k) do { if (IN(k) && IN((k) + 1)) { xcd_barrier(xbar); } } while (0)
#else
#define SEAM(k) do { if (IN(k) && IN((k) + 1)) { cg::this_grid().sync(); } } while (0)
#endif
    if (IN(0)) for (int r_ = 0; r_ <= REPS(0); ++r_) { phase_prologue(a, lds); if (r_ < REPS(0)) xcd_barrier(xbar); }
    SEAM(0);
    if (IN(1)) { EpiG1 f{(const float*)(ws + WS_RS0), (bf16_t*)(ws + WS_PA), (bf16_t*)(ws + WS_PB)};
        gemm_any(lds, (const bf16_t*)(ws + WS_XN), (const bf16_t*)(ws + WS_W1T), M, N1, DM, f); }
    SEAM(1);
    if (IN(2)) for (int r_ = 0; r_ <= REPS(1); ++r_) { phase_prep(a, lds, (PROBE_LOOPS || N_LAUNCH_MODE == 3) ? a.rep[0] : 0); if (r_ < REPS(1)) xcd_barrier(xbar); }
    SEAM(2);
    #if PROBE & 1
    phase_prep(a, lds); cg::this_grid().sync();
#endif
#if USE_NAIVE_MIX
    if (IN(3)) { phase_scan_naive(a); phase_attn_naive(a); }
#else
    if (IN(3)) for (int r_ = 0; r_ <= REPS(2); ++r_) { phase_mix(a, (LAS unsigned char*)lds, a.rep[0] < 2, a.rep[0] != 1); if (r_ < REPS(2)) { xcd_barrier(xbar); if (blockIdx.x == 0 && threadIdx.x == 0) *(unsigned*)(ws + WS_CTR) = 0u; xcd_barrier(xbar); } }
#endif
    SEAM(3);
#if PROBE & 2
    phase_prep(a, lds); cg::this_grid().sync(); phase_mix(a, (LAS unsigned char*)lds); cg::this_grid().sync();
#endif
#if PROBE & 64
    phase_prep(a, lds); cg::this_grid().sync(); phase_mix(a, (LAS unsigned char*)lds, true, false); cg::this_grid().sync();
#endif
#if PROBE & 32
    if (blockIdx.x == 0 && threadIdx.x == 0) *(unsigned*)(ws + WS_CTR) = 0u;
    cg::this_grid().sync(); phase_mix(a, (LAS unsigned char*)lds, false); cg::this_grid().sync();
#endif
#if PROBE & 4
    phase_prologue(a, lds); cg::this_grid().sync();
#endif
#if PROBE & 16
    { EpiG1 f{(const float*)(ws + WS_RS0), (bf16_t*)(ws + WS_PA), (bf16_t*)(ws + WS_PB)};
        gemm_any(lds, (const bf16_t*)(ws + WS_XN), (const bf16_t*)(ws + WS_W1T), M, N1, DM, f); cg::this_grid().sync(); }
#endif
    if (IN(4)) { EpiG2 f{a.in[I_X], a.out, (bf16_t*)(ws + WS_XN), (float*)(ws + WS_RS1)};
        gemm_any(lds, (const bf16_t*)(ws + WS_YMIX), (const bf16_t*)(ws + WS_W2T), M, DM, DM, f); }
    SEAM(4);
#if PROBE & 128
    { EpiG2 f{a.in[I_X], a.out, (bf16_t*)(ws + WS_XN), (float*)(ws + 640 * 1024)};
        gemm_any(lds, (const bf16_t*)(ws + WS_YMIX), (const bf16_t*)(ws + WS_W2T), M, DM, DM, f); cg::this_grid().sync(); }
#endif
    if (IN(5)) { EpiG3 f{(const float*)(ws + WS_RS1), (bf16_t*)(ws + WS_P1), (float*)(ws + WS_VSUM), (float*)(ws + WS_VSQ)};
        gemm_any(lds, (const bf16_t*)(ws + WS_XN), (const bf16_t*)(ws + WS_W3T), M, N3, DM, f); }
    SEAM(5);
    if (IN(6)) for (int r_ = 0; r_ <= REPS(3); ++r_) { phase_sg(a, (LAS unsigned char*)lds, (PROBE_LOOPS || N_LAUNCH_MODE == 3) ? a.rep[0] : 0); if (r_ < REPS(3)) xcd_barrier(xbar); }
    SEAM(6);
#if PROBE & 8
    phase_sg(a, (LAS unsigned char*)lds); cg::this_grid().sync();
#endif
    if (IN(7)) { EpiG4 f{a.out, (float*)(ws + WS_RS2)};
        gemm_any(lds, (const bf16_t*)(ws + WS_YMIX), (const bf16_t*)(ws + WS_W4T), M, DM, DM, f); }
    SEAM(7);
#if PROBE & 256
    for (int i_ = 0; i_ < 8; ++i_) cg::this_grid().sync();
#endif
    if (IN(8)) { phase_final(a); }
#undef IN
#undef SEAM
}
constexpr int NPHASE = 9;
}
#if defined(__HIP_DEVICE_COMPILE__)
#pragma clang attribute pop
#endif

extern "C" void kernel_launch(void* const* d_in, const int* in_sizes, int n_in, void* d_out, int out_size, void* d_ws, size_t ws_size, hipStream_t stream) {
    using namespace mk;
    static int grid = 0;
    if (grid == 0) {
        if (n_in != 22 || out_size != M * DM || ws_size < WS_END) { fprintf(stderr, "kernel_launch: unexpected shapes (n_in %d out %d ws %zu)\n", n_in, out_size, ws_size); grid = -1; return; }
        int dev = 0, cus = 0, per_cu = 0;
        (void)hipGetDevice(&dev); (void)hipDeviceGetAttribute(&cus, hipDeviceAttributeMultiprocessorCount, dev);
#if N_LAUNCH_MODE == 1 || N_LAUNCH_MODE == 3
        if (hipFuncSetAttribute((const void*)mega<0x1ff>, hipFuncAttributeMaxDynamicSharedMemorySize, LDS_BYTES) != hipSuccess) { fprintf(stderr, "kernel_launch: hipFuncSetAttribute failed\n"); grid = -1; return; }
        if (hipOccupancyMaxActiveBlocksPerMultiprocessor(&per_cu, (const void*)mega<0x1ff>, NTHR, LDS_BYTES) != hipSuccess || per_cu < 1) { fprintf(stderr, "kernel_launch: occupancy query says %d\n", per_cu); per_cu = 1; }
#else
        if (hipFuncSetAttribute((const void*)mega<0x1f7>, hipFuncAttributeMaxDynamicSharedMemorySize, LDS_BYTES) != hipSuccess || hipFuncSetAttribute((const void*)mega<0x008>, hipFuncAttributeMaxDynamicSharedMemorySize, LDS_BYTES) != hipSuccess) { fprintf(stderr, "kernel_launch: hipFuncSetAttribute failed\n"); grid = -1; return; }
#endif
        (void)hipGetLastError();
        grid = cus * 1;
        if (grid <= 0) grid = 256;
    }
    if (grid < 0) return;
    Args a{};
    for (int i = 0; i < 22; ++i) a.in[i] = (const float*)d_in[i];
    a.out = (float*)d_out; a.ws = (unsigned char*)d_ws;
    a.rep[0] = PROBE_REP0; a.rep[1] = PROBE_REP1; a.rep[2] = PROBE_REP2; a.rep[3] = PROBE_REP3;
    if (hipMemsetAsync((char*)d_ws + WS_BAR, 0, 16384, stream) != hipSuccess) { fprintf(stderr, "kernel_launch: hipMemsetAsync failed\n"); return; }
#if N_LAUNCH_MODE == 3
    {
        constexpr int P = PROBE_PHASE; constexpr int MLO = (1 << P) - 1, MP = 1 << P, MHI = 0x1ff & ~((1 << (P + 1)) - 1);
        void* args[] = {&a};
        (void)hipFuncSetAttribute((const void*)mega<MP>, hipFuncAttributeMaxDynamicSharedMemorySize, LDS_BYTES);
        (void)hipFuncSetAttribute((const void*)mega<MHI>, hipFuncAttributeMaxDynamicSharedMemorySize, LDS_BYTES);
        if (P > 0) { (void)hipFuncSetAttribute((const void*)mega<MLO>, hipFuncAttributeMaxDynamicSharedMemorySize, LDS_BYTES);
            a.lo = 0; a.hi = P; (void)hipLaunchCooperativeKernel((const void*)mega<MLO>, dim3(grid), dim3(NTHR), args, LDS_BYTES, stream); }
        for (int r = 0; r <= PROBE_REP2; ++r) {
            a.lo = P; a.hi = P + 1; a.rep[0] = (r == PROBE_REP2) ? 0 : PROBE_MIXMODE;
            (void)hipMemsetAsync((char*)d_ws + WS_CTR, 0, 4, stream);
            (void)hipMemsetAsync((char*)d_ws + WS_BAR, 0, 16384, stream);
            hipLaunchKernelGGL(mega<MP>, dim3(grid), dim3(NTHR), LDS_BYTES, stream, a);
        }
        a.rep[0] = 0;
        (void)hipMemsetAsync((char*)d_ws + WS_BAR, 0, 16384, stream);
        a.lo = P + 1; a.hi = NPHASE;
        (void)hipLaunchCooperativeKernel((const void*)mega<MHI>, dim3(grid), dim3(NTHR), args, LDS_BYTES, stream);
    }
#elif N_LAUNCH_MODE == 2
    {
        void* args[] = {&a};
        a.lo = 0; a.hi = 3;
        hipError_t e = hipLaunchCooperativeKernel((const void*)mega<0x1f7>, dim3(grid), dim3(NTHR), args, LDS_BYTES, stream);
        if (e != hipSuccess) fprintf(stderr, "kernel_launch: cooperative launch A failed: %s (grid %d)\n", hipGetErrorString(e), grid);
        a.lo = 3; a.hi = 4;
        hipLaunchKernelGGL(mega<0x008>, dim3(grid), dim3(NTHR), LDS_BYTES, stream, a);
        a.lo = 4; a.hi = NPHASE;
        e = hipLaunchCooperativeKernel((const void*)mega<0x1f7>, dim3(grid), dim3(NTHR), args, LDS_BYTES, stream);
        if (e != hipSuccess) fprintf(stderr, "kernel_launch: cooperative launch B failed: %s (grid %d)\n", hipGetErrorString(e), grid);
    }
#elif N_LAUNCH_MODE == 1
    a.lo = 0; a.hi = NPHASE;
    void* args[] = {&a};
    hipError_t e = hipLaunchCooperativeKernel((const void*)mega<0x1ff>, dim3(grid), dim3(NTHR), args, LDS_BYTES, stream);
    if (e != hipSuccess) fprintf(stderr, "kernel_launch: cooperative launch failed: %s (grid %d)\n", hipGetErrorString(e), grid);
#else
    for (int ph = 0; ph < NPHASE; ++ph) {
        a.lo = ph; a.hi = ph + 1;
        if (ph == 3) hipLaunchKernelGGL(mega<0x008>, dim3(grid), dim3(NTHR), LDS_BYTES, stream, a);
        else hipLaunchKernelGGL(mega<0x1f7>, dim3(grid), dim3(NTHR), LDS_BYTES, stream, a);
    }
#endif
}
```

```cpp
#if defined(__HIP_DEVICE_COMPILE__)
#pragma clang attribute push(__attribute__((target("no-packed-fp32-ops"))), apply_to = function)
#endif
#include <hip/hip_runtime.h>
#include <hip/hip_cooperative_groups.h>
#include <cstdio>
#include <cstdint>
namespace cg = cooperative_groups;
#ifndef USE_PG8
#define USE_PG8 1
#endif
#ifndef N_LAUNCH_MODE
#define N_LAUNCH_MODE 1
#endif
#ifndef PHMASK
#define PHMASK 0x1ff
#endif
#ifndef USE_NAIVE_MIX
#define USE_NAIVE_MIX 0
#endif
#ifndef PROBE
#define PROBE 0
#endif
#ifndef USE_XBAR
#define USE_XBAR 1
#endif
#ifndef PROBE_REP0
#define PROBE_REP0 0
#define PROBE_REP1 0
#define PROBE_REP2 0
#define PROBE_REP3 0
#endif
#ifndef SCAN_PREFETCH
#define SCAN_PREFETCH 1
#endif
#ifndef PROBE_LOOPS
#define PROBE_LOOPS 0
#endif
#ifndef PROBE_MIXMODE
#define PROBE_MIXMODE 0
#endif
#ifndef PROBE_PHASE
#define PROBE_PHASE 3
#endif
#ifndef FUSE_FINAL
#define FUSE_FINAL 1
#endif
namespace pg8 {
#define PG8_LAS __attribute__((address_space(3)))
typedef unsigned short bf16_t;
typedef short bf16x8 __attribute__((ext_vector_type(8)));
typedef float f32x4 __attribute__((ext_vector_type(4)));
typedef unsigned u32x4 __attribute__((ext_vector_type(4)));
constexpr int BM = 256, BK = 64, HALF = 128, HTB = HALF * BK * 2  , STAGE_BYTES = 8 * HTB, NXCD = 8, WGM = 8;

__host__ __device__ __forceinline__ int lds_byte(int r, int c) { const int st = (r >> 4) * 2 + (c >> 5), rr = r & 15, cc = c & 31, ob = rr * 64 + cc * 2; return st * 1024 + (ob ^ (((ob >> 9) & 1) << 5)); }
__host__ __device__ __forceinline__ void stage_rc(int b, int& R, int& C) { const int st = b / 1024, sb = b % 1024, swz = sb ^ (((sb >> 9) & 1) << 5); R = (st >> 1) * 16 + swz / 64; C = (st & 1) * 32 + (swz % 64) / 2; }
__host__ __device__ __forceinline__ int perm32(int rho) { const int n = rho >> 4, i = rho & 15; return 8 * (i >> 2) + 4 * n + (i & 3); }

struct Unit { int pm, pn; };
struct Gemm { const bf16_t* A; const bf16_t* Bt; int M, N, K; };

struct StaticOrder {
    int nM, nN, nwg, G, c;
    __host__ __device__ void init(int M, int N, int G_, int c_) { nM = M / BM; nN = N / BM; nwg = nM * nN; G = G_; c = c_; }
    __host__ __device__ bool next(int i, Unit& u) const {
        const long L = (long)i * G + c; if (L >= nwg) return false;
        int wgid = (int)L; { const int q = nwg / NXCD, r = nwg % NXCD, xcd = wgid % NXCD, off = wgid / NXCD; wgid = (xcd < r ? xcd * (q + 1) : r * (q + 1) + (xcd - r) * q) + off; }
        const int nig = WGM * nN, gid = wgid / nig, fm = gid * WGM, gsz = (nM - fm) < WGM ? (nM - fm) : WGM;
        u.pm = fm + ((wgid % nig) % gsz); u.pn = (wgid % nig) / gsz; return true;
    }
    __device__ __forceinline__ void a_ready(const Unit&) const {}
    __device__ __forceinline__ void done(const Unit&) const {}
};

__device__ __forceinline__ unsigned cvt_pk_bf16(float lo, float hi) { unsigned r; asm volatile("v_cvt_pk_bf16_f32 %0, %1, %2" : "=v"(r) : "v"(lo), "v"(hi)); return r; }
typedef float f32x2 __attribute__((ext_vector_type(2)));
__device__ __forceinline__ f32x2 gelu_pk(f32x2 v) {
    const f32x2 av = __builtin_elementwise_abs(v), d = av * 0.2316418882f + 1.0f;
    f32x2 t; t.x = __builtin_amdgcn_rcpf(d.x); t.y = __builtin_amdgcn_rcpf(d.y);
    f32x2 q = t * 0.5307027145f + (-0.7265760135f); q = q * t + 0.7107068705f; q = q * t + (-0.142248368f); q = q * t + 0.127414796f; q = q * t;
    const f32x2 s = (v * v) * (-0.72134752044f);
    f32x2 e; e.x = __builtin_amdgcn_exp2f(s.x); e.y = __builtin_amdgcn_exp2f(s.y);
    const f32x2 m = v * (q * e), r = v - m;
    f32x2 o; o.x = v.x < 0.f ? m.x : r.x; o.y = v.y < 0.f ? m.y : r.y; return o;
}

template <int ACT  > struct EpiBf16 {
    static constexpr bool PERM = true, AFTER_DRAIN = false; static_assert(ACT == 0 || ACT == 1, "EpiBf16: ACT is 0 (none) or 1 (gelu_pk)");
    bf16_t* O; int ldc; const float* bias; int split_cols; size_t split_stride; float scale0;
    __device__ __forceinline__ void operator()(const f32x4 (&acc)[2][2][4][2], const Unit& u, int wr, int wc, int fr, int fq) const {
        const int row0 = u.pm * BM + wr * 64 + fr; int colt = u.pn * BM; bf16_t* base = O;
        float sc = 1.f; if (split_cols) { const int t = colt / split_cols; base += (size_t)t * split_stride; colt -= t * split_cols; if (t == 0) sc = scale0; }
        const int col0 = colt + wc * 32 + 8 * fq, bcol0 = u.pn * BM + wc * 32 + 8 * fq;
        f32x4 bv[2][2];
#pragma unroll
        for (int bj = 0; bj < 2; ++bj)
#pragma unroll
            for (int n = 0; n < 2; ++n) bv[bj][n] = bias ? *(const f32x4*)(bias + bcol0 + bj * HALF + 4 * n) : (f32x4){0.f, 0.f, 0.f, 0.f};
#pragma unroll
        for (int ai = 0; ai < 2; ++ai)
#pragma unroll
            for (int m = 0; m < 4; ++m) { bf16_t* rowp = base + (size_t)(row0 + ai * HALF + m * 16) * ldc + col0;
#pragma unroll
                for (int bj = 0; bj < 2; ++bj) { f32x4 v0 = acc[ai][bj][m][0] + bv[bj][0], v1 = acc[ai][bj][m][1] + bv[bj][1];
                    if (ACT == 1) { f32x2 a = gelu_pk((f32x2){v0[0], v0[1]}), b = gelu_pk((f32x2){v0[2], v0[3]}), c = gelu_pk((f32x2){v1[0], v1[1]}), d = gelu_pk((f32x2){v1[2], v1[3]});
                        v0 = (f32x4){a.x, a.y, b.x, b.y}; v1 = (f32x4){c.x, c.y, d.x, d.y}; }
                    v0 = v0 * sc; v1 = v1 * sc; u32x4 w; w.x = cvt_pk_bf16(v0[0], v0[1]); w.y = cvt_pk_bf16(v0[2], v0[3]); w.z = cvt_pk_bf16(v1[0], v1[1]); w.w = cvt_pk_bf16(v1[2], v1[3]);
                    *(u32x4*)(rowp + bj * HALF) = w; } }
    }
};
template <class Epi, class Sched, bool ALIGN_EPI = false, bool SP2 = false>
__device__ __forceinline__ void gemm_phase(PG8_LAS unsigned char* lds, const Gemm g, const Sched& S, const Epi& E) {
    const int tid = threadIdx.x, wid = __builtin_amdgcn_readfirstlane(tid >> 6), lane = tid & 63, wr = wid >> 2, wc = wid & 3, fr = lane & 15, fq = lane >> 4;
    const int K = g.K, nt = K / BK;
    unsigned voffA[2], voffB[2];
#pragma unroll
    for (int i = 0; i < 2; ++i) { int R, C; stage_rc(tid * 16 + i * 8192, R, C); const int Rb = Epi::PERM ? ((R & ~31) + perm32(R & 31)) : R;
        voffA[i] = (unsigned)(R * K + C) * 2u; voffB[i] = (unsigned)(Rb * K + C) * 2u; }
    const size_t kstep = (size_t)(BK * 2);
    const size_t hstep = (size_t)HALF * K * 2;
    const size_t tstep = 2 * hstep;
    const unsigned ldsw = (unsigned)wid * 1024u;
    const int aoff = lds_byte(wr * 64 + fr, fq * 8), boff = lds_byte(wc * 32 + fr, fq * 8);
#define PG8_SA(b, h) (((b) * 2 + (h)) * HTB)
#define PG8_SB(b, h) ((4 + (b) * 2 + (h)) * HTB)
#define PG8_STAGE(bufoff, gbase, voff) do { _Pragma("unroll") for (int _i = 0; _i < 2; ++_i) \
        __builtin_amdgcn_global_load_lds((const unsigned*)((const char*)(gbase) + (voff)[_i]), (PG8_LAS unsigned*)(lds + (bufoff) + ldsw + _i * 8192), 16, 0, 0); } while (0)
#define PG8_LDA(dst, b, h) do { _Pragma("unroll") for (int m = 0; m < 4; ++m) _Pragma("unroll") for (int k = 0; k < 2; ++k) dst[m][k] = *(const PG8_LAS bf16x8*)(lds + PG8_SA(b, h) + aoff + m * 2048 + k * 1024); } while (0)
#define PG8_LDB(dst, b, h) do { _Pragma("unroll") for (int n = 0; n < 2; ++n) _Pragma("unroll") for (int k = 0; k < 2; ++k) dst[n][k] = *(const PG8_LAS bf16x8*)(lds + PG8_SB(b, h) + boff + n * 2048 + k * 1024); } while (0)
#define PG8_MMA(ai, bj, At, Bt) do { __builtin_amdgcn_s_setprio(1); _Pragma("unroll") for (int m = 0; m < 4; ++m) _Pragma("unroll") for (int n = 0; n < 2; ++n) _Pragma("unroll") for (int k = 0; k < 2; ++k) \
        acc[ai][bj][m][n] = __builtin_amdgcn_mfma_f32_16x16x32_bf16(Bt[n][k], At[m][k], acc[ai][bj][m][n], 0, 0, 0); __builtin_amdgcn_s_setprio(0); } while (0)
#define PG8_WAIT_V(n) asm volatile("s_waitcnt vmcnt(" #n ")" ::: "memory")
#define PG8_WAIT_L(n) asm volatile("s_waitcnt lgkmcnt(" #n ")" ::: "memory")
#define PG8_BAR __builtin_amdgcn_s_barrier()
#define PG8_SCHED __builtin_amdgcn_sched_barrier(0)
    Unit cur, nxt; int ui = 0;
    if (!S.next(0, cur)) return;
    f32x4 acc[2][2][4][2];
#pragma unroll
    for (int a = 0; a < 2; ++a)
#pragma unroll
        for (int b = 0; b < 2; ++b)
#pragma unroll
            for (int m = 0; m < 4; ++m)
#pragma unroll
                for (int n = 0; n < 2; ++n) acc[a][b][m][n] = (f32x4){0.f, 0.f, 0.f, 0.f};
    bf16x8 At[4][2], B0[2][2], B1[2][2];
    const char* cA = (const char*)g.A + (size_t)cur.pm * tstep; const char* cB = (const char*)g.Bt + (size_t)cur.pn * tstep;
    S.a_ready(cur);
    if constexpr (SP2) {
        PG8_STAGE(PG8_SB(0, 0), cB, voffB); PG8_STAGE(PG8_SB(0, 1), cB + hstep, voffB); PG8_STAGE(PG8_SA(0, 0), cA, voffA); PG8_STAGE(PG8_SA(0, 1), cA + hstep, voffA);
        if (wr == 1) PG8_BAR;
        PG8_WAIT_V(2); PG8_BAR;
        PG8_STAGE(PG8_SB(1, 0), cB + kstep, voffB); PG8_STAGE(PG8_SA(1, 0), cA + kstep, voffA); PG8_STAGE(PG8_SB(1, 1), cB + hstep + kstep, voffB);
        PG8_WAIT_V(6); PG8_BAR;
    } else {
        PG8_STAGE(PG8_SB(0, 0), cB, voffB); PG8_STAGE(PG8_SA(0, 0), cA, voffA); PG8_STAGE(PG8_SB(0, 1), cB + hstep, voffB); PG8_STAGE(PG8_SA(0, 1), cA + hstep, voffA);
        if (wr == 1) PG8_BAR;
        PG8_WAIT_V(4); PG8_BAR;
        PG8_STAGE(PG8_SB(1, 0), cB + kstep, voffB); PG8_STAGE(PG8_SA(1, 0), cA + kstep, voffA); PG8_STAGE(PG8_SB(1, 1), cB + hstep + kstep, voffB);
        PG8_WAIT_V(6); PG8_BAR;
    }
    for (;;) {
        const bool has_next = S.next(ui + 1, nxt);
        const char* nA = has_next ? (const char*)g.A + (size_t)nxt.pm * tstep : cA; const char* nB = has_next ? (const char*)g.Bt + (size_t)nxt.pn * tstep : cB;
        for (int t = 0; t < nt; t += 2) {
            const bool last = (t == nt - 2);
            const char* a1 = cA + (size_t)(t + 1) * kstep;
            const char* a2 = last ? nA : cA + (size_t)(t + 2) * kstep; const char* b2 = last ? nB : cB + (size_t)(t + 2) * kstep;
            const char* a3 = a2 + kstep; const char* b3 = b2 + kstep;
            if (last && has_next) S.a_ready(nxt);
            if constexpr (SP2) {
            PG8_LDB(B0, 0, 0); PG8_LDB(B1, 0, 1); PG8_SCHED; PG8_LDA(At, 0, 0); PG8_STAGE(PG8_SA(1, 1), a1 + hstep, voffA);
            PG8_WAIT_V(8); PG8_WAIT_L(0); PG8_BAR; PG8_MMA(0, 0, At, B0); PG8_MMA(0, 1, At, B1); PG8_BAR; PG8_SCHED;
            PG8_LDA(At, 0, 1); PG8_STAGE(PG8_SB(0, 0), b2, voffB); PG8_STAGE(PG8_SB(0, 1), b2 + hstep, voffB); PG8_STAGE(PG8_SA(0, 0), a2, voffA);
            PG8_WAIT_V(8); PG8_WAIT_L(0); PG8_BAR; PG8_MMA(1, 0, At, B0); PG8_MMA(1, 1, At, B1); PG8_BAR; PG8_SCHED;
            PG8_LDB(B0, 1, 0); PG8_LDB(B1, 1, 1); PG8_SCHED; PG8_LDA(At, 1, 0); PG8_STAGE(PG8_SA(0, 1), a2 + hstep, voffA);
            PG8_WAIT_V(8); PG8_WAIT_L(0); PG8_BAR; PG8_MMA(0, 0, At, B0); PG8_MMA(0, 1, At, B1); PG8_BAR; PG8_SCHED;
            PG8_LDA(At, 1, 1); PG8_STAGE(PG8_SB(1, 0), b3, voffB); PG8_STAGE(PG8_SB(1, 1), b3 + hstep, voffB); PG8_STAGE(PG8_SA(1, 0), a3, voffA);
            PG8_WAIT_V(8); PG8_WAIT_L(0); PG8_BAR; PG8_MMA(1, 0, At, B0); PG8_MMA(1, 1, At, B1); PG8_BAR; PG8_SCHED;
            } else {
            PG8_LDB(B0, 0, 0); PG8_SCHED; PG8_LDA(At, 0, 0); PG8_STAGE(PG8_SA(1, 1), a1 + hstep, voffA);
            PG8_WAIT_L(8); PG8_BAR; PG8_WAIT_L(0); PG8_MMA(0, 0, At, B0); PG8_BAR; PG8_SCHED;
            PG8_LDB(B1, 0, 1); PG8_STAGE(PG8_SB(0, 0), b2, voffB);
            PG8_BAR; PG8_WAIT_L(0); PG8_MMA(0, 1, At, B1); PG8_BAR;
            PG8_LDA(At, 0, 1); PG8_STAGE(PG8_SA(0, 0), a2, voffA);
            PG8_BAR; PG8_WAIT_L(0); PG8_MMA(1, 0, At, B0); PG8_BAR; PG8_SCHED;
            PG8_STAGE(PG8_SB(0, 1), b2 + hstep, voffB);
            PG8_WAIT_V(6); PG8_BAR; PG8_MMA(1, 1, At, B1); PG8_BAR;
            PG8_LDB(B0, 1, 0); PG8_SCHED; PG8_LDA(At, 1, 0); PG8_STAGE(PG8_SA(0, 1), a2 + hstep, voffA);
            PG8_WAIT_L(8); PG8_BAR; PG8_WAIT_L(0); PG8_MMA(0, 0, At, B0); PG8_BAR; PG8_SCHED;
            PG8_LDB(B1, 1, 1); PG8_STAGE(PG8_SB(1, 0), b3, voffB);
            PG8_BAR; PG8_WAIT_L(0); PG8_MMA(0, 1, At, B1); PG8_BAR;
            PG8_LDA(At, 1, 1); PG8_STAGE(PG8_SA(1, 0), a3, voffA);
            PG8_BAR; PG8_WAIT_L(0); PG8_MMA(1, 0, At, B0); PG8_BAR; PG8_SCHED;
            PG8_STAGE(PG8_SB(1, 1), b3 + hstep, voffB);
            PG8_WAIT_V(6); PG8_BAR; PG8_MMA(1, 1, At, B1); PG8_BAR;
            }
        }
        if constexpr (ALIGN_EPI) { if (wr == 0) PG8_BAR; }
        if constexpr (!Epi::AFTER_DRAIN) { E(acc, cur, wr, wc, fr, fq); S.done(cur); }
        if (!has_next) break;
#pragma unroll
        for (int a = 0; a < 2; ++a)
#pragma unroll
            for (int b = 0; b < 2; ++b)
#pragma unroll
                for (int m = 0; m < 4; ++m)
#pragma unroll
                    for (int n = 0; n < 2; ++n) acc[a][b][m][n] = (f32x4){0.f, 0.f, 0.f, 0.f};
        cur = nxt; cA = nA; cB = nB; ++ui;
        if constexpr (ALIGN_EPI) { if (wr == 1) PG8_BAR; }
    }
    PG8_WAIT_V(0);
    if constexpr (!ALIGN_EPI) { if (wr == 0) PG8_BAR; }
    PG8_BAR;
    if constexpr (Epi::AFTER_DRAIN) { E.fused(acc, cur, wr, wc, fr, fq, lds, wid, lane); S.done(cur); }
#undef PG8_SA
#undef PG8_SB
#undef PG8_STAGE
#undef PG8_LDA
#undef PG8_LDB
#undef PG8_MMA
#undef PG8_WAIT_V
#undef PG8_WAIT_L
#undef PG8_BAR
#undef PG8_SCHED
}
}

namespace mk {
typedef unsigned short bf16_t;
typedef float f32x4 __attribute__((ext_vector_type(4)));
typedef unsigned u32x4 __attribute__((ext_vector_type(4)));
typedef unsigned u32x2 __attribute__((ext_vector_type(2)));
typedef float f32x2 __attribute__((ext_vector_type(2)));
#define LAS __attribute__((address_space(3)))

constexpr int BATCH = 16, SEQ = 2048, DM = 1024, M = BATCH * SEQ;
constexpr int NA = 1792, NB = 2560, N1 = NA + NB;
constexpr int N3 = 3072;
constexpr int EVEN_IN = 4224, SHIFT_W = 1664;
constexpr float RMS_EPS = 1e-6f, LN_EPS = 1e-5f, GN_EPS = 64e-5f;
constexpr int NTHR = 512;

constexpr size_t MiB = 1u << 20;
constexpr size_t WS_CTR = 768 * 1024;
constexpr size_t WS_LW = 23 * MiB + 512 * 1024;
constexpr size_t WS_SGW = 23 * MiB;
constexpr size_t WS_RS0 = 0, WS_RS1 = 128 * 1024, WS_RS2 = 256 * 1024, WS_VSUM = 384 * 1024, WS_VSQ = 512 * 1024, WS_BON = 1 * MiB;
constexpr size_t WS_BAR = 2 * MiB;
constexpr size_t WS_PCNT = 2 * MiB + 65536;
constexpr size_t WS_EXCH = 3 * MiB;
constexpr size_t WS_W1T = 4 * MiB, WS_W2T = 13 * MiB, WS_W3T = 15 * MiB, WS_W4T = 21 * MiB;
constexpr size_t WS_XN = 24 * MiB;
constexpr size_t WS_PA = 88 * MiB;
constexpr size_t WS_PB = 200 * MiB;
constexpr size_t WS_YMIX = 360 * MiB;
constexpr size_t WS_TAIL = 424 * MiB;
constexpr size_t WS_VRAW = 448 * MiB;
constexpr size_t WS_END = 480 * MiB;
constexpr int RSZ = 12544;
constexpr size_t WS_P1 = WS_PA;
constexpr int LDS_BYTES = 147456;

struct Args {
    const float* in[22];
    float* out; unsigned char* ws;
    int lo, hi;
    int rep[4];
};
enum { I_X = 0, I_NORMG, I_WINE, I_SHMU, I_W0, I_W2, I_A0, I_A2, I_KK, I_KA, I_RK, I_LNXG, I_LNXB, I_ABIAS, I_WOUTE, I_WINO, I_SGLNG, I_SGLNB, I_SGW, I_SGB, I_WOUTO, I_FG };

__device__ __forceinline__ float bf2f(unsigned short h) { return __uint_as_float((unsigned)h << 16); }
typedef __bf16 bf2_t __attribute__((ext_vector_type(2)));
__device__ __forceinline__ unsigned pk2(float lo, float hi) { const f32x2 v = {lo, hi}; const bf2_t b = __builtin_convertvector(v, bf2_t); return __builtin_bit_cast(unsigned, b); }
__device__ __forceinline__ unsigned short f2bf(float f) { return (unsigned short)(pk2(f, 0.f) & 0xffffu); }
__device__ __forceinline__ float bflo(unsigned w) { return __uint_as_float(w << 16); }
__device__ __forceinline__ float bfhi(unsigned w) { return __uint_as_float(w & 0xffff0000u); }
__device__ __forceinline__ float wave_sum(float v) {
#pragma unroll
    for (int o = 1; o < 64; o <<= 1) v += __shfl_xor(v, o);
    return v;
}
__device__ __forceinline__ float sigmoidf_(float x) { return __builtin_amdgcn_rcpf(1.0f + __expf(-x)); }
__device__ __forceinline__ float siluf_(float x) { return x * sigmoidf_(x); }
__device__ __forceinline__ float gelu_tanh(float x) { const float t = x * x; const float q = x * __builtin_fmaf(t, -0.10294324f, -2.3022082f);
    return x * __builtin_amdgcn_rcpf(1.0f + __builtin_amdgcn_exp2f(q)); }

__device__ __forceinline__ void phase_prologue(const Args& a, unsigned char* ldsb) {
    const int tid = threadIdx.x, lane = tid & 63, wave = tid >> 6;
    unsigned char* ws = a.ws;
    const int gtid = blockIdx.x * NTHR + tid, nthr = gridDim.x * NTHR;
    {
        LAS float* scr = (LAS float*)((LAS unsigned char*)ldsb + wave * 8448);
        constexpr int NB1 = N1 / 32, NB2 = 32, NB3 = N3 / 32, NB4 = 32, NITEM = (NB1 + NB2 + NB3 + NB4) * 16;
        for (int it = blockIdx.x * 8 + wave; it < NITEM; it += gridDim.x * 8) {
            int nb = it >> 4; const int k0 = (it & 15) * 64;
            const float* src; const float* g; int N, col0; bf16_t* dst; bool zero = false;
            if (nb < NB1) { const int n0 = nb * 32; src = a.in[I_WINE]; g = a.in[I_NORMG]; N = EVEN_IN; dst = (bf16_t*)(ws + WS_W1T) + (size_t)n0 * 1024;
                if (n0 < SHIFT_W) col0 = n0; else if (n0 < NA) { col0 = 0; zero = true; } else col0 = n0 - (NA - SHIFT_W); }
            else if ((nb -= NB1) < NB2) { src = a.in[I_WOUTE]; g = nullptr; N = 1024; col0 = nb * 32; dst = (bf16_t*)(ws + WS_W2T) + (size_t)col0 * 1024; }
            else if ((nb -= NB2) < NB3) { src = a.in[I_WINO]; g = a.in[I_NORMG] + 1024; N = N3; col0 = nb * 32; dst = (bf16_t*)(ws + WS_W3T) + (size_t)col0 * 1024; }
            else { nb -= NB3; src = a.in[I_WOUTO]; g = nullptr; N = 1024; col0 = nb * 32; dst = (bf16_t*)(ws + WS_W4T) + (size_t)col0 * 1024; }
            float xv[32];
#pragma unroll
            for (int i = 0; i < 32; ++i) { const int kk = 2 * i + (lane >> 5); xv[i] = zero ? 0.f : src[(size_t)(k0 + kk) * N + col0 + (lane & 31)]; }
#pragma unroll
            for (int i = 0; i < 32; ++i) { const int kk = 2 * i + (lane >> 5); float x = xv[i]; if (g) x *= g[k0 + kk]; scr[kk * 33 + (lane & 31)] = x; }
            asm volatile("s_waitcnt lgkmcnt(0)" ::: "memory");
            const int c8 = lane & 7;
#pragma unroll
            for (int j = 0; j < 4; ++j) { const int n = (lane >> 3) + 8 * j; const LAS float* sp = scr + (8 * c8) * 33 + n;
                u32x4 o; o.x = pk2(sp[0 * 33], sp[1 * 33]); o.y = pk2(sp[2 * 33], sp[3 * 33]); o.z = pk2(sp[4 * 33], sp[5 * 33]); o.w = pk2(sp[6 * 33], sp[7 * 33]);
                *(u32x4*)(dst + (size_t)n * 1024 + k0 + 8 * c8) = o; }
            asm volatile("s_waitcnt lgkmcnt(0)" ::: "memory");
        }
    }
    const float* x = a.in[I_X]; bf16_t* XN = (bf16_t*)(ws + WS_XN); float* rs0 = (float*)(ws + WS_RS0);
    const int gw = blockIdx.x * 8 + wave, NGW = gridDim.x * 8;
    for (int m0 = gw; m0 < M; m0 += 8 * NGW) {
        f32x4 v[8][4];
#pragma unroll
        for (int r = 0; r < 8; ++r) { const int m = m0 + r * NGW; if (m < M) { const f32x4* xr = (const f32x4*)(x + (size_t)m * DM) + lane;
#pragma unroll
            for (int j = 0; j < 4; ++j) v[r][j] = __builtin_nontemporal_load(xr + 64 * j); } }
#pragma unroll
        for (int r = 0; r < 8; ++r) { const int m = m0 + r * NGW; if (m < M) {
            float s = 0.f;
#pragma unroll
            for (int j = 0; j < 4; ++j) s += (v[r][j].x * v[r][j].x + v[r][j].y * v[r][j].y) + (v[r][j].z * v[r][j].z + v[r][j].w * v[r][j].w);
            s = wave_sum(s);
            const float rinv = rsqrtf(s * (1.0f / DM) + RMS_EPS);
            u32x2* o = (u32x2*)(XN + (size_t)m * DM) + lane;
#pragma unroll
            for (int j = 0; j < 4; ++j) { u32x2 w; w.x = pk2(v[r][j].x * rinv, v[r][j].y * rinv); w.y = pk2(v[r][j].z * rinv, v[r][j].w * rinv); o[64 * j] = w; }
            if (lane == 0) rs0[m] = s; } }
    }
    float* rs1 = (float*)(ws + WS_RS1); float* rs2 = (float*)(ws + WS_RS2); float* vsum = (float*)(ws + WS_VSUM); float* vsq = (float*)(ws + WS_VSQ);
    for (int i = gtid; i < M; i += nthr) { rs1[i] = 0.f; rs2[i] = 0.f; vsum[i] = 0.f; vsq[i] = 0.f; }
    { bf16_t* LW = (bf16_t*)(ws + WS_LW); const float* w2 = a.in[I_W2]; const float* a2 = a.in[I_A2];
      for (int i = gtid; i < 2 * 512 * 64; i += nthr) { const int j = i & 63, cc = (i >> 6) & 511, mat = i >> 15; LW[i] = f2bf((mat ? a2 : w2)[j * 512 + cc]); } }
    { bf16_t* SGW = (bf16_t*)(ws + WS_SGW); const float* sgw = a.in[I_SGW];
      for (int i = gtid; i < 8 * 128 * 128; i += nthr) { const int jj = i & 127, ii = (i >> 7) & 127; SGW[i] = f2bf(((jj >> 6) <= (ii >> 6)) ? sgw[i] : 0.f); } }
}

struct EpiG1 {
    const float* rs0; bf16_t* PA; bf16_t* PB;
    static constexpr int NSTAT = 0; static constexpr bool HAS_RES = false;
    __device__ __forceinline__ float rowval(int) const { return 0.f; }
    __device__ __forceinline__ f32x4 resload(int, int) const { return (f32x4){0.f, 0.f, 0.f, 0.f}; }
    __device__ __forceinline__ void commit(int, float, float) const {}
    __device__ __forceinline__ f32x2 operator()(int row, int col, f32x4 v0, f32x4 v1, float = 0.f) const {
        u32x4 w; w.x = pk2(v0[0], v0[1]); w.y = pk2(v0[2], v0[3]); w.z = pk2(v1[0], v1[1]); w.w = pk2(v1[2], v1[3]);
        bf16_t* dst = col < NA ? PA + (size_t)row * NA + col : PB + (size_t)row * NB + (col - NA);
        *(u32x4*)dst = w;
        return (f32x2){0.f, 0.f};
    }
};
struct EpiG2 {
    const float* x; float* out; bf16_t* HB; float* rs1;
    __device__ __forceinline__ float quad(int row, int col, f32x4 v) const {
        const size_t off = (size_t)row * DM + col;
        v = v + *(const f32x4*)(x + off);
        *(f32x4*)(out + off) = v;
        u32x2 w; w.x = pk2(v[0], v[1]); w.y = pk2(v[2], v[3]);
        *(u32x2*)(HB + off) = w;
        return (v[0] * v[0] + v[1] * v[1]) + (v[2] * v[2] + v[3] * v[3]);
    }
    static constexpr int NSTAT = 1; static constexpr bool HAS_RES = true;
    __device__ __forceinline__ float rowval(int) const { return 0.f; }
    __device__ __forceinline__ f32x4 resload(int row, int col) const { return *(const f32x4*)(x + (size_t)row * DM + col); }
    __device__ __forceinline__ void commit(int row, float s0, float) const { unsafeAtomicAdd(rs1 + row, s0); }
    __device__ __forceinline__ f32x2 operator()(int row, int col, f32x4 v0, f32x4 v1, float = 0.f) const {
        const size_t off = (size_t)row * DM + col;
        __builtin_nontemporal_store(v0, (f32x4*)(out + off)); __builtin_nontemporal_store(v1, (f32x4*)(out + off + 4));
        u32x4 w; w.x = pk2(v0[0], v0[1]); w.y = pk2(v0[2], v0[3]); w.z = pk2(v1[0], v1[1]); w.w = pk2(v1[2], v1[3]);
        *(u32x4*)(HB + off) = w;
        const float s = (v0[0] * v0[0] + v0[1] * v0[1]) + (v0[2] * v0[2] + v0[3] * v0[3]) + (v1[0] * v1[0] + v1[1] * v1[1]) + (v1[2] * v1[2] + v1[3] * v1[3]);
        return (f32x2){s, 0.f};
    }
};
struct EpiG3 {
    const float* rs1; bf16_t* P1; float* vsum; float* vsq;
    static constexpr int NSTAT = 2; static constexpr bool HAS_RES = false;
    __device__ __forceinline__ float rowval(int row) const { return rs1[row]; }
    __device__ __forceinline__ f32x4 resload(int, int) const { return (f32x4){0.f, 0.f, 0.f, 0.f}; }
    __device__ __forceinline__ void commit(int row, float s0, float s1) const { if (s1 != 0.f) { unsafeAtomicAdd(vsum + row, s0); unsafeAtomicAdd(vsq + row, s1); } }
    __device__ __forceinline__ f32x2 operator()(int row, int col, f32x4 v0, f32x4 v1, float rsv) const {
        f32x2 ret = (f32x2){0.f, 0.f};
        const float rinv = rsqrtf(rsv * (1.0f / DM) + RMS_EPS);
        float v[8];
#pragma unroll
        for (int j = 0; j < 4; ++j) { v[j] = v0[j] * rinv; v[4 + j] = v1[j] * rinv; }
        if (col < 2048) {
#pragma unroll
            for (int j = 0; j < 8; ++j) v[j] = gelu_tanh(v[j]);
            if (col >= 1024) {
                float s = 0.f, q = 0.f;
#pragma unroll
                for (int j = 0; j < 8; ++j) { s += v[j]; q += v[j] * v[j]; }
                ret = (f32x2){s, q};
            }
        } else {
#pragma unroll
            for (int j = 0; j < 8; ++j) v[j] = siluf_(v[j]);
        }
        u32x4 w; w.x = pk2(v[0], v[1]); w.y = pk2(v[2], v[3]); w.z = pk2(v[4], v[5]); w.w = pk2(v[6], v[7]);
        *(u32x4*)(P1 + (size_t)row * N3 + col) = w;
        return ret;
    }
};
struct EpiG4 {
    float* out; float* rs2;
    __device__ __forceinline__ float quad(int row, int col, f32x4 v) const {
        const size_t off = (size_t)row * DM + col;
        v = v + *(const f32x4*)(out + off);
        *(f32x4*)(out + off) = v;
        return (v[0] * v[0] + v[1] * v[1]) + (v[2] * v[2] + v[3] * v[3]);
    }
    static constexpr int NSTAT = 1; static constexpr bool HAS_RES = false;
    __device__ __forceinline__ float rowval(int) const { return 0.f; }
    __device__ __forceinline__ f32x4 resload(int, int) const { return (f32x4){0.f, 0.f, 0.f, 0.f}; }
    __device__ __forceinline__ void commit(int row, float s0, float) const { unsafeAtomicAdd(rs2 + row, s0); }
    __device__ __forceinline__ f32x2 operator()(int row, int col, f32x4 v0, f32x4 v1, float = 0.f) const {
        const size_t off = (size_t)row * DM + col;
        v0 = v0 + *(const f32x4*)(out + off); v1 = v1 + *(const f32x4*)(out + off + 4);
        *(f32x4*)(out + off) = v0; *(f32x4*)(out + off + 4) = v1;
        const float s = (v0[0] * v0[0] + v0[1] * v0[1]) + (v0[2] * v0[2] + v0[3] * v0[3]) + (v1[0] * v1[0] + v1[1] * v1[1]) + (v1[2] * v1[2] + v1[3] * v1[3]);
        return (f32x2){s, 0.f};
    }
};


struct EpiG4X {
    static constexpr bool PERM = true, AFTER_DRAIN = false;
    float* out; const float* fg; float* exch; unsigned* cnt; LAS unsigned char* scr;
    __device__ __forceinline__ void operator()(pg8::f32x4 (&acc)[2][2][4][2], const pg8::Unit& u, int wr_, int wc_, int fr_, int fq_) const {
        int tid = threadIdx.x, wr = wr_, wc = wc_, fr = fr_, fq = fq_;
        asm volatile("" : "+v"(tid), "+v"(fr), "+v"(fq));
        const int lane = tid & 63;
        LAS float* P = (LAS float*)scr;
        LAS float* S = (LAS float*)(scr + 4096);
#pragma unroll
        for (int ai = 0; ai < 2; ++ai)
#pragma unroll
            for (int m = 0; m < 4; ++m) {
                const int rl = ai * 128 + wr * 64 + m * 16 + fr; const size_t rowoff = (size_t)(u.pm * 256 + rl) * DM;
                float sq = 0.f;
#pragma unroll
                for (int bj = 0; bj < 2; ++bj) { const size_t off = rowoff + u.pn * 256 + bj * 128 + wc * 32 + 8 * fq;
                    f32x4 v0 = acc[ai][bj][m][0] + *(const f32x4*)(out + off), v1 = acc[ai][bj][m][1] + *(const f32x4*)(out + off + 4);
                    acc[ai][bj][m][0] = v0; acc[ai][bj][m][1] = v1;
                    sq += ((v0[0] * v0[0] + v0[1] * v0[1]) + (v0[2] * v0[2] + v0[3] * v0[3])) + ((v1[0] * v1[0] + v1[1] * v1[1]) + (v1[2] * v1[2] + v1[3] * v1[3])); }
                sq += __shfl_xor(sq, 16); sq += __shfl_xor(sq, 32);
                if (fq == 0) P[rl * 4 + wc] = sq;
                if (m == 3) asm volatile("" ::: "memory");
            }
        asm volatile("s_waitcnt vmcnt(0) lgkmcnt(0)" ::: "memory"); __builtin_amdgcn_s_barrier(); asm volatile("" ::: "memory");
        if (tid < 256) {
            const f32x4 p = *(const LAS f32x4*)(P + tid * 4);
            __hip_atomic_store(exch + (size_t)(u.pm * 256 + tid) * 4 + u.pn, (p[0] + p[1]) + (p[2] + p[3]), __ATOMIC_RELAXED, __HIP_MEMORY_SCOPE_AGENT);
            asm volatile("s_waitcnt vmcnt(0)" ::: "memory");
            if (lane == 0) __hip_atomic_fetch_add(cnt + 64 * u.pm, 1u, __ATOMIC_RELAXED, __HIP_MEMORY_SCOPE_AGENT);
        }
        if (tid < 64) {
            unsigned spins = 0;
            while ((unsigned)__builtin_amdgcn_readfirstlane(__hip_atomic_load(cnt + 64 * u.pm, __ATOMIC_RELAXED, __HIP_MEMORY_SCOPE_AGENT)) < 16u) { __builtin_amdgcn_s_sleep(2); if (++spins > (1u << 22)) break; }
            __builtin_amdgcn_fence(__ATOMIC_ACQUIRE, "agent");
        }
        asm volatile("s_waitcnt vmcnt(0) lgkmcnt(0)" ::: "memory"); __builtin_amdgcn_s_barrier(); asm volatile("" ::: "memory");
        if (tid < 256) {
            const float* e = exch + (size_t)(u.pm * 256 + tid) * 4;
            const float t = (__hip_atomic_load(e, __ATOMIC_RELAXED, __HIP_MEMORY_SCOPE_AGENT) + __hip_atomic_load(e + 1, __ATOMIC_RELAXED, __HIP_MEMORY_SCOPE_AGENT))
                          + (__hip_atomic_load(e + 2, __ATOMIC_RELAXED, __HIP_MEMORY_SCOPE_AGENT) + __hip_atomic_load(e + 3, __ATOMIC_RELAXED, __HIP_MEMORY_SCOPE_AGENT));
            S[tid] = rsqrtf(t * (1.0f / DM) + RMS_EPS);
        }
        asm volatile("s_waitcnt vmcnt(0) lgkmcnt(0)" ::: "memory"); __builtin_amdgcn_s_barrier(); asm volatile("" ::: "memory");
        const int pm5 = u.pm, pn5 = u.pn;
#pragma unroll
        for (int bj = 0; bj < 2; ++bj) {
            const int colb = pn5 * 256 + bj * 128 + wc * 32 + 8 * fq;
            const f32x4 g0 = *(const f32x4*)(fg + colb), g1 = *(const f32x4*)(fg + colb + 4);
#pragma unroll
            for (int ai = 0; ai < 2; ++ai)
#pragma unroll
                for (int m = 0; m < 4; ++m) {
                    const int rl = ai * 128 + wr * 64 + m * 16 + fr; const float rinv = S[rl];
                    const size_t off = (size_t)(pm5 * 256 + rl) * DM + colb;
                    __builtin_nontemporal_store(acc[ai][bj][m][0] * rinv * g0, (f32x4*)(out + off)); __builtin_nontemporal_store(acc[ai][bj][m][1] * rinv * g1, (f32x4*)(out + off + 4));
                }
        }
        asm volatile("s_waitcnt lgkmcnt(0)" ::: "memory"); __builtin_amdgcn_s_barrier(); asm volatile("" ::: "memory");
    }
};

template <class F> struct EpiAdapt {
    static constexpr bool PERM = true, AFTER_DRAIN = false;
    F f;
    __device__ __forceinline__ void operator()(const pg8::f32x4 (&acc)[2][2][4][2], const pg8::Unit& u, int wr, int wc, int fr, int fq) const {
        float rv[2][4];
#pragma unroll
        for (int ai = 0; ai < 2; ++ai)
#pragma unroll
            for (int m = 0; m < 4; ++m) rv[ai][m] = f.rowval(u.pm * 256 + ai * 128 + wr * 64 + m * 16 + fr);
#pragma unroll
        for (int ai = 0; ai < 2; ++ai) {
            f32x4 res[4][2][2];
            if (F::HAS_RES) {
#pragma unroll
                for (int m = 0; m < 4; ++m)
#pragma unroll
                    for (int bj = 0; bj < 2; ++bj) { const int row = u.pm * 256 + ai * 128 + wr * 64 + m * 16 + fr; const int col = u.pn * 256 + bj * 128 + wc * 32 + 8 * fq;
                        res[m][bj][0] = f.resload(row, col); res[m][bj][1] = f.resload(row, col + 4); }
                asm volatile("" ::: "memory");
            }
#pragma unroll
            for (int m = 0; m < 4; ++m) {
                const int row = u.pm * 256 + ai * 128 + wr * 64 + m * 16 + fr;
                f32x2 st = (f32x2){0.f, 0.f};
#pragma unroll
                for (int bj = 0; bj < 2; ++bj) { const int col = u.pn * 256 + bj * 128 + wc * 32 + 8 * fq;
                    f32x4 a0 = acc[ai][bj][m][0], a1 = acc[ai][bj][m][1];
                    if (F::HAS_RES) { a0 = a0 + res[m][bj][0]; a1 = a1 + res[m][bj][1]; }
                    const f32x2 r = f(row, col, a0, a1, rv[ai][m]); st = st + r; }
                if (F::NSTAT >= 1) { st.x += __shfl_xor(st.x, 16); st.x += __shfl_xor(st.x, 32); }
                if (F::NSTAT >= 2) { st.y += __shfl_xor(st.y, 16); st.y += __shfl_xor(st.y, 32); }
                if (F::NSTAT >= 1 && fq == 0) f.commit(row, st.x, st.y);
            }
        }
    }
};


template <class F> struct EpiAdaptNP {
    static constexpr bool PERM = false, AFTER_DRAIN = false;
    F f;
    __device__ __forceinline__ void operator()(const pg8::f32x4 (&acc)[2][2][4][2], const pg8::Unit& u, int wr, int wc, int fr, int fq) const {
#pragma unroll
        for (int ai = 0; ai < 2; ++ai)
#pragma unroll
            for (int m = 0; m < 4; ++m) {
                const int row = u.pm * 256 + ai * 128 + wr * 64 + m * 16 + fr;
                float st = 0.f;
#pragma unroll
                for (int bj = 0; bj < 2; ++bj)
#pragma unroll
                    for (int n = 0; n < 2; ++n) { const int col = u.pn * 256 + bj * 128 + wc * 32 + 16 * n + 4 * fq; st += f.quad(row, col, acc[ai][bj][m][n]); }
                st += __shfl_xor(st, 16); st += __shfl_xor(st, 32);
                if (fq == 0) f.commit(row, st, 0.f);
            }
    }
};

template <class F> __device__ __forceinline__ void gemm_naive(float* lds, const bf16_t* A, const bf16_t* Bt, int Mm, int N, int K, const F& f) {
    const int tid = threadIdx.x, ty = tid >> 4, tx = tid & 15;
    float* As = lds; float* Bs = lds + 32 * 132;
    const int ntn = N / 128, ntiles = (Mm / 128) * ntn;
    for (int tile = blockIdx.x; tile < ntiles; tile += gridDim.x) {
        const int tm = tile / ntn, tn = tile % ntn;
        float acc[4][8];
#pragma unroll
        for (int i = 0; i < 4; ++i)
#pragma unroll
            for (int j = 0; j < 8; ++j) acc[i][j] = 0.f;
        for (int k0 = 0; k0 < K; k0 += 32) {
            { const int row = tid >> 2, kc = (tid & 3) * 8;
              const u32x4 va = *(const u32x4*)(A + (size_t)(tm * 128 + row) * K + k0 + kc);
              const u32x4 vb = *(const u32x4*)(Bt + (size_t)(tn * 128 + row) * K + k0 + kc);
              As[(kc + 0) * 132 + row] = bflo(va.x); As[(kc + 1) * 132 + row] = bfhi(va.x); As[(kc + 2) * 132 + row] = bflo(va.y); As[(kc + 3) * 132 + row] = bfhi(va.y);
              As[(kc + 4) * 132 + row] = bflo(va.z); As[(kc + 5) * 132 + row] = bfhi(va.z); As[(kc + 6) * 132 + row] = bflo(va.w); As[(kc + 7) * 132 + row] = bfhi(va.w);
              Bs[(kc + 0) * 132 + row] = bflo(vb.x); Bs[(kc + 1) * 132 + row] = bfhi(vb.x); Bs[(kc + 2) * 132 + row] = bflo(vb.y); Bs[(kc + 3) * 132 + row] = bfhi(vb.y);
              Bs[(kc + 4) * 132 + row] = bflo(vb.z); Bs[(kc + 5) * 132 + row] = bfhi(vb.z); Bs[(kc + 6) * 132 + row] = bflo(vb.w); Bs[(kc + 7) * 132 + row] = bfhi(vb.w); }
            __syncthreads();
#pragma unroll 8
            for (int kk = 0; kk < 32; ++kk) {
                const f32x4 a4 = *(const f32x4*)(As + kk * 132 + ty * 4);
                const f32x4 b0 = *(const f32x4*)(Bs + kk * 132 + tx * 8), b1 = *(const f32x4*)(Bs + kk * 132 + tx * 8 + 4);
#pragma unroll
                for (int i = 0; i < 4; ++i) {
#pragma unroll
                    for (int j = 0; j < 4; ++j) { acc[i][j] += a4[i] * b0[j]; acc[i][4 + j] += a4[i] * b1[j]; }
                }
            }
            __syncthreads();
        }
#pragma unroll
        for (int i = 0; i < 4; ++i) { const f32x2 r = f(tm * 128 + ty * 4 + i, tn * 128 + tx * 8, (f32x4){acc[i][0], acc[i][1], acc[i][2], acc[i][3]}, (f32x4){acc[i][4], acc[i][5], acc[i][6], acc[i][7]}); if (F::NSTAT >= 1) f.commit(tm * 128 + ty * 4 + i, r.x, r.y); }
    }
}

template <class F> __device__ __forceinline__ void gemm_np(unsigned char* lds, const bf16_t* A, const bf16_t* Bt, int Mm, int N, int K, const F& f) {
    pg8::Gemm g{A, Bt, Mm, N, K}; pg8::StaticOrder S; S.init(Mm, N, (int)gridDim.x, (int)blockIdx.x);
    EpiAdaptNP<F> E{f};
    pg8::gemm_phase<EpiAdaptNP<F>, pg8::StaticOrder, false, true>((PG8_LAS unsigned char*)lds, g, S, E);
}
template <class F, bool ALIGN = true> __device__ __forceinline__ void gemm_any(unsigned char* lds, const bf16_t* A, const bf16_t* Bt, int Mm, int N, int K, const F& f) {
#if USE_PG8
    pg8::Gemm g{A, Bt, Mm, N, K}; pg8::StaticOrder S; S.init(Mm, N, (int)gridDim.x, (int)blockIdx.x);
    EpiAdapt<F> E{f};
    pg8::gemm_phase<EpiAdapt<F>, pg8::StaticOrder, ALIGN, true>((PG8_LAS unsigned char*)lds, g, S, E);
#else
    gemm_naive((float*)lds, A, Bt, Mm, N, K, f);
#endif
}

typedef short pbf16x8 __attribute__((ext_vector_type(8)));
template <int CTRL> __device__ __forceinline__ float pdpp_add(float x) { return x + __uint_as_float(__builtin_amdgcn_update_dpp(0, __float_as_uint(x), CTRL, 0xf, 0xf, true)); }
__device__ __forceinline__ float wave_sum_dpp(float x) {
    x = pdpp_add<0x128>(x); x = pdpp_add<0x124>(x); x = pdpp_add<0x122>(x); x = pdpp_add<0x121>(x);
    const unsigned u = __float_as_uint(x);
    return (__uint_as_float(__builtin_amdgcn_readlane(u, 0)) + __uint_as_float(__builtin_amdgcn_readlane(u, 16))) + (__uint_as_float(__builtin_amdgcn_readlane(u, 32)) + __uint_as_float(__builtin_amdgcn_readlane(u, 48)));
}
__device__ __forceinline__ void lds_barrier() { asm volatile("s_waitcnt lgkmcnt(0)" ::: "memory"); __builtin_amdgcn_s_barrier(); asm volatile("" ::: "memory"); }
__device__ __forceinline__ unsigned char* rec_base(const Args& a, int u) {
    if (u < 80) return (unsigned char*)a.out + (size_t)u * 128 * RSZ;
    if (u < 118) return a.ws + WS_XN + (size_t)(u - 80) * 128 * RSZ;
    return a.ws + WS_TAIL + (size_t)(u - 118) * 128 * RSZ;
}
__device__ __forceinline__ void phase_prep(const Args& a, unsigned char* ldsb, int variant = 0) {
    const int tid = threadIdx.x, lane = tid & 63, wave = tid >> 6, fr = lane & 15, quad = lane >> 4;
    unsigned char* ws = a.ws;
    const bf16_t* PA = (const bf16_t*)(ws + WS_PA);
    bf16_t* VR = (bf16_t*)(ws + WS_VRAW); float* BON = (float*)(ws + WS_BON);
    const float* mu = a.in[I_SHMU];
    LAS unsigned char* lds = (LAS unsigned char*)ldsb;
    constexpr int HAT_OFF = 69888;
    constexpr int XPB = 272;
    constexpr int RES_OFF = 4352;
    if (blockIdx.x == 0 && tid == 0) *(unsigned*)(ws + WS_CTR) = 0u;
    const int c = tid;
    const float w0 = a.in[I_W0][c], a0 = a.in[I_A0][c], kkc = a.in[I_KK][c], kac = a.in[I_KA][c], rkc = a.in[I_RK][c];
    const float mur = mu[c], muk = mu[512 + c], muv = mu[1024 + c];
    const bf16_t* LW = (const bf16_t*)(ws + WS_LW);
    pbf16x8 wf[2][4][2];
#pragma unroll
    for (int mat = 0; mat < 2; ++mat)
#pragma unroll
        for (int mt = 0; mt < 4; ++mt)
#pragma unroll
            for (int ks = 0; ks < 2; ++ks) wf[mat][mt][ks] = *(const pbf16x8*)(LW + (size_t)(mat * 512 + wave * 64 + mt * 16 + fr) * 64 + ks * 32 + 8 * quad);
    const int stok = tid >> 5, sj4 = (tid & 31) * 4;
    const f32x4 smu = *(const f32x4*)(mu + 1536 + sj4);
    u32x2 spw, sqw;
#define PREP_SLOAD(uu) do { const int t_ = (uu) * 16 + stok; spw = *(const u32x2*)(PA + (size_t)t_ * NA + 1536 + sj4); sqw = spw; if ((t_ % SEQ) != 0) sqw = *(const u32x2*)(PA + (size_t)(t_ - 1) * NA + 1536 + sj4); } while (0)
    if ((int)blockIdx.x < M / 16) PREP_SLOAD(blockIdx.x);
    for (int u = blockIdx.x; u < M / 16; u += gridDim.x) {
        const int t0 = u * 16;
        unsigned short gr[17], gk[17], gv[17];
        { const bool first0 = (t0 % SEQ) == 0;
          gr[0] = 0; gk[0] = 0; gv[0] = 0;
          if (!first0) { const bf16_t* q = PA + (size_t)(t0 - 1) * NA; gr[0] = q[c]; gk[0] = q[512 + c]; gv[0] = q[1024 + c]; }
#pragma unroll
          for (int i = 0; i < 16; ++i) { const bf16_t* p = PA + (size_t)(t0 + i) * NA; gr[i + 1] = p[c]; gk[i + 1] = p[512 + c]; gv[i + 1] = p[1024 + c]; } }
        {   const int t = t0 + stok; const bool first = (t % SEQ) == 0;
            const u32x2 pw = spw, qw = sqw;
            float x0 = bflo(pw.x), x1 = bfhi(pw.x), x2 = bflo(pw.y), x3 = bfhi(pw.y);
            const float y0 = first ? 0.f : bflo(qw.x), y1 = first ? 0.f : bfhi(qw.x), y2 = first ? 0.f : bflo(qw.y), y3 = first ? 0.f : bfhi(qw.y);
            x0 += (y0 - x0) * smu.x; x1 += (y1 - x1) * smu.y; x2 += (y2 - x2) * smu.z; x3 += (y3 - x3) * smu.w;
            if (sj4 < 64) { x0 = 1.0f - 2.0f / (__expf(2.0f * x0) + 1.0f); x1 = 1.0f - 2.0f / (__expf(2.0f * x1) + 1.0f); x2 = 1.0f - 2.0f / (__expf(2.0f * x2) + 1.0f); x3 = 1.0f - 2.0f / (__expf(2.0f * x3) + 1.0f); }
            u32x2 o; o.x = pk2(x0, x1); o.y = pk2(x2, x3);
            *(LAS u32x2*)(lds + stok * XPB + sj4 * 2) = o; }
        if (u + (int)gridDim.x < M / 16) PREP_SLOAD(u + gridDim.x);
        lds_barrier();
#pragma unroll
        for (int mat = 0; mat < 2; ++mat)
#pragma unroll
            for (int mt = 0; mt < 4; ++mt) {
                f32x4 acc = (f32x4){0.f, 0.f, 0.f, 0.f};
#pragma unroll
                for (int ks = 0; ks < 2; ++ks) { const pbf16x8 xf = *(const LAS pbf16x8*)(lds + fr * XPB + (mat * 64 + ks * 32 + 8 * quad) * 2); acc = __builtin_amdgcn_mfma_f32_16x16x32_bf16(wf[mat][mt][ks], xf, acc, 0, 0, 0); }
                *(LAS f32x4*)(lds + RES_OFF + ((mat * 16 + fr) * 512 + wave * 64 + mt * 16 + 4 * quad) * 4) = acc;
            }
        lds_barrier();
        float rp = bf2f(gr[0]), kp_ = bf2f(gk[0]), vp = bf2f(gv[0]);
        unsigned char* rec = rec_base(a, (t0 / SEQ) * 8 + wave) + (size_t)((t0 % SEQ) / 16) * RSZ;
        LAS unsigned char* hb = lds + HAT_OFF + wave * 9216;
        float Pprev = 1.0f;
        if (variant != 2)
#pragma unroll
        for (int i = 0; i < 16; ++i) {
            const int t = t0 + i;
            const float rc = bf2f(gr[i + 1]), kc = bf2f(gk[i + 1]), vc = bf2f(gv[i + 1]);
            const float r = rc + (rp - rc) * mur, k = kc + (kp_ - kc) * muk, v = vc + (vp - vc) * muv;
            rp = rc; kp_ = kc; vp = vc;
            const float z = *(const LAS float*)(lds + RES_OFF + (i * 512 + c) * 4) + w0;
            const float za = *(const LAS float*)(lds + RES_OFF + ((16 + i) * 512 + c) * 4) + a0;
            const float sp = fmaxf(-z, 0.f) + __logf(1.0f + __expf(-fabsf(z)));
            const float w = -sp - 0.5f;
            const float dec = __expf(-__expf(w));
            const float av = __builtin_amdgcn_rcpf(1.0f + __expf(-za));
            float kk = k * kkc; const float ss = wave_sum_dpp(kk * kk); kk = kk * __builtin_amdgcn_rcpf(fmaxf(__builtin_amdgcn_sqrtf(ss), 1e-12f));
            const float kn = k * (1.0f + (av - 1.0f) * kac);
            const float bon = wave_sum_dpp(r * kn * rkc);
            const float P = Pprev * dec, iP = __builtin_amdgcn_rcpf(P);
            LAS unsigned short* hat = (LAS unsigned short*)hb + i * 72 + lane;
            hat[0] = f2bf(-kk * Pprev); hat[1152] = f2bf(r * P); hat[2304] = f2bf(kk * av * iP); hat[3456] = f2bf(kn * iP);
            Pprev = P;
            const unsigned short vb16 = f2bf(v);
            VR[(size_t)t * 512 + c] = vb16;
            *(unsigned short*)(rec + 8192 + (lane >> 4) * 512 + ((i >> 2) * 16 + (lane & 15)) * 8 + (i & 3) * 2) = vb16;
            if (lane == 0) BON[t * 8 + wave] = bon;
        }
        *(float*)(rec + 12288 + lane * 4) = Pprev;
        asm volatile("s_waitcnt lgkmcnt(0)" ::: "memory");
        if (variant != 1) {
            pbf16x8 fa[2], fr2[2], fb[2], fk[2];
#pragma unroll
            for (int ks = 0; ks < 2; ++ks) { const int off = fr * 144 + (ks * 32 + 8 * quad) * 2;
                fa[ks] = *(const LAS pbf16x8*)(hb + off); fr2[ks] = *(const LAS pbf16x8*)(hb + 2304 + off); fb[ks] = *(const LAS pbf16x8*)(hb + 4608 + off); fk[ks] = *(const LAS pbf16x8*)(hb + 6912 + off); }
            f32x4 cba = (f32x4){0.f, 0.f, 0.f, 0.f}, cka = cba, cbr = cba, ckr = cba;
#pragma unroll
            for (int ks = 0; ks < 2; ++ks) { cba = __builtin_amdgcn_mfma_f32_16x16x32_bf16(fb[ks], fa[ks], cba, 0, 0, 0); cka = __builtin_amdgcn_mfma_f32_16x16x32_bf16(fk[ks], fa[ks], cka, 0, 0, 0);
                                             cbr = __builtin_amdgcn_mfma_f32_16x16x32_bf16(fb[ks], fr2[ks], cbr, 0, 0, 0); ckr = __builtin_amdgcn_mfma_f32_16x16x32_bf16(fk[ks], fr2[ks], ckr, 0, 0, 0); }
            float nn[4];
            {   float x0[4], x1[4], x2[4];
#pragma unroll
                for (int e = 0; e < 4; ++e) { const int j = 4 * quad + e; x0[e] = (j < fr) ? cka[e] : 0.f; x1[e] = (j <= fr) ? ckr[e] : 0.f; x2[e] = (j <= fr) ? cbr[e] : 0.f; nn[e] = (j < fr) ? cba[e] : 0.f; }
                u32x2 w; w.x = pk2(x0[0], x0[1]); w.y = pk2(x0[2], x0[3]); *(u32x2*)(rec + 10240 + lane * 8) = w;
                w.x = pk2(x1[0], x1[1]); w.y = pk2(x1[2], x1[3]); *(u32x2*)(rec + 10752 + lane * 8) = w;
                w.x = pk2(x2[0], x2[1]); w.y = pk2(x2[2], x2[3]); *(u32x2*)(rec + 11776 + lane * 8) = w; }
#pragma unroll
            for (int ks = 0; ks < 2; ++ks) {
                const u32x2 alo = *(const LAS u32x2*)(hb + fr * 144 + (32 * ks + 4 * quad) * 2), ahi = *(const LAS u32x2*)(hb + fr * 144 + (32 * ks + 16 + 4 * quad) * 2);
                const u32x2 rlo = *(const LAS u32x2*)(hb + 2304 + fr * 144 + (32 * ks + 4 * quad) * 2), rhi = *(const LAS u32x2*)(hb + 2304 + fr * 144 + (32 * ks + 16 + 4 * quad) * 2);
                __builtin_nontemporal_store((u32x4){alo.x, alo.y, ahi.x, ahi.y}, (u32x4*)(rec + ks * 1024 + lane * 16));
                __builtin_nontemporal_store((u32x4){rlo.x, rlo.y, rhi.x, rhi.y}, (u32x4*)(rec + 2048 + ks * 1024 + lane * 16));
            }
#pragma unroll
            for (int mt = 0; mt < 4; ++mt) {
                const LAS unsigned short* hB = (const LAS unsigned short*)(hb + 4608) + (4 * quad) * 72 + 16 * mt + fr;
                const LAS unsigned short* hK = (const LAS unsigned short*)(hb + 6912) + (4 * quad) * 72 + 16 * mt + fr;
                u32x4 o; o.x = (unsigned)hB[0] | ((unsigned)hB[72] << 16); o.y = (unsigned)hB[144] | ((unsigned)hB[216] << 16); o.z = (unsigned)hK[0] | ((unsigned)hK[72] << 16); o.w = (unsigned)hK[144] | ((unsigned)hK[216] << 16);
                __builtin_nontemporal_store(o, (u32x4*)(rec + 4096 + mt * 1024 + lane * 16));
            }
            asm volatile("s_waitcnt lgkmcnt(0)" ::: "memory");
            LAS float* NL = (LAS float*)hb;
#pragma unroll
            for (int e = 0; e < 4; ++e) NL[(4 * quad + e) * 16 + fr] = nn[e];
            asm volatile("s_waitcnt lgkmcnt(0)" ::: "memory");
            float X[16];
#pragma unroll
            for (int l = 0; l < 16; ++l) X[l] = (l == fr) ? 1.0f : 0.f;
#pragma unroll
            for (int j = 14; j >= 0; --j) {
                const f32x4 n0 = ((const LAS f32x4*)NL)[j * 4], n1 = ((const LAS f32x4*)NL)[j * 4 + 1], n2 = ((const LAS f32x4*)NL)[j * 4 + 2], n3 = ((const LAS f32x4*)NL)[j * 4 + 3];
                const float nr[16] = {n0.x, n0.y, n0.z, n0.w, n1.x, n1.y, n1.z, n1.w, n2.x, n2.y, n2.z, n2.w, n3.x, n3.y, n3.z, n3.w};
                float acc = X[j];
#pragma unroll
                for (int l = j + 1; l < 16; ++l) acc = __builtin_fmaf(nr[l], X[l], acc);
                X[j] = acc;
            }
            float mv[4];
#pragma unroll
            for (int e = 0; e < 4; ++e) mv[e] = quad == 0 ? X[e] : (quad == 1 ? X[4 + e] : (quad == 2 ? X[8 + e] : X[12 + e]));
            u32x2 w; w.x = pk2(mv[0], mv[1]); w.y = pk2(mv[2], mv[3]); *(u32x2*)(rec + 11264 + lane * 8) = w;
            asm volatile("s_waitcnt lgkmcnt(0)" ::: "memory");
        }
    }
}

__device__ __forceinline__ float rdlane(float x, int k) { return __uint_as_float(__builtin_amdgcn_readlane(__float_as_uint(x), k)); }
__device__ __forceinline__ void phase_scan_naive(const Args& a) {
    const int tid = threadIdx.x, lane = tid & 63, wave = tid >> 6;
    if (wave != 0) return;
    unsigned char* ws = a.ws;
    const bf16_t* R = (const bf16_t*)a.out; const bf16_t* KP = R + (size_t)M * 512; const bf16_t* V = KP + (size_t)M * 512; const bf16_t* AN = V + (size_t)M * 512;
    bf16_t* YM = (bf16_t*)(ws + WS_YMIX); const float* DEC = (const float*)(ws + WS_XN); const float* BON = (const float*)(ws + WS_BON);
    const bf16_t* PB = (const bf16_t*)(ws + WS_PB);
    for (int u = blockIdx.x; u < BATCH * 8; u += gridDim.x) {
        const int b = u >> 3, h = u & 7;
        const float lg = a.in[I_LNXG][h * 64 + lane], lb = a.in[I_LNXB][h * 64 + lane];
        float s[64];
#pragma unroll
        for (int k = 0; k < 64; ++k) s[k] = 0.f;
        for (int t = 0; t < SEQ; ++t) {
            const int tok = b * SEQ + t; const size_t o = (size_t)tok * 512 + h * 64 + lane;
            const float ca = bf2f(AN[o]), cw = DEC[o], cb = bf2f(YM[(size_t)tok * 1024 + h * 64 + lane]), ck = bf2f(KP[o]), cr = bf2f(R[o]), vv = bf2f(V[o]);
            float sa = 0.f;
#pragma unroll
            for (int k = 0; k < 64; ++k) sa += s[k] * rdlane(ca, k);
            float y = 0.f;
#pragma unroll
            for (int k = 0; k < 64; ++k) { s[k] = s[k] * rdlane(cw, k) + sa * rdlane(cb, k) + vv * rdlane(ck, k); y += s[k] * rdlane(cr, k); }
            const float mean = wave_sum(y) * (1.0f / 64.0f); const float d = y - mean; const float var = wave_sum(d * d) * (1.0f / 64.0f);
            float yn = d * rsqrtf(var + GN_EPS) * lg + lb;
            yn += BON[tok * 8 + h] * vv;
            const float g = bf2f(PB[(size_t)tok * NB + h * 64 + lane]);
            YM[(size_t)tok * 1024 + h * 64 + lane] = f2bf(yn * siluf_(g));
        }
    }
}

__device__ __forceinline__ void phase_attn_naive(const Args& a) {
    const int tid = threadIdx.x, lane = tid & 63, wave = tid >> 6;
    unsigned char* ws = a.ws;
    const bf16_t* PB = (const bf16_t*)(ws + WS_PB); bf16_t* YM = (bf16_t*)(ws + WS_YMIX);
    for (int u = blockIdx.x * 8 + wave; u < BATCH * 8 * 32; u += gridDim.x * 8) {
        const int c = u & 31, h = (u >> 5) & 7, b = u >> 8;
        const int t = b * SEQ + c * 64 + lane;
        float q[64], acc[64];
        { const u32x4* qp = (const u32x4*)(PB + (size_t)t * NB + 512 + h * 64);
#pragma unroll
          for (int i = 0; i < 8; ++i) { const u32x4 w = qp[i]; q[8 * i] = bflo(w.x) * 0.125f; q[8 * i + 1] = bfhi(w.x) * 0.125f; q[8 * i + 2] = bflo(w.y) * 0.125f; q[8 * i + 3] = bfhi(w.y) * 0.125f;
              q[8 * i + 4] = bflo(w.z) * 0.125f; q[8 * i + 5] = bfhi(w.z) * 0.125f; q[8 * i + 6] = bflo(w.w) * 0.125f; q[8 * i + 7] = bfhi(w.w) * 0.125f; } }
#pragma unroll
        for (int d = 0; d < 64; ++d) acc[d] = 0.f;
        float m = -1e30f, l = 0.f;
        const float* bt = a.in[I_ABIAS] + h * 257;
        const int k0 = (c - 8 > 0 ? c - 8 : 0) * 64, k1 = (c + 1) * 64;
        for (int kj = k0; kj < k1; ++kj) {
            const bf16_t* kr = PB + (size_t)(b * SEQ + kj) * NB + 1024 + h * 64;
            float s = 0.f;
#pragma unroll
            for (int i = 0; i < 8; ++i) { const u32x4 w = ((const u32x4*)kr)[i];
                s += q[8 * i] * bflo(w.x) + q[8 * i + 1] * bfhi(w.x) + q[8 * i + 2] * bflo(w.y) + q[8 * i + 3] * bfhi(w.y) + q[8 * i + 4] * bflo(w.z) + q[8 * i + 5] * bfhi(w.z) + q[8 * i + 6] * bflo(w.w) + q[8 * i + 7] * bfhi(w.w); }
            int rel = c * 64 + lane - kj; rel = rel < -128 ? -128 : (rel > 128 ? 128 : rel);
            s += bt[rel + 128];
            const float mn = fmaxf(m, s), al = __expf(m - mn), p = __expf(s - mn);
            l = l * al + p; m = mn;
            const bf16_t* vr = kr + 512;
#pragma unroll
            for (int i = 0; i < 8; ++i) { const u32x4 w = ((const u32x4*)vr)[i];
                acc[8 * i] = acc[8 * i] * al + p * bflo(w.x); acc[8 * i + 1] = acc[8 * i + 1] * al + p * bfhi(w.x); acc[8 * i + 2] = acc[8 * i + 2] * al + p * bflo(w.y); acc[8 * i + 3] = acc[8 * i + 3] * al + p * bfhi(w.y);
                acc[8 * i + 4] = acc[8 * i + 4] * al + p * bflo(w.z); acc[8 * i + 5] = acc[8 * i + 5] * al + p * bfhi(w.z); acc[8 * i + 6] = acc[8 * i + 6] * al + p * bflo(w.w); acc[8 * i + 7] = acc[8 * i + 7] * al + p * bfhi(w.w); }
        }
        const float il = 1.0f / l;
        const u32x4* gp = (const u32x4*)(PB + (size_t)t * NB + 2048 + h * 64);
        u32x4* op = (u32x4*)(YM + (size_t)t * 1024 + 512 + h * 64);
#pragma unroll
        for (int i = 0; i < 8; ++i) { const u32x4 g = gp[i]; u32x4 o;
            o.x = pk2(acc[8 * i] * il * siluf_(bflo(g.x)), acc[8 * i + 1] * il * siluf_(bfhi(g.x))); o.y = pk2(acc[8 * i + 2] * il * siluf_(bflo(g.y)), acc[8 * i + 3] * il * siluf_(bfhi(g.y)));
            o.z = pk2(acc[8 * i + 4] * il * siluf_(bflo(g.z)), acc[8 * i + 5] * il * siluf_(bfhi(g.z))); o.w = pk2(acc[8 * i + 6] * il * siluf_(bflo(g.w)), acc[8 * i + 7] * il * siluf_(bfhi(g.w)));
            op[i] = o; }
    }
}


typedef _Float16 h8 __attribute__((ext_vector_type(8)));
typedef _Float16 h4 __attribute__((ext_vector_type(4)));
typedef short bf16x8 __attribute__((ext_vector_type(8)));
template <int CTRL> __device__ __forceinline__ float dpp_add(float x) { return x + __uint_as_float(__builtin_amdgcn_update_dpp(0, __float_as_uint(x), CTRL, 0xf, 0xf, true)); }
__device__ __forceinline__ float red8(float x) { x = dpp_add<0xB1>(x); x = dpp_add<0x4E>(x); x = dpp_add<0x141>(x); return x; }
__device__ __forceinline__ float red16(float x) { x = dpp_add<0x128>(x); x = dpp_add<0x124>(x); x = dpp_add<0x122>(x); x = dpp_add<0x121>(x); return x; }
constexpr int SC_PH = 0, SC_VV = 40960, SC_SC = 57344, SC_YY = 57856;
constexpr int TC = 32;

__device__ __forceinline__ void scan_unit(const Args& a, LAS unsigned char* lds, int u) {
    const int tid = threadIdx.x, lane = tid & 63, wave = tid >> 6;
    const int b = u >> 3, h = u & 7;
    unsigned char* ws = a.ws;
    const bf16_t* R = (const bf16_t*)a.out; const bf16_t* KP = R + (size_t)M * 512; const bf16_t* V = KP + (size_t)M * 512; const bf16_t* AN = V + (size_t)M * 512;
    bf16_t* YM = (bf16_t*)(ws + WS_YMIX); const float* DEC = (const float*)(ws + WS_XN); const float* BON = (const float*)(ws + WS_BON);
    const bf16_t* PB = (const bf16_t*)(ws + WS_PB);
    const int st = tid >> 4, sq = tid & 15;
    const int row = wave * 8 + (lane >> 3), cg = lane & 7;
    const int colbase = h * 64 + 4 * sq;
    const f32x4 lg = *(const f32x4*)(a.in[I_LNXG] + colbase), lb = *(const f32x4*)(a.in[I_LNXB] + colbase);
    float s[8];
#pragma unroll
    for (int j = 0; j < 8; ++j) s[j] = 0.f;
    u32x2 gR, gK, gV, gA, gB; f32x4 gD;
#define SC_GLOAD(c) do { const size_t tok_ = (size_t)b * SEQ + (c) * TC + st; const size_t o_ = tok_ * 512 + colbase; \
        gR = *(const u32x2*)(R + o_); gK = *(const u32x2*)(KP + o_); gV = *(const u32x2*)(V + o_); gA = *(const u32x2*)(AN + o_); \
        gB = *(const u32x2*)(YM + tok_ * 1024 + colbase); gD = *(const f32x4*)(DEC + o_); } while (0)
#define SC_STAGE(buf) do { \
        const float r0 = bflo(gR.x), r1 = bfhi(gR.x), r2 = bflo(gR.y), r3 = bfhi(gR.y); \
        const float k0 = bflo(gK.x), k1 = bfhi(gK.x), k2 = bflo(gK.y), k3 = bfhi(gK.y); \
        const float b0 = bflo(gB.x), b1 = bfhi(gB.x), b2 = bflo(gB.y), b3 = bfhi(gB.y); \
        LAS h4* ph4 = (LAS h4*)(lds + SC_PH) + (size_t)(((buf) * TC + st) * 5) * 16 + sq; \
        ph4[0]  = (h4){(_Float16)bflo(gA.x), (_Float16)bfhi(gA.x), (_Float16)bflo(gA.y), (_Float16)bfhi(gA.y)}; \
        ph4[16] = (h4){(_Float16)(1.0f - gD.x), (_Float16)(1.0f - gD.y), (_Float16)(1.0f - gD.z), (_Float16)(1.0f - gD.w)}; \
        ph4[32] = (h4){(_Float16)b0, (_Float16)b1, (_Float16)b2, (_Float16)b3}; \
        ph4[48] = (h4){(_Float16)k0, (_Float16)k1, (_Float16)k2, (_Float16)k3}; \
        ph4[64] = (h4){(_Float16)(gD.x * r0), (_Float16)(gD.y * r1), (_Float16)(gD.z * r2), (_Float16)(gD.w * r3)}; \
        *((LAS f32x4*)(lds + SC_VV) + ((buf) * TC + st) * 16 + sq) = (f32x4){bflo(gV.x), bfhi(gV.x), bflo(gV.y), bfhi(gV.y)}; \
        float br_ = (b0 * r0 + b1 * r1) + (b2 * r2 + b3 * r3), kr_ = (k0 * r0 + k1 * r1) + (k2 * r2 + k3 * r3); \
        br_ = red16(br_); kr_ = red16(kr_); \
        if (sq == 0) *((LAS f32x2*)(lds + SC_SC) + (buf) * TC + st) = (f32x2){br_, kr_}; } while (0)
    SC_GLOAD(0); SC_STAGE(0);
    __syncthreads();
    for (int c = 0; c < SEQ / TC; ++c) {
        const int buf = c & 1;
        if (c + 1 < SEQ / TC) SC_GLOAD(c + 1);
        const size_t tokE = (size_t)b * SEQ + c * TC + st;
        const u32x2 gG = *(const u32x2*)(PB + tokE * NB + colbase);
        const float bon = BON[tokE * 8 + h];
        {
            const LAS h8* ph8 = (const LAS h8*)(lds + SC_PH) + buf * TC * 40 + cg;
            const LAS float* vvp = (const LAS float*)(lds + SC_VV) + buf * TC * 64 + row;
            const LAS f32x2* scp = (const LAS f32x2*)(lds + SC_SC) + buf * TC;
            LAS float* yyp = (LAS float*)(lds + SC_YY) + row;
            h8 cA = ph8[0], cE = ph8[8], cB = ph8[16], cK = ph8[24], cW = ph8[32]; float cv = vvp[0]; f32x2 cs = scp[0];
#pragma unroll 2
            for (int t = 0; t < TC; ++t) {
                const int tn = (t + 1 < TC) ? t + 1 : t;
                const h8 nA = ph8[tn * 40], nE = ph8[tn * 40 + 8], nB = ph8[tn * 40 + 16], nK = ph8[tn * 40 + 24], nW = ph8[tn * 40 + 32]; const float nv = vvp[tn * 64]; const f32x2 ns = scp[tn];
                float sa0 = 0.f, sa1 = 0.f, yw0 = 0.f, yw1 = 0.f;
#pragma unroll
                for (int j = 0; j < 4; ++j) { sa0 = __builtin_fmaf(s[j], (float)cA[j], sa0); sa1 = __builtin_fmaf(s[4 + j], (float)cA[4 + j], sa1);
                                              yw0 = __builtin_fmaf(s[j], (float)cW[j], yw0); yw1 = __builtin_fmaf(s[4 + j], (float)cW[4 + j], yw1); }
                float sa = red8(sa0 + sa1), yw = red8(yw0 + yw1);
#pragma unroll
                for (int j = 0; j < 8; ++j) { float uu = __builtin_fmaf(sa, (float)cB[j], s[j]); uu = __builtin_fmaf(cv, (float)cK[j], uu); s[j] = __builtin_fmaf(-(float)cE[j], s[j], uu); }
                const float y = yw + sa * cs.x + cv * cs.y;
                yyp[t * 64] = y;
                cA = nA; cE = nE; cB = nB; cK = nK; cW = nW; cv = nv; cs = ns;
            }
        }
        __syncthreads();
        {
            const f32x4 y4 = *((const LAS f32x4*)(lds + SC_YY) + st * 16 + sq);
            const f32x4 v4 = *((const LAS f32x4*)(lds + SC_VV) + (buf * TC + st) * 16 + sq);
            const float mean = red16((y4.x + y4.y) + (y4.z + y4.w)) * (1.0f / 64.0f);
            const f32x4 d = y4 - mean;
            const float var = red16((d.x * d.x + d.y * d.y) + (d.z * d.z + d.w * d.w)) * (1.0f / 64.0f);
            const float rstd = rsqrtf(var + GN_EPS);
            f32x4 o = d * rstd * lg + lb + v4 * bon;
            o.x *= siluf_(bflo(gG.x)); o.y *= siluf_(bfhi(gG.x)); o.z *= siluf_(bflo(gG.y)); o.w *= siluf_(bfhi(gG.y));
            u32x2 w; w.x = pk2(o.x, o.y); w.y = pk2(o.z, o.w);
            *(u32x2*)(YM + tokE * 1024 + colbase) = w;
        }
        if (c + 1 < SEQ / TC) SC_STAGE(buf ^ 1);
        __syncthreads();
    }
#undef SC_GLOAD
#undef SC_STAGE
}


struct ChOps { u32x4 Aa[2], Ar[2], Abk[4]; u32x2 Acka, Ackr, Aminv, Acbr, Vb; f32x4 P[4]; };
__device__ __forceinline__ void ch_load(ChOps& o, const unsigned char* rec, int nt, int lane, int quad) {
#pragma unroll
    for (int ks = 0; ks < 2; ++ks) { o.Aa[ks] = *(const u32x4*)(rec + ks * 1024 + lane * 16); o.Ar[ks] = *(const u32x4*)(rec + 2048 + ks * 1024 + lane * 16); }
#pragma unroll
    for (int mt = 0; mt < 4; ++mt) { o.Abk[mt] = *(const u32x4*)(rec + 4096 + mt * 1024 + lane * 16); o.P[mt] = *(const f32x4*)(rec + 12288 + (16 * mt + 4 * quad) * 4); }
    o.Vb = *(const u32x2*)(rec + 8192 + nt * 512 + lane * 8);
    o.Acka = *(const u32x2*)(rec + 10240 + lane * 8); o.Ackr = *(const u32x2*)(rec + 10752 + lane * 8); o.Aminv = *(const u32x2*)(rec + 11264 + lane * 8); o.Acbr = *(const u32x2*)(rec + 11776 + lane * 8);
}
__device__ __forceinline__ void ch_load_lds(ChOps& o, const LAS unsigned char* rec, int nt, int lane, int quad) {
#pragma unroll
    for (int ks = 0; ks < 2; ++ks) { o.Aa[ks] = *(const LAS u32x4*)(rec + ks * 1024 + lane * 16); o.Ar[ks] = *(const LAS u32x4*)(rec + 2048 + ks * 1024 + lane * 16); }
    o.Vb = *(const LAS u32x2*)(rec + 8192 + nt * 512 + lane * 8);
    o.Acka = *(const LAS u32x2*)(rec + 10240 + lane * 8); o.Ackr = *(const LAS u32x2*)(rec + 10752 + lane * 8); o.Aminv = *(const LAS u32x2*)(rec + 11264 + lane * 8); o.Acbr = *(const LAS u32x2*)(rec + 11776 + lane * 8);
#pragma unroll
    for (int mt = 0; mt < 4; ++mt) { o.Abk[mt] = *(const LAS u32x4*)(rec + 4096 + mt * 1024 + lane * 16); o.P[mt] = *(const LAS f32x4*)(rec + 12288 + (16 * mt + 4 * quad) * 4); }
}
__device__ __forceinline__ bf16x8 asbf(u32x4 v) { return __builtin_bit_cast(bf16x8, v); }
__device__ __forceinline__ void scan_unit_chunked(const Args& a, LAS unsigned char* lds, int u) {
    const int tid = threadIdx.x, lane = tid & 63, wave = tid >> 6, fr = lane & 15, quad = lane >> 4;
    const int b = u >> 3, h = u & 7;
    unsigned char* ws = a.ws;
    const bf16_t* VR = (const bf16_t*)(ws + WS_VRAW); bf16_t* YM = (bf16_t*)(ws + WS_YMIX); const float* BON = (const float*)(ws + WS_BON);
    const bf16_t* PB = (const bf16_t*)(ws + WS_PB);
    const unsigned char* recs = rec_base(a, u);
    LAS float* YY = (LAS float*)lds;
    constexpr int REC_OFF = 16384, GRPB = 4 * RSZ, NPIECE = GRPB / 16;
    const int etok = tid >> 3, er8 = (tid & 7) * 8;
    const f32x4 lg0 = *(const f32x4*)(a.in[I_LNXG] + h * 64 + er8), lg1 = *(const f32x4*)(a.in[I_LNXG] + h * 64 + er8 + 4);
    const f32x4 lb0 = *(const f32x4*)(a.in[I_LNXB] + h * 64 + er8), lb1 = *(const f32x4*)(a.in[I_LNXB] + h * 64 + er8 + 4);
    f32x4 S[4];
#pragma unroll
    for (int mt = 0; mt < 4; ++mt) S[mt] = (f32x4){0.f, 0.f, 0.f, 0.f};
    u32x4 ltmp[13];
#define SC_ISSUE(gidx) do { const unsigned char* src_ = recs + (size_t)(gidx) * GRPB; \
        _Pragma("unroll") for (int k_ = 0; k_ < 13; ++k_) { const int idx_ = (tid - 256) + 256 * k_; if (idx_ < NPIECE) ltmp[k_] = *(const u32x4*)(src_ + (size_t)idx_ * 16); } } while (0)
#define SC_COMMIT(bufi) do { LAS unsigned char* dst_ = lds + REC_OFF + (bufi) * GRPB; \
        _Pragma("unroll") for (int k_ = 0; k_ < 13; ++k_) { const int idx_ = (tid - 256) + 256 * k_; if (idx_ < NPIECE) *(LAS u32x4*)(dst_ + idx_ * 16) = ltmp[k_]; } } while (0)
    if (wave >= 4) { SC_ISSUE(0); SC_COMMIT(0); SC_ISSUE(1); }
    lds_barrier();
    for (int g = 0; g < SEQ / 64; ++g) {
        const int buf = g & 1;
        const size_t tokE = (size_t)b * SEQ + g * 64 + etok;
        const u32x4 ev = *(const u32x4*)(VR + tokE * 512 + h * 64 + er8);
        const u32x4 eg = *(const u32x4*)(PB + tokE * NB + h * 64 + er8);
        const float bon = BON[tokE * 8 + h];
        if (wave < 4) {
#pragma unroll
            for (int cc = 0; cc < 4; ++cc) {
                ChOps cur;
                ch_load_lds(cur, lds + REC_OFF + buf * GRPB + cc * RSZ, wave, lane, quad);
                u32x4 sb[2];
#pragma unroll
                for (int ks = 0; ks < 2; ++ks) { sb[ks].x = pk2(S[2 * ks][0], S[2 * ks][1]); sb[ks].y = pk2(S[2 * ks][2], S[2 * ks][3]);
                                                 sb[ks].z = pk2(S[2 * ks + 1][0], S[2 * ks + 1][1]); sb[ks].w = pk2(S[2 * ks + 1][2], S[2 * ks + 1][3]); }
                const u32x4 vb = (u32x4){cur.Vb.x, cur.Vb.y, 0u, 0u};
                f32x4 rhs = (f32x4){0.f, 0.f, 0.f, 0.f}, hv = rhs;
#pragma unroll
                for (int ks = 0; ks < 2; ++ks) { rhs = __builtin_amdgcn_mfma_f32_16x16x32_bf16(asbf(cur.Aa[ks]), asbf(sb[ks]), rhs, 0, 0, 0); hv = __builtin_amdgcn_mfma_f32_16x16x32_bf16(asbf(cur.Ar[ks]), asbf(sb[ks]), hv, 0, 0, 0); }
                rhs = __builtin_amdgcn_mfma_f32_16x16x32_bf16(asbf((u32x4){cur.Acka.x, cur.Acka.y, 0u, 0u}), asbf(vb), rhs, 0, 0, 0);
                hv = __builtin_amdgcn_mfma_f32_16x16x32_bf16(asbf((u32x4){cur.Ackr.x, cur.Ackr.y, 0u, 0u}), asbf(vb), hv, 0, 0, 0);
                const u32x4 rb = (u32x4){pk2(rhs[0], rhs[1]), pk2(rhs[2], rhs[3]), 0u, 0u};
                const f32x4 sa = __builtin_amdgcn_mfma_f32_16x16x32_bf16(asbf((u32x4){cur.Aminv.x, cur.Aminv.y, 0u, 0u}), asbf(rb), (f32x4){0.f, 0.f, 0.f, 0.f}, 0, 0, 0);
                const u32x4 svb = (u32x4){pk2(sa[0], sa[1]), pk2(sa[2], sa[3]), cur.Vb.x, cur.Vb.y};
                const f32x4 y = __builtin_amdgcn_mfma_f32_16x16x32_bf16(asbf((u32x4){cur.Acbr.x, cur.Acbr.y, 0u, 0u}), asbf(svb), hv, 0, 0, 0);
#pragma unroll
                for (int mt = 0; mt < 4; ++mt) { S[mt] = __builtin_amdgcn_mfma_f32_16x16x32_bf16(asbf(cur.Abk[mt]), asbf(svb), S[mt], 0, 0, 0); S[mt] = S[mt] * cur.P[mt]; }
#pragma unroll
                for (int jj = 0; jj < 4; ++jj) YY[(cc * 16 + 4 * quad + jj) * 64 + 16 * wave + fr] = y[jj];
            }
        } else {
            if (g + 1 < SEQ / 64) SC_COMMIT(buf ^ 1);
            if (g + 2 < SEQ / 64) SC_ISSUE(g + 2);
        }
        lds_barrier();
        {
            const f32x4 y0 = *(const LAS f32x4*)(YY + etok * 64 + er8), y1 = *(const LAS f32x4*)(YY + etok * 64 + er8 + 4);
            const float mean = red8(((y0.x + y0.y) + (y0.z + y0.w)) + ((y1.x + y1.y) + (y1.z + y1.w))) * (1.0f / 64.0f);
            const f32x4 d0 = y0 - mean, d1 = y1 - mean;
            const float var = red8(((d0.x * d0.x + d0.y * d0.y) + (d0.z * d0.z + d0.w * d0.w)) + ((d1.x * d1.x + d1.y * d1.y) + (d1.z * d1.z + d1.w * d1.w))) * (1.0f / 64.0f);
            const float rstd = rsqrtf(var + GN_EPS);
            const f32x4 v0 = (f32x4){bflo(ev.x), bfhi(ev.x), bflo(ev.y), bfhi(ev.y)}, v1 = (f32x4){bflo(ev.z), bfhi(ev.z), bflo(ev.w), bfhi(ev.w)};
            f32x4 o0 = d0 * rstd * lg0 + lb0 + v0 * bon, o1 = d1 * rstd * lg1 + lb1 + v1 * bon;
            o0.x *= siluf_(bflo(eg.x)); o0.y *= siluf_(bfhi(eg.x)); o0.z *= siluf_(bflo(eg.y)); o0.w *= siluf_(bfhi(eg.y));
            o1.x *= siluf_(bflo(eg.z)); o1.y *= siluf_(bfhi(eg.z)); o1.z *= siluf_(bflo(eg.w)); o1.w *= siluf_(bfhi(eg.w));
            u32x4 w; w.x = pk2(o0.x, o0.y); w.y = pk2(o0.z, o0.w); w.z = pk2(o1.x, o1.y); w.w = pk2(o1.z, o1.w);
            *(u32x4*)(YM + tokE * 1024 + h * 64 + er8) = w;
        }
        lds_barrier();
    }
#undef SC_ISSUE
#undef SC_COMMIT
}


constexpr int AT_KS = 0, AT_VT = 18432, AT_BT = 36864, AT_PITCH = 144, AT_VT2 = 32768, AT_BT2 = 65536;
__device__ __forceinline__ void attn_unit(const Args& a, LAS unsigned char* lds, int u, int variant = 0) {
    const int tid = threadIdx.x, lane = tid & 63, wave = tid >> 6, fr = lane & 15, quad = lane >> 4;
    const int cp = u & 15, h = (u >> 4) & 7, b = u >> 7;
    unsigned char* ws = a.ws;
    const bf16_t* PB = (const bf16_t*)(ws + WS_PB); bf16_t* YM = (bf16_t*)(ws + WS_YMIX);
    const int c0 = 2 * cp, cq = c0 + (wave >> 2), qrow = (wave & 3) * 16 + fr;
    const size_t tq = (size_t)b * SEQ + cq * 64 + qrow;
    constexpr float LOG2E = 1.4426950408889634f;
    if (tid < 257) ((LAS float*)(lds + AT_BT2))[tid] = a.in[I_ABIAS][h * 257 + tid] * LOG2E;
    bf16x8 qf[2];
    qf[0] = *(const bf16x8*)(PB + tq * NB + 512 + h * 64 + 8 * quad); qf[1] = *(const bf16x8*)(PB + tq * NB + 512 + h * 64 + 32 + 8 * quad);
    u32x2 gpre[4];
#pragma unroll
    for (int dt = 0; dt < 4; ++dt) gpre[dt] = *(const u32x2*)(PB + tq * NB + 2048 + h * 64 + dt * 16 + 4 * quad);
    f32x4 O[4];
#pragma unroll
    for (int i = 0; i < 4; ++i) O[i] = (f32x4){0.f, 0.f, 0.f, 0.f};
    f32x4 Lacc = (f32x4){0.f, 0.f, 0.f, 0.f};
    const unsigned onev = (fr == 0) ? 0x3f803f80u : 0u; const bf16x8 ones = __builtin_bit_cast(bf16x8, (u32x4){onev, onev, onev, onev});
    const int kfirst = c0 - 8 > 0 ? c0 - 8 : 0, klast = c0 + 1;
    const int kkey = tid >> 3, kdch = tid & 7;
    const int vkey = tid & 63, vdch = tid >> 6;
    const int vpos = (vkey & 32) + 8 * ((vkey >> 2) & 3) + 4 * ((vkey >> 4) & 1) + (vkey & 3);
    u32x4 gkA, gvA, gkB, gvB, gkC, gvC, gkD, gvD;
    const int ntile = klast - kfirst + 1;
#define AT_GLD(ti, K_, V_) do { if ((ti) < ntile) { K_ = *(const u32x4*)(PB + ((size_t)b * SEQ + (kfirst + (ti)) * 64 + kkey) * NB + 1024 + h * 64 + kdch * 8); \
                        V_ = *(const u32x4*)(PB + ((size_t)b * SEQ + (kfirst + (ti)) * 64 + vkey) * NB + 1536 + h * 64 + vdch * 8); } } while (0)
#define AT_SST(slot, gk, gv) do { *(LAS u32x4*)(lds + AT_KS + (slot) * 8192 + kkey * 128 + ((kdch ^ (kkey & 7)) * 16)) = gk; \
        LAS unsigned char* vt_ = lds + AT_VT2 + (slot) * 8192 + (vdch * 8) * 128 + (vpos & 7) * 2; const int vch_ = vpos >> 3; \
        *(LAS unsigned short*)(vt_ + 0 * 128 + ((vch_ ^ 0) * 16)) = (unsigned short)(gv.x & 0xffffu); *(LAS unsigned short*)(vt_ + 1 * 128 + ((vch_ ^ 1) * 16)) = (unsigned short)(gv.x >> 16); \
        *(LAS unsigned short*)(vt_ + 2 * 128 + ((vch_ ^ 2) * 16)) = (unsigned short)(gv.y & 0xffffu); *(LAS unsigned short*)(vt_ + 3 * 128 + ((vch_ ^ 3) * 16)) = (unsigned short)(gv.y >> 16); \
        *(LAS unsigned short*)(vt_ + 4 * 128 + ((vch_ ^ 4) * 16)) = (unsigned short)(gv.z & 0xffffu); *(LAS unsigned short*)(vt_ + 5 * 128 + ((vch_ ^ 5) * 16)) = (unsigned short)(gv.z >> 16); \
        *(LAS unsigned short*)(vt_ + 6 * 128 + ((vch_ ^ 6) * 16)) = (unsigned short)(gv.w & 0xffffu); *(LAS unsigned short*)(vt_ + 7 * 128 + ((vch_ ^ 7) * 16)) = (unsigned short)(gv.w >> 16); } while (0)
    gkA = gvA = gkB = gvB = gkC = gvC = gkD = gvD = (u32x4){0u, 0u, 0u, 0u};
    AT_GLD(0, gkA, gvA); AT_GLD(1, gkB, gvB); AT_GLD(2, gkC, gvC); AT_GLD(3, gkD, gvD);
    AT_SST(0, gkA, gvA); AT_SST(1, gkB, gvB);
    gkA = gkC; gvA = gvC; gkB = gkD; gvB = gvD;
    AT_GLD(4, gkC, gvC); AT_GLD(5, gkD, gvD);
    lds_barrier();
    for (int it = 0; 2 * it < ntile; ++it) {
#pragma unroll
      for (int sub = 0; sub < 2; ++sub) {
        const int kc = kfirst + 2 * it + sub, slot = (2 * it + sub) & 3;
        if (variant != 3 && kc <= cq && kc >= cq - 8) {
            const LAS unsigned char* ks = lds + AT_KS + slot * 8192 + fr * 128;
            const LAS unsigned char* vt = lds + AT_VT2 + slot * 8192 + fr * 128;
            f32x4 sc[4];
#pragma unroll
            for (int kt = 0; kt < 4; ++kt) {
                sc[kt] = (f32x4){0.f, 0.f, 0.f, 0.f};
#pragma unroll
                for (int k2 = 0; k2 < 2; ++k2) { const bf16x8 kf = *(const LAS bf16x8*)(ks + kt * 16 * 128 + (((k2 * 4 + quad) ^ (fr & 7)) * 16)); sc[kt] = __builtin_amdgcn_mfma_f32_16x16x32_bf16(kf, qf[k2], sc[kt], 0, 0, 0); }
            }
            bf16x8 vfr[2][4];
#pragma unroll
            for (int s2 = 0; s2 < 2; ++s2)
#pragma unroll
                for (int dt = 0; dt < 4; ++dt) vfr[s2][dt] = *(const LAS bf16x8*)(vt + dt * 16 * 128 + (((s2 * 4 + quad) ^ (fr & 7)) * 16));
            asm volatile("" ::: "memory");
            const int dch = cq - kc;
            const LAS float* bt = (const LAS float*)(lds + AT_BT2);
            if (dch >= 3) {
                const float bc = bt[256];
#pragma unroll
                for (int kt = 0; kt < 4; ++kt)
#pragma unroll
                    for (int j = 0; j < 4; ++j) sc[kt][j] = __builtin_amdgcn_exp2f(__builtin_amdgcn_fmed3f(__builtin_fmaf(sc[kt][j], 0.125f * LOG2E, bc), -100.0f, 100.0f));
            } else {
                const int base = dch * 64 + qrow + 128 - 4 * quad;
#pragma unroll
                for (int kt = 0; kt < 4; ++kt)
#pragma unroll
                    for (int j = 0; j < 4; ++j) { int idx = base - kt * 16 - j; idx = idx > 256 ? 256 : idx; sc[kt][j] = __builtin_amdgcn_exp2f(__builtin_amdgcn_fmed3f(__builtin_fmaf(sc[kt][j], 0.125f * LOG2E, bt[idx]), -100.0f, 100.0f)); }
            }
#pragma unroll
            for (int s2 = 0; s2 < 2; ++s2) {
                u32x4 pw; pw.x = pk2(sc[2 * s2][0], sc[2 * s2][1]); pw.y = pk2(sc[2 * s2][2], sc[2 * s2][3]); pw.z = pk2(sc[2 * s2 + 1][0], sc[2 * s2 + 1][1]); pw.w = pk2(sc[2 * s2 + 1][2], sc[2 * s2 + 1][3]);
                const bf16x8 pf = __builtin_bit_cast(bf16x8, pw);
#pragma unroll
                for (int dt = 0; dt < 4; ++dt) O[dt] = __builtin_amdgcn_mfma_f32_16x16x32_bf16(vfr[s2][dt], pf, O[dt], 0, 0, 0);
                Lacc = __builtin_amdgcn_mfma_f32_16x16x32_bf16(ones, pf, Lacc, 0, 0, 0);
            }
        }
      }
        if (2 * it + 2 < ntile) { AT_SST((2 * it + 2) & 3, gkA, gvA); AT_SST((2 * it + 3) & 3, gkB, gvB); }
        gkA = gkC; gvA = gvC; gkB = gkD; gvB = gvD;
        AT_GLD(2 * it + 6, gkC, gvC); AT_GLD(2 * it + 7, gkD, gvD);
        lds_barrier();
    }
#undef AT_GLD
#undef AT_SST
    const float l = __shfl(Lacc[0], fr);
    const float il = 1.0f / l;
#pragma unroll
    for (int dt = 0; dt < 4; ++dt) {
        const int dcol = h * 64 + dt * 16 + 4 * quad;
        const u32x2 g = gpre[dt];
        const f32x4 o = O[dt] * il;
        u32x2 w; w.x = pk2(o[0] * siluf_(bflo(g.x)), o[1] * siluf_(bfhi(g.x))); w.y = pk2(o[2] * siluf_(bflo(g.y)), o[3] * siluf_(bfhi(g.y)));
        *(u32x2*)(YM + tq * 1024 + 512 + dcol) = w;
    }
}

constexpr int AT_GRAB = 1;
__device__ __forceinline__ void phase_mix(const Args& a, LAS unsigned char* lds, bool do_scan = true, bool do_attn = true) {
    unsigned* ctr = (unsigned*)(a.ws + WS_CTR);
    if (do_scan) for (int u = blockIdx.x; u < BATCH * 8; u += gridDim.x) scan_unit_chunked(a, lds, u);
    LAS int* uw = (LAS int*)(lds + 70000);
    if (do_attn) for (;;) {
        __syncthreads();
        if (threadIdx.x == 0) *uw = (int)atomicAdd(ctr, (unsigned)AT_GRAB);
        __syncthreads();
        const int u = *uw;
        if (u >= BATCH * 8 * 16) break;
        for (int k = 0; k < AT_GRAB && u + k < BATCH * 8 * 16; ++k) attn_unit(a, lds, u + k, (PROBE_LOOPS || N_LAUNCH_MODE == 3) ? a.rep[0] : 0);
    }
}

__device__ __forceinline__ void phase_sg_naive(const Args& a, unsigned char* ldsb) {
    const int tid = threadIdx.x;
    unsigned char* ws = a.ws;
    const bf16_t* P1 = (const bf16_t*)(ws + WS_P1); bf16_t* Y2 = (bf16_t*)(ws + WS_YMIX);
    const float* vsum = (const float*)(ws + WS_VSUM); const float* vsq = (const float*)(ws + WS_VSQ);
    float* vn = (float*)ldsb;
    const int c = tid & 127, i0 = tid >> 7;
    for (int u = blockIdx.x; u < BATCH * 16 * 8; u += gridDim.x) {
        const int g = u & 7, nb = (u >> 3) & 15, b = u >> 7;
        const int tbase = b * SEQ + nb * 128;
        const float lg = a.in[I_SGLNG][g * 128 + c], lb = a.in[I_SGLNB][g * 128 + c];
        for (int j = i0; j < 128; j += 4) {
            const int t = tbase + j; const float mean = vsum[t] * (1.0f / 1024.0f); const float var = vsq[t] * (1.0f / 1024.0f) - mean * mean;
            const float rstd = rsqrtf(fmaxf(var, 0.f) + LN_EPS);
            vn[j * 128 + c] = (bf2f(P1[(size_t)t * N3 + 1024 + g * 128 + c]) - mean) * rstd * lg + lb;
        }
        __syncthreads();
        const float* wg = a.in[I_SGW] + (size_t)g * 128 * 128; const float* sb = a.in[I_SGB] + g * 128;
        for (int i = i0; i < 128; i += 4) {
            const int jend = (i < 64) ? 64 : 128;
            float acc = 0.f;
            for (int j = 0; j < jend; ++j) acc += wg[i * 128 + j] * vn[j * 128 + c];
            const int t = tbase + i;
            const float uu = bf2f(P1[(size_t)t * N3 + g * 128 + c]), gt = bf2f(P1[(size_t)t * N3 + 2048 + g * 128 + c]);
            Y2[(size_t)t * 1024 + g * 128 + c] = f2bf(uu * (acc + sb[i]) * gt);
        }
        __syncthreads();
    }
}


__device__ __forceinline__ void phase_sg(const Args& a, LAS unsigned char* lds, int variant = 0) {
    const int tid = threadIdx.x, lane = tid & 63, wave = tid >> 6, fr = lane & 15, quad = lane >> 4;
    unsigned char* ws = a.ws;
    const bf16_t* P1 = (const bf16_t*)(ws + WS_P1); bf16_t* Y2 = (bf16_t*)(ws + WS_YMIX); const bf16_t* SGW = (const bf16_t*)(ws + WS_SGW);
    const float* vsum = (const float*)(ws + WS_VSUM); const float* vsq = (const float*)(ws + WS_VSQ);
    constexpr int VPB = 272;
    constexpr int NUN = BATCH * 16 * 8;
    const int per = (NUN + (int)gridDim.x - 1) / (int)gridDim.x;
    const int u0 = blockIdx.x * per, u1 = (u0 + per < NUN) ? u0 + per : NUN;
    u32x4 vw[4]; float vmean[4], vrstd[4];
    const int lpc = tid & 15, lrb = tid >> 4;
#define SG_VLOAD(uu_) do { const int g_ = (uu_) >> 8, tb_ = (((uu_) >> 4) & 15) * SEQ + ((uu_) & 15) * 128; \
        _Pragma("unroll") for (int q_ = 0; q_ < 4; ++q_) { const int t_ = tb_ + lrb + 32 * q_; \
            const float m_ = vsum[t_] * (1.0f / 1024.0f); const float var_ = vsq[t_] * (1.0f / 1024.0f) - m_ * m_; vmean[q_] = m_; vrstd[q_] = rsqrtf(fmaxf(var_, 0.f) + LN_EPS); \
            vw[q_] = *(const u32x4*)(P1 + (size_t)t_ * N3 + 1024 + g_ * 128 + lpc * 8); } } while (0)
    if (u0 < u1) SG_VLOAD(u0);
    for (int u = u0; u < u1; ++u) {
        const int g = u >> 8, b = (u >> 4) & 15, nb = u & 15;
        const int tbase = b * SEQ + nb * 128;
        const int irow = 16 * wave + fr;
        const int epc = tid & 15, erb = tid >> 4;
        const f32x4 g0 = *(const f32x4*)(a.in[I_SGLNG] + g * 128 + lpc * 8), g1 = *(const f32x4*)(a.in[I_SGLNG] + g * 128 + lpc * 8 + 4);
        const f32x4 b0 = *(const f32x4*)(a.in[I_SGLNB] + g * 128 + lpc * 8), b1 = *(const f32x4*)(a.in[I_SGLNB] + g * 128 + lpc * 8 + 4);
        float sbq[4];
#pragma unroll
        for (int q = 0; q < 4; ++q) sbq[q] = a.in[I_SGB][g * 128 + erb + 32 * q];
        u32x4 uu[4], gg[4];
#pragma unroll
        for (int q = 0; q < 4; ++q) { const size_t te = (size_t)tbase + erb + 32 * q; uu[q] = *(const u32x4*)(P1 + te * N3 + g * 128 + epc * 8); gg[q] = *(const u32x4*)(P1 + te * N3 + 2048 + g * 128 + epc * 8); }
        bf16x8 wf[4];
#pragma unroll
        for (int ks = 0; ks < 4; ++ks) wf[ks] = *(const bf16x8*)(SGW + (size_t)(g * 128 + irow) * 128 + ks * 32 + 8 * quad);
        if (variant != 2) {
            const int c8 = lpc * 8;
#pragma unroll
            for (int q = 0; q < 4; ++q) {
                const int j = lrb + 32 * q; const float mean = vmean[q], rstd = vrstd[q];
                const u32x4 w = vw[q];
                LAS unsigned short* vt = (LAS unsigned short*)(lds + c8 * VPB + (((j >> 3) ^ lpc) * 16) + (j & 7) * 2);
                vt[0 * (VPB / 2)] = f2bf((bflo(w.x) - mean) * rstd * g0.x + b0.x); vt[1 * (VPB / 2)] = f2bf((bfhi(w.x) - mean) * rstd * g0.y + b0.y);
                vt[2 * (VPB / 2)] = f2bf((bflo(w.y) - mean) * rstd * g0.z + b0.z); vt[3 * (VPB / 2)] = f2bf((bfhi(w.y) - mean) * rstd * g0.w + b0.w);
                vt[4 * (VPB / 2)] = f2bf((bflo(w.z) - mean) * rstd * g1.x + b1.x); vt[5 * (VPB / 2)] = f2bf((bfhi(w.z) - mean) * rstd * g1.y + b1.y);
                vt[6 * (VPB / 2)] = f2bf((bflo(w.w) - mean) * rstd * g1.z + b1.z); vt[7 * (VPB / 2)] = f2bf((bfhi(w.w) - mean) * rstd * g1.w + b1.w);
            }
        }
        if (u + 1 < u1) SG_VLOAD(u + 1);
        lds_barrier();
        if (variant == 1) { lds_barrier(); continue; }
        f32x4 acc[8];
#pragma unroll
        for (int ct = 0; ct < 8; ++ct) {
            acc[ct] = (f32x4){0.f, 0.f, 0.f, 0.f};
#pragma unroll
            for (int ks = 0; ks < 4; ++ks) {
                if (ks < 2 || wave >= 4) { const bf16x8 vf = *(const LAS bf16x8*)(lds + (ct * 16 + fr) * VPB + (((ks * 4 + quad) ^ (ct * 2 + (fr >> 3))) * 16)); acc[ct] = __builtin_amdgcn_mfma_f32_16x16x32_bf16(vf, wf[ks], acc[ct], 0, 0, 0); }
            }
        }
        {
            LAS float* ot = (LAS float*)(lds + 36864);
#pragma unroll
            for (int ct = 0; ct < 8; ++ct) *(LAS f32x4*)(ot + irow * 132 + ct * 16 + 4 * quad) = acc[ct];
            lds_barrier();
#pragma unroll
            for (int q = 0; q < 4; ++q) {
                const int i = erb + 32 * q; const size_t te = (size_t)tbase + i; const float sbv = sbq[q];
                const f32x4 s0 = *(const LAS f32x4*)(ot + i * 132 + epc * 8), s1 = *(const LAS f32x4*)(ot + i * 132 + epc * 8 + 4);
                u32x4 w;
                w.x = pk2(bflo(uu[q].x) * (s0[0] + sbv) * bflo(gg[q].x), bfhi(uu[q].x) * (s0[1] + sbv) * bfhi(gg[q].x));
                w.y = pk2(bflo(uu[q].y) * (s0[2] + sbv) * bflo(gg[q].y), bfhi(uu[q].y) * (s0[3] + sbv) * bfhi(gg[q].y));
                w.z = pk2(bflo(uu[q].z) * (s1[0] + sbv) * bflo(gg[q].z), bfhi(uu[q].z) * (s1[1] + sbv) * bfhi(gg[q].z));
                w.w = pk2(bflo(uu[q].w) * (s1[2] + sbv) * bflo(gg[q].w), bfhi(uu[q].w) * (s1[3] + sbv) * bfhi(gg[q].w));
                *(u32x4*)(Y2 + te * 1024 + g * 128 + epc * 8) = w;
            }
        }
        lds_barrier();
    }
#undef SG_VLOAD
}

__device__ __forceinline__ void phase_final(const Args& a) {
    const int tid = threadIdx.x, lane = tid & 63, wave = tid >> 6;
    const float* rs2 = (const float*)(a.ws + WS_RS2); const float* fg = a.in[I_FG];
    const int gw = blockIdx.x * 8 + wave, NGW = gridDim.x * 8;
    f32x4 g4[4];
#pragma unroll
    for (int j = 0; j < 4; ++j) g4[j] = ((const f32x4*)fg)[lane + 64 * j];
    for (int m = gw; m < M; m += NGW) {
        const float rinv = rsqrtf(rs2[m] * (1.0f / DM) + RMS_EPS);
        f32x4* p = (f32x4*)(a.out + (size_t)m * DM) + lane;
#pragma unroll
        for (int j = 0; j < 4; ++j) { f32x4 v = p[64 * j]; v = v * rinv * g4[j]; p[64 * j] = v; }
    }
}

#define XB_TMO      128
#define XB_XCNT(j)  (256  + 64 * (j))
#define XB_XSUB(j)  (1280 + 64 * (j))
#define XB_XGEN(j)  (2304 + 64 * (j))
#define XB_TOP      3328
#define XB_TOPGEN   3392
#define XCD_BAR_WORDS 3456
#define XB_SPIN_CAP (1u << 18)

__device__ __forceinline__ unsigned xb_ld(unsigned* p)              { return __hip_atomic_load(p, __ATOMIC_RELAXED, __HIP_MEMORY_SCOPE_AGENT); }
__device__ __forceinline__ unsigned xb_add(unsigned* p, unsigned v) { return __hip_atomic_fetch_add(p, v, __ATOMIC_RELAXED, __HIP_MEMORY_SCOPE_AGENT); }
__device__ __forceinline__ unsigned xb_xcc_id() { return (unsigned)__builtin_amdgcn_s_getreg((3 << 11) | 20) & 0xFu; }
#define XB_SPIN(cond, bar) do { unsigned _sp = 0; while (cond) { __builtin_amdgcn_s_sleep(1); \
    if ((++_sp & 255u) == 0u) { if (xb_ld(&(bar)[XB_TMO])) break; if (_sp > XB_SPIN_CAP) { atomicAdd(&(bar)[XB_TMO], 1u); break; } } } } while (0)

struct XcdBarrier {
    unsigned* bar; unsigned x;
    volatile LAS unsigned* st;
};

__device__ __forceinline__ XcdBarrier xcd_barrier_post(unsigned* bar, volatile LAS unsigned* st) {
    XcdBarrier b; b.bar = bar; b.x = xb_xcc_id(); b.st = st;
    if (threadIdx.x == 0) (void)xb_add(&bar[XB_XCNT(b.x)], 1u);
    return b;
}
__device__ __forceinline__ void xcd_barrier_complete(unsigned* bar, unsigned x, unsigned& nloc, unsigned& nx) {
    const unsigned G = gridDim.x * gridDim.y * gridDim.z;
    unsigned sum, cnt, mine, sp = 0u;
    for (;;) {
        sum = 0u; cnt = 0u; mine = 0u;
#pragma unroll
        for (unsigned j = 0; j < 16; ++j) { const unsigned c = xb_ld(&bar[XB_XCNT(j)]); sum += c; cnt += (c > 0u) ? 1u : 0u; mine = (j == x) ? c : mine; }
        if (sum == G) break;
        __builtin_amdgcn_s_sleep(1);
        if ((++sp & 255u) == 0u) { if (xb_ld(&bar[XB_TMO])) break; if (sp > XB_SPIN_CAP) { atomicAdd(&bar[XB_TMO], 1u); break; } }
    }
    nloc = mine > 0u ? mine : 1u; nx = cnt > 0u ? cnt : 1u;
}

__device__ __forceinline__ void xcd_barrier(const XcdBarrier& b) {
    asm volatile("s_waitcnt vmcnt(0)" ::: "memory");
    __syncthreads();
    if (threadIdx.x == 0) {
        unsigned* bar = b.bar;
        __builtin_amdgcn_s_waitcnt(0);
        unsigned nloc = b.st[0], nx = b.st[1];
        if (nloc == 0u) { xcd_barrier_complete(bar, b.x, nloc, nx); b.st[0] = nloc; b.st[1] = nx; }
        const unsigned old = xb_add(&bar[XB_XSUB(b.x)], 1u);
        const unsigned gen = old / nloc;
        if (old + 1u == (gen + 1u) * nloc) {
            __builtin_amdgcn_fence(__ATOMIC_RELEASE, "agent");
            asm volatile("s_waitcnt vmcnt(0)" ::: "memory");
            const unsigned og = xb_add(&bar[XB_TOP], 1u);
            const unsigned tg = og / nx;
            if (og + 1u == (tg + 1u) * nx) xb_add(&bar[XB_TOPGEN], 1u);
            else XB_SPIN(xb_ld(&bar[XB_TOPGEN]) == tg, bar);
            __builtin_amdgcn_fence(__ATOMIC_ACQUIRE, "agent");
            xb_add(&bar[XB_XGEN(b.x)], 1u);
            asm volatile("s_waitcnt vmcnt(0)" ::: "memory");
        } else {
            XB_SPIN(xb_ld(&bar[XB_XGEN(b.x)]) == gen, bar);
            __builtin_amdgcn_fence(__ATOMIC_ACQUIRE, "agent");
            asm volatile("s_waitcnt vmcnt(0)" ::: "memory");
        }
    }
    __syncthreads();
}

template <int PHM> __global__ void __launch_bounds__(NTHR, 2) mega(Args a) {
    extern __shared__ __attribute__((aligned(16))) unsigned char lds[];
    unsigned char* ws = a.ws;
    const int lo = a.lo, hi = a.hi;
    volatile LAS unsigned* bst = (volatile LAS unsigned*)((LAS unsigned char*)lds + (LDS_BYTES - 64));
    if (threadIdx.x < 2) bst[threadIdx.x] = 0u;
    __syncthreads();
    XcdBarrier xbar = xcd_barrier_post((unsigned*)(ws + WS_BAR), bst);
    if (hi > 1000) cg::this_grid().sync();
#define IN(k) (((PHM >> (k)) & 1) && lo <= (k) && (k) < hi)
#if PROBE_LOOPS
#define REPS(i) a.rep[i]
#else
#define REPS(i) 0
#endif
#if USE_XBAR
#define SEAM(k) do { if (IN(k) && IN((k) + 1)) { xcd_barrier(xbar); } } while (0)
#else
#define SEAM(k) do { if (IN(k) && IN((k) + 1)) { cg::this_grid().sync(); } } while (0)
#endif
    if (IN(0)) for (int r_ = 0; r_ <= REPS(0); ++r_) { phase_prologue(a, lds); if (r_ < REPS(0)) xcd_barrier(xbar); }
    SEAM(0);
    if (IN(1)) { EpiG1 f{(const float*)(ws + WS_RS0), (bf16_t*)(ws + WS_PA), (bf16_t*)(ws + WS_PB)};
        gemm_any(lds, (const bf16_t*)(ws + WS_XN), (const bf16_t*)(ws + WS_W1T), M, N1, DM, f); }
    SEAM(1);
    if (IN(2)) for (int r_ = 0; r_ <= REPS(1); ++r_) { phase_prep(a, lds, (PROBE_LOOPS || N_LAUNCH_MODE == 3) ? a.rep[0] : 0); if (r_ < REPS(1)) xcd_barrier(xbar); }
    SEAM(2);
    #if PROBE & 1
    phase_prep(a, lds); cg::this_grid().sync();
#endif
#if USE_NAIVE_MIX
    if (IN(3)) { phase_scan_naive(a); phase_attn_naive(a); }
#else
    if (IN(3)) for (int r_ = 0; r_ <= REPS(2); ++r_) { phase_mix(a, (LAS unsigned char*)lds, a.rep[0] < 2, a.rep[0] != 1); if (r_ < REPS(2)) { xcd_barrier(xbar); if (blockIdx.x == 0 && threadIdx.x == 0) *(unsigned*)(ws + WS_CTR) = 0u; xcd_barrier(xbar); } }
#endif
    SEAM(3);
#if PROBE & 2
    phase_prep(a, lds); cg::this_grid().sync(); phase_mix(a, (LAS unsigned char*)lds); cg::this_grid().sync();
#endif
#if PROBE & 64
    phase_prep(a, lds); cg::this_grid().sync(); phase_mix(a, (LAS unsigned char*)lds, true, false); cg::this_grid().sync();
#endif
#if PROBE & 32
    if (blockIdx.x == 0 && threadIdx.x == 0) *(unsigned*)(ws + WS_CTR) = 0u;
    cg::this_grid().sync(); phase_mix(a, (LAS unsigned char*)lds, false); cg::this_grid().sync();
#endif
#if PROBE & 4
    phase_prologue(a, lds); cg::this_grid().sync();
#endif
#if PROBE & 16
    { EpiG1 f{(const float*)(ws + WS_RS0), (bf16_t*)(ws + WS_PA), (bf16_t*)(ws + WS_PB)};
        gemm_any(lds, (const bf16_t*)(ws + WS_XN), (const bf16_t*)(ws + WS_W1T), M, N1, DM, f); cg::this_grid().sync(); }
#endif
    if (IN(4)) { EpiG2 f{a.in[I_X], a.out, (bf16_t*)(ws + WS_XN), (float*)(ws + WS_RS1)};
        gemm_any<EpiG2, false>(lds, (const bf16_t*)(ws + WS_YMIX), (const bf16_t*)(ws + WS_W2T), M, DM, DM, f); }
    SEAM(4);
#if PROBE & 128
    { EpiG2 f{a.in[I_X], a.out, (bf16_t*)(ws + WS_XN), (float*)(ws + 640 * 1024)};
        gemm_any(lds, (const bf16_t*)(ws + WS_YMIX), (const bf16_t*)(ws + WS_W2T), M, DM, DM, f); cg::this_grid().sync(); }
#endif
    if (IN(5)) { EpiG3 f{(const float*)(ws + WS_RS1), (bf16_t*)(ws + WS_P1), (float*)(ws + WS_VSUM), (float*)(ws + WS_VSQ)};
        gemm_any(lds, (const bf16_t*)(ws + WS_XN), (const bf16_t*)(ws + WS_W3T), M, N3, DM, f); }
    SEAM(5);
    if (IN(6)) for (int r_ = 0; r_ <= REPS(3); ++r_) { phase_sg(a, (LAS unsigned char*)lds, (PROBE_LOOPS || N_LAUNCH_MODE == 3) ? a.rep[0] : 0); if (r_ < REPS(3)) xcd_barrier(xbar); }
    SEAM(6);
#if PROBE & 8
    phase_sg(a, (LAS unsigned char*)lds); cg::this_grid().sync();
#endif
    const bool fuse_final = FUSE_FINAL && gridDim.x == 256;
    if (IN(7) && fuse_final) { pg8::Gemm g{(const bf16_t*)(ws + WS_YMIX), (const bf16_t*)(ws + WS_W4T), M, DM, DM}; pg8::StaticOrder S; S.init(M, DM, (int)gridDim.x, (int)blockIdx.x);
        EpiG4X E{a.out, a.in[I_FG], (float*)(ws + WS_EXCH), (unsigned*)(ws + WS_PCNT), (LAS unsigned char*)lds + 131072};
        pg8::gemm_phase<EpiG4X, pg8::StaticOrder, true, true>((PG8_LAS unsigned char*)lds, g, S, E); }
    if (!fuse_final) {
        if (IN(7)) { EpiG4 f{a.out, (float*)(ws + WS_RS2)};
            gemm_any<EpiG4, false>(lds, (const bf16_t*)(ws + WS_YMIX), (const bf16_t*)(ws + WS_W4T), M, DM, DM, f); }
        SEAM(7);
        if (IN(8)) { phase_final(a); }
    }
#undef IN
#undef SEAM
}
constexpr int NPHASE = 9;
}
#if defined(__HIP_DEVICE_COMPILE__)
#pragma clang attribute pop
#endif

extern "C" void kernel_launch(void* const* d_in, const int* in_sizes, int n_in, void* d_out, int out_size, void* d_ws, size_t ws_size, hipStream_t stream) {
    using namespace mk;
    static int grid = 0;
    if (grid == 0) {
        if (n_in != 22 || out_size != M * DM || ws_size < WS_END) { fprintf(stderr, "kernel_launch: unexpected shapes (n_in %d out %d ws %zu)\n", n_in, out_size, ws_size); grid = -1; return; }
        int dev = 0, cus = 0, per_cu = 0;
        (void)hipGetDevice(&dev); (void)hipDeviceGetAttribute(&cus, hipDeviceAttributeMultiprocessorCount, dev);
#if N_LAUNCH_MODE == 1 || N_LAUNCH_MODE == 3
        if (hipFuncSetAttribute((const void*)mega<0x1ff>, hipFuncAttributeMaxDynamicSharedMemorySize, LDS_BYTES) != hipSuccess) { fprintf(stderr, "kernel_launch: hipFuncSetAttribute failed\n"); grid = -1; return; }
        if (hipOccupancyMaxActiveBlocksPerMultiprocessor(&per_cu, (const void*)mega<0x1ff>, NTHR, LDS_BYTES) != hipSuccess || per_cu < 1) { fprintf(stderr, "kernel_launch: occupancy query says %d\n", per_cu); per_cu = 1; }
#else
        if (hipFuncSetAttribute((const void*)mega<0x1f7>, hipFuncAttributeMaxDynamicSharedMemorySize, LDS_BYTES) != hipSuccess || hipFuncSetAttribute((const void*)mega<0x008>, hipFuncAttributeMaxDynamicSharedMemorySize, LDS_BYTES) != hipSuccess) { fprintf(stderr, "kernel_launch: hipFuncSetAttribute failed\n"); grid = -1; return; }
#endif
        (void)hipGetLastError();
        grid = cus * 1;
        if (grid <= 0) grid = 256;
    }
    if (grid < 0) return;
    Args a{};
    for (int i = 0; i < 22; ++i) a.in[i] = (const float*)d_in[i];
    a.out = (float*)d_out; a.ws = (unsigned char*)d_ws;
    a.rep[0] = PROBE_REP0; a.rep[1] = PROBE_REP1; a.rep[2] = PROBE_REP2; a.rep[3] = PROBE_REP3;
    if (hipMemsetAsync((char*)d_ws + WS_BAR, 0, 65536 + 32768, stream) != hipSuccess) { fprintf(stderr, "kernel_launch: hipMemsetAsync failed\n"); return; }
#if N_LAUNCH_MODE == 3
    {
        constexpr int P = PROBE_PHASE; constexpr int MLO = (1 << P) - 1, MP = 1 << P, MHI = 0x0ff & ~((1 << (P + 1)) - 1);
        void* args[] = {&a};
        (void)hipFuncSetAttribute((const void*)mega<MP>, hipFuncAttributeMaxDynamicSharedMemorySize, LDS_BYTES);
        (void)hipFuncSetAttribute((const void*)mega<MHI>, hipFuncAttributeMaxDynamicSharedMemorySize, LDS_BYTES);
        if (P > 0) { (void)hipFuncSetAttribute((const void*)mega<MLO>, hipFuncAttributeMaxDynamicSharedMemorySize, LDS_BYTES);
            a.lo = 0; a.hi = P; (void)hipLaunchCooperativeKernel((const void*)mega<MLO>, dim3(grid), dim3(NTHR), args, LDS_BYTES, stream); }
        for (int r = 0; r <= PROBE_REP2; ++r) {
            a.lo = P; a.hi = P + 1; a.rep[0] = (r == PROBE_REP2) ? 0 : PROBE_MIXMODE;
            (void)hipMemsetAsync((char*)d_ws + WS_CTR, 0, 4, stream);
            (void)hipMemsetAsync((char*)d_ws + WS_BAR, 0, 16384, stream);
            hipLaunchKernelGGL(mega<MP>, dim3(grid), dim3(NTHR), LDS_BYTES, stream, a);
        }
        a.rep[0] = 0;
        (void)hipMemsetAsync((char*)d_ws + WS_BAR, 0, 16384, stream);
        a.lo = P + 1; a.hi = NPHASE;
        (void)hipLaunchCooperativeKernel((const void*)mega<MHI>, dim3(grid), dim3(NTHR), args, LDS_BYTES, stream);
    }
#elif N_LAUNCH_MODE == 2
    {
        void* args[] = {&a};
        a.lo = 0; a.hi = 3;
        hipError_t e = hipLaunchCooperativeKernel((const void*)mega<0x1f7>, dim3(grid), dim3(NTHR), args, LDS_BYTES, stream);
        if (e != hipSuccess) fprintf(stderr, "kernel_launch: cooperative launch A failed: %s (grid %d)\n", hipGetErrorString(e), grid);
        a.lo = 3; a.hi = 4;
        hipLaunchKernelGGL(mega<0x008>, dim3(grid), dim3(NTHR), LDS_BYTES, stream, a);
        a.lo = 4; a.hi = NPHASE;
        e = hipLaunchCooperativeKernel((const void*)mega<0x1f7>, dim3(grid), dim3(NTHR), args, LDS_BYTES, stream);
        if (e != hipSuccess) fprintf(stderr, "kernel_launch: cooperative launch B failed: %s (grid %d)\n", hipGetErrorString(e), grid);
    }
#elif N_LAUNCH_MODE == 1
    a.lo = 0; a.hi = NPHASE;
    void* args[] = {&a};
    hipError_t e = hipLaunchCooperativeKernel((const void*)mega<0x1ff>, dim3(grid), dim3(NTHR), args, LDS_BYTES, stream);
    if (e != hipSuccess) fprintf(stderr, "kernel_launch: cooperative launch failed: %s (grid %d)\n", hipGetErrorString(e), grid);
#else
    for (int ph = 0; ph < NPHASE; ++ph) {
        a.lo = ph; a.hi = ph + 1;
        if (ph == 3) hipLaunchKernelGGL(mega<0x008>, dim3(grid), dim3(NTHR), LDS_BYTES, stream, a);
        else hipLaunchKernelGGL(mega<0x1f7>, dim3(grid), dim3(NTHR), LDS_BYTES, stream, a);
    }
#endif
}
```

```cpp
#if defined(__HIP_DEVICE_COMPILE__)
#pragma clang attribute push(__attribute__((target("no-packed-fp32-ops"))), apply_to = function)
#endif
#include <hip/hip_runtime.h>
#include <hip/hip_cooperative_groups.h>
#include <cstdio>
#include <cstdint>
namespace cg = cooperative_groups;
#ifndef USE_PG8
#define USE_PG8 1
#endif
#ifndef N_LAUNCH_MODE
#define N_LAUNCH_MODE 1
#endif
#ifndef PHMASK
#define PHMASK 0x1ff
#endif
#ifndef USE_NAIVE_MIX
#define USE_NAIVE_MIX 0
#endif
#ifndef PROBE
#define PROBE 0
#endif
#ifndef USE_XBAR
#define USE_XBAR 1
#endif
#ifndef PROBE_REP0
#define PROBE_REP0 0
#define PROBE_REP1 0
#define PROBE_REP2 0
#define PROBE_REP3 0
#endif
#ifndef SCAN_PREFETCH
#define SCAN_PREFETCH 1
#endif
#ifndef PROBE_LOOPS
#define PROBE_LOOPS 0
#endif
#ifndef PROBE_MIXMODE
#define PROBE_MIXMODE 0
#endif
#ifndef PROBE_PHASE
#define PROBE_PHASE 3
#endif
#ifndef FUSE_FINAL
#define FUSE_FINAL 1
#endif
namespace pg8 {
#define PG8_LAS __attribute__((address_space(3)))
typedef unsigned short bf16_t;
typedef short bf16x8 __attribute__((ext_vector_type(8)));
typedef float f32x4 __attribute__((ext_vector_type(4)));
typedef unsigned u32x4 __attribute__((ext_vector_type(4)));
constexpr int BM = 256, BK = 64, HALF = 128, HTB = HALF * BK * 2  , STAGE_BYTES = 8 * HTB, NXCD = 8, WGM = 8;

__host__ __device__ __forceinline__ int lds_byte(int r, int c) { const int st = (r >> 4) * 2 + (c >> 5), rr = r & 15, cc = c & 31, ob = rr * 64 + cc * 2; return st * 1024 + (ob ^ (((ob >> 9) & 1) << 5)); }
__host__ __device__ __forceinline__ void stage_rc(int b, int& R, int& C) { const int st = b / 1024, sb = b % 1024, swz = sb ^ (((sb >> 9) & 1) << 5); R = (st >> 1) * 16 + swz / 64; C = (st & 1) * 32 + (swz % 64) / 2; }
__host__ __device__ __forceinline__ int perm32(int rho) { const int n = rho >> 4, i = rho & 15; return 8 * (i >> 2) + 4 * n + (i & 3); }

struct Unit { int pm, pn; };
struct Gemm { const bf16_t* A; const bf16_t* Bt; int M, N, K; };

struct StaticOrder {
    int nM, nN, nwg, G, c;
    __host__ __device__ void init(int M, int N, int G_, int c_) { nM = M / BM; nN = N / BM; nwg = nM * nN; G = G_; c = c_; }
    __host__ __device__ bool next(int i, Unit& u) const {
        const long L = (long)i * G + c; if (L >= nwg) return false;
        int wgid = (int)L; { const int q = nwg / NXCD, r = nwg % NXCD, xcd = wgid % NXCD, off = wgid / NXCD; wgid = (xcd < r ? xcd * (q + 1) : r * (q + 1) + (xcd - r) * q) + off; }
        const int nig = WGM * nN, gid = wgid / nig, fm = gid * WGM, gsz = (nM - fm) < WGM ? (nM - fm) : WGM;
        u.pm = fm + ((wgid % nig) % gsz); u.pn = (wgid % nig) / gsz; return true;
    }
    __device__ __forceinline__ void a_ready(const Unit&) const {}
    __device__ __forceinline__ void done(const Unit&) const {}
};

__device__ __forceinline__ unsigned cvt_pk_bf16(float lo, float hi) { unsigned r; asm volatile("v_cvt_pk_bf16_f32 %0, %1, %2" : "=v"(r) : "v"(lo), "v"(hi)); return r; }
typedef float f32x2 __attribute__((ext_vector_type(2)));
__device__ __forceinline__ f32x2 gelu_pk(f32x2 v) {
    const f32x2 av = __builtin_elementwise_abs(v), d = av * 0.2316418882f + 1.0f;
    f32x2 t; t.x = __builtin_amdgcn_rcpf(d.x); t.y = __builtin_amdgcn_rcpf(d.y);
    f32x2 q = t * 0.5307027145f + (-0.7265760135f); q = q * t + 0.7107068705f; q = q * t + (-0.142248368f); q = q * t + 0.127414796f; q = q * t;
    const f32x2 s = (v * v) * (-0.72134752044f);
    f32x2 e; e.x = __builtin_amdgcn_exp2f(s.x); e.y = __builtin_amdgcn_exp2f(s.y);
    const f32x2 m = v * (q * e), r = v - m;
    f32x2 o; o.x = v.x < 0.f ? m.x : r.x; o.y = v.y < 0.f ? m.y : r.y; return o;
}

template <int ACT  > struct EpiBf16 {
    static constexpr bool PERM = true, AFTER_DRAIN = false; static_assert(ACT == 0 || ACT == 1, "EpiBf16: ACT is 0 (none) or 1 (gelu_pk)");
    bf16_t* O; int ldc; const float* bias; int split_cols; size_t split_stride; float scale0;
    __device__ __forceinline__ void operator()(const f32x4 (&acc)[2][2][4][2], const Unit& u, int wr, int wc, int fr, int fq) const {
        const int row0 = u.pm * BM + wr * 64 + fr; int colt = u.pn * BM; bf16_t* base = O;
        float sc = 1.f; if (split_cols) { const int t = colt / split_cols; base += (size_t)t * split_stride; colt -= t * split_cols; if (t == 0) sc = scale0; }
        const int col0 = colt + wc * 32 + 8 * fq, bcol0 = u.pn * BM + wc * 32 + 8 * fq;
        f32x4 bv[2][2];
#pragma unroll
        for (int bj = 0; bj < 2; ++bj)
#pragma unroll
            for (int n = 0; n < 2; ++n) bv[bj][n] = bias ? *(const f32x4*)(bias + bcol0 + bj * HALF + 4 * n) : (f32x4){0.f, 0.f, 0.f, 0.f};
#pragma unroll
        for (int ai = 0; ai < 2; ++ai)
#pragma unroll
            for (int m = 0; m < 4; ++m) { bf16_t* rowp = base + (size_t)(row0 + ai * HALF + m * 16) * ldc + col0;
#pragma unroll
                for (int bj = 0; bj < 2; ++bj) { f32x4 v0 = acc[ai][bj][m][0] + bv[bj][0], v1 = acc[ai][bj][m][1] + bv[bj][1];
                    if (ACT == 1) { f32x2 a = gelu_pk((f32x2){v0[0], v0[1]}), b = gelu_pk((f32x2){v0[2], v0[3]}), c = gelu_pk((f32x2){v1[0], v1[1]}), d = gelu_pk((f32x2){v1[2], v1[3]});
                        v0 = (f32x4){a.x, a.y, b.x, b.y}; v1 = (f32x4){c.x, c.y, d.x, d.y}; }
                    v0 = v0 * sc; v1 = v1 * sc; u32x4 w; w.x = cvt_pk_bf16(v0[0], v0[1]); w.y = cvt_pk_bf16(v0[2], v0[3]); w.z = cvt_pk_bf16(v1[0], v1[1]); w.w = cvt_pk_bf16(v1[2], v1[3]);
                    *(u32x4*)(rowp + bj * HALF) = w; } }
    }
};
template <class Epi, class Sched, bool ALIGN_EPI = false, bool SP2 = false>
__device__ __forceinline__ void gemm_phase(PG8_LAS unsigned char* lds, const Gemm g, const Sched& S, const Epi& E) {
    const int tid = threadIdx.x, wid = __builtin_amdgcn_readfirstlane(tid >> 6), lane = tid & 63, wr = wid >> 2, wc = wid & 3, fr = lane & 15, fq = lane >> 4;
    const int K = g.K, nt = K / BK;
    unsigned voffA[2], voffB[2];
#pragma unroll
    for (int i = 0; i < 2; ++i) { int R, C; stage_rc(tid * 16 + i * 8192, R, C); const int Rb = Epi::PERM ? ((R & ~31) + perm32(R & 31)) : R;
        voffA[i] = (unsigned)(R * K + C) * 2u; voffB[i] = (unsigned)(Rb * K + C) * 2u; }
    const size_t kstep = (size_t)(BK * 2);
    const size_t hstep = (size_t)HALF * K * 2;
    const size_t tstep = 2 * hstep;
    const unsigned ldsw = (unsigned)wid * 1024u;
    const int aoff = lds_byte(wr * 64 + fr, fq * 8), boff = lds_byte(wc * 32 + fr, fq * 8);
#define PG8_SA(b, h) (((b) * 2 + (h)) * HTB)
#define PG8_SB(b, h) ((4 + (b) * 2 + (h)) * HTB)
#define PG8_STAGE(bufoff, gbase, voff) do { _Pragma("unroll") for (int _i = 0; _i < 2; ++_i) \
        __builtin_amdgcn_global_load_lds((const unsigned*)((const char*)(gbase) + (voff)[_i]), (PG8_LAS unsigned*)(lds + (bufoff) + ldsw + _i * 8192), 16, 0, 0); } while (0)
#define PG8_LDA(dst, b, h) do { _Pragma("unroll") for (int m = 0; m < 4; ++m) _Pragma("unroll") for (int k = 0; k < 2; ++k) dst[m][k] = *(const PG8_LAS bf16x8*)(lds + PG8_SA(b, h) + aoff + m * 2048 + k * 1024); } while (0)
#define PG8_LDB(dst, b, h) do { _Pragma("unroll") for (int n = 0; n < 2; ++n) _Pragma("unroll") for (int k = 0; k < 2; ++k) dst[n][k] = *(const PG8_LAS bf16x8*)(lds + PG8_SB(b, h) + boff + n * 2048 + k * 1024); } while (0)
#define PG8_MMA(ai, bj, At, Bt) do { __builtin_amdgcn_s_setprio(1); _Pragma("unroll") for (int m = 0; m < 4; ++m) _Pragma("unroll") for (int n = 0; n < 2; ++n) _Pragma("unroll") for (int k = 0; k < 2; ++k) \
        acc[ai][bj][m][n] = __builtin_amdgcn_mfma_f32_16x16x32_bf16(Bt[n][k], At[m][k], acc[ai][bj][m][n], 0, 0, 0); __builtin_amdgcn_s_setprio(0); } while (0)
#define PG8_WAIT_V(n) asm volatile("s_waitcnt vmcnt(" #n ")" ::: "memory")
#define PG8_WAIT_L(n) asm volatile("s_waitcnt lgkmcnt(" #n ")" ::: "memory")
#define PG8_BAR __builtin_amdgcn_s_barrier()
#define PG8_SCHED __builtin_amdgcn_sched_barrier(0)
    Unit cur, nxt; int ui = 0;
    if (!S.next(0, cur)) return;
    f32x4 acc[2][2][4][2];
#pragma unroll
    for (int a = 0; a < 2; ++a)
#pragma unroll
        for (int b = 0; b < 2; ++b)
#pragma unroll
            for (int m = 0; m < 4; ++m)
#pragma unroll
                for (int n = 0; n < 2; ++n) acc[a][b][m][n] = (f32x4){0.f, 0.f, 0.f, 0.f};
    bf16x8 At[4][2], B0[2][2], B1[2][2];
    const char* cA = (const char*)g.A + (size_t)cur.pm * tstep; const char* cB = (const char*)g.Bt + (size_t)cur.pn * tstep;
    S.a_ready(cur);
    if constexpr (SP2) {
        PG8_STAGE(PG8_SB(0, 0), cB, voffB); PG8_STAGE(PG8_SB(0, 1), cB + hstep, voffB); PG8_STAGE(PG8_SA(0, 0), cA, voffA); PG8_STAGE(PG8_SA(0, 1), cA + hstep, voffA);
        if (wr == 1) PG8_BAR;
        PG8_WAIT_V(2); PG8_BAR;
        PG8_STAGE(PG8_SB(1, 0), cB + kstep, voffB); PG8_STAGE(PG8_SA(1, 0), cA + kstep, voffA); PG8_STAGE(PG8_SB(1, 1), cB + hstep + kstep, voffB);
        PG8_WAIT_V(6); PG8_BAR;
    } else {
        PG8_STAGE(PG8_SB(0, 0), cB, voffB); PG8_STAGE(PG8_SA(0, 0), cA, voffA); PG8_STAGE(PG8_SB(0, 1), cB + hstep, voffB); PG8_STAGE(PG8_SA(0, 1), cA + hstep, voffA);
        if (wr == 1) PG8_BAR;
        PG8_WAIT_V(4); PG8_BAR;
        PG8_STAGE(PG8_SB(1, 0), cB + kstep, voffB); PG8_STAGE(PG8_SA(1, 0), cA + kstep, voffA); PG8_STAGE(PG8_SB(1, 1), cB + hstep + kstep, voffB);
        PG8_WAIT_V(6); PG8_BAR;
    }
    for (;;) {
        const bool has_next = S.next(ui + 1, nxt);
        const char* nA = has_next ? (const char*)g.A + (size_t)nxt.pm * tstep : cA; const char* nB = has_next ? (const char*)g.Bt + (size_t)nxt.pn * tstep : cB;
        for (int t = 0; t < nt; t += 2) {
            const bool last = (t == nt - 2);
            const char* a1 = cA + (size_t)(t + 1) * kstep;
            const char* a2 = last ? nA : cA + (size_t)(t + 2) * kstep; const char* b2 = last ? nB : cB + (size_t)(t + 2) * kstep;
            const char* a3 = a2 + kstep; const char* b3 = b2 + kstep;
            if (last && has_next) S.a_ready(nxt);
            if constexpr (SP2) {
            PG8_LDB(B0, 0, 0); PG8_LDB(B1, 0, 1); PG8_SCHED; PG8_LDA(At, 0, 0); PG8_STAGE(PG8_SA(1, 1), a1 + hstep, voffA);
            PG8_WAIT_V(8); PG8_WAIT_L(0); PG8_BAR; PG8_MMA(0, 0, At, B0); PG8_MMA(0, 1, At, B1); PG8_BAR; PG8_SCHED;
            PG8_LDA(At, 0, 1); PG8_STAGE(PG8_SB(0, 0), b2, voffB); PG8_STAGE(PG8_SB(0, 1), b2 + hstep, voffB); PG8_STAGE(PG8_SA(0, 0), a2, voffA);
            PG8_WAIT_V(8); PG8_WAIT_L(0); PG8_BAR; PG8_MMA(1, 0, At, B0); PG8_MMA(1, 1, At, B1); PG8_BAR; PG8_SCHED;
            PG8_LDB(B0, 1, 0); PG8_LDB(B1, 1, 1); PG8_SCHED; PG8_LDA(At, 1, 0); PG8_STAGE(PG8_SA(0, 1), a2 + hstep, voffA);
            PG8_WAIT_V(8); PG8_WAIT_L(0); PG8_BAR; PG8_MMA(0, 0, At, B0); PG8_MMA(0, 1, At, B1); PG8_BAR; PG8_SCHED;
            PG8_LDA(At, 1, 1); PG8_STAGE(PG8_SB(1, 0), b3, voffB); PG8_STAGE(PG8_SB(1, 1), b3 + hstep, voffB); PG8_STAGE(PG8_SA(1, 0), a3, voffA);
            PG8_WAIT_V(8); PG8_WAIT_L(0); PG8_BAR; PG8_MMA(1, 0, At, B0); PG8_MMA(1, 1, At, B1); PG8_BAR; PG8_SCHED;
            } else {
            PG8_LDB(B0, 0, 0); PG8_SCHED; PG8_LDA(At, 0, 0); PG8_STAGE(PG8_SA(1, 1), a1 + hstep, voffA);
            PG8_WAIT_L(8); PG8_BAR; PG8_WAIT_L(0); PG8_MMA(0, 0, At, B0); PG8_BAR; PG8_SCHED;
            PG8_LDB(B1, 0, 1); PG8_STAGE(PG8_SB(0, 0), b2, voffB);
            PG8_BAR; PG8_WAIT_L(0); PG8_MMA(0, 1, At, B1); PG8_BAR;
            PG8_LDA(At, 0, 1); PG8_STAGE(PG8_SA(0, 0), a2, voffA);
            PG8_BAR; PG8_WAIT_L(0); PG8_MMA(1, 0, At, B0); PG8_BAR; PG8_SCHED;
            PG8_STAGE(PG8_SB(0, 1), b2 + hstep, voffB);
            PG8_WAIT_V(6); PG8_BAR; PG8_MMA(1, 1, At, B1); PG8_BAR;
            PG8_LDB(B0, 1, 0); PG8_SCHED; PG8_LDA(At, 1, 0); PG8_STAGE(PG8_SA(0, 1), a2 + hstep, voffA);
            PG8_WAIT_L(8); PG8_BAR; PG8_WAIT_L(0); PG8_MMA(0, 0, At, B0); PG8_BAR; PG8_SCHED;
            PG8_LDB(B1, 1, 1); PG8_STAGE(PG8_SB(1, 0), b3, voffB);
            PG8_BAR; PG8_WAIT_L(0); PG8_MMA(0, 1, At, B1); PG8_BAR;
            PG8_LDA(At, 1, 1); PG8_STAGE(PG8_SA(1, 0), a3, voffA);
            PG8_BAR; PG8_WAIT_L(0); PG8_MMA(1, 0, At, B0); PG8_BAR; PG8_SCHED;
            PG8_STAGE(PG8_SB(1, 1), b3 + hstep, voffB);
            PG8_WAIT_V(6); PG8_BAR; PG8_MMA(1, 1, At, B1); PG8_BAR;
            }
        }
        if constexpr (ALIGN_EPI) { if (wr == 0) PG8_BAR; }
        if constexpr (!Epi::AFTER_DRAIN) { E(acc, cur, wr, wc, fr, fq); S.done(cur); }
        if (!has_next) break;
#pragma unroll
        for (int a = 0; a < 2; ++a)
#pragma unroll
            for (int b = 0; b < 2; ++b)
#pragma unroll
                for (int m = 0; m < 4; ++m)
#pragma unroll
                    for (int n = 0; n < 2; ++n) acc[a][b][m][n] = (f32x4){0.f, 0.f, 0.f, 0.f};
        cur = nxt; cA = nA; cB = nB; ++ui;
        if constexpr (ALIGN_EPI) { if (wr == 1) PG8_BAR; }
    }
    PG8_WAIT_V(0);
    if constexpr (!ALIGN_EPI) { if (wr == 0) PG8_BAR; }
    PG8_BAR;
    if constexpr (Epi::AFTER_DRAIN) { E.fused(acc, cur, wr, wc, fr, fq, lds, wid, lane); S.done(cur); }
#undef PG8_SA
#undef PG8_SB
#undef PG8_STAGE
#undef PG8_LDA
#undef PG8_LDB
#undef PG8_MMA
#undef PG8_WAIT_V
#undef PG8_WAIT_L
#undef PG8_BAR
#undef PG8_SCHED
}
}

namespace mk {
typedef unsigned short bf16_t;
typedef float f32x4 __attribute__((ext_vector_type(4)));
typedef unsigned u32x4 __attribute__((ext_vector_type(4)));
typedef unsigned u32x2 __attribute__((ext_vector_type(2)));
typedef float f32x2 __attribute__((ext_vector_type(2)));
#define LAS __attribute__((address_space(3)))

constexpr int BATCH = 16, SEQ = 2048, DM = 1024, M = BATCH * SEQ;
constexpr int NA = 1792, NB = 2560, N1 = NA + NB;
constexpr int N3 = 3072;
constexpr int EVEN_IN = 4224, SHIFT_W = 1664;
constexpr float RMS_EPS = 1e-6f, LN_EPS = 1e-5f, GN_EPS = 64e-5f;
constexpr int NTHR = 512;

constexpr size_t MiB = 1u << 20;
constexpr size_t WS_CTR = 768 * 1024;
constexpr size_t WS_LW = 23 * MiB + 512 * 1024;
constexpr size_t WS_SGW = 23 * MiB;
constexpr size_t WS_RS0 = 0, WS_RS1 = 128 * 1024, WS_RS2 = 256 * 1024, WS_VSUM = 384 * 1024, WS_VSQ = 512 * 1024, WS_BON = 1 * MiB;
constexpr size_t WS_BAR = 2 * MiB;
constexpr size_t WS_PCNT = 2 * MiB + 65536;
constexpr size_t WS_EXCH = 3 * MiB;
constexpr size_t WS_W1T = 4 * MiB, WS_W2T = 13 * MiB, WS_W3T = 15 * MiB, WS_W4T = 21 * MiB;
constexpr size_t WS_XN = 24 * MiB;
constexpr size_t WS_PA = 88 * MiB;
constexpr size_t WS_PB = 200 * MiB;
constexpr size_t WS_YMIX = 360 * MiB;
constexpr size_t WS_TAIL = 424 * MiB;
constexpr size_t WS_VRAW = 448 * MiB;
constexpr size_t WS_END = 480 * MiB;
constexpr int RSZ = 12544;
constexpr size_t WS_P1 = WS_PA;
constexpr int LDS_BYTES = 147456;

struct Args {
    const float* in[22];
    float* out; unsigned char* ws;
    int lo, hi;
    int rep[4];
};
enum { I_X = 0, I_NORMG, I_WINE, I_SHMU, I_W0, I_W2, I_A0, I_A2, I_KK, I_KA, I_RK, I_LNXG, I_LNXB, I_ABIAS, I_WOUTE, I_WINO, I_SGLNG, I_SGLNB, I_SGW, I_SGB, I_WOUTO, I_FG };

__device__ __forceinline__ float bf2f(unsigned short h) { return __uint_as_float((unsigned)h << 16); }
typedef __bf16 bf2_t __attribute__((ext_vector_type(2)));
__device__ __forceinline__ unsigned pk2(float lo, float hi) { const f32x2 v = {lo, hi}; const bf2_t b = __builtin_convertvector(v, bf2_t); return __builtin_bit_cast(unsigned, b); }
__device__ __forceinline__ unsigned short f2bf(float f) { return (unsigned short)(pk2(f, 0.f) & 0xffffu); }
__device__ __forceinline__ float bflo(unsigned w) { return __uint_as_float(w << 16); }
__device__ __forceinline__ float bfhi(unsigned w) { return __uint_as_float(w & 0xffff0000u); }
__device__ __forceinline__ float wave_sum(float v) {
#pragma unroll
    for (int o = 1; o < 64; o <<= 1) v += __shfl_xor(v, o);
    return v;
}
__device__ __forceinline__ float sigmoidf_(float x) { return __builtin_amdgcn_rcpf(1.0f + __expf(-x)); }
__device__ __forceinline__ float siluf_(float x) { return x * sigmoidf_(x); }
__device__ __forceinline__ float gelu_tanh(float x) { const float t = x * x; const float q = x * __builtin_fmaf(t, -0.10294324f, -2.3022082f);
    return x * __builtin_amdgcn_rcpf(1.0f + __builtin_amdgcn_exp2f(q)); }

__device__ __forceinline__ void phase_prologue(const Args& a, unsigned char* ldsb) {
    const int tid = threadIdx.x, lane = tid & 63, wave = tid >> 6;
    unsigned char* ws = a.ws;
    const int gtid = blockIdx.x * NTHR + tid, nthr = gridDim.x * NTHR;
    {
        LAS float* scr = (LAS float*)((LAS unsigned char*)ldsb + wave * 8448);
        constexpr int NB1 = N1 / 32, NB2 = 32, NB3 = N3 / 32, NB4 = 32, NITEM = (NB1 + NB2 + NB3 + NB4) * 16;
        for (int it = blockIdx.x * 8 + wave; it < NITEM; it += gridDim.x * 8) {
            int nb = it >> 4; const int k0 = (it & 15) * 64;
            const float* src; const float* g; int N, col0; bf16_t* dst; bool zero = false;
            if (nb < NB1) { const int n0 = nb * 32; src = a.in[I_WINE]; g = a.in[I_NORMG]; N = EVEN_IN; dst = (bf16_t*)(ws + WS_W1T) + (size_t)n0 * 1024;
                if (n0 < SHIFT_W) col0 = n0; else if (n0 < NA) { col0 = 0; zero = true; } else col0 = n0 - (NA - SHIFT_W); }
            else if ((nb -= NB1) < NB2) { src = a.in[I_WOUTE]; g = nullptr; N = 1024; col0 = nb * 32; dst = (bf16_t*)(ws + WS_W2T) + (size_t)col0 * 1024; }
            else if ((nb -= NB2) < NB3) { src = a.in[I_WINO]; g = a.in[I_NORMG] + 1024; N = N3; col0 = nb * 32; dst = (bf16_t*)(ws + WS_W3T) + (size_t)col0 * 1024; }
            else { nb -= NB3; src = a.in[I_WOUTO]; g = nullptr; N = 1024; col0 = nb * 32; dst = (bf16_t*)(ws + WS_W4T) + (size_t)col0 * 1024; }
            float xv[32];
#pragma unroll
            for (int i = 0; i < 32; ++i) { const int kk = 2 * i + (lane >> 5); xv[i] = zero ? 0.f : src[(size_t)(k0 + kk) * N + col0 + (lane & 31)]; }
#pragma unroll
            for (int i = 0; i < 32; ++i) { const int kk = 2 * i + (lane >> 5); float x = xv[i]; if (g) x *= g[k0 + kk]; scr[kk * 33 + (lane & 31)] = x; }
            asm volatile("s_waitcnt lgkmcnt(0)" ::: "memory");
            const int c8 = lane & 7;
#pragma unroll
            for (int j = 0; j < 4; ++j) { const int n = (lane >> 3) + 8 * j; const LAS float* sp = scr + (8 * c8) * 33 + n;
                u32x4 o; o.x = pk2(sp[0 * 33], sp[1 * 33]); o.y = pk2(sp[2 * 33], sp[3 * 33]); o.z = pk2(sp[4 * 33], sp[5 * 33]); o.w = pk2(sp[6 * 33], sp[7 * 33]);
                *(u32x4*)(dst + (size_t)n * 1024 + k0 + 8 * c8) = o; }
            asm volatile("s_waitcnt lgkmcnt(0)" ::: "memory");
        }
    }
    const float* x = a.in[I_X]; bf16_t* XN = (bf16_t*)(ws + WS_XN); float* rs0 = (float*)(ws + WS_RS0);
    const int gw = blockIdx.x * 8 + wave, NGW = gridDim.x * 8;
    for (int m0 = gw; m0 < M; m0 += 8 * NGW) {
        f32x4 v[8][4];
#pragma unroll
        for (int r = 0; r < 8; ++r) { const int m = m0 + r * NGW; if (m < M) { const f32x4* xr = (const f32x4*)(x + (size_t)m * DM) + lane;
#pragma unroll
            for (int j = 0; j < 4; ++j) v[r][j] = __builtin_nontemporal_load(xr + 64 * j); } }
#pragma unroll
        for (int r = 0; r < 8; ++r) { const int m = m0 + r * NGW; if (m < M) {
            float s = 0.f;
#pragma unroll
            for (int j = 0; j < 4; ++j) s += (v[r][j].x * v[r][j].x + v[r][j].y * v[r][j].y) + (v[r][j].z * v[r][j].z + v[r][j].w * v[r][j].w);
            s = wave_sum(s);
            const float rinv = rsqrtf(s * (1.0f / DM) + RMS_EPS);
            u32x2* o = (u32x2*)(XN + (size_t)m * DM) + lane;
#pragma unroll
            for (int j = 0; j < 4; ++j) { u32x2 w; w.x = pk2(v[r][j].x * rinv, v[r][j].y * rinv); w.y = pk2(v[r][j].z * rinv, v[r][j].w * rinv); o[64 * j] = w; }
            if (lane == 0) rs0[m] = s; } }
    }
    float* rs1 = (float*)(ws + WS_RS1); float* rs2 = (float*)(ws + WS_RS2); float* vsum = (float*)(ws + WS_VSUM); float* vsq = (float*)(ws + WS_VSQ);
    for (int i = gtid; i < M; i += nthr) { rs1[i] = 0.f; rs2[i] = 0.f; vsum[i] = 0.f; vsq[i] = 0.f; }
    { bf16_t* LW = (bf16_t*)(ws + WS_LW); const float* w2 = a.in[I_W2]; const float* a2 = a.in[I_A2];
      for (int i = gtid; i < 2 * 512 * 64; i += nthr) { const int j = i & 63, cc = (i >> 6) & 511, mat = i >> 15; LW[i] = f2bf((mat ? a2 : w2)[j * 512 + cc]); } }
    { bf16_t* SGW = (bf16_t*)(ws + WS_SGW); const float* sgw = a.in[I_SGW];
      for (int i = gtid; i < 8 * 128 * 128; i += nthr) { const int jj = i & 127, ii = (i >> 7) & 127; SGW[i] = f2bf(((jj >> 6) <= (ii >> 6)) ? sgw[i] : 0.f); } }
}

struct EpiG1 {
    const float* rs0; bf16_t* PA; bf16_t* PB;
    static constexpr int NSTAT = 0; static constexpr bool HAS_RES = false;
    __device__ __forceinline__ float rowval(int) const { return 0.f; }
    __device__ __forceinline__ f32x4 resload(int, int) const { return (f32x4){0.f, 0.f, 0.f, 0.f}; }
    __device__ __forceinline__ void commit(int, float, float) const {}
    __device__ __forceinline__ f32x2 operator()(int row, int col, f32x4 v0, f32x4 v1, float = 0.f) const {
        u32x4 w; w.x = pk2(v0[0], v0[1]); w.y = pk2(v0[2], v0[3]); w.z = pk2(v1[0], v1[1]); w.w = pk2(v1[2], v1[3]);
        bf16_t* dst = col < NA ? PA + (size_t)row * NA + col : PB + (size_t)row * NB + (col - NA);
        *(u32x4*)dst = w;
        return (f32x2){0.f, 0.f};
    }
};
struct EpiG2 {
    const float* x; float* out; bf16_t* HB; float* rs1;
    __device__ __forceinline__ float quad(int row, int col, f32x4 v) const {
        const size_t off = (size_t)row * DM + col;
        v = v + *(const f32x4*)(x + off);
        *(f32x4*)(out + off) = v;
        u32x2 w; w.x = pk2(v[0], v[1]); w.y = pk2(v[2], v[3]);
        *(u32x2*)(HB + off) = w;
        return (v[0] * v[0] + v[1] * v[1]) + (v[2] * v[2] + v[3] * v[3]);
    }
    static constexpr int NSTAT = 1; static constexpr bool HAS_RES = true;
    __device__ __forceinline__ float rowval(int) const { return 0.f; }
    __device__ __forceinline__ f32x4 resload(int row, int col) const { return *(const f32x4*)(x + (size_t)row * DM + col); }
    __device__ __forceinline__ void commit(int row, float s0, float) const { unsafeAtomicAdd(rs1 + row, s0); }
    __device__ __forceinline__ f32x2 operator()(int row, int col, f32x4 v0, f32x4 v1, float = 0.f) const {
        const size_t off = (size_t)row * DM + col;
        *(f32x4*)(out + off) = v0; *(f32x4*)(out + off + 4) = v1;
        u32x4 w; w.x = pk2(v0[0], v0[1]); w.y = pk2(v0[2], v0[3]); w.z = pk2(v1[0], v1[1]); w.w = pk2(v1[2], v1[3]);
        *(u32x4*)(HB + off) = w;
        const float s = (v0[0] * v0[0] + v0[1] * v0[1]) + (v0[2] * v0[2] + v0[3] * v0[3]) + (v1[0] * v1[0] + v1[1] * v1[1]) + (v1[2] * v1[2] + v1[3] * v1[3]);
        return (f32x2){s, 0.f};
    }
};
struct EpiG3 {
    const float* rs1; bf16_t* P1; float* vsum; float* vsq;
    static constexpr int NSTAT = 2; static constexpr bool HAS_RES = false;
    __device__ __forceinline__ float rowval(int row) const { return rs1[row]; }
    __device__ __forceinline__ f32x4 resload(int, int) const { return (f32x4){0.f, 0.f, 0.f, 0.f}; }
    __device__ __forceinline__ void commit(int row, float s0, float s1) const { if (s1 != 0.f) { unsafeAtomicAdd(vsum + row, s0); unsafeAtomicAdd(vsq + row, s1); } }
    __device__ __forceinline__ f32x2 operator()(int row, int col, f32x4 v0, f32x4 v1, float rsv) const {
        f32x2 ret = (f32x2){0.f, 0.f};
        const float rinv = rsqrtf(rsv * (1.0f / DM) + RMS_EPS);
        float v[8];
#pragma unroll
        for (int j = 0; j < 4; ++j) { v[j] = v0[j] * rinv; v[4 + j] = v1[j] * rinv; }
        if (col < 2048) {
#pragma unroll
            for (int j = 0; j < 8; ++j) v[j] = gelu_tanh(v[j]);
            if (col >= 1024) {
                float s = 0.f, q = 0.f;
#pragma unroll
                for (int j = 0; j < 8; ++j) { s += v[j]; q += v[j] * v[j]; }
                ret = (f32x2){s, q};
            }
        } else {
#pragma unroll
            for (int j = 0; j < 8; ++j) v[j] = siluf_(v[j]);
        }
        u32x4 w; w.x = pk2(v[0], v[1]); w.y = pk2(v[2], v[3]); w.z = pk2(v[4], v[5]); w.w = pk2(v[6], v[7]);
        *(u32x4*)(P1 + (size_t)row * N3 + col) = w;
        return ret;
    }
};
struct EpiG4 {
    float* out; float* rs2;
    __device__ __forceinline__ float quad(int row, int col, f32x4 v) const {
        const size_t off = (size_t)row * DM + col;
        v = v + *(const f32x4*)(out + off);
        *(f32x4*)(out + off) = v;
        return (v[0] * v[0] + v[1] * v[1]) + (v[2] * v[2] + v[3] * v[3]);
    }
    static constexpr int NSTAT = 1; static constexpr bool HAS_RES = false;
    __device__ __forceinline__ float rowval(int) const { return 0.f; }
    __device__ __forceinline__ f32x4 resload(int, int) const { return (f32x4){0.f, 0.f, 0.f, 0.f}; }
    __device__ __forceinline__ void commit(int row, float s0, float) const { unsafeAtomicAdd(rs2 + row, s0); }
    __device__ __forceinline__ f32x2 operator()(int row, int col, f32x4 v0, f32x4 v1, float = 0.f) const {
        const size_t off = (size_t)row * DM + col;
        v0 = v0 + *(const f32x4*)(out + off); v1 = v1 + *(const f32x4*)(out + off + 4);
        *(f32x4*)(out + off) = v0; *(f32x4*)(out + off + 4) = v1;
        const float s = (v0[0] * v0[0] + v0[1] * v0[1]) + (v0[2] * v0[2] + v0[3] * v0[3]) + (v1[0] * v1[0] + v1[1] * v1[1]) + (v1[2] * v1[2] + v1[3] * v1[3]);
        return (f32x2){s, 0.f};
    }
};


struct EpiG4X {
    static constexpr bool PERM = true, AFTER_DRAIN = false;
    float* out; const float* fg; float* exch; unsigned* cnt; LAS unsigned char* scr;
    __device__ __forceinline__ void operator()(pg8::f32x4 (&acc)[2][2][4][2], const pg8::Unit& u, int wr_, int wc_, int fr_, int fq_) const {
        int tid = threadIdx.x, wr = wr_, wc = wc_, fr = fr_, fq = fq_;
        asm volatile("" : "+v"(tid), "+v"(fr), "+v"(fq));
        const int lane = tid & 63;
        LAS float* P = (LAS float*)scr;
        LAS float* S = (LAS float*)(scr + 4096);
#pragma unroll
        for (int ai = 0; ai < 2; ++ai)
#pragma unroll
            for (int m = 0; m < 4; ++m) {
                const int rl = ai * 128 + wr * 64 + m * 16 + fr; const size_t rowoff = (size_t)(u.pm * 256 + rl) * DM;
                float sq = 0.f;
#pragma unroll
                for (int bj = 0; bj < 2; ++bj) { const size_t off = rowoff + u.pn * 256 + bj * 128 + wc * 32 + 8 * fq;
                    f32x4 v0 = acc[ai][bj][m][0] + *(const f32x4*)(out + off), v1 = acc[ai][bj][m][1] + *(const f32x4*)(out + off + 4);
                    acc[ai][bj][m][0] = v0; acc[ai][bj][m][1] = v1;
                    sq += ((v0[0] * v0[0] + v0[1] * v0[1]) + (v0[2] * v0[2] + v0[3] * v0[3])) + ((v1[0] * v1[0] + v1[1] * v1[1]) + (v1[2] * v1[2] + v1[3] * v1[3])); }
                sq += __shfl_xor(sq, 16); sq += __shfl_xor(sq, 32);
                if (fq == 0) P[rl * 4 + wc] = sq;
                if (m == 3) asm volatile("" ::: "memory");
            }
        asm volatile("s_waitcnt vmcnt(0) lgkmcnt(0)" ::: "memory"); __builtin_amdgcn_s_barrier(); asm volatile("" ::: "memory");
        if (tid < 256) {
            const f32x4 p = *(const LAS f32x4*)(P + tid * 4);
            __hip_atomic_store(exch + (size_t)(u.pm * 256 + tid) * 4 + u.pn, (p[0] + p[1]) + (p[2] + p[3]), __ATOMIC_RELAXED, __HIP_MEMORY_SCOPE_AGENT);
            asm volatile("s_waitcnt vmcnt(0)" ::: "memory");
            if (lane == 0) __hip_atomic_fetch_add(cnt + 64 * u.pm, 1u, __ATOMIC_RELAXED, __HIP_MEMORY_SCOPE_AGENT);
        }
        if (tid < 64) {
            unsigned spins = 0;
            while ((unsigned)__builtin_amdgcn_readfirstlane(__hip_atomic_load(cnt + 64 * u.pm, __ATOMIC_RELAXED, __HIP_MEMORY_SCOPE_AGENT)) < 16u) { __builtin_amdgcn_s_sleep(2); if (++spins > (1u << 22)) break; }
            __builtin_amdgcn_fence(__ATOMIC_ACQUIRE, "agent");
        }
        asm volatile("s_waitcnt vmcnt(0) lgkmcnt(0)" ::: "memory"); __builtin_amdgcn_s_barrier(); asm volatile("" ::: "memory");
        if (tid < 256) {
            const float* e = exch + (size_t)(u.pm * 256 + tid) * 4;
            const float t = (__hip_atomic_load(e, __ATOMIC_RELAXED, __HIP_MEMORY_SCOPE_AGENT) + __hip_atomic_load(e + 1, __ATOMIC_RELAXED, __HIP_MEMORY_SCOPE_AGENT))
                          + (__hip_atomic_load(e + 2, __ATOMIC_RELAXED, __HIP_MEMORY_SCOPE_AGENT) + __hip_atomic_load(e + 3, __ATOMIC_RELAXED, __HIP_MEMORY_SCOPE_AGENT));
            S[tid] = rsqrtf(t * (1.0f / DM) + RMS_EPS);
        }
        asm volatile("s_waitcnt vmcnt(0) lgkmcnt(0)" ::: "memory"); __builtin_amdgcn_s_barrier(); asm volatile("" ::: "memory");
        const int pm5 = u.pm, pn5 = u.pn;
#pragma unroll
        for (int bj = 0; bj < 2; ++bj) {
            const int colb = pn5 * 256 + bj * 128 + wc * 32 + 8 * fq;
            const f32x4 g0 = *(const f32x4*)(fg + colb), g1 = *(const f32x4*)(fg + colb + 4);
#pragma unroll
            for (int ai = 0; ai < 2; ++ai)
#pragma unroll
                for (int m = 0; m < 4; ++m) {
                    const int rl = ai * 128 + wr * 64 + m * 16 + fr; const float rinv = S[rl];
                    const size_t off = (size_t)(pm5 * 256 + rl) * DM + colb;
                    __builtin_nontemporal_store(acc[ai][bj][m][0] * rinv * g0, (f32x4*)(out + off)); __builtin_nontemporal_store(acc[ai][bj][m][1] * rinv * g1, (f32x4*)(out + off + 4));
                }
        }
        asm volatile("s_waitcnt lgkmcnt(0)" ::: "memory"); __builtin_amdgcn_s_barrier(); asm volatile("" ::: "memory");
    }
};

template <class F> struct EpiAdapt {
    static constexpr bool PERM = true, AFTER_DRAIN = false;
    F f;
    __device__ __forceinline__ void operator()(const pg8::f32x4 (&acc)[2][2][4][2], const pg8::Unit& u, int wr, int wc, int fr, int fq) const {
        float rv[2][4];
#pragma unroll
        for (int ai = 0; ai < 2; ++ai)
#pragma unroll
            for (int m = 0; m < 4; ++m) rv[ai][m] = f.rowval(u.pm * 256 + ai * 128 + wr * 64 + m * 16 + fr);
#pragma unroll
        for (int ai = 0; ai < 2; ++ai) {
            f32x4 res[4][2][2];
            if (F::HAS_RES) {
#pragma unroll
                for (int m = 0; m < 4; ++m)
#pragma unroll
                    for (int bj = 0; bj < 2; ++bj) { const int row = u.pm * 256 + ai * 128 + wr * 64 + m * 16 + fr; const int col = u.pn * 256 + bj * 128 + wc * 32 + 8 * fq;
                        res[m][bj][0] = f.resload(row, col); res[m][bj][1] = f.resload(row, col + 4); }
                asm volatile("" ::: "memory");
            }
#pragma unroll
            for (int m = 0; m < 4; ++m) {
                const int row = u.pm * 256 + ai * 128 + wr * 64 + m * 16 + fr;
                f32x2 st = (f32x2){0.f, 0.f};
#pragma unroll
                for (int bj = 0; bj < 2; ++bj) { const int col = u.pn * 256 + bj * 128 + wc * 32 + 8 * fq;
                    f32x4 a0 = acc[ai][bj][m][0], a1 = acc[ai][bj][m][1];
                    if (F::HAS_RES) { a0 = a0 + res[m][bj][0]; a1 = a1 + res[m][bj][1]; }
                    const f32x2 r = f(row, col, a0, a1, rv[ai][m]); st = st + r; }
                if (F::NSTAT >= 1) { st.x += __shfl_xor(st.x, 16); st.x += __shfl_xor(st.x, 32); }
                if (F::NSTAT >= 2) { st.y += __shfl_xor(st.y, 16); st.y += __shfl_xor(st.y, 32); }
                if (F::NSTAT >= 1 && fq == 0) f.commit(row, st.x, st.y);
            }
        }
    }
};


template <class F> struct EpiAdaptNP {
    static constexpr bool PERM = false, AFTER_DRAIN = false;
    F f;
    __device__ __forceinline__ void operator()(const pg8::f32x4 (&acc)[2][2][4][2], const pg8::Unit& u, int wr, int wc, int fr, int fq) const {
#pragma unroll
        for (int ai = 0; ai < 2; ++ai)
#pragma unroll
            for (int m = 0; m < 4; ++m) {
                const int row = u.pm * 256 + ai * 128 + wr * 64 + m * 16 + fr;
                float st = 0.f;
#pragma unroll
                for (int bj = 0; bj < 2; ++bj)
#pragma unroll
                    for (int n = 0; n < 2; ++n) { const int col = u.pn * 256 + bj * 128 + wc * 32 + 16 * n + 4 * fq; st += f.quad(row, col, acc[ai][bj][m][n]); }
                st += __shfl_xor(st, 16); st += __shfl_xor(st, 32);
                if (fq == 0) f.commit(row, st, 0.f);
            }
    }
};

template <class F> __device__ __forceinline__ void gemm_naive(float* lds, const bf16_t* A, const bf16_t* Bt, int Mm, int N, int K, const F& f) {
    const int tid = threadIdx.x, ty = tid >> 4, tx = tid & 15;
    float* As = lds; float* Bs = lds + 32 * 132;
    const int ntn = N / 128, ntiles = (Mm / 128) * ntn;
    for (int tile = blockIdx.x; tile < ntiles; tile += gridDim.x) {
        const int tm = tile / ntn, tn = tile % ntn;
        float acc[4][8];
#pragma unroll
        for (int i = 0; i < 4; ++i)
#pragma unroll
            for (int j = 0; j < 8; ++j) acc[i][j] = 0.f;
        for (int k0 = 0; k0 < K; k0 += 32) {
            { const int row = tid >> 2, kc = (tid & 3) * 8;
              const u32x4 va = *(const u32x4*)(A + (size_t)(tm * 128 + row) * K + k0 + kc);
              const u32x4 vb = *(const u32x4*)(Bt + (size_t)(tn * 128 + row) * K + k0 + kc);
              As[(kc + 0) * 132 + row] = bflo(va.x); As[(kc + 1) * 132 + row] = bfhi(va.x); As[(kc + 2) * 132 + row] = bflo(va.y); As[(kc + 3) * 132 + row] = bfhi(va.y);
              As[(kc + 4) * 132 + row] = bflo(va.z); As[(kc + 5) * 132 + row] = bfhi(va.z); As[(kc + 6) * 132 + row] = bflo(va.w); As[(kc + 7) * 132 + row] = bfhi(va.w);
              Bs[(kc + 0) * 132 + row] = bflo(vb.x); Bs[(kc + 1) * 132 + row] = bfhi(vb.x); Bs[(kc + 2) * 132 + row] = bflo(vb.y); Bs[(kc + 3) * 132 + row] = bfhi(vb.y);
              Bs[(kc + 4) * 132 + row] = bflo(vb.z); Bs[(kc + 5) * 132 + row] = bfhi(vb.z); Bs[(kc + 6) * 132 + row] = bflo(vb.w); Bs[(kc + 7) * 132 + row] = bfhi(vb.w); }
            __syncthreads();
#pragma unroll 8
            for (int kk = 0; kk < 32; ++kk) {
                const f32x4 a4 = *(const f32x4*)(As + kk * 132 + ty * 4);
                const f32x4 b0 = *(const f32x4*)(Bs + kk * 132 + tx * 8), b1 = *(const f32x4*)(Bs + kk * 132 + tx * 8 + 4);
#pragma unroll
                for (int i = 0; i < 4; ++i) {
#pragma unroll
                    for (int j = 0; j < 4; ++j) { acc[i][j] += a4[i] * b0[j]; acc[i][4 + j] += a4[i] * b1[j]; }
                }
            }
            __syncthreads();
        }
#pragma unroll
        for (int i = 0; i < 4; ++i) { const f32x2 r = f(tm * 128 + ty * 4 + i, tn * 128 + tx * 8, (f32x4){acc[i][0], acc[i][1], acc[i][2], acc[i][3]}, (f32x4){acc[i][4], acc[i][5], acc[i][6], acc[i][7]}); if (F::NSTAT >= 1) f.commit(tm * 128 + ty * 4 + i, r.x, r.y); }
    }
}

template <class F> __device__ __forceinline__ void gemm_np(unsigned char* lds, const bf16_t* A, const bf16_t* Bt, int Mm, int N, int K, const F& f) {
    pg8::Gemm g{A, Bt, Mm, N, K}; pg8::StaticOrder S; S.init(Mm, N, (int)gridDim.x, (int)blockIdx.x);
    EpiAdaptNP<F> E{f};
    pg8::gemm_phase<EpiAdaptNP<F>, pg8::StaticOrder, false, true>((PG8_LAS unsigned char*)lds, g, S, E);
}
template <class F, bool ALIGN = true> __device__ __forceinline__ void gemm_any(unsigned char* lds, const bf16_t* A, const bf16_t* Bt, int Mm, int N, int K, const F& f) {
#if USE_PG8
    pg8::Gemm g{A, Bt, Mm, N, K}; pg8::StaticOrder S; S.init(Mm, N, (int)gridDim.x, (int)blockIdx.x);
    EpiAdapt<F> E{f};
    pg8::gemm_phase<EpiAdapt<F>, pg8::StaticOrder, ALIGN, true>((PG8_LAS unsigned char*)lds, g, S, E);
#else
    gemm_naive((float*)lds, A, Bt, Mm, N, K, f);
#endif
}

typedef short pbf16x8 __attribute__((ext_vector_type(8)));
template <int CTRL> __device__ __forceinline__ float pdpp_add(float x) { return x + __uint_as_float(__builtin_amdgcn_update_dpp(0, __float_as_uint(x), CTRL, 0xf, 0xf, true)); }
__device__ __forceinline__ float wave_sum_dpp(float x) {
    x = pdpp_add<0x128>(x); x = pdpp_add<0x124>(x); x = pdpp_add<0x122>(x); x = pdpp_add<0x121>(x);
    const unsigned u = __float_as_uint(x);
    return (__uint_as_float(__builtin_amdgcn_readlane(u, 0)) + __uint_as_float(__builtin_amdgcn_readlane(u, 16))) + (__uint_as_float(__builtin_amdgcn_readlane(u, 32)) + __uint_as_float(__builtin_amdgcn_readlane(u, 48)));
}
__device__ __forceinline__ void lds_barrier() { asm volatile("s_waitcnt lgkmcnt(0)" ::: "memory"); __builtin_amdgcn_s_barrier(); asm volatile("" ::: "memory"); }
__device__ __forceinline__ unsigned char* rec_base(const Args& a, int u) {
    if (u < 80) return (unsigned char*)a.out + (size_t)u * 128 * RSZ;
    if (u < 118) return a.ws + WS_XN + (size_t)(u - 80) * 128 * RSZ;
    return a.ws + WS_TAIL + (size_t)(u - 118) * 128 * RSZ;
}
__device__ __forceinline__ void phase_prep(const Args& a, unsigned char* ldsb, int variant = 0) {
    const int tid = threadIdx.x, lane = tid & 63, wave = tid >> 6, fr = lane & 15, quad = lane >> 4;
    unsigned char* ws = a.ws;
    const bf16_t* PA = (const bf16_t*)(ws + WS_PA);
    bf16_t* VR = (bf16_t*)(ws + WS_VRAW); float* BON = (float*)(ws + WS_BON);
    const float* mu = a.in[I_SHMU];
    LAS unsigned char* lds = (LAS unsigned char*)ldsb;
    constexpr int HAT_OFF = 69888;
    constexpr int XPB = 272;
    constexpr int RES_OFF = 4352;
    if (blockIdx.x == 0 && tid == 0) *(unsigned*)(ws + WS_CTR) = 0u;
    const int c = tid;
    const float w0 = a.in[I_W0][c], a0 = a.in[I_A0][c], kkc = a.in[I_KK][c], kac = a.in[I_KA][c], rkc = a.in[I_RK][c];
    const float mur = mu[c], muk = mu[512 + c], muv = mu[1024 + c];
    const bf16_t* LW = (const bf16_t*)(ws + WS_LW);
    pbf16x8 wf[2][4][2];
#pragma unroll
    for (int mat = 0; mat < 2; ++mat)
#pragma unroll
        for (int mt = 0; mt < 4; ++mt)
#pragma unroll
            for (int ks = 0; ks < 2; ++ks) wf[mat][mt][ks] = *(const pbf16x8*)(LW + (size_t)(mat * 512 + wave * 64 + mt * 16 + fr) * 64 + ks * 32 + 8 * quad);
    const int stok = tid >> 5, sj4 = (tid & 31) * 4;
    const f32x4 smu = *(const f32x4*)(mu + 1536 + sj4);
    u32x2 spw, sqw;
#define PREP_SLOAD(uu) do { const int t_ = (uu) * 16 + stok; spw = *(const u32x2*)(PA + (size_t)t_ * NA + 1536 + sj4); sqw = spw; if ((t_ % SEQ) != 0) sqw = *(const u32x2*)(PA + (size_t)(t_ - 1) * NA + 1536 + sj4); } while (0)
    if ((int)blockIdx.x < M / 16) PREP_SLOAD(blockIdx.x);
    for (int u = blockIdx.x; u < M / 16; u += gridDim.x) {
        const int t0 = u * 16;
        unsigned short gr[17], gk[17], gv[17];
        { const bool first0 = (t0 % SEQ) == 0;
          gr[0] = 0; gk[0] = 0; gv[0] = 0;
          if (!first0) { const bf16_t* q = PA + (size_t)(t0 - 1) * NA; gr[0] = q[c]; gk[0] = q[512 + c]; gv[0] = q[1024 + c]; }
#pragma unroll
          for (int i = 0; i < 16; ++i) { const bf16_t* p = PA + (size_t)(t0 + i) * NA; gr[i + 1] = p[c]; gk[i + 1] = p[512 + c]; gv[i + 1] = p[1024 + c]; } }
        {   const int t = t0 + stok; const bool first = (t % SEQ) == 0;
            const u32x2 pw = spw, qw = sqw;
            float x0 = bflo(pw.x), x1 = bfhi(pw.x), x2 = bflo(pw.y), x3 = bfhi(pw.y);
            const float y0 = first ? 0.f : bflo(qw.x), y1 = first ? 0.f : bfhi(qw.x), y2 = first ? 0.f : bflo(qw.y), y3 = first ? 0.f : bfhi(qw.y);
            x0 += (y0 - x0) * smu.x; x1 += (y1 - x1) * smu.y; x2 += (y2 - x2) * smu.z; x3 += (y3 - x3) * smu.w;
            if (sj4 < 64) { x0 = 1.0f - 2.0f / (__expf(2.0f * x0) + 1.0f); x1 = 1.0f - 2.0f / (__expf(2.0f * x1) + 1.0f); x2 = 1.0f - 2.0f / (__expf(2.0f * x2) + 1.0f); x3 = 1.0f - 2.0f / (__expf(2.0f * x3) + 1.0f); }
            u32x2 o; o.x = pk2(x0, x1); o.y = pk2(x2, x3);
            *(LAS u32x2*)(lds + stok * XPB + sj4 * 2) = o; }
        if (u + (int)gridDim.x < M / 16) PREP_SLOAD(u + gridDim.x);
        lds_barrier();
#pragma unroll
        for (int mat = 0; mat < 2; ++mat)
#pragma unroll
            for (int mt = 0; mt < 4; ++mt) {
                f32x4 acc = (f32x4){0.f, 0.f, 0.f, 0.f};
#pragma unroll
                for (int ks = 0; ks < 2; ++ks) { const pbf16x8 xf = *(const LAS pbf16x8*)(lds + fr * XPB + (mat * 64 + ks * 32 + 8 * quad) * 2); acc = __builtin_amdgcn_mfma_f32_16x16x32_bf16(wf[mat][mt][ks], xf, acc, 0, 0, 0); }
                *(LAS f32x4*)(lds + RES_OFF + ((mat * 16 + fr) * 512 + wave * 64 + mt * 16 + 4 * quad) * 4) = acc;
            }
        lds_barrier();
        float rp = bf2f(gr[0]), kp_ = bf2f(gk[0]), vp = bf2f(gv[0]);
        unsigned char* rec = rec_base(a, (t0 / SEQ) * 8 + wave) + (size_t)((t0 % SEQ) / 16) * RSZ;
        LAS unsigned char* hb = lds + HAT_OFF + wave * 9216;
        float Pprev = 1.0f;
        if (variant != 2)
#pragma unroll
        for (int i = 0; i < 16; ++i) {
            const int t = t0 + i;
            const float rc = bf2f(gr[i + 1]), kc = bf2f(gk[i + 1]), vc = bf2f(gv[i + 1]);
            const float r = rc + (rp - rc) * mur, k = kc + (kp_ - kc) * muk, v = vc + (vp - vc) * muv;
            rp = rc; kp_ = kc; vp = vc;
            const float z = *(const LAS float*)(lds + RES_OFF + (i * 512 + c) * 4) + w0;
            const float za = *(const LAS float*)(lds + RES_OFF + ((16 + i) * 512 + c) * 4) + a0;
            const float sp = fmaxf(-z, 0.f) + __logf(1.0f + __expf(-fabsf(z)));
            const float w = -sp - 0.5f;
            const float dec = __expf(-__expf(w));
            const float av = __builtin_amdgcn_rcpf(1.0f + __expf(-za));
            float kk = k * kkc; const float ss = wave_sum_dpp(kk * kk); kk = kk * __builtin_amdgcn_rcpf(fmaxf(__builtin_amdgcn_sqrtf(ss), 1e-12f));
            const float kn = k * (1.0f + (av - 1.0f) * kac);
            const float bon = wave_sum_dpp(r * kn * rkc);
            const float P = Pprev * dec, iP = __builtin_amdgcn_rcpf(P);
            LAS unsigned short* hat = (LAS unsigned short*)hb + i * 72 + lane;
            hat[0] = f2bf(-kk * Pprev); hat[1152] = f2bf(r * P); hat[2304] = f2bf(kk * av * iP); hat[3456] = f2bf(kn * iP);
            Pprev = P;
            const unsigned short vb16 = f2bf(v);
            VR[(size_t)t * 512 + c] = vb16;
            *(unsigned short*)(rec + 8192 + (lane >> 4) * 512 + ((i >> 2) * 16 + (lane & 15)) * 8 + (i & 3) * 2) = vb16;
            if (lane == 0) BON[t * 8 + wave] = bon;
        }
        __builtin_nontemporal_store(Pprev, (float*)(rec + 12288 + lane * 4));
        asm volatile("s_waitcnt lgkmcnt(0)" ::: "memory");
        if (variant != 1) {
            pbf16x8 fa[2], fr2[2], fb[2], fk[2];
#pragma unroll
            for (int ks = 0; ks < 2; ++ks) { const int off = fr * 144 + (ks * 32 + 8 * quad) * 2;
                fa[ks] = *(const LAS pbf16x8*)(hb + off); fr2[ks] = *(const LAS pbf16x8*)(hb + 2304 + off); fb[ks] = *(const LAS pbf16x8*)(hb + 4608 + off); fk[ks] = *(const LAS pbf16x8*)(hb + 6912 + off); }
            f32x4 cba = (f32x4){0.f, 0.f, 0.f, 0.f}, cka = cba, cbr = cba, ckr = cba;
#pragma unroll
            for (int ks = 0; ks < 2; ++ks) { cba = __builtin_amdgcn_mfma_f32_16x16x32_bf16(fb[ks], fa[ks], cba, 0, 0, 0); cka = __builtin_amdgcn_mfma_f32_16x16x32_bf16(fk[ks], fa[ks], cka, 0, 0, 0);
                                             cbr = __builtin_amdgcn_mfma_f32_16x16x32_bf16(fb[ks], fr2[ks], cbr, 0, 0, 0); ckr = __builtin_amdgcn_mfma_f32_16x16x32_bf16(fk[ks], fr2[ks], ckr, 0, 0, 0); }
            float nn[4];
            {   float x0[4], x1[4], x2[4];
#pragma unroll
                for (int e = 0; e < 4; ++e) { const int j = 4 * quad + e; x0[e] = (j < fr) ? cka[e] : 0.f; x1[e] = (j <= fr) ? ckr[e] : 0.f; x2[e] = (j <= fr) ? cbr[e] : 0.f; nn[e] = (j < fr) ? cba[e] : 0.f; }
                u32x2 w; w.x = pk2(x0[0], x0[1]); w.y = pk2(x0[2], x0[3]); __builtin_nontemporal_store(w, (u32x2*)(rec + 10240 + lane * 8));
                w.x = pk2(x1[0], x1[1]); w.y = pk2(x1[2], x1[3]); __builtin_nontemporal_store(w, (u32x2*)(rec + 10752 + lane * 8));
                w.x = pk2(x2[0], x2[1]); w.y = pk2(x2[2], x2[3]); __builtin_nontemporal_store(w, (u32x2*)(rec + 11776 + lane * 8)); }
#pragma unroll
            for (int ks = 0; ks < 2; ++ks) {
                const u32x2 alo = *(const LAS u32x2*)(hb + fr * 144 + (32 * ks + 4 * quad) * 2), ahi = *(const LAS u32x2*)(hb + fr * 144 + (32 * ks + 16 + 4 * quad) * 2);
                const u32x2 rlo = *(const LAS u32x2*)(hb + 2304 + fr * 144 + (32 * ks + 4 * quad) * 2), rhi = *(const LAS u32x2*)(hb + 2304 + fr * 144 + (32 * ks + 16 + 4 * quad) * 2);
                __builtin_nontemporal_store((u32x4){alo.x, alo.y, ahi.x, ahi.y}, (u32x4*)(rec + ks * 1024 + lane * 16));
                __builtin_nontemporal_store((u32x4){rlo.x, rlo.y, rhi.x, rhi.y}, (u32x4*)(rec + 2048 + ks * 1024 + lane * 16));
            }
#pragma unroll
            for (int mt = 0; mt < 4; ++mt) {
                const LAS unsigned short* hB = (const LAS unsigned short*)(hb + 4608) + (4 * quad) * 72 + 16 * mt + fr;
                const LAS unsigned short* hK = (const LAS unsigned short*)(hb + 6912) + (4 * quad) * 72 + 16 * mt + fr;
                u32x4 o; o.x = (unsigned)hB[0] | ((unsigned)hB[72] << 16); o.y = (unsigned)hB[144] | ((unsigned)hB[216] << 16); o.z = (unsigned)hK[0] | ((unsigned)hK[72] << 16); o.w = (unsigned)hK[144] | ((unsigned)hK[216] << 16);
                __builtin_nontemporal_store(o, (u32x4*)(rec + 4096 + mt * 1024 + lane * 16));
            }
            asm volatile("s_waitcnt lgkmcnt(0)" ::: "memory");
            LAS float* NL = (LAS float*)hb;
#pragma unroll
            for (int e = 0; e < 4; ++e) NL[(4 * quad + e) * 16 + fr] = nn[e];
            asm volatile("s_waitcnt lgkmcnt(0)" ::: "memory");
            float X[16];
#pragma unroll
            for (int l = 0; l < 16; ++l) X[l] = (l == fr) ? 1.0f : 0.f;
#pragma unroll
            for (int j = 14; j >= 0; --j) {
                const f32x4 n0 = ((const LAS f32x4*)NL)[j * 4], n1 = ((const LAS f32x4*)NL)[j * 4 + 1], n2 = ((const LAS f32x4*)NL)[j * 4 + 2], n3 = ((const LAS f32x4*)NL)[j * 4 + 3];
                const float nr[16] = {n0.x, n0.y, n0.z, n0.w, n1.x, n1.y, n1.z, n1.w, n2.x, n2.y, n2.z, n2.w, n3.x, n3.y, n3.z, n3.w};
                float acc = X[j];
#pragma unroll
                for (int l = j + 1; l < 16; ++l) acc = __builtin_fmaf(nr[l], X[l], acc);
                X[j] = acc;
            }
            float mv[4];
#pragma unroll
            for (int e = 0; e < 4; ++e) mv[e] = quad == 0 ? X[e] : (quad == 1 ? X[4 + e] : (quad == 2 ? X[8 + e] : X[12 + e]));
            u32x2 w; w.x = pk2(mv[0], mv[1]); w.y = pk2(mv[2], mv[3]); __builtin_nontemporal_store(w, (u32x2*)(rec + 11264 + lane * 8));
            asm volatile("s_waitcnt lgkmcnt(0)" ::: "memory");
        }
    }
}

__device__ __forceinline__ float rdlane(float x, int k) { return __uint_as_float(__builtin_amdgcn_readlane(__float_as_uint(x), k)); }
__device__ __forceinline__ void phase_scan_naive(const Args& a) {
    const int tid = threadIdx.x, lane = tid & 63, wave = tid >> 6;
    if (wave != 0) return;
    unsigned char* ws = a.ws;
    const bf16_t* R = (const bf16_t*)a.out; const bf16_t* KP = R + (size_t)M * 512; const bf16_t* V = KP + (size_t)M * 512; const bf16_t* AN = V + (size_t)M * 512;
    bf16_t* YM = (bf16_t*)(ws + WS_YMIX); const float* DEC = (const float*)(ws + WS_XN); const float* BON = (const float*)(ws + WS_BON);
    const bf16_t* PB = (const bf16_t*)(ws + WS_PB);
    for (int u = blockIdx.x; u < BATCH * 8; u += gridDim.x) {
        const int b = u >> 3, h = u & 7;
        const float lg = a.in[I_LNXG][h * 64 + lane], lb = a.in[I_LNXB][h * 64 + lane];
        float s[64];
#pragma unroll
        for (int k = 0; k < 64; ++k) s[k] = 0.f;
        for (int t = 0; t < SEQ; ++t) {
            const int tok = b * SEQ + t; const size_t o = (size_t)tok * 512 + h * 64 + lane;
            const float ca = bf2f(AN[o]), cw = DEC[o], cb = bf2f(YM[(size_t)tok * 1024 + h * 64 + lane]), ck = bf2f(KP[o]), cr = bf2f(R[o]), vv = bf2f(V[o]);
            float sa = 0.f;
#pragma unroll
            for (int k = 0; k < 64; ++k) sa += s[k] * rdlane(ca, k);
            float y = 0.f;
#pragma unroll
            for (int k = 0; k < 64; ++k) { s[k] = s[k] * rdlane(cw, k) + sa * rdlane(cb, k) + vv * rdlane(ck, k); y += s[k] * rdlane(cr, k); }
            const float mean = wave_sum(y) * (1.0f / 64.0f); const float d = y - mean; const float var = wave_sum(d * d) * (1.0f / 64.0f);
            float yn = d * rsqrtf(var + GN_EPS) * lg + lb;
            yn += BON[tok * 8 + h] * vv;
            const float g = bf2f(PB[(size_t)tok * NB + h * 64 + lane]);
            YM[(size_t)tok * 1024 + h * 64 + lane] = f2bf(yn * siluf_(g));
        }
    }
}

__device__ __forceinline__ void phase_attn_naive(const Args& a) {
    const int tid = threadIdx.x, lane = tid & 63, wave = tid >> 6;
    unsigned char* ws = a.ws;
    const bf16_t* PB = (const bf16_t*)(ws + WS_PB); bf16_t* YM = (bf16_t*)(ws + WS_YMIX);
    for (int u = blockIdx.x * 8 + wave; u < BATCH * 8 * 32; u += gridDim.x * 8) {
        const int c = u & 31, h = (u >> 5) & 7, b = u >> 8;
        const int t = b * SEQ + c * 64 + lane;
        float q[64], acc[64];
        { const u32x4* qp = (const u32x4*)(PB + (size_t)t * NB + 512 + h * 64);
#pragma unroll
          for (int i = 0; i < 8; ++i) { const u32x4 w = qp[i]; q[8 * i] = bflo(w.x) * 0.125f; q[8 * i + 1] = bfhi(w.x) * 0.125f; q[8 * i + 2] = bflo(w.y) * 0.125f; q[8 * i + 3] = bfhi(w.y) * 0.125f;
              q[8 * i + 4] = bflo(w.z) * 0.125f; q[8 * i + 5] = bfhi(w.z) * 0.125f; q[8 * i + 6] = bflo(w.w) * 0.125f; q[8 * i + 7] = bfhi(w.w) * 0.125f; } }
#pragma unroll
        for (int d = 0; d < 64; ++d) acc[d] = 0.f;
        float m = -1e30f, l = 0.f;
        const float* bt = a.in[I_ABIAS] + h * 257;
        const int k0 = (c - 8 > 0 ? c - 8 : 0) * 64, k1 = (c + 1) * 64;
        for (int kj = k0; kj < k1; ++kj) {
            const bf16_t* kr = PB + (size_t)(b * SEQ + kj) * NB + 1024 + h * 64;
            float s = 0.f;
#pragma unroll
            for (int i = 0; i < 8; ++i) { const u32x4 w = ((const u32x4*)kr)[i];
                s += q[8 * i] * bflo(w.x) + q[8 * i + 1] * bfhi(w.x) + q[8 * i + 2] * bflo(w.y) + q[8 * i + 3] * bfhi(w.y) + q[8 * i + 4] * bflo(w.z) + q[8 * i + 5] * bfhi(w.z) + q[8 * i + 6] * bflo(w.w) + q[8 * i + 7] * bfhi(w.w); }
            int rel = c * 64 + lane - kj; rel = rel < -128 ? -128 : (rel > 128 ? 128 : rel);
            s += bt[rel + 128];
            const float mn = fmaxf(m, s), al = __expf(m - mn), p = __expf(s - mn);
            l = l * al + p; m = mn;
            const bf16_t* vr = kr + 512;
#pragma unroll
            for (int i = 0; i < 8; ++i) { const u32x4 w = ((const u32x4*)vr)[i];
                acc[8 * i] = acc[8 * i] * al + p * bflo(w.x); acc[8 * i + 1] = acc[8 * i + 1] * al + p * bfhi(w.x); acc[8 * i + 2] = acc[8 * i + 2] * al + p * bflo(w.y); acc[8 * i + 3] = acc[8 * i + 3] * al + p * bfhi(w.y);
                acc[8 * i + 4] = acc[8 * i + 4] * al + p * bflo(w.z); acc[8 * i + 5] = acc[8 * i + 5] * al + p * bfhi(w.z); acc[8 * i + 6] = acc[8 * i + 6] * al + p * bflo(w.w); acc[8 * i + 7] = acc[8 * i + 7] * al + p * bfhi(w.w); }
        }
        const float il = 1.0f / l;
        const u32x4* gp = (const u32x4*)(PB + (size_t)t * NB + 2048 + h * 64);
        u32x4* op = (u32x4*)(YM + (size_t)t * 1024 + 512 + h * 64);
#pragma unroll
        for (int i = 0; i < 8; ++i) { const u32x4 g = gp[i]; u32x4 o;
            o.x = pk2(acc[8 * i] * il * siluf_(bflo(g.x)), acc[8 * i + 1] * il * siluf_(bfhi(g.x))); o.y = pk2(acc[8 * i + 2] * il * siluf_(bflo(g.y)), acc[8 * i + 3] * il * siluf_(bfhi(g.y)));
            o.z = pk2(acc[8 * i + 4] * il * siluf_(bflo(g.z)), acc[8 * i + 5] * il * siluf_(bfhi(g.z))); o.w = pk2(acc[8 * i + 6] * il * siluf_(bflo(g.w)), acc[8 * i + 7] * il * siluf_(bfhi(g.w)));
            op[i] = o; }
    }
}


typedef _Float16 h8 __attribute__((ext_vector_type(8)));
typedef _Float16 h4 __attribute__((ext_vector_type(4)));
typedef short bf16x8 __attribute__((ext_vector_type(8)));
template <int CTRL> __device__ __forceinline__ float dpp_add(float x) { return x + __uint_as_float(__builtin_amdgcn_update_dpp(0, __float_as_uint(x), CTRL, 0xf, 0xf, true)); }
__device__ __forceinline__ float red8(float x) { x = dpp_add<0xB1>(x); x = dpp_add<0x4E>(x); x = dpp_add<0x141>(x); return x; }
__device__ __forceinline__ float red16(float x) { x = dpp_add<0x128>(x); x = dpp_add<0x124>(x); x = dpp_add<0x122>(x); x = dpp_add<0x121>(x); return x; }
constexpr int SC_PH = 0, SC_VV = 40960, SC_SC = 57344, SC_YY = 57856;
constexpr int TC = 32;

__device__ __forceinline__ void scan_unit(const Args& a, LAS unsigned char* lds, int u) {
    const int tid = threadIdx.x, lane = tid & 63, wave = tid >> 6;
    const int b = u >> 3, h = u & 7;
    unsigned char* ws = a.ws;
    const bf16_t* R = (const bf16_t*)a.out; const bf16_t* KP = R + (size_t)M * 512; const bf16_t* V = KP + (size_t)M * 512; const bf16_t* AN = V + (size_t)M * 512;
    bf16_t* YM = (bf16_t*)(ws + WS_YMIX); const float* DEC = (const float*)(ws + WS_XN); const float* BON = (const float*)(ws + WS_BON);
    const bf16_t* PB = (const bf16_t*)(ws + WS_PB);
    const int st = tid >> 4, sq = tid & 15;
    const int row = wave * 8 + (lane >> 3), cg = lane & 7;
    const int colbase = h * 64 + 4 * sq;
    const f32x4 lg = *(const f32x4*)(a.in[I_LNXG] + colbase), lb = *(const f32x4*)(a.in[I_LNXB] + colbase);
    float s[8];
#pragma unroll
    for (int j = 0; j < 8; ++j) s[j] = 0.f;
    u32x2 gR, gK, gV, gA, gB; f32x4 gD;
#define SC_GLOAD(c) do { const size_t tok_ = (size_t)b * SEQ + (c) * TC + st; const size_t o_ = tok_ * 512 + colbase; \
        gR = *(const u32x2*)(R + o_); gK = *(const u32x2*)(KP + o_); gV = *(const u32x2*)(V + o_); gA = *(const u32x2*)(AN + o_); \
        gB = *(const u32x2*)(YM + tok_ * 1024 + colbase); gD = *(const f32x4*)(DEC + o_); } while (0)
#define SC_STAGE(buf) do { \
        const float r0 = bflo(gR.x), r1 = bfhi(gR.x), r2 = bflo(gR.y), r3 = bfhi(gR.y); \
        const float k0 = bflo(gK.x), k1 = bfhi(gK.x), k2 = bflo(gK.y), k3 = bfhi(gK.y); \
        const float b0 = bflo(gB.x), b1 = bfhi(gB.x), b2 = bflo(gB.y), b3 = bfhi(gB.y); \
        LAS h4* ph4 = (LAS h4*)(lds + SC_PH) + (size_t)(((buf) * TC + st) * 5) * 16 + sq; \
        ph4[0]  = (h4){(_Float16)bflo(gA.x), (_Float16)bfhi(gA.x), (_Float16)bflo(gA.y), (_Float16)bfhi(gA.y)}; \
        ph4[16] = (h4){(_Float16)(1.0f - gD.x), (_Float16)(1.0f - gD.y), (_Float16)(1.0f - gD.z), (_Float16)(1.0f - gD.w)}; \
        ph4[32] = (h4){(_Float16)b0, (_Float16)b1, (_Float16)b2, (_Float16)b3}; \
        ph4[48] = (h4){(_Float16)k0, (_Float16)k1, (_Float16)k2, (_Float16)k3}; \
        ph4[64] = (h4){(_Float16)(gD.x * r0), (_Float16)(gD.y * r1), (_Float16)(gD.z * r2), (_Float16)(gD.w * r3)}; \
        *((LAS f32x4*)(lds + SC_VV) + ((buf) * TC + st) * 16 + sq) = (f32x4){bflo(gV.x), bfhi(gV.x), bflo(gV.y), bfhi(gV.y)}; \
        float br_ = (b0 * r0 + b1 * r1) + (b2 * r2 + b3 * r3), kr_ = (k0 * r0 + k1 * r1) + (k2 * r2 + k3 * r3); \
        br_ = red16(br_); kr_ = red16(kr_); \
        if (sq == 0) *((LAS f32x2*)(lds + SC_SC) + (buf) * TC + st) = (f32x2){br_, kr_}; } while (0)
    SC_GLOAD(0); SC_STAGE(0);
    __syncthreads();
    for (int c = 0; c < SEQ / TC; ++c) {
        const int buf = c & 1;
        if (c + 1 < SEQ / TC) SC_GLOAD(c + 1);
        const size_t tokE = (size_t)b * SEQ + c * TC + st;
        const u32x2 gG = *(const u32x2*)(PB + tokE * NB + colbase);
        const float bon = BON[tokE * 8 + h];
        {
            const LAS h8* ph8 = (const LAS h8*)(lds + SC_PH) + buf * TC * 40 + cg;
            const LAS float* vvp = (const LAS float*)(lds + SC_VV) + buf * TC * 64 + row;
            const LAS f32x2* scp = (const LAS f32x2*)(lds + SC_SC) + buf * TC;
            LAS float* yyp = (LAS float*)(lds + SC_YY) + row;
            h8 cA = ph8[0], cE = ph8[8], cB = ph8[16], cK = ph8[24], cW = ph8[32]; float cv = vvp[0]; f32x2 cs = scp[0];
#pragma unroll 2
            for (int t = 0; t < TC; ++t) {
                const int tn = (t + 1 < TC) ? t + 1 : t;
                const h8 nA = ph8[tn * 40], nE = ph8[tn * 40 + 8], nB = ph8[tn * 40 + 16], nK = ph8[tn * 40 + 24], nW = ph8[tn * 40 + 32]; const float nv = vvp[tn * 64]; const f32x2 ns = scp[tn];
                float sa0 = 0.f, sa1 = 0.f, yw0 = 0.f, yw1 = 0.f;
#pragma unroll
                for (int j = 0; j < 4; ++j) { sa0 = __builtin_fmaf(s[j], (float)cA[j], sa0); sa1 = __builtin_fmaf(s[4 + j], (float)cA[4 + j], sa1);
                                              yw0 = __builtin_fmaf(s[j], (float)cW[j], yw0); yw1 = __builtin_fmaf(s[4 + j], (float)cW[4 + j], yw1); }
                float sa = red8(sa0 + sa1), yw = red8(yw0 + yw1);
#pragma unroll
                for (int j = 0; j < 8; ++j) { float uu = __builtin_fmaf(sa, (float)cB[j], s[j]); uu = __builtin_fmaf(cv, (float)cK[j], uu); s[j] = __builtin_fmaf(-(float)cE[j], s[j], uu); }
                const float y = yw + sa * cs.x + cv * cs.y;
                yyp[t * 64] = y;
                cA = nA; cE = nE; cB = nB; cK = nK; cW = nW; cv = nv; cs = ns;
            }
        }
        __syncthreads();
        {
            const f32x4 y4 = *((const LAS f32x4*)(lds + SC_YY) + st * 16 + sq);
            const f32x4 v4 = *((const LAS f32x4*)(lds + SC_VV) + (buf * TC + st) * 16 + sq);
            const float mean = red16((y4.x + y4.y) + (y4.z + y4.w)) * (1.0f / 64.0f);
            const f32x4 d = y4 - mean;
            const float var = red16((d.x * d.x + d.y * d.y) + (d.z * d.z + d.w * d.w)) * (1.0f / 64.0f);
            const float rstd = rsqrtf(var + GN_EPS);
            f32x4 o = d * rstd * lg + lb + v4 * bon;
            o.x *= siluf_(bflo(gG.x)); o.y *= siluf_(bfhi(gG.x)); o.z *= siluf_(bflo(gG.y)); o.w *= siluf_(bfhi(gG.y));
            u32x2 w; w.x = pk2(o.x, o.y); w.y = pk2(o.z, o.w);
            *(u32x2*)(YM + tokE * 1024 + colbase) = w;
        }
        if (c + 1 < SEQ / TC) SC_STAGE(buf ^ 1);
        __syncthreads();
    }
#undef SC_GLOAD
#undef SC_STAGE
}


struct ChOps { u32x4 Aa[2], Ar[2], Abk[4]; u32x2 Acka, Ackr, Aminv, Acbr, Vb; f32x4 P[4]; };
__device__ __forceinline__ void ch_load(ChOps& o, const unsigned char* rec, int nt, int lane, int quad) {
#pragma unroll
    for (int ks = 0; ks < 2; ++ks) { o.Aa[ks] = *(const u32x4*)(rec + ks * 1024 + lane * 16); o.Ar[ks] = *(const u32x4*)(rec + 2048 + ks * 1024 + lane * 16); }
#pragma unroll
    for (int mt = 0; mt < 4; ++mt) { o.Abk[mt] = *(const u32x4*)(rec + 4096 + mt * 1024 + lane * 16); o.P[mt] = *(const f32x4*)(rec + 12288 + (16 * mt + 4 * quad) * 4); }
    o.Vb = *(const u32x2*)(rec + 8192 + nt * 512 + lane * 8);
    o.Acka = *(const u32x2*)(rec + 10240 + lane * 8); o.Ackr = *(const u32x2*)(rec + 10752 + lane * 8); o.Aminv = *(const u32x2*)(rec + 11264 + lane * 8); o.Acbr = *(const u32x2*)(rec + 11776 + lane * 8);
}
__device__ __forceinline__ void ch_load_lds(ChOps& o, const LAS unsigned char* rec, int nt, int lane, int quad) {
#pragma unroll
    for (int ks = 0; ks < 2; ++ks) { o.Aa[ks] = *(const LAS u32x4*)(rec + ks * 1024 + lane * 16); o.Ar[ks] = *(const LAS u32x4*)(rec + 2048 + ks * 1024 + lane * 16); }
    o.Vb = *(const LAS u32x2*)(rec + 8192 + nt * 512 + lane * 8);
    o.Acka = *(const LAS u32x2*)(rec + 10240 + lane * 8); o.Ackr = *(const LAS u32x2*)(rec + 10752 + lane * 8); o.Aminv = *(const LAS u32x2*)(rec + 11264 + lane * 8); o.Acbr = *(const LAS u32x2*)(rec + 11776 + lane * 8);
#pragma unroll
    for (int mt = 0; mt < 4; ++mt) { o.Abk[mt] = *(const LAS u32x4*)(rec + 4096 + mt * 1024 + lane * 16); o.P[mt] = *(const LAS f32x4*)(rec + 12288 + (16 * mt + 4 * quad) * 4); }
}
__device__ __forceinline__ bf16x8 asbf(u32x4 v) { return __builtin_bit_cast(bf16x8, v); }
__device__ __forceinline__ void scan_unit_chunked(const Args& a, LAS unsigned char* lds, int u) {
    const int tid = threadIdx.x, lane = tid & 63, wave = tid >> 6, fr = lane & 15, quad = lane >> 4;
    const int b = u >> 3, h = u & 7;
    unsigned char* ws = a.ws;
    const bf16_t* VR = (const bf16_t*)(ws + WS_VRAW); bf16_t* YM = (bf16_t*)(ws + WS_YMIX); const float* BON = (const float*)(ws + WS_BON);
    const bf16_t* PB = (const bf16_t*)(ws + WS_PB);
    const unsigned char* recs = rec_base(a, u);
    LAS float* YY = (LAS float*)lds;
    constexpr int REC_OFF = 16384, GRPB = 4 * RSZ, NPIECE = GRPB / 16;
    const int etok = tid >> 3, er8 = (tid & 7) * 8;
    const f32x4 lg0 = *(const f32x4*)(a.in[I_LNXG] + h * 64 + er8), lg1 = *(const f32x4*)(a.in[I_LNXG] + h * 64 + er8 + 4);
    const f32x4 lb0 = *(const f32x4*)(a.in[I_LNXB] + h * 64 + er8), lb1 = *(const f32x4*)(a.in[I_LNXB] + h * 64 + er8 + 4);
    f32x4 S[4];
#pragma unroll
    for (int mt = 0; mt < 4; ++mt) S[mt] = (f32x4){0.f, 0.f, 0.f, 0.f};
    u32x4 ltmp[13];
#define SC_ISSUE(gidx) do { const unsigned char* src_ = recs + (size_t)(gidx) * GRPB; \
        _Pragma("unroll") for (int k_ = 0; k_ < 13; ++k_) { const int idx_ = (tid - 256) + 256 * k_; if (idx_ < NPIECE) ltmp[k_] = *(const u32x4*)(src_ + (size_t)idx_ * 16); } } while (0)
#define SC_COMMIT(bufi) do { LAS unsigned char* dst_ = lds + REC_OFF + (bufi) * GRPB; \
        _Pragma("unroll") for (int k_ = 0; k_ < 13; ++k_) { const int idx_ = (tid - 256) + 256 * k_; if (idx_ < NPIECE) *(LAS u32x4*)(dst_ + idx_ * 16) = ltmp[k_]; } } while (0)
    if (wave >= 4) { SC_ISSUE(0); SC_COMMIT(0); SC_ISSUE(1); }
    lds_barrier();
    for (int g = 0; g < SEQ / 64; ++g) {
        const int buf = g & 1;
        const size_t tokE = (size_t)b * SEQ + g * 64 + etok;
        const u32x4 ev = *(const u32x4*)(VR + tokE * 512 + h * 64 + er8);
        const u32x4 eg = *(const u32x4*)(PB + tokE * NB + h * 64 + er8);
        const float bon = BON[tokE * 8 + h];
        if (wave < 4) {
#pragma unroll
            for (int cc = 0; cc < 4; ++cc) {
                ChOps cur;
                ch_load_lds(cur, lds + REC_OFF + buf * GRPB + cc * RSZ, wave, lane, quad);
                u32x4 sb[2];
#pragma unroll
                for (int ks = 0; ks < 2; ++ks) { sb[ks].x = pk2(S[2 * ks][0], S[2 * ks][1]); sb[ks].y = pk2(S[2 * ks][2], S[2 * ks][3]);
                                                 sb[ks].z = pk2(S[2 * ks + 1][0], S[2 * ks + 1][1]); sb[ks].w = pk2(S[2 * ks + 1][2], S[2 * ks + 1][3]); }
                const u32x4 vb = (u32x4){cur.Vb.x, cur.Vb.y, 0u, 0u};
                f32x4 rhs = (f32x4){0.f, 0.f, 0.f, 0.f}, hv = rhs;
#pragma unroll
                for (int ks = 0; ks < 2; ++ks) { rhs = __builtin_amdgcn_mfma_f32_16x16x32_bf16(asbf(cur.Aa[ks]), asbf(sb[ks]), rhs, 0, 0, 0); hv = __builtin_amdgcn_mfma_f32_16x16x32_bf16(asbf(cur.Ar[ks]), asbf(sb[ks]), hv, 0, 0, 0); }
                rhs = __builtin_amdgcn_mfma_f32_16x16x32_bf16(asbf((u32x4){cur.Acka.x, cur.Acka.y, 0u, 0u}), asbf(vb), rhs, 0, 0, 0);
                hv = __builtin_amdgcn_mfma_f32_16x16x32_bf16(asbf((u32x4){cur.Ackr.x, cur.Ackr.y, 0u, 0u}), asbf(vb), hv, 0, 0, 0);
                const u32x4 rb = (u32x4){pk2(rhs[0], rhs[1]), pk2(rhs[2], rhs[3]), 0u, 0u};
                const f32x4 sa = __builtin_amdgcn_mfma_f32_16x16x32_bf16(asbf((u32x4){cur.Aminv.x, cur.Aminv.y, 0u, 0u}), asbf(rb), (f32x4){0.f, 0.f, 0.f, 0.f}, 0, 0, 0);
                const u32x4 svb = (u32x4){pk2(sa[0], sa[1]), pk2(sa[2], sa[3]), cur.Vb.x, cur.Vb.y};
                const f32x4 y = __builtin_amdgcn_mfma_f32_16x16x32_bf16(asbf((u32x4){cur.Acbr.x, cur.Acbr.y, 0u, 0u}), asbf(svb), hv, 0, 0, 0);
#pragma unroll
                for (int mt = 0; mt < 4; ++mt) { S[mt] = __builtin_amdgcn_mfma_f32_16x16x32_bf16(asbf(cur.Abk[mt]), asbf(svb), S[mt], 0, 0, 0); S[mt] = S[mt] * cur.P[mt]; }
#pragma unroll
                for (int jj = 0; jj < 4; ++jj) YY[(cc * 16 + 4 * quad + jj) * 64 + 16 * wave + fr] = y[jj];
            }
        } else {
            if (g + 1 < SEQ / 64) SC_COMMIT(buf ^ 1);
            if (g + 2 < SEQ / 64) SC_ISSUE(g + 2);
        }
        lds_barrier();
        {
            const f32x4 y0 = *(const LAS f32x4*)(YY + etok * 64 + er8), y1 = *(const LAS f32x4*)(YY + etok * 64 + er8 + 4);
            const float mean = red8(((y0.x + y0.y) + (y0.z + y0.w)) + ((y1.x + y1.y) + (y1.z + y1.w))) * (1.0f / 64.0f);
            const f32x4 d0 = y0 - mean, d1 = y1 - mean;
            const float var = red8(((d0.x * d0.x + d0.y * d0.y) + (d0.z * d0.z + d0.w * d0.w)) + ((d1.x * d1.x + d1.y * d1.y) + (d1.z * d1.z + d1.w * d1.w))) * (1.0f / 64.0f);
            const float rstd = rsqrtf(var + GN_EPS);
            const f32x4 v0 = (f32x4){bflo(ev.x), bfhi(ev.x), bflo(ev.y), bfhi(ev.y)}, v1 = (f32x4){bflo(ev.z), bfhi(ev.z), bflo(ev.w), bfhi(ev.w)};
            f32x4 o0 = d0 * rstd * lg0 + lb0 + v0 * bon, o1 = d1 * rstd * lg1 + lb1 + v1 * bon;
            o0.x *= siluf_(bflo(eg.x)); o0.y *= siluf_(bfhi(eg.x)); o0.z *= siluf_(bflo(eg.y)); o0.w *= siluf_(bfhi(eg.y));
            o1.x *= siluf_(bflo(eg.z)); o1.y *= siluf_(bfhi(eg.z)); o1.z *= siluf_(bflo(eg.w)); o1.w *= siluf_(bfhi(eg.w));
            u32x4 w; w.x = pk2(o0.x, o0.y); w.y = pk2(o0.z, o0.w); w.z = pk2(o1.x, o1.y); w.w = pk2(o1.z, o1.w);
            *(u32x4*)(YM + tokE * 1024 + h * 64 + er8) = w;
        }
        lds_barrier();
    }
#undef SC_ISSUE
#undef SC_COMMIT
}


constexpr int AT_KS = 0, AT_VT = 18432, AT_BT = 36864, AT_PITCH = 144, AT_VT2 = 32768, AT_BT2 = 65536;
__device__ __forceinline__ void attn_unit(const Args& a, LAS unsigned char* lds, int u, int variant = 0) {
    const int tid = threadIdx.x, lane = tid & 63, wave = tid >> 6, fr = lane & 15, quad = lane >> 4;
    const int cp = u & 15, h = (u >> 4) & 7, b = u >> 7;
    unsigned char* ws = a.ws;
    const bf16_t* PB = (const bf16_t*)(ws + WS_PB); bf16_t* YM = (bf16_t*)(ws + WS_YMIX);
    const int c0 = 2 * cp, cq = c0 + (wave >> 2), qrow = (wave & 3) * 16 + fr;
    const size_t tq = (size_t)b * SEQ + cq * 64 + qrow;
    constexpr float LOG2E = 1.4426950408889634f;
    if (tid < 257) ((LAS float*)(lds + AT_BT2))[tid] = a.in[I_ABIAS][h * 257 + tid] * LOG2E;
    bf16x8 qf[2];
    qf[0] = *(const bf16x8*)(PB + tq * NB + 512 + h * 64 + 8 * quad); qf[1] = *(const bf16x8*)(PB + tq * NB + 512 + h * 64 + 32 + 8 * quad);
    u32x2 gpre[4];
#pragma unroll
    for (int dt = 0; dt < 4; ++dt) gpre[dt] = *(const u32x2*)(PB + tq * NB + 2048 + h * 64 + dt * 16 + 4 * quad);
    f32x4 O[4];
#pragma unroll
    for (int i = 0; i < 4; ++i) O[i] = (f32x4){0.f, 0.f, 0.f, 0.f};
    f32x4 Lacc = (f32x4){0.f, 0.f, 0.f, 0.f};
    const unsigned onev = (fr == 0) ? 0x3f803f80u : 0u; const bf16x8 ones = __builtin_bit_cast(bf16x8, (u32x4){onev, onev, onev, onev});
    const int kfirst = c0 - 8 > 0 ? c0 - 8 : 0, klast = c0 + 1;
    const int kkey = tid >> 3, kdch = tid & 7;
    const int vkey = tid & 63, vdch = tid >> 6;
    const int vpos = (vkey & 32) + 8 * ((vkey >> 2) & 3) + 4 * ((vkey >> 4) & 1) + (vkey & 3);
    u32x4 gkA, gvA, gkB, gvB, gkC, gvC, gkD, gvD;
    const int ntile = klast - kfirst + 1;
#define AT_GLD(ti, K_, V_) do { if ((ti) < ntile) { K_ = *(const u32x4*)(PB + ((size_t)b * SEQ + (kfirst + (ti)) * 64 + kkey) * NB + 1024 + h * 64 + kdch * 8); \
                        V_ = *(const u32x4*)(PB + ((size_t)b * SEQ + (kfirst + (ti)) * 64 + vkey) * NB + 1536 + h * 64 + vdch * 8); } } while (0)
#define AT_SST(slot, gk, gv) do { *(LAS u32x4*)(lds + AT_KS + (slot) * 8192 + kkey * 128 + ((kdch ^ (kkey & 7)) * 16)) = gk; \
        LAS unsigned char* vt_ = lds + AT_VT2 + (slot) * 8192 + (vdch * 8) * 128 + (vpos & 7) * 2; const int vch_ = vpos >> 3; \
        *(LAS unsigned short*)(vt_ + 0 * 128 + ((vch_ ^ 0) * 16)) = (unsigned short)(gv.x & 0xffffu); *(LAS unsigned short*)(vt_ + 1 * 128 + ((vch_ ^ 1) * 16)) = (unsigned short)(gv.x >> 16); \
        *(LAS unsigned short*)(vt_ + 2 * 128 + ((vch_ ^ 2) * 16)) = (unsigned short)(gv.y & 0xffffu); *(LAS unsigned short*)(vt_ + 3 * 128 + ((vch_ ^ 3) * 16)) = (unsigned short)(gv.y >> 16); \
        *(LAS unsigned short*)(vt_ + 4 * 128 + ((vch_ ^ 4) * 16)) = (unsigned short)(gv.z & 0xffffu); *(LAS unsigned short*)(vt_ + 5 * 128 + ((vch_ ^ 5) * 16)) = (unsigned short)(gv.z >> 16); \
        *(LAS unsigned short*)(vt_ + 6 * 128 + ((vch_ ^ 6) * 16)) = (unsigned short)(gv.w & 0xffffu); *(LAS unsigned short*)(vt_ + 7 * 128 + ((vch_ ^ 7) * 16)) = (unsigned short)(gv.w >> 16); } while (0)
    gkA = gvA = gkB = gvB = gkC = gvC = gkD = gvD = (u32x4){0u, 0u, 0u, 0u};
    AT_GLD(0, gkA, gvA); AT_GLD(1, gkB, gvB); AT_GLD(2, gkC, gvC); AT_GLD(3, gkD, gvD);
    AT_SST(0, gkA, gvA); AT_SST(1, gkB, gvB);
    gkA = gkC; gvA = gvC; gkB = gkD; gvB = gvD;
    AT_GLD(4, gkC, gvC); AT_GLD(5, gkD, gvD);
    lds_barrier();
    for (int it = 0; 2 * it < ntile; ++it) {
#pragma unroll
      for (int sub = 0; sub < 2; ++sub) {
        const int kc = kfirst + 2 * it + sub, slot = (2 * it + sub) & 3;
        if (variant != 3 && kc <= cq && kc >= cq - 8) {
            const LAS unsigned char* ks = lds + AT_KS + slot * 8192 + fr * 128;
            const LAS unsigned char* vt = lds + AT_VT2 + slot * 8192 + fr * 128;
            f32x4 sc[4];
#pragma unroll
            for (int kt = 0; kt < 4; ++kt) {
                sc[kt] = (f32x4){0.f, 0.f, 0.f, 0.f};
#pragma unroll
                for (int k2 = 0; k2 < 2; ++k2) { const bf16x8 kf = *(const LAS bf16x8*)(ks + kt * 16 * 128 + (((k2 * 4 + quad) ^ (fr & 7)) * 16)); sc[kt] = __builtin_amdgcn_mfma_f32_16x16x32_bf16(kf, qf[k2], sc[kt], 0, 0, 0); }
            }
            bf16x8 vfr[2][4];
#pragma unroll
            for (int s2 = 0; s2 < 2; ++s2)
#pragma unroll
                for (int dt = 0; dt < 4; ++dt) vfr[s2][dt] = *(const LAS bf16x8*)(vt + dt * 16 * 128 + (((s2 * 4 + quad) ^ (fr & 7)) * 16));
            asm volatile("" ::: "memory");
            const int dch = cq - kc;
            const LAS float* bt = (const LAS float*)(lds + AT_BT2);
            if (dch >= 3) {
                const float bc = bt[256];
#pragma unroll
                for (int kt = 0; kt < 4; ++kt)
#pragma unroll
                    for (int j = 0; j < 4; ++j) sc[kt][j] = __builtin_amdgcn_exp2f(__builtin_amdgcn_fmed3f(__builtin_fmaf(sc[kt][j], 0.125f * LOG2E, bc), -100.0f, 100.0f));
            } else {
                const int base = dch * 64 + qrow + 128 - 4 * quad;
#pragma unroll
                for (int kt = 0; kt < 4; ++kt)
#pragma unroll
                    for (int j = 0; j < 4; ++j) { int idx = base - kt * 16 - j; idx = idx > 256 ? 256 : idx; sc[kt][j] = __builtin_amdgcn_exp2f(__builtin_amdgcn_fmed3f(__builtin_fmaf(sc[kt][j], 0.125f * LOG2E, bt[idx]), -100.0f, 100.0f)); }
            }
#pragma unroll
            for (int s2 = 0; s2 < 2; ++s2) {
                u32x4 pw; pw.x = pk2(sc[2 * s2][0], sc[2 * s2][1]); pw.y = pk2(sc[2 * s2][2], sc[2 * s2][3]); pw.z = pk2(sc[2 * s2 + 1][0], sc[2 * s2 + 1][1]); pw.w = pk2(sc[2 * s2 + 1][2], sc[2 * s2 + 1][3]);
                const bf16x8 pf = __builtin_bit_cast(bf16x8, pw);
#pragma unroll
                for (int dt = 0; dt < 4; ++dt) O[dt] = __builtin_amdgcn_mfma_f32_16x16x32_bf16(vfr[s2][dt], pf, O[dt], 0, 0, 0);
                Lacc = __builtin_amdgcn_mfma_f32_16x16x32_bf16(ones, pf, Lacc, 0, 0, 0);
            }
        }
      }
        if (2 * it + 2 < ntile) { AT_SST((2 * it + 2) & 3, gkA, gvA); AT_SST((2 * it + 3) & 3, gkB, gvB); }
        gkA = gkC; gvA = gvC; gkB = gkD; gvB = gvD;
        AT_GLD(2 * it + 6, gkC, gvC); AT_GLD(2 * it + 7, gkD, gvD);
        lds_barrier();
    }
#undef AT_GLD
#undef AT_SST
    const float l = __shfl(Lacc[0], fr);
    const float il = 1.0f / l;
#pragma unroll
    for (int dt = 0; dt < 4; ++dt) {
        const int dcol = h * 64 + dt * 16 + 4 * quad;
        const u32x2 g = gpre[dt];
        const f32x4 o = O[dt] * il;
        u32x2 w; w.x = pk2(o[0] * siluf_(bflo(g.x)), o[1] * siluf_(bfhi(g.x))); w.y = pk2(o[2] * siluf_(bflo(g.y)), o[3] * siluf_(bfhi(g.y)));
        *(u32x2*)(YM + tq * 1024 + 512 + dcol) = w;
    }
}

constexpr int AT_GRAB = 1;
__device__ __forceinline__ void phase_mix(const Args& a, LAS unsigned char* lds, bool do_scan = true, bool do_attn = true) {
    unsigned* ctr = (unsigned*)(a.ws + WS_CTR);
    if (do_scan) for (int u = blockIdx.x; u < BATCH * 8; u += gridDim.x) scan_unit_chunked(a, lds, u);
    LAS int* uw = (LAS int*)(lds + 70000);
    if (do_attn) for (;;) {
        __syncthreads();
        if (threadIdx.x == 0) *uw = (int)atomicAdd(ctr, (unsigned)AT_GRAB);
        __syncthreads();
        const int u = *uw;
        if (u >= BATCH * 8 * 16) break;
        for (int k = 0; k < AT_GRAB && u + k < BATCH * 8 * 16; ++k) attn_unit(a, lds, u + k, (PROBE_LOOPS || N_LAUNCH_MODE == 3) ? a.rep[0] : 0);
    }
}

__device__ __forceinline__ void phase_sg_naive(const Args& a, unsigned char* ldsb) {
    const int tid = threadIdx.x;
    unsigned char* ws = a.ws;
    const bf16_t* P1 = (const bf16_t*)(ws + WS_P1); bf16_t* Y2 = (bf16_t*)(ws + WS_YMIX);
    const float* vsum = (const float*)(ws + WS_VSUM); const float* vsq = (const float*)(ws + WS_VSQ);
    float* vn = (float*)ldsb;
    const int c = tid & 127, i0 = tid >> 7;
    for (int u = blockIdx.x; u < BATCH * 16 * 8; u += gridDim.x) {
        const int g = u & 7, nb = (u >> 3) & 15, b = u >> 7;
        const int tbase = b * SEQ + nb * 128;
        const float lg = a.in[I_SGLNG][g * 128 + c], lb = a.in[I_SGLNB][g * 128 + c];
        for (int j = i0; j < 128; j += 4) {
            const int t = tbase + j; const float mean = vsum[t] * (1.0f / 1024.0f); const float var = vsq[t] * (1.0f / 1024.0f) - mean * mean;
            const float rstd = rsqrtf(fmaxf(var, 0.f) + LN_EPS);
            vn[j * 128 + c] = (bf2f(P1[(size_t)t * N3 + 1024 + g * 128 + c]) - mean) * rstd * lg + lb;
        }
        __syncthreads();
        const float* wg = a.in[I_SGW] + (size_t)g * 128 * 128; const float* sb = a.in[I_SGB] + g * 128;
        for (int i = i0; i < 128; i += 4) {
            const int jend = (i < 64) ? 64 : 128;
            float acc = 0.f;
            for (int j = 0; j < jend; ++j) acc += wg[i * 128 + j] * vn[j * 128 + c];
            const int t = tbase + i;
            const float uu = bf2f(P1[(size_t)t * N3 + g * 128 + c]), gt = bf2f(P1[(size_t)t * N3 + 2048 + g * 128 + c]);
            Y2[(size_t)t * 1024 + g * 128 + c] = f2bf(uu * (acc + sb[i]) * gt);
        }
        __syncthreads();
    }
}


__device__ __forceinline__ void phase_sg(const Args& a, LAS unsigned char* lds, int variant = 0) {
    const int tid = threadIdx.x, lane = tid & 63, wave = tid >> 6, fr = lane & 15, quad = lane >> 4;
    unsigned char* ws = a.ws;
    const bf16_t* P1 = (const bf16_t*)(ws + WS_P1); bf16_t* Y2 = (bf16_t*)(ws + WS_YMIX); const bf16_t* SGW = (const bf16_t*)(ws + WS_SGW);
    const float* vsum = (const float*)(ws + WS_VSUM); const float* vsq = (const float*)(ws + WS_VSQ);
    constexpr int VPB = 272;
    constexpr int NUN = BATCH * 16 * 8;
    const int per = (NUN + (int)gridDim.x - 1) / (int)gridDim.x;
    const int u0 = blockIdx.x * per, u1 = (u0 + per < NUN) ? u0 + per : NUN;
    u32x4 vw[4]; float vmean[4], vrstd[4];
    const int lpc = tid & 15, lrb = tid >> 4;
#define SG_VLOAD(uu_) do { const int g_ = (uu_) >> 8, tb_ = (((uu_) >> 4) & 15) * SEQ + ((uu_) & 15) * 128; \
        _Pragma("unroll") for (int q_ = 0; q_ < 4; ++q_) { const int t_ = tb_ + lrb + 32 * q_; \
            const float m_ = vsum[t_] * (1.0f / 1024.0f); const float var_ = vsq[t_] * (1.0f / 1024.0f) - m_ * m_; vmean[q_] = m_; vrstd[q_] = rsqrtf(fmaxf(var_, 0.f) + LN_EPS); \
            vw[q_] = *(const u32x4*)(P1 + (size_t)t_ * N3 + 1024 + g_ * 128 + lpc * 8); } } while (0)
    if (u0 < u1) SG_VLOAD(u0);
    for (int u = u0; u < u1; ++u) {
        const int g = u >> 8, b = (u >> 4) & 15, nb = u & 15;
        const int tbase = b * SEQ + nb * 128;
        const int irow = 16 * wave + fr;
        const int epc = tid & 15, erb = tid >> 4;
        const f32x4 g0 = *(const f32x4*)(a.in[I_SGLNG] + g * 128 + lpc * 8), g1 = *(const f32x4*)(a.in[I_SGLNG] + g * 128 + lpc * 8 + 4);
        const f32x4 b0 = *(const f32x4*)(a.in[I_SGLNB] + g * 128 + lpc * 8), b1 = *(const f32x4*)(a.in[I_SGLNB] + g * 128 + lpc * 8 + 4);
        float sbq[4];
#pragma unroll
        for (int q = 0; q < 4; ++q) sbq[q] = a.in[I_SGB][g * 128 + erb + 32 * q];
        u32x4 uu[4], gg[4];
#pragma unroll
        for (int q = 0; q < 4; ++q) { const size_t te = (size_t)tbase + erb + 32 * q; uu[q] = *(const u32x4*)(P1 + te * N3 + g * 128 + epc * 8); gg[q] = *(const u32x4*)(P1 + te * N3 + 2048 + g * 128 + epc * 8); }
        bf16x8 wf[4];
#pragma unroll
        for (int ks = 0; ks < 4; ++ks) wf[ks] = *(const bf16x8*)(SGW + (size_t)(g * 128 + irow) * 128 + ks * 32 + 8 * quad);
        if (variant != 2) {
            const int c8 = lpc * 8;
#pragma unroll
            for (int q = 0; q < 4; ++q) {
                const int j = lrb + 32 * q; const float mean = vmean[q], rstd = vrstd[q];
                const u32x4 w = vw[q];
                LAS unsigned short* vt = (LAS unsigned short*)(lds + c8 * VPB + (((j >> 3) ^ lpc) * 16) + (j & 7) * 2);
                vt[0 * (VPB / 2)] = f2bf((bflo(w.x) - mean) * rstd * g0.x + b0.x); vt[1 * (VPB / 2)] = f2bf((bfhi(w.x) - mean) * rstd * g0.y + b0.y);
                vt[2 * (VPB / 2)] = f2bf((bflo(w.y) - mean) * rstd * g0.z + b0.z); vt[3 * (VPB / 2)] = f2bf((bfhi(w.y) - mean) * rstd * g0.w + b0.w);
                vt[4 * (VPB / 2)] = f2bf((bflo(w.z) - mean) * rstd * g1.x + b1.x); vt[5 * (VPB / 2)] = f2bf((bfhi(w.z) - mean) * rstd * g1.y + b1.y);
                vt[6 * (VPB / 2)] = f2bf((bflo(w.w) - mean) * rstd * g1.z + b1.z); vt[7 * (VPB / 2)] = f2bf((bfhi(w.w) - mean) * rstd * g1.w + b1.w);
            }
        }
        if (u + 1 < u1) SG_VLOAD(u + 1);
        lds_barrier();
        if (variant == 1) { lds_barrier(); continue; }
        f32x4 acc[8];
#pragma unroll
        for (int ct = 0; ct < 8; ++ct) {
            acc[ct] = (f32x4){0.f, 0.f, 0.f, 0.f};
#pragma unroll
            for (int ks = 0; ks < 4; ++ks) {
                if (ks < 2 || wave >= 4) { const bf16x8 vf = *(const LAS bf16x8*)(lds + (ct * 16 + fr) * VPB + (((ks * 4 + quad) ^ (ct * 2 + (fr >> 3))) * 16)); acc[ct] = __builtin_amdgcn_mfma_f32_16x16x32_bf16(vf, wf[ks], acc[ct], 0, 0, 0); }
            }
        }
        {
            LAS float* ot = (LAS float*)(lds + 36864);
#pragma unroll
            for (int ct = 0; ct < 8; ++ct) *(LAS f32x4*)(ot + irow * 132 + ct * 16 + 4 * quad) = acc[ct];
            lds_barrier();
#pragma unroll
            for (int q = 0; q < 4; ++q) {
                const int i = erb + 32 * q; const size_t te = (size_t)tbase + i; const float sbv = sbq[q];
                const f32x4 s0 = *(const LAS f32x4*)(ot + i * 132 + epc * 8), s1 = *(const LAS f32x4*)(ot + i * 132 + epc * 8 + 4);
                u32x4 w;
                w.x = pk2(bflo(uu[q].x) * (s0[0] + sbv) * bflo(gg[q].x), bfhi(uu[q].x) * (s0[1] + sbv) * bfhi(gg[q].x));
                w.y = pk2(bflo(uu[q].y) * (s0[2] + sbv) * bflo(gg[q].y), bfhi(uu[q].y) * (s0[3] + sbv) * bfhi(gg[q].y));
                w.z = pk2(bflo(uu[q].z) * (s1[0] + sbv) * bflo(gg[q].z), bfhi(uu[q].z) * (s1[1] + sbv) * bfhi(gg[q].z));
                w.w = pk2(bflo(uu[q].w) * (s1[2] + sbv) * bflo(gg[q].w), bfhi(uu[q].w) * (s1[3] + sbv) * bfhi(gg[q].w));
                *(u32x4*)(Y2 + te * 1024 + g * 128 + epc * 8) = w;
            }
        }
        lds_barrier();
    }
#undef SG_VLOAD
}

__device__ __forceinline__ void phase_final(const Args& a) {
    const int tid = threadIdx.x, lane = tid & 63, wave = tid >> 6;
    const float* rs2 = (const float*)(a.ws + WS_RS2); const float* fg = a.in[I_FG];
    const int gw = blockIdx.x * 8 + wave, NGW = gridDim.x * 8;
    f32x4 g4[4];
#pragma unroll
    for (int j = 0; j < 4; ++j) g4[j] = ((const f32x4*)fg)[lane + 64 * j];
    for (int m = gw; m < M; m += NGW) {
        const float rinv = rsqrtf(rs2[m] * (1.0f / DM) + RMS_EPS);
        f32x4* p = (f32x4*)(a.out + (size_t)m * DM) + lane;
#pragma unroll
        for (int j = 0; j < 4; ++j) { f32x4 v = p[64 * j]; v = v * rinv * g4[j]; p[64 * j] = v; }
    }
}

#define XB_TMO      128
#define XB_XCNT(j)  (256  + 64 * (j))
#define XB_XSUB(j)  (1280 + 64 * (j))
#define XB_XGEN(j)  (2304 + 64 * (j))
#define XB_TOP      3328
#define XB_TOPGEN   3392
#define XCD_BAR_WORDS 3456
#define XB_SPIN_CAP (1u << 18)

__device__ __forceinline__ unsigned xb_ld(unsigned* p)              { return __hip_atomic_load(p, __ATOMIC_RELAXED, __HIP_MEMORY_SCOPE_AGENT); }
__device__ __forceinline__ unsigned xb_add(unsigned* p, unsigned v) { return __hip_atomic_fetch_add(p, v, __ATOMIC_RELAXED, __HIP_MEMORY_SCOPE_AGENT); }
__device__ __forceinline__ unsigned xb_xcc_id() { return (unsigned)__builtin_amdgcn_s_getreg((3 << 11) | 20) & 0xFu; }
#define XB_SPIN(cond, bar) do { unsigned _sp = 0; while (cond) { __builtin_amdgcn_s_sleep(1); \
    if ((++_sp & 255u) == 0u) { if (xb_ld(&(bar)[XB_TMO])) break; if (_sp > XB_SPIN_CAP) { atomicAdd(&(bar)[XB_TMO], 1u); break; } } } } while (0)

struct XcdBarrier {
    unsigned* bar; unsigned x;
    volatile LAS unsigned* st;
};

__device__ __forceinline__ XcdBarrier xcd_barrier_post(unsigned* bar, volatile LAS unsigned* st) {
    XcdBarrier b; b.bar = bar; b.x = xb_xcc_id(); b.st = st;
    if (threadIdx.x == 0) (void)xb_add(&bar[XB_XCNT(b.x)], 1u);
    return b;
}
__device__ __forceinline__ void xcd_barrier_complete(unsigned* bar, unsigned x, unsigned& nloc, unsigned& nx) {
    const unsigned G = gridDim.x * gridDim.y * gridDim.z;
    unsigned sum, cnt, mine, sp = 0u;
    for (;;) {
        sum = 0u; cnt = 0u; mine = 0u;
#pragma unroll
        for (unsigned j = 0; j < 16; ++j) { const unsigned c = xb_ld(&bar[XB_XCNT(j)]); sum += c; cnt += (c > 0u) ? 1u : 0u; mine = (j == x) ? c : mine; }
        if (sum == G) break;
        __builtin_amdgcn_s_sleep(1);
        if ((++sp & 255u) == 0u) { if (xb_ld(&bar[XB_TMO])) break; if (sp > XB_SPIN_CAP) { atomicAdd(&bar[XB_TMO], 1u); break; } }
    }
    nloc = mine > 0u ? mine : 1u; nx = cnt > 0u ? cnt : 1u;
}

__device__ __forceinline__ void xcd_barrier(const XcdBarrier& b) {
    asm volatile("s_waitcnt vmcnt(0)" ::: "memory");
    __syncthreads();
    if (threadIdx.x == 0) {
        unsigned* bar = b.bar;
        __builtin_amdgcn_s_waitcnt(0);
        unsigned nloc = b.st[0], nx = b.st[1];
        if (nloc == 0u) { xcd_barrier_complete(bar, b.x, nloc, nx); b.st[0] = nloc; b.st[1] = nx; }
        const unsigned old = xb_add(&bar[XB_XSUB(b.x)], 1u);
        const unsigned gen = old / nloc;
        if (old + 1u == (gen + 1u) * nloc) {
            __builtin_amdgcn_fence(__ATOMIC_RELEASE, "agent");
            asm volatile("s_waitcnt vmcnt(0)" ::: "memory");
            const unsigned og = xb_add(&bar[XB_TOP], 1u);
            const unsigned tg = og / nx;
            if (og + 1u == (tg + 1u) * nx) xb_add(&bar[XB_TOPGEN], 1u);
            else XB_SPIN(xb_ld(&bar[XB_TOPGEN]) == tg, bar);
            __builtin_amdgcn_fence(__ATOMIC_ACQUIRE, "agent");
            xb_add(&bar[XB_XGEN(b.x)], 1u);
            asm volatile("s_waitcnt vmcnt(0)" ::: "memory");
        } else {
            XB_SPIN(xb_ld(&bar[XB_XGEN(b.x)]) == gen, bar);
            __builtin_amdgcn_fence(__ATOMIC_ACQUIRE, "agent");
            asm volatile("s_waitcnt vmcnt(0)" ::: "memory");
        }
    }
    __syncthreads();
}

template <int PHM> __global__ void __launch_bounds__(NTHR, 2) mega(Args a) {
    extern __shared__ __attribute__((aligned(16))) unsigned char lds[];
    unsigned char* ws = a.ws;
    const int lo = a.lo, hi = a.hi;
    volatile LAS unsigned* bst = (volatile LAS unsigned*)((LAS unsigned char*)lds + (LDS_BYTES - 64));
    if (threadIdx.x < 2) bst[threadIdx.x] = 0u;
    __syncthreads();
    XcdBarrier xbar = xcd_barrier_post((unsigned*)(ws + WS_BAR), bst);
    if (hi > 1000) cg::this_grid().sync();
#define IN(k) (((PHM >> (k)) & 1) && lo <= (k) && (k) < hi)
#if PROBE_LOOPS
#define REPS(i) a.rep[i]
#else
#define REPS(i) 0
#endif
#if USE_XBAR
#define SEAM(k) do { if (IN(k) && IN((k) + 1)) { xcd_barrier(xbar); } } while (0)
#else
#define SEAM(k) do { if (IN(k) && IN((k) + 1)) { cg::this_grid().sync(); } } while (0)
#endif
    if (IN(0)) for (int r_ = 0; r_ <= REPS(0); ++r_) { phase_prologue(a, lds); if (r_ < REPS(0)) xcd_barrier(xbar); }
    SEAM(0);
    if (IN(1)) { EpiG1 f{(const float*)(ws + WS_RS0), (bf16_t*)(ws + WS_PA), (bf16_t*)(ws + WS_PB)};
        gemm_any(lds, (const bf16_t*)(ws + WS_XN), (const bf16_t*)(ws + WS_W1T), M, N1, DM, f); }
    SEAM(1);
    if (IN(2)) for (int r_ = 0; r_ <= REPS(1); ++r_) { phase_prep(a, lds, (PROBE_LOOPS || N_LAUNCH_MODE == 3) ? a.rep[0] : 0); if (r_ < REPS(1)) xcd_barrier(xbar); }
    SEAM(2);
    #if PROBE & 1
    phase_prep(a, lds); cg::this_grid().sync();
#endif
#if USE_NAIVE_MIX
    if (IN(3)) { phase_scan_naive(a); phase_attn_naive(a); }
#else
    if (IN(3)) for (int r_ = 0; r_ <= REPS(2); ++r_) { phase_mix(a, (LAS unsigned char*)lds, a.rep[0] < 2, a.rep[0] != 1); if (r_ < REPS(2)) { xcd_barrier(xbar); if (blockIdx.x == 0 && threadIdx.x == 0) *(unsigned*)(ws + WS_CTR) = 0u; xcd_barrier(xbar); } }
#endif
    SEAM(3);
#if PROBE & 2
    phase_prep(a, lds); cg::this_grid().sync(); phase_mix(a, (LAS unsigned char*)lds); cg::this_grid().sync();
#endif
#if PROBE & 64
    phase_prep(a, lds); cg::this_grid().sync(); phase_mix(a, (LAS unsigned char*)lds, true, false); cg::this_grid().sync();
#endif
#if PROBE & 32
    if (blockIdx.x == 0 && threadIdx.x == 0) *(unsigned*)(ws + WS_CTR) = 0u;
    cg::this_grid().sync(); phase_mix(a, (LAS unsigned char*)lds, false); cg::this_grid().sync();
#endif
#if PROBE & 4
    phase_prologue(a, lds); cg::this_grid().sync();
#endif
#if PROBE & 16
    { EpiG1 f{(const float*)(ws + WS_RS0), (bf16_t*)(ws + WS_PA), (bf16_t*)(ws + WS_PB)};
        gemm_any(lds, (const bf16_t*)(ws + WS_XN), (const bf16_t*)(ws + WS_W1T), M, N1, DM, f); cg::this_grid().sync(); }
#endif
    if (IN(4)) { EpiG2 f{a.in[I_X], a.out, (bf16_t*)(ws + WS_XN), (float*)(ws + WS_RS1)};
        gemm_any<EpiG2, false>(lds, (const bf16_t*)(ws + WS_YMIX), (const bf16_t*)(ws + WS_W2T), M, DM, DM, f); }
    SEAM(4);
#if PROBE & 128
    { EpiG2 f{a.in[I_X], a.out, (bf16_t*)(ws + WS_XN), (float*)(ws + 640 * 1024)};
        gemm_any(lds, (const bf16_t*)(ws + WS_YMIX), (const bf16_t*)(ws + WS_W2T), M, DM, DM, f); cg::this_grid().sync(); }
#endif
    if (IN(5)) { EpiG3 f{(const float*)(ws + WS_RS1), (bf16_t*)(ws + WS_P1), (float*)(ws + WS_VSUM), (float*)(ws + WS_VSQ)};
        gemm_any(lds, (const bf16_t*)(ws + WS_XN), (const bf16_t*)(ws + WS_W3T), M, N3, DM, f); }
    SEAM(5);
    if (IN(6)) for (int r_ = 0; r_ <= REPS(3); ++r_) { phase_sg(a, (LAS unsigned char*)lds, (PROBE_LOOPS || N_LAUNCH_MODE == 3) ? a.rep[0] : 0); if (r_ < REPS(3)) xcd_barrier(xbar); }
    SEAM(6);
#if PROBE & 8
    phase_sg(a, (LAS unsigned char*)lds); cg::this_grid().sync();
#endif
    const bool fuse_final = FUSE_FINAL && gridDim.x == 256;
    if (IN(7) && fuse_final) { pg8::Gemm g{(const bf16_t*)(ws + WS_YMIX), (const bf16_t*)(ws + WS_W4T), M, DM, DM}; pg8::StaticOrder S; S.init(M, DM, (int)gridDim.x, (int)blockIdx.x);
        EpiG4X E{a.out, a.in[I_FG], (float*)(ws + WS_EXCH), (unsigned*)(ws + WS_PCNT), (LAS unsigned char*)lds + 131072};
        pg8::gemm_phase<EpiG4X, pg8::StaticOrder, true, true>((PG8_LAS unsigned char*)lds, g, S, E); }
    if (!fuse_final) {
        if (IN(7)) { EpiG4 f{a.out, (float*)(ws + WS_RS2)};
            gemm_any<EpiG4, false>(lds, (const bf16_t*)(ws + WS_YMIX), (const bf16_t*)(ws + WS_W4T), M, DM, DM, f); }
        SEAM(7);
        if (IN(8)) { phase_final(a); }
    }
#undef IN
#undef SEAM
}
constexpr int NPHASE = 9;
}
#if defined(__HIP_DEVICE_COMPILE__)
#pragma clang attribute pop
#endif

extern "C" void kernel_launch(void* const* d_in, const int* in_sizes, int n_in, void* d_out, int out_size, void* d_ws, size_t ws_size, hipStream_t stream) {
    using namespace mk;
    static int grid = 0;
    if (grid == 0) {
        if (n_in != 22 || out_size != M * DM || ws_size < WS_END) { fprintf(stderr, "kernel_launch: unexpected shapes (n_in %d out %d ws %zu)\n", n_in, out_size, ws_size); grid = -1; return; }
        int dev = 0, cus = 0, per_cu = 0;
        (void)hipGetDevice(&dev); (void)hipDeviceGetAttribute(&cus, hipDeviceAttributeMultiprocessorCount, dev);
#if N_LAUNCH_MODE == 1 || N_LAUNCH_MODE == 3
        if (hipFuncSetAttribute((const void*)mega<0x1ff>, hipFuncAttributeMaxDynamicSharedMemorySize, LDS_BYTES) != hipSuccess) { fprintf(stderr, "kernel_launch: hipFuncSetAttribute failed\n"); grid = -1; return; }
        if (hipOccupancyMaxActiveBlocksPerMultiprocessor(&per_cu, (const void*)mega<0x1ff>, NTHR, LDS_BYTES) != hipSuccess || per_cu < 1) { fprintf(stderr, "kernel_launch: occupancy query says %d\n", per_cu); per_cu = 1; }
#else
        if (hipFuncSetAttribute((const void*)mega<0x1f7>, hipFuncAttributeMaxDynamicSharedMemorySize, LDS_BYTES) != hipSuccess || hipFuncSetAttribute((const void*)mega<0x008>, hipFuncAttributeMaxDynamicSharedMemorySize, LDS_BYTES) != hipSuccess) { fprintf(stderr, "kernel_launch: hipFuncSetAttribute failed\n"); grid = -1; return; }
#endif
        (void)hipGetLastError();
        grid = cus * 1;
        if (grid <= 0) grid = 256;
    }
    if (grid < 0) return;
    Args a{};
    for (int i = 0; i < 22; ++i) a.in[i] = (const float*)d_in[i];
    a.out = (float*)d_out; a.ws = (unsigned char*)d_ws;
    a.rep[0] = PROBE_REP0; a.rep[1] = PROBE_REP1; a.rep[2] = PROBE_REP2; a.rep[3] = PROBE_REP3;
    if (hipMemsetAsync((char*)d_ws + WS_BAR, 0, 65536 + 32768, stream) != hipSuccess) { fprintf(stderr, "kernel_launch: hipMemsetAsync failed\n"); return; }
#if N_LAUNCH_MODE == 3
    {
        constexpr int P = PROBE_PHASE; constexpr int MLO = (1 << P) - 1, MP = 1 << P, MHI = 0x0ff & ~((1 << (P + 1)) - 1);
        void* args[] = {&a};
        (void)hipFuncSetAttribute((const void*)mega<MP>, hipFuncAttributeMaxDynamicSharedMemorySize, LDS_BYTES);
        (void)hipFuncSetAttribute((const void*)mega<MHI>, hipFuncAttributeMaxDynamicSharedMemorySize, LDS_BYTES);
        if (P > 0) { (void)hipFuncSetAttribute((const void*)mega<MLO>, hipFuncAttributeMaxDynamicSharedMemorySize, LDS_BYTES);
            a.lo = 0; a.hi = P; (void)hipLaunchCooperativeKernel((const void*)mega<MLO>, dim3(grid), dim3(NTHR), args, LDS_BYTES, stream); }
        for (int r = 0; r <= PROBE_REP2; ++r) {
            a.lo = P; a.hi = P + 1; a.rep[0] = (r == PROBE_REP2) ? 0 : PROBE_MIXMODE;
            (void)hipMemsetAsync((char*)d_ws + WS_CTR, 0, 4, stream);
            (void)hipMemsetAsync((char*)d_ws + WS_BAR, 0, 16384, stream);
            hipLaunchKernelGGL(mega<MP>, dim3(grid), dim3(NTHR), LDS_BYTES, stream, a);
        }
        a.rep[0] = 0;
        (void)hipMemsetAsync((char*)d_ws + WS_BAR, 0, 16384, stream);
        a.lo = P + 1; a.hi = NPHASE;
        (void)hipLaunchCooperativeKernel((const void*)mega<MHI>, dim3(grid), dim3(NTHR), args, LDS_BYTES, stream);
    }
#elif N_LAUNCH_MODE == 2
    {
        void* args[] = {&a};
        a.lo = 0; a.hi = 3;
        hipError_t e = hipLaunchCooperativeKernel((const void*)mega<0x1f7>, dim3(grid), dim3(NTHR), args, LDS_BYTES, stream);
        if (e != hipSuccess) fprintf(stderr, "kernel_launch: cooperative launch A failed: %s (grid %d)\n", hipGetErrorString(e), grid);
        a.lo = 3; a.hi = 4;
        hipLaunchKernelGGL(mega<0x008>, dim3(grid), dim3(NTHR), LDS_BYTES, stream, a);
        a.lo = 4; a.hi = NPHASE;
        e = hipLaunchCooperativeKernel((const void*)mega<0x1f7>, dim3(grid), dim3(NTHR), args, LDS_BYTES, stream);
        if (e != hipSuccess) fprintf(stderr, "kernel_launch: cooperative launch B failed: %s (grid %d)\n", hipGetErrorString(e), grid);
    }
#elif N_LAUNCH_MODE == 1
    a.lo = 0; a.hi = NPHASE;
    void* args[] = {&a};
    hipError_t e = hipLaunchCooperativeKernel((const void*)mega<0x1ff>, dim3(grid), dim3(NTHR), args, LDS_BYTES, stream);
    if (e != hipSuccess) fprintf(stderr, "kernel_launch: cooperative launch failed: %s (grid %d)\n", hipGetErrorString(e), grid);
#else
    for (int ph = 0; ph < NPHASE; ++ph) {
        a.lo = ph; a.hi = ph + 1;
        if (ph == 3) hipLaunchKernelGGL(mega<0x008>, dim3(grid), dim3(NTHR), LDS_BYTES, stream, a);
        else hipLaunchKernelGGL(mega<0x1f7>, dim3(grid), dim3(NTHR), LDS_BYTES, stream, a);
    }
#endif
}
```

```cpp
#if defined(__HIP_DEVICE_COMPILE__)
#pragma clang attribute push(__attribute__((target("no-packed-fp32-ops"))), apply_to = function)
#endif
#include <hip/hip_runtime.h>
#include <hip/hip_cooperative_groups.h>
#include <cstdio>
#include <cstdint>
namespace cg = cooperative_groups;
#ifndef USE_PG8
#define USE_PG8 1
#endif
#ifndef N_LAUNCH_MODE
#define N_LAUNCH_MODE 1
#endif
#ifndef PHMASK
#define PHMASK 0x1ff
#endif
#ifndef USE_NAIVE_MIX
#define USE_NAIVE_MIX 0
#endif
#ifndef PROBE
#define PROBE 0
#endif
#ifndef USE_XBAR
#define USE_XBAR 1
#endif
#ifndef PROBE_REP0
#define PROBE_REP0 0
#define PROBE_REP1 0
#define PROBE_REP2 0
#define PROBE_REP3 0
#endif
#ifndef SCAN_PREFETCH
#define SCAN_PREFETCH 1
#endif
#ifndef PROBE_LOOPS
#define PROBE_LOOPS 0
#endif
#ifndef PROBE_MIXMODE
#define PROBE_MIXMODE 0
#endif
#ifndef PROBE_PHASE
#define PROBE_PHASE 3
#endif
#ifndef FUSE_FINAL
#define FUSE_FINAL 1
#endif
namespace pg8 {
#define PG8_LAS __attribute__((address_space(3)))
typedef unsigned short bf16_t;
typedef short bf16x8 __attribute__((ext_vector_type(8)));
typedef float f32x4 __attribute__((ext_vector_type(4)));
typedef unsigned u32x4 __attribute__((ext_vector_type(4)));
constexpr int BM = 256, BK = 64, HALF = 128, HTB = HALF * BK * 2  , STAGE_BYTES = 8 * HTB, NXCD = 8, WGM = 8;

__host__ __device__ __forceinline__ int lds_byte(int r, int c) { const int st = (r >> 4) * 2 + (c >> 5), rr = r & 15, cc = c & 31, ob = rr * 64 + cc * 2; return st * 1024 + (ob ^ (((ob >> 9) & 1) << 5)); }
__host__ __device__ __forceinline__ void stage_rc(int b, int& R, int& C) { const int st = b / 1024, sb = b % 1024, swz = sb ^ (((sb >> 9) & 1) << 5); R = (st >> 1) * 16 + swz / 64; C = (st & 1) * 32 + (swz % 64) / 2; }
__host__ __device__ __forceinline__ int perm32(int rho) { const int n = rho >> 4, i = rho & 15; return 8 * (i >> 2) + 4 * n + (i & 3); }

struct Unit { int pm, pn; };
struct Gemm { const bf16_t* A; const bf16_t* Bt; int M, N, K; };

struct StaticOrder {
    int nM, nN, nwg, G, c;
    __host__ __device__ void init(int M, int N, int G_, int c_) { nM = M / BM; nN = N / BM; nwg = nM * nN; G = G_; c = c_; }
    __host__ __device__ bool next(int i, Unit& u) const {
        const long L = (long)i * G + c; if (L >= nwg) return false;
        int wgid = (int)L; { const int q = nwg / NXCD, r = nwg % NXCD, xcd = wgid % NXCD, off = wgid / NXCD; wgid = (xcd < r ? xcd * (q + 1) : r * (q + 1) + (xcd - r) * q) + off; }
        const int nig = WGM * nN, gid = wgid / nig, fm = gid * WGM, gsz = (nM - fm) < WGM ? (nM - fm) : WGM;
        u.pm = fm + ((wgid % nig) % gsz); u.pn = (wgid % nig) / gsz; return true;
    }
    __device__ __forceinline__ void a_ready(const Unit&) const {}
    __device__ __forceinline__ void done(const Unit&) const {}
};

__device__ __forceinline__ unsigned cvt_pk_bf16(float lo, float hi) { unsigned r; asm volatile("v_cvt_pk_bf16_f32 %0, %1, %2" : "=v"(r) : "v"(lo), "v"(hi)); return r; }
typedef float f32x2 __attribute__((ext_vector_type(2)));
__device__ __forceinline__ f32x2 gelu_pk(f32x2 v) {
    const f32x2 av = __builtin_elementwise_abs(v), d = av * 0.2316418882f + 1.0f;
    f32x2 t; t.x = __builtin_amdgcn_rcpf(d.x); t.y = __builtin_amdgcn_rcpf(d.y);
    f32x2 q = t * 0.5307027145f + (-0.7265760135f); q = q * t + 0.7107068705f; q = q * t + (-0.142248368f); q = q * t + 0.127414796f; q = q * t;
    const f32x2 s = (v * v) * (-0.72134752044f);
    f32x2 e; e.x = __builtin_amdgcn_exp2f(s.x); e.y = __builtin_amdgcn_exp2f(s.y);
    const f32x2 m = v * (q * e), r = v - m;
    f32x2 o; o.x = v.x < 0.f ? m.x : r.x; o.y = v.y < 0.f ? m.y : r.y; return o;
}

template <int ACT  > struct EpiBf16 {
    static constexpr bool PERM = true, AFTER_DRAIN = false; static_assert(ACT == 0 || ACT == 1, "EpiBf16: ACT is 0 (none) or 1 (gelu_pk)");
    bf16_t* O; int ldc; const float* bias; int split_cols; size_t split_stride; float scale0;
    __device__ __forceinline__ void operator()(const f32x4 (&acc)[2][2][4][2], const Unit& u, int wr, int wc, int fr, int fq) const {
        const int row0 = u.pm * BM + wr * 64 + fr; int colt = u.pn * BM; bf16_t* base = O;
        float sc = 1.f; if (split_cols) { const int t = colt / split_cols; base += (size_t)t * split_stride; colt -= t * split_cols; if (t == 0) sc = scale0; }
        const int col0 = colt + wc * 32 + 8 * fq, bcol0 = u.pn * BM + wc * 32 + 8 * fq;
        f32x4 bv[2][2];
#pragma unroll
        for (int bj = 0; bj < 2; ++bj)
#pragma unroll
            for (int n = 0; n < 2; ++n) bv[bj][n] = bias ? *(const f32x4*)(bias + bcol0 + bj * HALF + 4 * n) : (f32x4){0.f, 0.f, 0.f, 0.f};
#pragma unroll
        for (int ai = 0; ai < 2; ++ai)
#pragma unroll
            for (int m = 0; m < 4; ++m) { bf16_t* rowp = base + (size_t)(row0 + ai * HALF + m * 16) * ldc + col0;
#pragma unroll
                for (int bj = 0; bj < 2; ++bj) { f32x4 v0 = acc[ai][bj][m][0] + bv[bj][0], v1 = acc[ai][bj][m][1] + bv[bj][1];
                    if (ACT == 1) { f32x2 a = gelu_pk((f32x2){v0[0], v0[1]}), b = gelu_pk((f32x2){v0[2], v0[3]}), c = gelu_pk((f32x2){v1[0], v1[1]}), d = gelu_pk((f32x2){v1[2], v1[3]});
                        v0 = (f32x4){a.x, a.y, b.x, b.y}; v1 = (f32x4){c.x, c.y, d.x, d.y}; }
                    v0 = v0 * sc; v1 = v1 * sc; u32x4 w; w.x = cvt_pk_bf16(v0[0], v0[1]); w.y = cvt_pk_bf16(v0[2], v0[3]); w.z = cvt_pk_bf16(v1[0], v1[1]); w.w = cvt_pk_bf16(v1[2], v1[3]);
                    *(u32x4*)(rowp + bj * HALF) = w; } }
    }
};
template <class Epi, class Sched, bool ALIGN_EPI = false, bool SP2 = false>
__device__ __forceinline__ void gemm_phase(PG8_LAS unsigned char* lds, const Gemm g, const Sched& S, const Epi& E) {
    const int tid = threadIdx.x, wid = __builtin_amdgcn_readfirstlane(tid >> 6), lane = tid & 63, wr = wid >> 2, wc = wid & 3, fr = lane & 15, fq = lane >> 4;
    const int K = g.K, nt = K / BK;
    unsigned voffA[2], voffB[2];
#pragma unroll
    for (int i = 0; i < 2; ++i) { int R, C; stage_rc(tid * 16 + i * 8192, R, C); const int Rb = Epi::PERM ? ((R & ~31) + perm32(R & 31)) : R;
        voffA[i] = (unsigned)(R * K + C) * 2u; voffB[i] = (unsigned)(Rb * K + C) * 2u; }
    const size_t kstep = (size_t)(BK * 2);
    const size_t hstep = (size_t)HALF * K * 2;
    const size_t tstep = 2 * hstep;
    const unsigned ldsw = (unsigned)wid * 1024u;
    const int aoff = lds_byte(wr * 64 + fr, fq * 8), boff = lds_byte(wc * 32 + fr, fq * 8);
#define PG8_SA(b, h) (((b) * 2 + (h)) * HTB)
#define PG8_SB(b, h) ((4 + (b) * 2 + (h)) * HTB)
#define PG8_STAGE(bufoff, gbase, voff) do { _Pragma("unroll") for (int _i = 0; _i < 2; ++_i) \
        __builtin_amdgcn_global_load_lds((const unsigned*)((const char*)(gbase) + (voff)[_i]), (PG8_LAS unsigned*)(lds + (bufoff) + ldsw + _i * 8192), 16, 0, 0); } while (0)
#define PG8_LDA(dst, b, h) do { _Pragma("unroll") for (int m = 0; m < 4; ++m) _Pragma("unroll") for (int k = 0; k < 2; ++k) dst[m][k] = *(const PG8_LAS bf16x8*)(lds + PG8_SA(b, h) + aoff + m * 2048 + k * 1024); } while (0)
#define PG8_LDB(dst, b, h) do { _Pragma("unroll") for (int n = 0; n < 2; ++n) _Pragma("unroll") for (int k = 0; k < 2; ++k) dst[n][k] = *(const PG8_LAS bf16x8*)(lds + PG8_SB(b, h) + boff + n * 2048 + k * 1024); } while (0)
#define PG8_MMA(ai, bj, At, Bt) do { __builtin_amdgcn_s_setprio(1); _Pragma("unroll") for (int m = 0; m < 4; ++m) _Pragma("unroll") for (int n = 0; n < 2; ++n) _Pragma("unroll") for (int k = 0; k < 2; ++k) \
        acc[ai][bj][m][n] = __builtin_amdgcn_mfma_f32_16x16x32_bf16(Bt[n][k], At[m][k], acc[ai][bj][m][n], 0, 0, 0); __builtin_amdgcn_s_setprio(0); } while (0)
#define PG8_WAIT_V(n) asm volatile("s_waitcnt vmcnt(" #n ")" ::: "memory")
#define PG8_WAIT_L(n) asm volatile("s_waitcnt lgkmcnt(" #n ")" ::: "memory")
#define PG8_BAR __builtin_amdgcn_s_barrier()
#define PG8_SCHED __builtin_amdgcn_sched_barrier(0)
    Unit cur, nxt; int ui = 0;
    if (!S.next(0, cur)) return;
    f32x4 acc[2][2][4][2];
#pragma unroll
    for (int a = 0; a < 2; ++a)
#pragma unroll
        for (int b = 0; b < 2; ++b)
#pragma unroll
            for (int m = 0; m < 4; ++m)
#pragma unroll
                for (int n = 0; n < 2; ++n) acc[a][b][m][n] = (f32x4){0.f, 0.f, 0.f, 0.f};
    bf16x8 At[4][2], B0[2][2], B1[2][2];
    const char* cA = (const char*)g.A + (size_t)cur.pm * tstep; const char* cB = (const char*)g.Bt + (size_t)cur.pn * tstep;
    S.a_ready(cur);
    if constexpr (SP2) {
        PG8_STAGE(PG8_SB(0, 0), cB, voffB); PG8_STAGE(PG8_SB(0, 1), cB + hstep, voffB); PG8_STAGE(PG8_SA(0, 0), cA, voffA); PG8_STAGE(PG8_SA(0, 1), cA + hstep, voffA);
        if (wr == 1) PG8_BAR;
        PG8_WAIT_V(2); PG8_BAR;
        PG8_STAGE(PG8_SB(1, 0), cB + kstep, voffB); PG8_STAGE(PG8_SA(1, 0), cA + kstep, voffA); PG8_STAGE(PG8_SB(1, 1), cB + hstep + kstep, voffB);
        PG8_WAIT_V(6); PG8_BAR;
    } else {
        PG8_STAGE(PG8_SB(0, 0), cB, voffB); PG8_STAGE(PG8_SA(0, 0), cA, voffA); PG8_STAGE(PG8_SB(0, 1), cB + hstep, voffB); PG8_STAGE(PG8_SA(0, 1), cA + hstep, voffA);
        if (wr == 1) PG8_BAR;
        PG8_WAIT_V(4); PG8_BAR;
        PG8_STAGE(PG8_SB(1, 0), cB + kstep, voffB); PG8_STAGE(PG8_SA(1, 0), cA + kstep, voffA); PG8_STAGE(PG8_SB(1, 1), cB + hstep + kstep, voffB);
        PG8_WAIT_V(6); PG8_BAR;
    }
    for (;;) {
        const bool has_next = S.next(ui + 1, nxt);
        const char* nA = has_next ? (const char*)g.A + (size_t)nxt.pm * tstep : cA; const char* nB = has_next ? (const char*)g.Bt + (size_t)nxt.pn * tstep : cB;
        for (int t = 0; t < nt; t += 2) {
            const bool last = (t == nt - 2);
            const char* a1 = cA + (size_t)(t + 1) * kstep;
            const char* a2 = last ? nA : cA + (size_t)(t + 2) * kstep; const char* b2 = last ? nB : cB + (size_t)(t + 2) * kstep;
            const char* a3 = a2 + kstep; const char* b3 = b2 + kstep;
            if (last && has_next) S.a_ready(nxt);
            if constexpr (SP2) {
            PG8_LDB(B0, 0, 0); PG8_LDB(B1, 0, 1); PG8_SCHED; PG8_LDA(At, 0, 0); PG8_STAGE(PG8_SA(1, 1), a1 + hstep, voffA);
            PG8_WAIT_V(8); PG8_WAIT_L(0); PG8_BAR; PG8_MMA(0, 0, At, B0); PG8_MMA(0, 1, At, B1); PG8_BAR; PG8_SCHED;
            PG8_LDA(At, 0, 1); PG8_STAGE(PG8_SB(0, 0), b2, voffB); PG8_STAGE(PG8_SB(0, 1), b2 + hstep, voffB); PG8_STAGE(PG8_SA(0, 0), a2, voffA);
            PG8_WAIT_V(8); PG8_WAIT_L(0); PG8_BAR; PG8_MMA(1, 0, At, B0); PG8_MMA(1, 1, At, B1); PG8_BAR; PG8_SCHED;
            PG8_LDB(B0, 1, 0); PG8_LDB(B1, 1, 1); PG8_SCHED; PG8_LDA(At, 1, 0); PG8_STAGE(PG8_SA(0, 1), a2 + hstep, voffA);
            PG8_WAIT_V(8); PG8_WAIT_L(0); PG8_BAR; PG8_MMA(0, 0, At, B0); PG8_MMA(0, 1, At, B1); PG8_BAR; PG8_SCHED;
            PG8_LDA(At, 1, 1); PG8_STAGE(PG8_SB(1, 0), b3, voffB); PG8_STAGE(PG8_SB(1, 1), b3 + hstep, voffB); PG8_STAGE(PG8_SA(1, 0), a3, voffA);
            PG8_WAIT_V(8); PG8_WAIT_L(0); PG8_BAR; PG8_MMA(1, 0, At, B0); PG8_MMA(1, 1, At, B1); PG8_BAR; PG8_SCHED;
            } else {
            PG8_LDB(B0, 0, 0); PG8_SCHED; PG8_LDA(At, 0, 0); PG8_STAGE(PG8_SA(1, 1), a1 + hstep, voffA);
            PG8_WAIT_L(8); PG8_BAR; PG8_WAIT_L(0); PG8_MMA(0, 0, At, B0); PG8_BAR; PG8_SCHED;
            PG8_LDB(B1, 0, 1); PG8_STAGE(PG8_SB(0, 0), b2, voffB);
            PG8_BAR; PG8_WAIT_L(0); PG8_MMA(0, 1, At, B1); PG8_BAR;
            PG8_LDA(At, 0, 1); PG8_STAGE(PG8_SA(0, 0), a2, voffA);
            PG8_BAR; PG8_WAIT_L(0); PG8_MMA(1, 0, At, B0); PG8_BAR; PG8_SCHED;
            PG8_STAGE(PG8_SB(0, 1), b2 + hstep, voffB);
            PG8_WAIT_V(6); PG8_BAR; PG8_MMA(1, 1, At, B1); PG8_BAR;
            PG8_LDB(B0, 1, 0); PG8_SCHED; PG8_LDA(At, 1, 0); PG8_STAGE(PG8_SA(0, 1), a2 + hstep, voffA);
            PG8_WAIT_L(8); PG8_BAR; PG8_WAIT_L(0); PG8_MMA(0, 0, At, B0); PG8_BAR; PG8_SCHED;
            PG8_LDB(B1, 1, 1); PG8_STAGE(PG8_SB(1, 0), b3, voffB);
            PG8_BAR; PG8_WAIT_L(0); PG8_MMA(0, 1, At, B1); PG8_BAR;
            PG8_LDA(At, 1, 1); PG8_STAGE(PG8_SA(1, 0), a3, voffA);
            PG8_BAR; PG8_WAIT_L(0); PG8_MMA(1, 0, At, B0); PG8_BAR; PG8_SCHED;
            PG8_STAGE(PG8_SB(1, 1), b3 + hstep, voffB);
            PG8_WAIT_V(6); PG8_BAR; PG8_MMA(1, 1, At, B1); PG8_BAR;
            }
        }
        if constexpr (ALIGN_EPI) { if (wr == 0) PG8_BAR; }
        if constexpr (!Epi::AFTER_DRAIN) { E(acc, cur, wr, wc, fr, fq); S.done(cur); }
        if (!has_next) break;
#pragma unroll
        for (int a = 0; a < 2; ++a)
#pragma unroll
            for (int b = 0; b < 2; ++b)
#pragma unroll
                for (int m = 0; m < 4; ++m)
#pragma unroll
                    for (int n = 0; n < 2; ++n) acc[a][b][m][n] = (f32x4){0.f, 0.f, 0.f, 0.f};
        cur = nxt; cA = nA; cB = nB; ++ui;
        if constexpr (ALIGN_EPI) { if (wr == 1) PG8_BAR; }
    }
    PG8_WAIT_V(0);
    if constexpr (!ALIGN_EPI) { if (wr == 0) PG8_BAR; }
    PG8_BAR;
    if constexpr (Epi::AFTER_DRAIN) { E.fused(acc, cur, wr, wc, fr, fq, lds, wid, lane); S.done(cur); }
#undef PG8_SA
#undef PG8_SB
#undef PG8_STAGE
#undef PG8_LDA
#undef PG8_LDB
#undef PG8_MMA
#undef PG8_WAIT_V
#undef PG8_WAIT_L
#undef PG8_BAR
#undef PG8_SCHED
}
}

namespace mk {
typedef unsigned short bf16_t;
typedef float f32x4 __attribute__((ext_vector_type(4)));
typedef unsigned u32x4 __attribute__((ext_vector_type(4)));
typedef unsigned u32x2 __attribute__((ext_vector_type(2)));
typedef float f32x2 __attribute__((ext_vector_type(2)));
#define LAS __attribute__((address_space(3)))

constexpr int BATCH = 16, SEQ = 2048, DM = 1024, M = BATCH * SEQ;
constexpr int NA = 1792, NB = 2560, N1 = NA + NB;
constexpr int N3 = 3072;
constexpr int EVEN_IN = 4224, SHIFT_W = 1664;
constexpr float RMS_EPS = 1e-6f, LN_EPS = 1e-5f, GN_EPS = 64e-5f;
constexpr int NTHR = 512;

constexpr size_t MiB = 1u << 20;
constexpr size_t WS_CTR = 768 * 1024;
constexpr size_t WS_LW = 23 * MiB + 512 * 1024;
constexpr size_t WS_SGW = 23 * MiB;
constexpr size_t WS_RS0 = 0, WS_RS1 = 128 * 1024, WS_RS2 = 256 * 1024, WS_VSUM = 384 * 1024, WS_VSQ = 512 * 1024, WS_BON = 1 * MiB;
constexpr size_t WS_BAR = 2 * MiB;
constexpr size_t WS_PCNT = 2 * MiB + 65536;
constexpr size_t WS_EXCH = 3 * MiB;
constexpr size_t WS_W1T = 4 * MiB, WS_W2T = 13 * MiB, WS_W3T = 15 * MiB, WS_W4T = 21 * MiB;
constexpr size_t WS_XN = 24 * MiB;
constexpr size_t WS_PA = 88 * MiB;
constexpr size_t WS_PB = 200 * MiB;
constexpr size_t WS_YMIX = 360 * MiB;
constexpr size_t WS_TAIL = 424 * MiB;
constexpr size_t WS_VRAW = 448 * MiB;
constexpr size_t WS_END = 480 * MiB;
constexpr int RSZ = 12544;
constexpr size_t WS_P1 = WS_PA;
constexpr int LDS_BYTES = 147456;

struct Args {
    const float* in[22];
    float* out; unsigned char* ws;
    int lo, hi;
    int rep[4];
};
enum { I_X = 0, I_NORMG, I_WINE, I_SHMU, I_W0, I_W2, I_A0, I_A2, I_KK, I_KA, I_RK, I_LNXG, I_LNXB, I_ABIAS, I_WOUTE, I_WINO, I_SGLNG, I_SGLNB, I_SGW, I_SGB, I_WOUTO, I_FG };

__device__ __forceinline__ float bf2f(unsigned short h) { return __uint_as_float((unsigned)h << 16); }
typedef __bf16 bf2_t __attribute__((ext_vector_type(2)));
__device__ __forceinline__ unsigned pk2(float lo, float hi) { const f32x2 v = {lo, hi}; const bf2_t b = __builtin_convertvector(v, bf2_t); return __builtin_bit_cast(unsigned, b); }
__device__ __forceinline__ unsigned short f2bf(float f) { return (unsigned short)(pk2(f, 0.f) & 0xffffu); }
__device__ __forceinline__ float bflo(unsigned w) { return __uint_as_float(w << 16); }
__device__ __forceinline__ float bfhi(unsigned w) { return __uint_as_float(w & 0xffff0000u); }
__device__ __forceinline__ float wave_sum(float v) {
#pragma unroll
    for (int o = 1; o < 64; o <<= 1) v += __shfl_xor(v, o);
    return v;
}
__device__ __forceinline__ float sigmoidf_(float x) { return __builtin_amdgcn_rcpf(1.0f + __expf(-x)); }
__device__ __forceinline__ float siluf_(float x) { return x * sigmoidf_(x); }
__device__ __forceinline__ float gelu_tanh(float x) { const float t = x * x; const float q = x * __builtin_fmaf(t, -0.10294324f, -2.3022082f);
    return x * __builtin_amdgcn_rcpf(1.0f + __builtin_amdgcn_exp2f(q)); }

__device__ __forceinline__ void phase_prologue(const Args& a, unsigned char* ldsb) {
    const int tid = threadIdx.x, lane = tid & 63, wave = tid >> 6;
    unsigned char* ws = a.ws;
    const int gtid = blockIdx.x * NTHR + tid, nthr = gridDim.x * NTHR;
    {
        LAS float* scr = (LAS float*)((LAS unsigned char*)ldsb + wave * 8448);
        constexpr int NB1 = N1 / 32, NB2 = 32, NB3 = N3 / 32, NB4 = 32, NITEM = (NB1 + NB2 + NB3 + NB4) * 16;
        for (int it = blockIdx.x * 8 + wave; it < NITEM; it += gridDim.x * 8) {
            int nb = it >> 4; const int k0 = (it & 15) * 64;
            const float* src; const float* g; int N, col0; bf16_t* dst; bool zero = false;
            if (nb < NB1) { const int n0 = nb * 32; src = a.in[I_WINE]; g = a.in[I_NORMG]; N = EVEN_IN; dst = (bf16_t*)(ws + WS_W1T) + (size_t)n0 * 1024;
                if (n0 < SHIFT_W) col0 = n0; else if (n0 < NA) { col0 = 0; zero = true; } else col0 = n0 - (NA - SHIFT_W); }
            else if ((nb -= NB1) < NB2) { src = a.in[I_WOUTE]; g = nullptr; N = 1024; col0 = nb * 32; dst = (bf16_t*)(ws + WS_W2T) + (size_t)col0 * 1024; }
            else if ((nb -= NB2) < NB3) { src = a.in[I_WINO]; g = a.in[I_NORMG] + 1024; N = N3; col0 = nb * 32; dst = (bf16_t*)(ws + WS_W3T) + (size_t)col0 * 1024; }
            else { nb -= NB3; src = a.in[I_WOUTO]; g = nullptr; N = 1024; col0 = nb * 32; dst = (bf16_t*)(ws + WS_W4T) + (size_t)col0 * 1024; }
            float xv[32];
#pragma unroll
            for (int i = 0; i < 32; ++i) { const int kk = 2 * i + (lane >> 5); xv[i] = zero ? 0.f : __builtin_nontemporal_load(src + (size_t)(k0 + kk) * N + col0 + (lane & 31)); }
#pragma unroll
            for (int i = 0; i < 32; ++i) { const int kk = 2 * i + (lane >> 5); float x = xv[i]; if (g) x *= g[k0 + kk]; scr[kk * 33 + (lane & 31)] = x; }
            asm volatile("s_waitcnt lgkmcnt(0)" ::: "memory");
            const int c8 = lane & 7;
#pragma unroll
            for (int j = 0; j < 4; ++j) { const int n = (lane >> 3) + 8 * j; const LAS float* sp = scr + (8 * c8) * 33 + n;
                u32x4 o; o.x = pk2(sp[0 * 33], sp[1 * 33]); o.y = pk2(sp[2 * 33], sp[3 * 33]); o.z = pk2(sp[4 * 33], sp[5 * 33]); o.w = pk2(sp[6 * 33], sp[7 * 33]);
                *(u32x4*)(dst + (size_t)n * 1024 + k0 + 8 * c8) = o; }
            asm volatile("s_waitcnt lgkmcnt(0)" ::: "memory");
        }
    }
    const float* x = a.in[I_X]; bf16_t* XN = (bf16_t*)(ws + WS_XN); float* rs0 = (float*)(ws + WS_RS0);
    const int gw = blockIdx.x * 8 + wave, NGW = gridDim.x * 8;
    for (int m0 = gw; m0 < M; m0 += 8 * NGW) {
        f32x4 v[8][4];
#pragma unroll
        for (int r = 0; r < 8; ++r) { const int m = m0 + r * NGW; if (m < M) { const f32x4* xr = (const f32x4*)(x + (size_t)m * DM) + lane;
#pragma unroll
            for (int j = 0; j < 4; ++j) v[r][j] = __builtin_nontemporal_load(xr + 64 * j); } }
#pragma unroll
        for (int r = 0; r < 8; ++r) { const int m = m0 + r * NGW; if (m < M) {
            float s = 0.f;
#pragma unroll
            for (int j = 0; j < 4; ++j) s += (v[r][j].x * v[r][j].x + v[r][j].y * v[r][j].y) + (v[r][j].z * v[r][j].z + v[r][j].w * v[r][j].w);
            s = wave_sum(s);
            const float rinv = rsqrtf(s * (1.0f / DM) + RMS_EPS);
            u32x2* o = (u32x2*)(XN + (size_t)m * DM) + lane;
#pragma unroll
            for (int j = 0; j < 4; ++j) { u32x2 w; w.x = pk2(v[r][j].x * rinv, v[r][j].y * rinv); w.y = pk2(v[r][j].z * rinv, v[r][j].w * rinv); o[64 * j] = w; }
            if (lane == 0) rs0[m] = s; } }
    }
    float* rs1 = (float*)(ws + WS_RS1); float* rs2 = (float*)(ws + WS_RS2); float* vsum = (float*)(ws + WS_VSUM); float* vsq = (float*)(ws + WS_VSQ);
    for (int i = gtid; i < M; i += nthr) { rs1[i] = 0.f; rs2[i] = 0.f; vsum[i] = 0.f; vsq[i] = 0.f; }
    { bf16_t* LW = (bf16_t*)(ws + WS_LW); const float* w2 = a.in[I_W2]; const float* a2 = a.in[I_A2];
      for (int i = gtid; i < 2 * 512 * 64; i += nthr) { const int j = i & 63, cc = (i >> 6) & 511, mat = i >> 15; LW[i] = f2bf((mat ? a2 : w2)[j * 512 + cc]); } }
    { bf16_t* SGW = (bf16_t*)(ws + WS_SGW); const float* sgw = a.in[I_SGW];
      for (int i = gtid; i < 8 * 128 * 128; i += nthr) { const int jj = i & 127, ii = (i >> 7) & 127; SGW[i] = f2bf(((jj >> 6) <= (ii >> 6)) ? sgw[i] : 0.f); } }
}

struct EpiG1 {
    const float* rs0; bf16_t* PA; bf16_t* PB;
    static constexpr int NSTAT = 0; static constexpr bool HAS_RES = false;
    __device__ __forceinline__ float rowval(int) const { return 0.f; }
    __device__ __forceinline__ f32x4 resload(int, int) const { return (f32x4){0.f, 0.f, 0.f, 0.f}; }
    __device__ __forceinline__ void commit(int, float, float) const {}
    __device__ __forceinline__ f32x2 operator()(int row, int col, f32x4 v0, f32x4 v1, float = 0.f) const {
        u32x4 w; w.x = pk2(v0[0], v0[1]); w.y = pk2(v0[2], v0[3]); w.z = pk2(v1[0], v1[1]); w.w = pk2(v1[2], v1[3]);
        bf16_t* dst = col < NA ? PA + (size_t)row * NA + col : PB + (size_t)row * NB + (col - NA);
        *(u32x4*)dst = w;
        return (f32x2){0.f, 0.f};
    }
};
struct EpiG2 {
    const float* x; float* out; bf16_t* HB; float* rs1;
    __device__ __forceinline__ float quad(int row, int col, f32x4 v) const {
        const size_t off = (size_t)row * DM + col;
        v = v + *(const f32x4*)(x + off);
        *(f32x4*)(out + off) = v;
        u32x2 w; w.x = pk2(v[0], v[1]); w.y = pk2(v[2], v[3]);
        *(u32x2*)(HB + off) = w;
        return (v[0] * v[0] + v[1] * v[1]) + (v[2] * v[2] + v[3] * v[3]);
    }
    static constexpr int NSTAT = 1; static constexpr bool HAS_RES = true;
    __device__ __forceinline__ float rowval(int) const { return 0.f; }
    __device__ __forceinline__ f32x4 resload(int row, int col) const { return *(const f32x4*)(x + (size_t)row * DM + col); }
    __device__ __forceinline__ void commit(int row, float s0, float) const { unsafeAtomicAdd(rs1 + row, s0); }
    __device__ __forceinline__ f32x2 operator()(int row, int col, f32x4 v0, f32x4 v1, float = 0.f) const {
        const size_t off = (size_t)row * DM + col;
        *(f32x4*)(out + off) = v0; *(f32x4*)(out + off + 4) = v1;
        u32x4 w; w.x = pk2(v0[0], v0[1]); w.y = pk2(v0[2], v0[3]); w.z = pk2(v1[0], v1[1]); w.w = pk2(v1[2], v1[3]);
        *(u32x4*)(HB + off) = w;
        const float s = (v0[0] * v0[0] + v0[1] * v0[1]) + (v0[2] * v0[2] + v0[3] * v0[3]) + (v1[0] * v1[0] + v1[1] * v1[1]) + (v1[2] * v1[2] + v1[3] * v1[3]);
        return (f32x2){s, 0.f};
    }
};
struct EpiG3 {
    const float* rs1; bf16_t* P1; float* vsum; float* vsq;
    static constexpr int NSTAT = 2; static constexpr bool HAS_RES = false;
    __device__ __forceinline__ float rowval(int row) const { return rs1[row]; }
    __device__ __forceinline__ f32x4 resload(int, int) const { return (f32x4){0.f, 0.f, 0.f, 0.f}; }
    __device__ __forceinline__ void commit(int row, float s0, float s1) const { if (s1 != 0.f) { unsafeAtomicAdd(vsum + row, s0); unsafeAtomicAdd(vsq + row, s1); } }
    __device__ __forceinline__ f32x2 operator()(int row, int col, f32x4 v0, f32x4 v1, float rsv) const {
        f32x2 ret = (f32x2){0.f, 0.f};
        const float rinv = rsqrtf(rsv * (1.0f / DM) + RMS_EPS);
        float v[8];
#pragma unroll
        for (int j = 0; j < 4; ++j) { v[j] = v0[j] * rinv; v[4 + j] = v1[j] * rinv; }
        if (col < 2048) {
#pragma unroll
            for (int j = 0; j < 8; ++j) v[j] = gelu_tanh(v[j]);
            if (col >= 1024) {
                float s = 0.f, q = 0.f;
#pragma unroll
                for (int j = 0; j < 8; ++j) { s += v[j]; q += v[j] * v[j]; }
                ret = (f32x2){s, q};
            }
        } else {
#pragma unroll
            for (int j = 0; j < 8; ++j) v[j] = siluf_(v[j]);
        }
        u32x4 w; w.x = pk2(v[0], v[1]); w.y = pk2(v[2], v[3]); w.z = pk2(v[4], v[5]); w.w = pk2(v[6], v[7]);
        *(u32x4*)(P1 + (size_t)row * N3 + col) = w;
        return ret;
    }
};
struct EpiG4 {
    float* out; float* rs2;
    __device__ __forceinline__ float quad(int row, int col, f32x4 v) const {
        const size_t off = (size_t)row * DM + col;
        v = v + *(const f32x4*)(out + off);
        *(f32x4*)(out + off) = v;
        return (v[0] * v[0] + v[1] * v[1]) + (v[2] * v[2] + v[3] * v[3]);
    }
    static constexpr int NSTAT = 1; static constexpr bool HAS_RES = false;
    __device__ __forceinline__ float rowval(int) const { return 0.f; }
    __device__ __forceinline__ f32x4 resload(int, int) const { return (f32x4){0.f, 0.f, 0.f, 0.f}; }
    __device__ __forceinline__ void commit(int row, float s0, float) const { unsafeAtomicAdd(rs2 + row, s0); }
    __device__ __forceinline__ f32x2 operator()(int row, int col, f32x4 v0, f32x4 v1, float = 0.f) const {
        const size_t off = (size_t)row * DM + col;
        v0 = v0 + *(const f32x4*)(out + off); v1 = v1 + *(const f32x4*)(out + off + 4);
        *(f32x4*)(out + off) = v0; *(f32x4*)(out + off + 4) = v1;
        const float s = (v0[0] * v0[0] + v0[1] * v0[1]) + (v0[2] * v0[2] + v0[3] * v0[3]) + (v1[0] * v1[0] + v1[1] * v1[1]) + (v1[2] * v1[2] + v1[3] * v1[3]);
        return (f32x2){s, 0.f};
    }
};


struct EpiG4X {
    static constexpr bool PERM = true, AFTER_DRAIN = false;
    float* out; const float* fg; float* exch; unsigned* cnt; LAS unsigned char* scr;
    __device__ __forceinline__ void operator()(pg8::f32x4 (&acc)[2][2][4][2], const pg8::Unit& u, int wr_, int wc_, int fr_, int fq_) const {
        int tid = threadIdx.x, wr = wr_, wc = wc_, fr = fr_, fq = fq_;
        asm volatile("" : "+v"(tid), "+v"(fr), "+v"(fq));
        const int lane = tid & 63;
        LAS float* P = (LAS float*)scr;
        LAS float* S = (LAS float*)(scr + 4096);
#pragma unroll
        for (int ai = 0; ai < 2; ++ai)
#pragma unroll
            for (int m = 0; m < 4; ++m) {
                const int rl = ai * 128 + wr * 64 + m * 16 + fr; const size_t rowoff = (size_t)(u.pm * 256 + rl) * DM;
                float sq = 0.f;
#pragma unroll
                for (int bj = 0; bj < 2; ++bj) { const size_t off = rowoff + u.pn * 256 + bj * 128 + wc * 32 + 8 * fq;
                    f32x4 v0 = acc[ai][bj][m][0] + *(const f32x4*)(out + off), v1 = acc[ai][bj][m][1] + *(const f32x4*)(out + off + 4);
                    acc[ai][bj][m][0] = v0; acc[ai][bj][m][1] = v1;
                    sq += ((v0[0] * v0[0] + v0[1] * v0[1]) + (v0[2] * v0[2] + v0[3] * v0[3])) + ((v1[0] * v1[0] + v1[1] * v1[1]) + (v1[2] * v1[2] + v1[3] * v1[3])); }
                sq += __shfl_xor(sq, 16); sq += __shfl_xor(sq, 32);
                if (fq == 0) P[rl * 4 + wc] = sq;
                if (m == 3) asm volatile("" ::: "memory");
            }
        asm volatile("s_waitcnt vmcnt(0) lgkmcnt(0)" ::: "memory"); __builtin_amdgcn_s_barrier(); asm volatile("" ::: "memory");
        if (tid < 256) {
            const f32x4 p = *(const LAS f32x4*)(P + tid * 4);
            __hip_atomic_store(exch + (size_t)(u.pm * 256 + tid) * 4 + u.pn, (p[0] + p[1]) + (p[2] + p[3]), __ATOMIC_RELAXED, __HIP_MEMORY_SCOPE_AGENT);
            asm volatile("s_waitcnt vmcnt(0)" ::: "memory");
            if (lane == 0) __hip_atomic_fetch_add(cnt + 64 * u.pm, 1u, __ATOMIC_RELAXED, __HIP_MEMORY_SCOPE_AGENT);
        }
        if (tid < 64) {
            unsigned spins = 0;
            while ((unsigned)__builtin_amdgcn_readfirstlane(__hip_atomic_load(cnt + 64 * u.pm, __ATOMIC_RELAXED, __HIP_MEMORY_SCOPE_AGENT)) < 16u) { __builtin_amdgcn_s_sleep(2); if (++spins > (1u << 22)) break; }
            __builtin_amdgcn_fence(__ATOMIC_ACQUIRE, "agent");
        }
        asm volatile("s_waitcnt vmcnt(0) lgkmcnt(0)" ::: "memory"); __builtin_amdgcn_s_barrier(); asm volatile("" ::: "memory");
        if (tid < 256) {
            const float* e = exch + (size_t)(u.pm * 256 + tid) * 4;
            const float t = (__hip_atomic_load(e, __ATOMIC_RELAXED, __HIP_MEMORY_SCOPE_AGENT) + __hip_atomic_load(e + 1, __ATOMIC_RELAXED, __HIP_MEMORY_SCOPE_AGENT))
                          + (__hip_atomic_load(e + 2, __ATOMIC_RELAXED, __HIP_MEMORY_SCOPE_AGENT) + __hip_atomic_load(e + 3, __ATOMIC_RELAXED, __HIP_MEMORY_SCOPE_AGENT));
            S[tid] = rsqrtf(t * (1.0f / DM) + RMS_EPS);
        }
        asm volatile("s_waitcnt vmcnt(0) lgkmcnt(0)" ::: "memory"); __builtin_amdgcn_s_barrier(); asm volatile("" ::: "memory");
        const int pm5 = u.pm, pn5 = u.pn;
#pragma unroll
        for (int bj = 0; bj < 2; ++bj) {
            const int colb = pn5 * 256 + bj * 128 + wc * 32 + 8 * fq;
            const f32x4 g0 = *(const f32x4*)(fg + colb), g1 = *(const f32x4*)(fg + colb + 4);
#pragma unroll
            for (int ai = 0; ai < 2; ++ai)
#pragma unroll
                for (int m = 0; m < 4; ++m) {
                    const int rl = ai * 128 + wr * 64 + m * 16 + fr; const float rinv = S[rl];
                    const size_t off = (size_t)(pm5 * 256 + rl) * DM + colb;
                    __builtin_nontemporal_store(acc[ai][bj][m][0] * rinv * g0, (f32x4*)(out + off)); __builtin_nontemporal_store(acc[ai][bj][m][1] * rinv * g1, (f32x4*)(out + off + 4));
                }
        }
        asm volatile("s_waitcnt lgkmcnt(0)" ::: "memory"); __builtin_amdgcn_s_barrier(); asm volatile("" ::: "memory");
    }
};

template <class F> struct EpiAdapt {
    static constexpr bool PERM = true, AFTER_DRAIN = false;
    F f;
    __device__ __forceinline__ void operator()(const pg8::f32x4 (&acc)[2][2][4][2], const pg8::Unit& u, int wr, int wc, int fr, int fq) const {
        float rv[2][4];
#pragma unroll
        for (int ai = 0; ai < 2; ++ai)
#pragma unroll
            for (int m = 0; m < 4; ++m) rv[ai][m] = f.rowval(u.pm * 256 + ai * 128 + wr * 64 + m * 16 + fr);
#pragma unroll
        for (int ai = 0; ai < 2; ++ai) {
            f32x4 res[4][2][2];
            if (F::HAS_RES) {
#pragma unroll
                for (int m = 0; m < 4; ++m)
#pragma unroll
                    for (int bj = 0; bj < 2; ++bj) { const int row = u.pm * 256 + ai * 128 + wr * 64 + m * 16 + fr; const int col = u.pn * 256 + bj * 128 + wc * 32 + 8 * fq;
                        res[m][bj][0] = f.resload(row, col); res[m][bj][1] = f.resload(row, col + 4); }
                asm volatile("" ::: "memory");
            }
#pragma unroll
            for (int m = 0; m < 4; ++m) {
                const int row = u.pm * 256 + ai * 128 + wr * 64 + m * 16 + fr;
                f32x2 st = (f32x2){0.f, 0.f};
#pragma unroll
                for (int bj = 0; bj < 2; ++bj) { const int col = u.pn * 256 + bj * 128 + wc * 32 + 8 * fq;
                    f32x4 a0 = acc[ai][bj][m][0], a1 = acc[ai][bj][m][1];
                    if (F::HAS_RES) { a0 = a0 + res[m][bj][0]; a1 = a1 + res[m][bj][1]; }
                    const f32x2 r = f(row, col, a0, a1, rv[ai][m]); st = st + r; }
                if (F::NSTAT >= 1) { st.x += __shfl_xor(st.x, 16); st.x += __shfl_xor(st.x, 32); }
                if (F::NSTAT >= 2) { st.y += __shfl_xor(st.y, 16); st.y += __shfl_xor(st.y, 32); }
                if (F::NSTAT >= 1 && fq == 0) f.commit(row, st.x, st.y);
            }
        }
    }
};


template <class F> struct EpiAdaptNP {
    static constexpr bool PERM = false, AFTER_DRAIN = false;
    F f;
    __device__ __forceinline__ void operator()(const pg8::f32x4 (&acc)[2][2][4][2], const pg8::Unit& u, int wr, int wc, int fr, int fq) const {
#pragma unroll
        for (int ai = 0; ai < 2; ++ai)
#pragma unroll
            for (int m = 0; m < 4; ++m) {
                const int row = u.pm * 256 + ai * 128 + wr * 64 + m * 16 + fr;
                float st = 0.f;
#pragma unroll
                for (int bj = 0; bj < 2; ++bj)
#pragma unroll
                    for (int n = 0; n < 2; ++n) { const int col = u.pn * 256 + bj * 128 + wc * 32 + 16 * n + 4 * fq; st += f.quad(row, col, acc[ai][bj][m][n]); }
                st += __shfl_xor(st, 16); st += __shfl_xor(st, 32);
                if (fq == 0) f.commit(row, st, 0.f);
            }
    }
};

template <class F> __device__ __forceinline__ void gemm_naive(float* lds, const bf16_t* A, const bf16_t* Bt, int Mm, int N, int K, const F& f) {
    const int tid = threadIdx.x, ty = tid >> 4, tx = tid & 15;
    float* As = lds; float* Bs = lds + 32 * 132;
    const int ntn = N / 128, ntiles = (Mm / 128) * ntn;
    for (int tile = blockIdx.x; tile < ntiles; tile += gridDim.x) {
        const int tm = tile / ntn, tn = tile % ntn;
        float acc[4][8];
#pragma unroll
        for (int i = 0; i < 4; ++i)
#pragma unroll
            for (int j = 0; j < 8; ++j) acc[i][j] = 0.f;
        for (int k0 = 0; k0 < K; k0 += 32) {
            { const int row = tid >> 2, kc = (tid & 3) * 8;
              const u32x4 va = *(const u32x4*)(A + (size_t)(tm * 128 + row) * K + k0 + kc);
              const u32x4 vb = *(const u32x4*)(Bt + (size_t)(tn * 128 + row) * K + k0 + kc);
              As[(kc + 0) * 132 + row] = bflo(va.x); As[(kc + 1) * 132 + row] = bfhi(va.x); As[(kc + 2) * 132 + row] = bflo(va.y); As[(kc + 3) * 132 + row] = bfhi(va.y);
              As[(kc + 4) * 132 + row] = bflo(va.z); As[(kc + 5) * 132 + row] = bfhi(va.z); As[(kc + 6) * 132 + row] = bflo(va.w); As[(kc + 7) * 132 + row] = bfhi(va.w);
              Bs[(kc + 0) * 132 + row] = bflo(vb.x); Bs[(kc + 1) * 132 + row] = bfhi(vb.x); Bs[(kc + 2) * 132 + row] = bflo(vb.y); Bs[(kc + 3) * 132 + row] = bfhi(vb.y);
              Bs[(kc + 4) * 132 + row] = bflo(vb.z); Bs[(kc + 5) * 132 + row] = bfhi(vb.z); Bs[(kc + 6) * 132 + row] = bflo(vb.w); Bs[(kc + 7) * 132 + row] = bfhi(vb.w); }
            __syncthreads();
#pragma unroll 8
            for (int kk = 0; kk < 32; ++kk) {
                const f32x4 a4 = *(const f32x4*)(As + kk * 132 + ty * 4);
                const f32x4 b0 = *(const f32x4*)(Bs + kk * 132 + tx * 8), b1 = *(const f32x4*)(Bs + kk * 132 + tx * 8 + 4);
#pragma unroll
                for (int i = 0; i < 4; ++i) {
#pragma unroll
                    for (int j = 0; j < 4; ++j) { acc[i][j] += a4[i] * b0[j]; acc[i][4 + j] += a4[i] * b1[j]; }
                }
            }
            __syncthreads();
        }
#pragma unroll
        for (int i = 0; i < 4; ++i) { const f32x2 r = f(tm * 128 + ty * 4 + i, tn * 128 + tx * 8, (f32x4){acc[i][0], acc[i][1], acc[i][2], acc[i][3]}, (f32x4){acc[i][4], acc[i][5], acc[i][6], acc[i][7]}); if (F::NSTAT >= 1) f.commit(tm * 128 + ty * 4 + i, r.x, r.y); }
    }
}

template <class F> __device__ __forceinline__ void gemm_np(unsigned char* lds, const bf16_t* A, const bf16_t* Bt, int Mm, int N, int K, const F& f) {
    pg8::Gemm g{A, Bt, Mm, N, K}; pg8::StaticOrder S; S.init(Mm, N, (int)gridDim.x, (int)blockIdx.x);
    EpiAdaptNP<F> E{f};
    pg8::gemm_phase<EpiAdaptNP<F>, pg8::StaticOrder, false, true>((PG8_LAS unsigned char*)lds, g, S, E);
}
template <class F, bool ALIGN = true> __device__ __forceinline__ void gemm_any(unsigned char* lds, const bf16_t* A, const bf16_t* Bt, int Mm, int N, int K, const F& f) {
#if USE_PG8
    pg8::Gemm g{A, Bt, Mm, N, K}; pg8::StaticOrder S; S.init(Mm, N, (int)gridDim.x, (int)blockIdx.x);
    EpiAdapt<F> E{f};
    pg8::gemm_phase<EpiAdapt<F>, pg8::StaticOrder, ALIGN, true>((PG8_LAS unsigned char*)lds, g, S, E);
#else
    gemm_naive((float*)lds, A, Bt, Mm, N, K, f);
#endif
}

typedef short pbf16x8 __attribute__((ext_vector_type(8)));
template <int CTRL> __device__ __forceinline__ float pdpp_add(float x) { return x + __uint_as_float(__builtin_amdgcn_update_dpp(0, __float_as_uint(x), CTRL, 0xf, 0xf, true)); }
__device__ __forceinline__ float wave_sum_dpp(float x) {
    x = pdpp_add<0x128>(x); x = pdpp_add<0x124>(x); x = pdpp_add<0x122>(x); x = pdpp_add<0x121>(x);
    const unsigned u = __float_as_uint(x);
    return (__uint_as_float(__builtin_amdgcn_readlane(u, 0)) + __uint_as_float(__builtin_amdgcn_readlane(u, 16))) + (__uint_as_float(__builtin_amdgcn_readlane(u, 32)) + __uint_as_float(__builtin_amdgcn_readlane(u, 48)));
}
__device__ __forceinline__ void lds_barrier() { asm volatile("s_waitcnt lgkmcnt(0)" ::: "memory"); __builtin_amdgcn_s_barrier(); asm volatile("" ::: "memory"); }
__device__ __forceinline__ unsigned char* rec_base(const Args& a, int u) {
    if (u < 80) return (unsigned char*)a.out + (size_t)u * 128 * RSZ;
    if (u < 118) return a.ws + WS_XN + (size_t)(u - 80) * 128 * RSZ;
    return a.ws + WS_TAIL + (size_t)(u - 118) * 128 * RSZ;
}
__device__ __forceinline__ void phase_prep(const Args& a, unsigned char* ldsb, int variant = 0) {
    const int tid = threadIdx.x, lane = tid & 63, wave = tid >> 6, fr = lane & 15, quad = lane >> 4;
    unsigned char* ws = a.ws;
    const bf16_t* PA = (const bf16_t*)(ws + WS_PA);
    bf16_t* VR = (bf16_t*)(ws + WS_VRAW); float* BON = (float*)(ws + WS_BON);
    const float* mu = a.in[I_SHMU];
    LAS unsigned char* lds = (LAS unsigned char*)ldsb;
    constexpr int HAT_OFF = 69888;
    constexpr int XPB = 272;
    constexpr int RES_OFF = 4352;
    if (blockIdx.x == 0 && tid == 0) *(unsigned*)(ws + WS_CTR) = 0u;
    const int c = tid;
    const float w0 = a.in[I_W0][c], a0 = a.in[I_A0][c], kkc = a.in[I_KK][c], kac = a.in[I_KA][c], rkc = a.in[I_RK][c];
    const float mur = mu[c], muk = mu[512 + c], muv = mu[1024 + c];
    const bf16_t* LW = (const bf16_t*)(ws + WS_LW);
    pbf16x8 wf[2][4][2];
#pragma unroll
    for (int mat = 0; mat < 2; ++mat)
#pragma unroll
        for (int mt = 0; mt < 4; ++mt)
#pragma unroll
            for (int ks = 0; ks < 2; ++ks) wf[mat][mt][ks] = *(const pbf16x8*)(LW + (size_t)(mat * 512 + wave * 64 + mt * 16 + fr) * 64 + ks * 32 + 8 * quad);
    const int stok = tid >> 5, sj4 = (tid & 31) * 4;
    const f32x4 smu = *(const f32x4*)(mu + 1536 + sj4);
    u32x2 spw, sqw;
#define PREP_SLOAD(uu) do { const int t_ = (uu) * 16 + stok; spw = *(const u32x2*)(PA + (size_t)t_ * NA + 1536 + sj4); sqw = spw; if ((t_ % SEQ) != 0) sqw = *(const u32x2*)(PA + (size_t)(t_ - 1) * NA + 1536 + sj4); } while (0)
    if ((int)blockIdx.x < M / 16) PREP_SLOAD(blockIdx.x);
    for (int u = blockIdx.x; u < M / 16; u += gridDim.x) {
        const int t0 = u * 16;
        unsigned short gr[17], gk[17], gv[17];
        { const bool first0 = (t0 % SEQ) == 0;
          gr[0] = 0; gk[0] = 0; gv[0] = 0;
          if (!first0) { const bf16_t* q = PA + (size_t)(t0 - 1) * NA; gr[0] = q[c]; gk[0] = q[512 + c]; gv[0] = q[1024 + c]; }
#pragma unroll
          for (int i = 0; i < 16; ++i) { const bf16_t* p = PA + (size_t)(t0 + i) * NA; gr[i + 1] = p[c]; gk[i + 1] = p[512 + c]; gv[i + 1] = p[1024 + c]; } }
        {   const int t = t0 + stok; const bool first = (t % SEQ) == 0;
            const u32x2 pw = spw, qw = sqw;
            float x0 = bflo(pw.x), x1 = bfhi(pw.x), x2 = bflo(pw.y), x3 = bfhi(pw.y);
            const float y0 = first ? 0.f : bflo(qw.x), y1 = first ? 0.f : bfhi(qw.x), y2 = first ? 0.f : bflo(qw.y), y3 = first ? 0.f : bfhi(qw.y);
            x0 += (y0 - x0) * smu.x; x1 += (y1 - x1) * smu.y; x2 += (y2 - x2) * smu.z; x3 += (y3 - x3) * smu.w;
            if (sj4 < 64) { x0 = 1.0f - 2.0f / (__expf(2.0f * x0) + 1.0f); x1 = 1.0f - 2.0f / (__expf(2.0f * x1) + 1.0f); x2 = 1.0f - 2.0f / (__expf(2.0f * x2) + 1.0f); x3 = 1.0f - 2.0f / (__expf(2.0f * x3) + 1.0f); }
            u32x2 o; o.x = pk2(x0, x1); o.y = pk2(x2, x3);
            *(LAS u32x2*)(lds + stok * XPB + sj4 * 2) = o; }
        if (u + (int)gridDim.x < M / 16) PREP_SLOAD(u + gridDim.x);
        lds_barrier();
#pragma unroll
        for (int mat = 0; mat < 2; ++mat)
#pragma unroll
            for (int mt = 0; mt < 4; ++mt) {
                f32x4 acc = (f32x4){0.f, 0.f, 0.f, 0.f};
#pragma unroll
                for (int ks = 0; ks < 2; ++ks) { const pbf16x8 xf = *(const LAS pbf16x8*)(lds + fr * XPB + (mat * 64 + ks * 32 + 8 * quad) * 2); acc = __builtin_amdgcn_mfma_f32_16x16x32_bf16(wf[mat][mt][ks], xf, acc, 0, 0, 0); }
                *(LAS f32x4*)(lds + RES_OFF + ((mat * 16 + fr) * 512 + wave * 64 + mt * 16 + 4 * quad) * 4) = acc;
            }
        lds_barrier();
        float rp = bf2f(gr[0]), kp_ = bf2f(gk[0]), vp = bf2f(gv[0]);
        unsigned char* rec = rec_base(a, (t0 / SEQ) * 8 + wave) + (size_t)((t0 % SEQ) / 16) * RSZ;
        LAS unsigned char* hb = lds + HAT_OFF + wave * 9216;
        float Pprev = 1.0f;
        if (variant != 2)
#pragma unroll
        for (int i = 0; i < 16; ++i) {
            const int t = t0 + i;
            const float rc = bf2f(gr[i + 1]), kc = bf2f(gk[i + 1]), vc = bf2f(gv[i + 1]);
            const float r = rc + (rp - rc) * mur, k = kc + (kp_ - kc) * muk, v = vc + (vp - vc) * muv;
            rp = rc; kp_ = kc; vp = vc;
            const float z = *(const LAS float*)(lds + RES_OFF + (i * 512 + c) * 4) + w0;
            const float za = *(const LAS float*)(lds + RES_OFF + ((16 + i) * 512 + c) * 4) + a0;
            const float sp = fmaxf(-z, 0.f) + __logf(1.0f + __expf(-fabsf(z)));
            const float w = -sp - 0.5f;
            const float dec = __expf(-__expf(w));
            const float av = __builtin_amdgcn_rcpf(1.0f + __expf(-za));
            float kk = k * kkc; const float ss = wave_sum_dpp(kk * kk); kk = kk * __builtin_amdgcn_rcpf(fmaxf(__builtin_amdgcn_sqrtf(ss), 1e-12f));
            const float kn = k * (1.0f + (av - 1.0f) * kac);
            const float bon = wave_sum_dpp(r * kn * rkc);
            const float P = Pprev * dec, iP = __builtin_amdgcn_rcpf(P);
            LAS unsigned short* hat = (LAS unsigned short*)hb + i * 72 + lane;
            hat[0] = f2bf(-kk * Pprev); hat[1152] = f2bf(r * P); hat[2304] = f2bf(kk * av * iP); hat[3456] = f2bf(kn * iP);
            Pprev = P;
            const unsigned short vb16 = f2bf(v);
            VR[(size_t)t * 512 + c] = vb16;
            *(unsigned short*)(rec + 8192 + (lane >> 4) * 512 + ((i >> 2) * 16 + (lane & 15)) * 8 + (i & 3) * 2) = vb16;
            if (lane == 0) BON[t * 8 + wave] = bon;
        }
        __builtin_nontemporal_store(Pprev, (float*)(rec + 12288 + lane * 4));
        asm volatile("s_waitcnt lgkmcnt(0)" ::: "memory");
        if (variant != 1) {
            pbf16x8 fa[2], fr2[2], fb[2], fk[2];
#pragma unroll
            for (int ks = 0; ks < 2; ++ks) { const int off = fr * 144 + (ks * 32 + 8 * quad) * 2;
                fa[ks] = *(const LAS pbf16x8*)(hb + off); fr2[ks] = *(const LAS pbf16x8*)(hb + 2304 + off); fb[ks] = *(const LAS pbf16x8*)(hb + 4608 + off); fk[ks] = *(const LAS pbf16x8*)(hb + 6912 + off); }
            f32x4 cba = (f32x4){0.f, 0.f, 0.f, 0.f}, cka = cba, cbr = cba, ckr = cba;
#pragma unroll
            for (int ks = 0; ks < 2; ++ks) { cba = __builtin_amdgcn_mfma_f32_16x16x32_bf16(fb[ks], fa[ks], cba, 0, 0, 0); cka = __builtin_amdgcn_mfma_f32_16x16x32_bf16(fk[ks], fa[ks], cka, 0, 0, 0);
                                             cbr = __builtin_amdgcn_mfma_f32_16x16x32_bf16(fb[ks], fr2[ks], cbr, 0, 0, 0); ckr = __builtin_amdgcn_mfma_f32_16x16x32_bf16(fk[ks], fr2[ks], ckr, 0, 0, 0); }
            float nn[4];
            {   float x0[4], x1[4], x2[4];
#pragma unroll
                for (int e = 0; e < 4; ++e) { const int j = 4 * quad + e; x0[e] = (j < fr) ? cka[e] : 0.f; x1[e] = (j <= fr) ? ckr[e] : 0.f; x2[e] = (j <= fr) ? cbr[e] : 0.f; nn[e] = (j < fr) ? cba[e] : 0.f; }
                u32x2 w; w.x = pk2(x0[0], x0[1]); w.y = pk2(x0[2], x0[3]); __builtin_nontemporal_store(w, (u32x2*)(rec + 10240 + lane * 8));
                w.x = pk2(x1[0], x1[1]); w.y = pk2(x1[2], x1[3]); __builtin_nontemporal_store(w, (u32x2*)(rec + 10752 + lane * 8));
                w.x = pk2(x2[0], x2[1]); w.y = pk2(x2[2], x2[3]); __builtin_nontemporal_store(w, (u32x2*)(rec + 11776 + lane * 8)); }
#pragma unroll
            for (int ks = 0; ks < 2; ++ks) {
                const u32x2 alo = *(const LAS u32x2*)(hb + fr * 144 + (32 * ks + 4 * quad) * 2), ahi = *(const LAS u32x2*)(hb + fr * 144 + (32 * ks + 16 + 4 * quad) * 2);
                const u32x2 rlo = *(const LAS u32x2*)(hb + 2304 + fr * 144 + (32 * ks + 4 * quad) * 2), rhi = *(const LAS u32x2*)(hb + 2304 + fr * 144 + (32 * ks + 16 + 4 * quad) * 2);
                __builtin_nontemporal_store((u32x4){alo.x, alo.y, ahi.x, ahi.y}, (u32x4*)(rec + ks * 1024 + lane * 16));
                __builtin_nontemporal_store((u32x4){rlo.x, rlo.y, rhi.x, rhi.y}, (u32x4*)(rec + 2048 + ks * 1024 + lane * 16));
            }
#pragma unroll
            for (int mt = 0; mt < 4; ++mt) {
                const LAS unsigned short* hB = (const LAS unsigned short*)(hb + 4608) + (4 * quad) * 72 + 16 * mt + fr;
                const LAS unsigned short* hK = (const LAS unsigned short*)(hb + 6912) + (4 * quad) * 72 + 16 * mt + fr;
                u32x4 o; o.x = (unsigned)hB[0] | ((unsigned)hB[72] << 16); o.y = (unsigned)hB[144] | ((unsigned)hB[216] << 16); o.z = (unsigned)hK[0] | ((unsigned)hK[72] << 16); o.w = (unsigned)hK[144] | ((unsigned)hK[216] << 16);
                __builtin_nontemporal_store(o, (u32x4*)(rec + 4096 + mt * 1024 + lane * 16));
            }
            asm volatile("s_waitcnt lgkmcnt(0)" ::: "memory");
            LAS float* NL = (LAS float*)hb;
#pragma unroll
            for (int e = 0; e < 4; ++e) NL[(4 * quad + e) * 16 + fr] = nn[e];
            asm volatile("s_waitcnt lgkmcnt(0)" ::: "memory");
            float X[16];
#pragma unroll
            for (int l = 0; l < 16; ++l) X[l] = (l == fr) ? 1.0f : 0.f;
#pragma unroll
            for (int j = 14; j >= 0; --j) {
                const f32x4 n0 = ((const LAS f32x4*)NL)[j * 4], n1 = ((const LAS f32x4*)NL)[j * 4 + 1], n2 = ((const LAS f32x4*)NL)[j * 4 + 2], n3 = ((const LAS f32x4*)NL)[j * 4 + 3];
                const float nr[16] = {n0.x, n0.y, n0.z, n0.w, n1.x, n1.y, n1.z, n1.w, n2.x, n2.y, n2.z, n2.w, n3.x, n3.y, n3.z, n3.w};
                float acc = X[j];
#pragma unroll
                for (int l = j + 1; l < 16; ++l) acc = __builtin_fmaf(nr[l], X[l], acc);
                X[j] = acc;
            }
            float mv[4];
#pragma unroll
            for (int e = 0; e < 4; ++e) mv[e] = quad == 0 ? X[e] : (quad == 1 ? X[4 + e] : (quad == 2 ? X[8 + e] : X[12 + e]));
            u32x2 w; w.x = pk2(mv[0], mv[1]); w.y = pk2(mv[2], mv[3]); __builtin_nontemporal_store(w, (u32x2*)(rec + 11264 + lane * 8));
            asm volatile("s_waitcnt lgkmcnt(0)" ::: "memory");
        }
    }
}

__device__ __forceinline__ float rdlane(float x, int k) { return __uint_as_float(__builtin_amdgcn_readlane(__float_as_uint(x), k)); }
__device__ __forceinline__ void phase_scan_naive(const Args& a) {
    const int tid = threadIdx.x, lane = tid & 63, wave = tid >> 6;
    if (wave != 0) return;
    unsigned char* ws = a.ws;
    const bf16_t* R = (const bf16_t*)a.out; const bf16_t* KP = R + (size_t)M * 512; const bf16_t* V = KP + (size_t)M * 512; const bf16_t* AN = V + (size_t)M * 512;
    bf16_t* YM = (bf16_t*)(ws + WS_YMIX); const float* DEC = (const float*)(ws + WS_XN); const float* BON = (const float*)(ws + WS_BON);
    const bf16_t* PB = (const bf16_t*)(ws + WS_PB);
    for (int u = blockIdx.x; u < BATCH * 8; u += gridDim.x) {
        const int b = u >> 3, h = u & 7;
        const float lg = a.in[I_LNXG][h * 64 + lane], lb = a.in[I_LNXB][h * 64 + lane];
        float s[64];
#pragma unroll
        for (int k = 0; k < 64; ++k) s[k] = 0.f;
        for (int t = 0; t < SEQ; ++t) {
            const int tok = b * SEQ + t; const size_t o = (size_t)tok * 512 + h * 64 + lane;
            const float ca = bf2f(AN[o]), cw = DEC[o], cb = bf2f(YM[(size_t)tok * 1024 + h * 64 + lane]), ck = bf2f(KP[o]), cr = bf2f(R[o]), vv = bf2f(V[o]);
            float sa = 0.f;
#pragma unroll
            for (int k = 0; k < 64; ++k) sa += s[k] * rdlane(ca, k);
            float y = 0.f;
#pragma unroll
            for (int k = 0; k < 64; ++k) { s[k] = s[k] * rdlane(cw, k) + sa * rdlane(cb, k) + vv * rdlane(ck, k); y += s[k] * rdlane(cr, k); }
            const float mean = wave_sum(y) * (1.0f / 64.0f); const float d = y - mean; const float var = wave_sum(d * d) * (1.0f / 64.0f);
            float yn = d * rsqrtf(var + GN_EPS) * lg + lb;
            yn += BON[tok * 8 + h] * vv;
            const float g = bf2f(PB[(size_t)tok * NB + h * 64 + lane]);
            YM[(size_t)tok * 1024 + h * 64 + lane] = f2bf(yn * siluf_(g));
        }
    }
}

__device__ __forceinline__ void phase_attn_naive(const Args& a) {
    const int tid = threadIdx.x, lane = tid & 63, wave = tid >> 6;
    unsigned char* ws = a.ws;
    const bf16_t* PB = (const bf16_t*)(ws + WS_PB); bf16_t* YM = (bf16_t*)(ws + WS_YMIX);
    for (int u = blockIdx.x * 8 + wave; u < BATCH * 8 * 32; u += gridDim.x * 8) {
        const int c = u & 31, h = (u >> 5) & 7, b = u >> 8;
        const int t = b * SEQ + c * 64 + lane;
        float q[64], acc[64];
        { const u32x4* qp = (const u32x4*)(PB + (size_t)t * NB + 512 + h * 64);
#pragma unroll
          for (int i = 0; i < 8; ++i) { const u32x4 w = qp[i]; q[8 * i] = bflo(w.x) * 0.125f; q[8 * i + 1] = bfhi(w.x) * 0.125f; q[8 * i + 2] = bflo(w.y) * 0.125f; q[8 * i + 3] = bfhi(w.y) * 0.125f;
              q[8 * i + 4] = bflo(w.z) * 0.125f; q[8 * i + 5] = bfhi(w.z) * 0.125f; q[8 * i + 6] = bflo(w.w) * 0.125f; q[8 * i + 7] = bfhi(w.w) * 0.125f; } }
#pragma unroll
        for (int d = 0; d < 64; ++d) acc[d] = 0.f;
        float m = -1e30f, l = 0.f;
        const float* bt = a.in[I_ABIAS] + h * 257;
        const int k0 = (c - 8 > 0 ? c - 8 : 0) * 64, k1 = (c + 1) * 64;
        for (int kj = k0; kj < k1; ++kj) {
            const bf16_t* kr = PB + (size_t)(b * SEQ + kj) * NB + 1024 + h * 64;
            float s = 0.f;
#pragma unroll
            for (int i = 0; i < 8; ++i) { const u32x4 w = ((const u32x4*)kr)[i];
                s += q[8 * i] * bflo(w.x) + q[8 * i + 1] * bfhi(w.x) + q[8 * i + 2] * bflo(w.y) + q[8 * i + 3] * bfhi(w.y) + q[8 * i + 4] * bflo(w.z) + q[8 * i + 5] * bfhi(w.z) + q[8 * i + 6] * bflo(w.w) + q[8 * i + 7] * bfhi(w.w); }
            int rel = c * 64 + lane - kj; rel = rel < -128 ? -128 : (rel > 128 ? 128 : rel);
            s += bt[rel + 128];
            const float mn = fmaxf(m, s), al = __expf(m - mn), p = __expf(s - mn);
            l = l * al + p; m = mn;
            const bf16_t* vr = kr + 512;
#pragma unroll
            for (int i = 0; i < 8; ++i) { const u32x4 w = ((const u32x4*)vr)[i];
                acc[8 * i] = acc[8 * i] * al + p * bflo(w.x); acc[8 * i + 1] = acc[8 * i + 1] * al + p * bfhi(w.x); acc[8 * i + 2] = acc[8 * i + 2] * al + p * bflo(w.y); acc[8 * i + 3] = acc[8 * i + 3] * al + p * bfhi(w.y);
                acc[8 * i + 4] = acc[8 * i + 4] * al + p * bflo(w.z); acc[8 * i + 5] = acc[8 * i + 5] * al + p * bfhi(w.z); acc[8 * i + 6] = acc[8 * i + 6] * al + p * bflo(w.w); acc[8 * i + 7] = acc[8 * i + 7] * al + p * bfhi(w.w); }
        }
        const float il = 1.0f / l;
        const u32x4* gp = (const u32x4*)(PB + (size_t)t * NB + 2048 + h * 64);
        u32x4* op = (u32x4*)(YM + (size_t)t * 1024 + 512 + h * 64);
#pragma unroll
        for (int i = 0; i < 8; ++i) { const u32x4 g = gp[i]; u32x4 o;
            o.x = pk2(acc[8 * i] * il * siluf_(bflo(g.x)), acc[8 * i + 1] * il * siluf_(bfhi(g.x))); o.y = pk2(acc[8 * i + 2] * il * siluf_(bflo(g.y)), acc[8 * i + 3] * il * siluf_(bfhi(g.y)));
            o.z = pk2(acc[8 * i + 4] * il * siluf_(bflo(g.z)), acc[8 * i + 5] * il * siluf_(bfhi(g.z))); o.w = pk2(acc[8 * i + 6] * il * siluf_(bflo(g.w)), acc[8 * i + 7] * il * siluf_(bfhi(g.w)));
            op[i] = o; }
    }
}


typedef _Float16 h8 __attribute__((ext_vector_type(8)));
typedef _Float16 h4 __attribute__((ext_vector_type(4)));
typedef short bf16x8 __attribute__((ext_vector_type(8)));
template <int CTRL> __device__ __forceinline__ float dpp_add(float x) { return x + __uint_as_float(__builtin_amdgcn_update_dpp(0, __float_as_uint(x), CTRL, 0xf, 0xf, true)); }
__device__ __forceinline__ float red8(float x) { x = dpp_add<0xB1>(x); x = dpp_add<0x4E>(x); x = dpp_add<0x141>(x); return x; }
__device__ __forceinline__ float red16(float x) { x = dpp_add<0x128>(x); x = dpp_add<0x124>(x); x = dpp_add<0x122>(x); x = dpp_add<0x121>(x); return x; }
constexpr int SC_PH = 0, SC_VV = 40960, SC_SC = 57344, SC_YY = 57856;
constexpr int TC = 32;

__device__ __forceinline__ void scan_unit(const Args& a, LAS unsigned char* lds, int u) {
    const int tid = threadIdx.x, lane = tid & 63, wave = tid >> 6;
    const int b = u >> 3, h = u & 7;
    unsigned char* ws = a.ws;
    const bf16_t* R = (const bf16_t*)a.out; const bf16_t* KP = R + (size_t)M * 512; const bf16_t* V = KP + (size_t)M * 512; const bf16_t* AN = V + (size_t)M * 512;
    bf16_t* YM = (bf16_t*)(ws + WS_YMIX); const float* DEC = (const float*)(ws + WS_XN); const float* BON = (const float*)(ws + WS_BON);
    const bf16_t* PB = (const bf16_t*)(ws + WS_PB);
    const int st = tid >> 4, sq = tid & 15;
    const int row = wave * 8 + (lane >> 3), cg = lane & 7;
    const int colbase = h * 64 + 4 * sq;
    const f32x4 lg = *(const f32x4*)(a.in[I_LNXG] + colbase), lb = *(const f32x4*)(a.in[I_LNXB] + colbase);
    float s[8];
#pragma unroll
    for (int j = 0; j < 8; ++j) s[j] = 0.f;
    u32x2 gR, gK, gV, gA, gB; f32x4 gD;
#define SC_GLOAD(c) do { const size_t tok_ = (size_t)b * SEQ + (c) * TC + st; const size_t o_ = tok_ * 512 + colbase; \
        gR = *(const u32x2*)(R + o_); gK = *(const u32x2*)(KP + o_); gV = *(const u32x2*)(V + o_); gA = *(const u32x2*)(AN + o_); \
        gB = *(const u32x2*)(YM + tok_ * 1024 + colbase); gD = *(const f32x4*)(DEC + o_); } while (0)
#define SC_STAGE(buf) do { \
        const float r0 = bflo(gR.x), r1 = bfhi(gR.x), r2 = bflo(gR.y), r3 = bfhi(gR.y); \
        const float k0 = bflo(gK.x), k1 = bfhi(gK.x), k2 = bflo(gK.y), k3 = bfhi(gK.y); \
        const float b0 = bflo(gB.x), b1 = bfhi(gB.x), b2 = bflo(gB.y), b3 = bfhi(gB.y); \
        LAS h4* ph4 = (LAS h4*)(lds + SC_PH) + (size_t)(((buf) * TC + st) * 5) * 16 + sq; \
        ph4[0]  = (h4){(_Float16)bflo(gA.x), (_Float16)bfhi(gA.x), (_Float16)bflo(gA.y), (_Float16)bfhi(gA.y)}; \
        ph4[16] = (h4){(_Float16)(1.0f - gD.x), (_Float16)(1.0f - gD.y), (_Float16)(1.0f - gD.z), (_Float16)(1.0f - gD.w)}; \
        ph4[32] = (h4){(_Float16)b0, (_Float16)b1, (_Float16)b2, (_Float16)b3}; \
        ph4[48] = (h4){(_Float16)k0, (_Float16)k1, (_Float16)k2, (_Float16)k3}; \
        ph4[64] = (h4){(_Float16)(gD.x * r0), (_Float16)(gD.y * r1), (_Float16)(gD.z * r2), (_Float16)(gD.w * r3)}; \
        *((LAS f32x4*)(lds + SC_VV) + ((buf) * TC + st) * 16 + sq) = (f32x4){bflo(gV.x), bfhi(gV.x), bflo(gV.y), bfhi(gV.y)}; \
        float br_ = (b0 * r0 + b1 * r1) + (b2 * r2 + b3 * r3), kr_ = (k0 * r0 + k1 * r1) + (k2 * r2 + k3 * r3); \
        br_ = red16(br_); kr_ = red16(kr_); \
        if (sq == 0) *((LAS f32x2*)(lds + SC_SC) + (buf) * TC + st) = (f32x2){br_, kr_}; } while (0)
    SC_GLOAD(0); SC_STAGE(0);
    __syncthreads();
    for (int c = 0; c < SEQ / TC; ++c) {
        const int buf = c & 1;
        if (c + 1 < SEQ / TC) SC_GLOAD(c + 1);
        const size_t tokE = (size_t)b * SEQ + c * TC + st;
        const u32x2 gG = *(const u32x2*)(PB + tokE * NB + colbase);
        const float bon = BON[tokE * 8 + h];
        {
            const LAS h8* ph8 = (const LAS h8*)(lds + SC_PH) + buf * TC * 40 + cg;
            const LAS float* vvp = (const LAS float*)(lds + SC_VV) + buf * TC * 64 + row;
            const LAS f32x2* scp = (const LAS f32x2*)(lds + SC_SC) + buf * TC;
            LAS float* yyp = (LAS float*)(lds + SC_YY) + row;
            h8 cA = ph8[0], cE = ph8[8], cB = ph8[16], cK = ph8[24], cW = ph8[32]; float cv = vvp[0]; f32x2 cs = scp[0];
#pragma unroll 2
            for (int t = 0; t < TC; ++t) {
                const int tn = (t + 1 < TC) ? t + 1 : t;
                const h8 nA = ph8[tn * 40], nE = ph8[tn * 40 + 8], nB = ph8[tn * 40 + 16], nK = ph8[tn * 40 + 24], nW = ph8[tn * 40 + 32]; const float nv = vvp[tn * 64]; const f32x2 ns = scp[tn];
                float sa0 = 0.f, sa1 = 0.f, yw0 = 0.f, yw1 = 0.f;
#pragma unroll
                for (int j = 0; j < 4; ++j) { sa0 = __builtin_fmaf(s[j], (float)cA[j], sa0); sa1 = __builtin_fmaf(s[4 + j], (float)cA[4 + j], sa1);
                                              yw0 = __builtin_fmaf(s[j], (float)cW[j], yw0); yw1 = __builtin_fmaf(s[4 + j], (float)cW[4 + j], yw1); }
                float sa = red8(sa0 + sa1), yw = red8(yw0 + yw1);
#pragma unroll
                for (int j = 0; j < 8; ++j) { float uu = __builtin_fmaf(sa, (float)cB[j], s[j]); uu = __builtin_fmaf(cv, (float)cK[j], uu); s[j] = __builtin_fmaf(-(float)cE[j], s[j], uu); }
                const float y = yw + sa * cs.x + cv * cs.y;
                yyp[t * 64] = y;
                cA = nA; cE = nE; cB = nB; cK = nK; cW = nW; cv = nv; cs = ns;
            }
        }
        __syncthreads();
        {
            const f32x4 y4 = *((const LAS f32x4*)(lds + SC_YY) + st * 16 + sq);
            const f32x4 v4 = *((const LAS f32x4*)(lds + SC_VV) + (buf * TC + st) * 16 + sq);
            const float mean = red16((y4.x + y4.y) + (y4.z + y4.w)) * (1.0f / 64.0f);
            const f32x4 d = y4 - mean;
            const float var = red16((d.x * d.x + d.y * d.y) + (d.z * d.z + d.w * d.w)) * (1.0f / 64.0f);
            const float rstd = rsqrtf(var + GN_EPS);
            f32x4 o = d * rstd * lg + lb + v4 * bon;
            o.x *= siluf_(bflo(gG.x)); o.y *= siluf_(bfhi(gG.x)); o.z *= siluf_(bflo(gG.y)); o.w *= siluf_(bfhi(gG.y));
            u32x2 w; w.x = pk2(o.x, o.y); w.y = pk2(o.z, o.w);
            *(u32x2*)(YM + tokE * 1024 + colbase) = w;
        }
        if (c + 1 < SEQ / TC) SC_STAGE(buf ^ 1);
        __syncthreads();
    }
#undef SC_GLOAD
#undef SC_STAGE
}


struct ChOps { u32x4 Aa[2], Ar[2], Abk[4]; u32x2 Acka, Ackr, Aminv, Acbr, Vb; f32x4 P[4]; };
__device__ __forceinline__ void ch_load(ChOps& o, const unsigned char* rec, int nt, int lane, int quad) {
#pragma unroll
    for (int ks = 0; ks < 2; ++ks) { o.Aa[ks] = *(const u32x4*)(rec + ks * 1024 + lane * 16); o.Ar[ks] = *(const u32x4*)(rec + 2048 + ks * 1024 + lane * 16); }
#pragma unroll
    for (int mt = 0; mt < 4; ++mt) { o.Abk[mt] = *(const u32x4*)(rec + 4096 + mt * 1024 + lane * 16); o.P[mt] = *(const f32x4*)(rec + 12288 + (16 * mt + 4 * quad) * 4); }
    o.Vb = *(const u32x2*)(rec + 8192 + nt * 512 + lane * 8);
    o.Acka = *(const u32x2*)(rec + 10240 + lane * 8); o.Ackr = *(const u32x2*)(rec + 10752 + lane * 8); o.Aminv = *(const u32x2*)(rec + 11264 + lane * 8); o.Acbr = *(const u32x2*)(rec + 11776 + lane * 8);
}
__device__ __forceinline__ void ch_load_lds(ChOps& o, const LAS unsigned char* rec, int nt, int lane, int quad) {
#pragma unroll
    for (int ks = 0; ks < 2; ++ks) { o.Aa[ks] = *(const LAS u32x4*)(rec + ks * 1024 + lane * 16); o.Ar[ks] = *(const LAS u32x4*)(rec + 2048 + ks * 1024 + lane * 16); }
    o.Vb = *(const LAS u32x2*)(rec + 8192 + nt * 512 + lane * 8);
    o.Acka = *(const LAS u32x2*)(rec + 10240 + lane * 8); o.Ackr = *(const LAS u32x2*)(rec + 10752 + lane * 8); o.Aminv = *(const LAS u32x2*)(rec + 11264 + lane * 8); o.Acbr = *(const LAS u32x2*)(rec + 11776 + lane * 8);
#pragma unroll
    for (int mt = 0; mt < 4; ++mt) { o.Abk[mt] = *(const LAS u32x4*)(rec + 4096 + mt * 1024 + lane * 16); o.P[mt] = *(const LAS f32x4*)(rec + 12288 + (16 * mt + 4 * quad) * 4); }
}
__device__ __forceinline__ bf16x8 asbf(u32x4 v) { return __builtin_bit_cast(bf16x8, v); }
__device__ __forceinline__ void scan_unit_chunked(const Args& a, LAS unsigned char* lds, int u) {
    const int tid = threadIdx.x, lane = tid & 63, wave = tid >> 6, fr = lane & 15, quad = lane >> 4;
    const int b = u >> 3, h = u & 7;
    unsigned char* ws = a.ws;
    const bf16_t* VR = (const bf16_t*)(ws + WS_VRAW); bf16_t* YM = (bf16_t*)(ws + WS_YMIX); const float* BON = (const float*)(ws + WS_BON);
    const bf16_t* PB = (const bf16_t*)(ws + WS_PB);
    const unsigned char* recs = rec_base(a, u);
    LAS float* YY = (LAS float*)lds;
    constexpr int REC_OFF = 16384, GRPB = 4 * RSZ, NPIECE = GRPB / 16;
    const int etok = tid >> 3, er8 = (tid & 7) * 8;
    const f32x4 lg0 = *(const f32x4*)(a.in[I_LNXG] + h * 64 + er8), lg1 = *(const f32x4*)(a.in[I_LNXG] + h * 64 + er8 + 4);
    const f32x4 lb0 = *(const f32x4*)(a.in[I_LNXB] + h * 64 + er8), lb1 = *(const f32x4*)(a.in[I_LNXB] + h * 64 + er8 + 4);
    f32x4 S[4];
#pragma unroll
    for (int mt = 0; mt < 4; ++mt) S[mt] = (f32x4){0.f, 0.f, 0.f, 0.f};
    u32x4 ltmp[13];
#define SC_ISSUE(gidx) do { const unsigned char* src_ = recs + (size_t)(gidx) * GRPB; \
        _Pragma("unroll") for (int k_ = 0; k_ < 13; ++k_) { const int idx_ = (tid - 256) + 256 * k_; if (idx_ < NPIECE) ltmp[k_] = *(const u32x4*)(src_ + (size_t)idx_ * 16); } } while (0)
#define SC_COMMIT(bufi) do { LAS unsigned char* dst_ = lds + REC_OFF + (bufi) * GRPB; \
        _Pragma("unroll") for (int k_ = 0; k_ < 13; ++k_) { const int idx_ = (tid - 256) + 256 * k_; if (idx_ < NPIECE) *(LAS u32x4*)(dst_ + idx_ * 16) = ltmp[k_]; } } while (0)
    if (wave >= 4) { SC_ISSUE(0); SC_COMMIT(0); SC_ISSUE(1); }
    lds_barrier();
    for (int g = 0; g < SEQ / 64; ++g) {
        const int buf = g & 1;
        const size_t tokE = (size_t)b * SEQ + g * 64 + etok;
        const u32x4 ev = *(const u32x4*)(VR + tokE * 512 + h * 64 + er8);
        const u32x4 eg = *(const u32x4*)(PB + tokE * NB + h * 64 + er8);
        const float bon = BON[tokE * 8 + h];
        if (wave < 4) {
#pragma unroll
            for (int cc = 0; cc < 4; ++cc) {
                ChOps cur;
                ch_load_lds(cur, lds + REC_OFF + buf * GRPB + cc * RSZ, wave, lane, quad);
                u32x4 sb[2];
#pragma unroll
                for (int ks = 0; ks < 2; ++ks) { sb[ks].x = pk2(S[2 * ks][0], S[2 * ks][1]); sb[ks].y = pk2(S[2 * ks][2], S[2 * ks][3]);
                                                 sb[ks].z = pk2(S[2 * ks + 1][0], S[2 * ks + 1][1]); sb[ks].w = pk2(S[2 * ks + 1][2], S[2 * ks + 1][3]); }
                const u32x4 vb = (u32x4){cur.Vb.x, cur.Vb.y, 0u, 0u};
                f32x4 rhs = (f32x4){0.f, 0.f, 0.f, 0.f}, hv = rhs;
#pragma unroll
                for (int ks = 0; ks < 2; ++ks) { rhs = __builtin_amdgcn_mfma_f32_16x16x32_bf16(asbf(cur.Aa[ks]), asbf(sb[ks]), rhs, 0, 0, 0); hv = __builtin_amdgcn_mfma_f32_16x16x32_bf16(asbf(cur.Ar[ks]), asbf(sb[ks]), hv, 0, 0, 0); }
                rhs = __builtin_amdgcn_mfma_f32_16x16x32_bf16(asbf((u32x4){cur.Acka.x, cur.Acka.y, 0u, 0u}), asbf(vb), rhs, 0, 0, 0);
                hv = __builtin_amdgcn_mfma_f32_16x16x32_bf16(asbf((u32x4){cur.Ackr.x, cur.Ackr.y, 0u, 0u}), asbf(vb), hv, 0, 0, 0);
                const u32x4 rb = (u32x4){pk2(rhs[0], rhs[1]), pk2(rhs[2], rhs[3]), 0u, 0u};
                const f32x4 sa = __builtin_amdgcn_mfma_f32_16x16x32_bf16(asbf((u32x4){cur.Aminv.x, cur.Aminv.y, 0u, 0u}), asbf(rb), (f32x4){0.f, 0.f, 0.f, 0.f}, 0, 0, 0);
                const u32x4 svb = (u32x4){pk2(sa[0], sa[1]), pk2(sa[2], sa[3]), cur.Vb.x, cur.Vb.y};
                const f32x4 y = __builtin_amdgcn_mfma_f32_16x16x32_bf16(asbf((u32x4){cur.Acbr.x, cur.Acbr.y, 0u, 0u}), asbf(svb), hv, 0, 0, 0);
#pragma unroll
                for (int mt = 0; mt < 4; ++mt) { S[mt] = __builtin_amdgcn_mfma_f32_16x16x32_bf16(asbf(cur.Abk[mt]), asbf(svb), S[mt], 0, 0, 0); S[mt] = S[mt] * cur.P[mt]; }
#pragma unroll
                for (int jj = 0; jj < 4; ++jj) YY[(cc * 16 + 4 * quad + jj) * 64 + 16 * wave + fr] = y[jj];
            }
        } else {
            if (g + 1 < SEQ / 64) SC_COMMIT(buf ^ 1);
            if (g + 2 < SEQ / 64) SC_ISSUE(g + 2);
        }
        lds_barrier();
        {
            const f32x4 y0 = *(const LAS f32x4*)(YY + etok * 64 + er8), y1 = *(const LAS f32x4*)(YY + etok * 64 + er8 + 4);
            const float mean = red8(((y0.x + y0.y) + (y0.z + y0.w)) + ((y1.x + y1.y) + (y1.z + y1.w))) * (1.0f / 64.0f);
            const f32x4 d0 = y0 - mean, d1 = y1 - mean;
            const float var = red8(((d0.x * d0.x + d0.y * d0.y) + (d0.z * d0.z + d0.w * d0.w)) + ((d1.x * d1.x + d1.y * d1.y) + (d1.z * d1.z + d1.w * d1.w))) * (1.0f / 64.0f);
            const float rstd = rsqrtf(var + GN_EPS);
            const f32x4 v0 = (f32x4){bflo(ev.x), bfhi(ev.x), bflo(ev.y), bfhi(ev.y)}, v1 = (f32x4){bflo(ev.z), bfhi(ev.z), bflo(ev.w), bfhi(ev.w)};
            f32x4 o0 = d0 * rstd * lg0 + lb0 + v0 * bon, o1 = d1 * rstd * lg1 + lb1 + v1 * bon;
            o0.x *= siluf_(bflo(eg.x)); o0.y *= siluf_(bfhi(eg.x)); o0.z *= siluf_(bflo(eg.y)); o0.w *= siluf_(bfhi(eg.y));
            o1.x *= siluf_(bflo(eg.z)); o1.y *= siluf_(bfhi(eg.z)); o1.z *= siluf_(bflo(eg.w)); o1.w *= siluf_(bfhi(eg.w));
            u32x4 w; w.x = pk2(o0.x, o0.y); w.y = pk2(o0.z, o0.w); w.z = pk2(o1.x, o1.y); w.w = pk2(o1.z, o1.w);
            *(u32x4*)(YM + tokE * 1024 + h * 64 + er8) = w;
        }
        lds_barrier();
    }
#undef SC_ISSUE
#undef SC_COMMIT
}


constexpr int AT_KS = 0, AT_VT = 18432, AT_BT = 36864, AT_PITCH = 144, AT_VT2 = 32768, AT_BT2 = 65536;
__device__ __forceinline__ void attn_unit(const Args& a, LAS unsigned char* lds, int u, int variant = 0) {
    const int tid = threadIdx.x, lane = tid & 63, wave = tid >> 6, fr = lane & 15, quad = lane >> 4;
    const int cp = u & 15, h = (u >> 4) & 7, b = u >> 7;
    unsigned char* ws = a.ws;
    const bf16_t* PB = (const bf16_t*)(ws + WS_PB); bf16_t* YM = (bf16_t*)(ws + WS_YMIX);
    const int c0 = 2 * cp, cq = c0 + (wave >> 2), qrow = (wave & 3) * 16 + fr;
    const size_t tq = (size_t)b * SEQ + cq * 64 + qrow;
    constexpr float LOG2E = 1.4426950408889634f;
    if (tid < 257) ((LAS float*)(lds + AT_BT2))[tid] = a.in[I_ABIAS][h * 257 + tid] * LOG2E;
    bf16x8 qf[2];
    qf[0] = *(const bf16x8*)(PB + tq * NB + 512 + h * 64 + 8 * quad); qf[1] = *(const bf16x8*)(PB + tq * NB + 512 + h * 64 + 32 + 8 * quad);
    u32x2 gpre[4];
#pragma unroll
    for (int dt = 0; dt < 4; ++dt) gpre[dt] = *(const u32x2*)(PB + tq * NB + 2048 + h * 64 + dt * 16 + 4 * quad);
    f32x4 O[4];
#pragma unroll
    for (int i = 0; i < 4; ++i) O[i] = (f32x4){0.f, 0.f, 0.f, 0.f};
    f32x4 Lacc = (f32x4){0.f, 0.f, 0.f, 0.f};
    const unsigned onev = (fr == 0) ? 0x3f803f80u : 0u; const bf16x8 ones = __builtin_bit_cast(bf16x8, (u32x4){onev, onev, onev, onev});
    const int kfirst = c0 - 8 > 0 ? c0 - 8 : 0, klast = c0 + 1;
    const int kkey = tid >> 3, kdch = tid & 7;
    const int vkey = tid & 63, vdch = tid >> 6;
    const int vpos = (vkey & 32) + 8 * ((vkey >> 2) & 3) + 4 * ((vkey >> 4) & 1) + (vkey & 3);
    u32x4 gkA, gvA, gkB, gvB, gkC, gvC, gkD, gvD;
    const int ntile = klast - kfirst + 1;
#define AT_GLD(ti, K_, V_) do { if ((ti) < ntile) { K_ = *(const u32x4*)(PB + ((size_t)b * SEQ + (kfirst + (ti)) * 64 + kkey) * NB + 1024 + h * 64 + kdch * 8); \
                        V_ = *(const u32x4*)(PB + ((size_t)b * SEQ + (kfirst + (ti)) * 64 + vkey) * NB + 1536 + h * 64 + vdch * 8); } } while (0)
#define AT_SST(slot, gk, gv) do { *(LAS u32x4*)(lds + AT_KS + (slot) * 8192 + kkey * 128 + ((kdch ^ (kkey & 7)) * 16)) = gk; \
        LAS unsigned char* vt_ = lds + AT_VT2 + (slot) * 8192 + (vdch * 8) * 128 + (vpos & 7) * 2; const int vch_ = vpos >> 3; \
        *(LAS unsigned short*)(vt_ + 0 * 128 + ((vch_ ^ 0) * 16)) = (unsigned short)(gv.x & 0xffffu); *(LAS unsigned short*)(vt_ + 1 * 128 + ((vch_ ^ 1) * 16)) = (unsigned short)(gv.x >> 16); \
        *(LAS unsigned short*)(vt_ + 2 * 128 + ((vch_ ^ 2) * 16)) = (unsigned short)(gv.y & 0xffffu); *(LAS unsigned short*)(vt_ + 3 * 128 + ((vch_ ^ 3) * 16)) = (unsigned short)(gv.y >> 16); \
        *(LAS unsigned short*)(vt_ + 4 * 128 + ((vch_ ^ 4) * 16)) = (unsigned short)(gv.z & 0xffffu); *(LAS unsigned short*)(vt_ + 5 * 128 + ((vch_ ^ 5) * 16)) = (unsigned short)(gv.z >> 16); \
        *(LAS unsigned short*)(vt_ + 6 * 128 + ((vch_ ^ 6) * 16)) = (unsigned short)(gv.w & 0xffffu); *(LAS unsigned short*)(vt_ + 7 * 128 + ((vch_ ^ 7) * 16)) = (unsigned short)(gv.w >> 16); } while (0)
    gkA = gvA = gkB = gvB = gkC = gvC = gkD = gvD = (u32x4){0u, 0u, 0u, 0u};
    AT_GLD(0, gkA, gvA); AT_GLD(1, gkB, gvB); AT_GLD(2, gkC, gvC); AT_GLD(3, gkD, gvD);
    AT_SST(0, gkA, gvA); AT_SST(1, gkB, gvB);
    gkA = gkC; gvA = gvC; gkB = gkD; gvB = gvD;
    AT_GLD(4, gkC, gvC); AT_GLD(5, gkD, gvD);
    lds_barrier();
    for (int it = 0; 2 * it < ntile; ++it) {
#pragma unroll
      for (int sub = 0; sub < 2; ++sub) {
        const int kc = kfirst + 2 * it + sub, slot = (2 * it + sub) & 3;
        if (variant != 3 && kc <= cq && kc >= cq - 8) {
            const LAS unsigned char* ks = lds + AT_KS + slot * 8192 + fr * 128;
            const LAS unsigned char* vt = lds + AT_VT2 + slot * 8192 + fr * 128;
            f32x4 sc[4];
#pragma unroll
            for (int kt = 0; kt < 4; ++kt) {
                sc[kt] = (f32x4){0.f, 0.f, 0.f, 0.f};
#pragma unroll
                for (int k2 = 0; k2 < 2; ++k2) { const bf16x8 kf = *(const LAS bf16x8*)(ks + kt * 16 * 128 + (((k2 * 4 + quad) ^ (fr & 7)) * 16)); sc[kt] = __builtin_amdgcn_mfma_f32_16x16x32_bf16(kf, qf[k2], sc[kt], 0, 0, 0); }
            }
            bf16x8 vfr[2][4];
#pragma unroll
            for (int s2 = 0; s2 < 2; ++s2)
#pragma unroll
                for (int dt = 0; dt < 4; ++dt) vfr[s2][dt] = *(const LAS bf16x8*)(vt + dt * 16 * 128 + (((s2 * 4 + quad) ^ (fr & 7)) * 16));
            asm volatile("" ::: "memory");
            const int dch = cq - kc;
            const LAS float* bt = (const LAS float*)(lds + AT_BT2);
            if (dch >= 3) {
                const float bc = bt[256];
#pragma unroll
                for (int kt = 0; kt < 4; ++kt)
#pragma unroll
                    for (int j = 0; j < 4; ++j) sc[kt][j] = __builtin_amdgcn_exp2f(__builtin_amdgcn_fmed3f(__builtin_fmaf(sc[kt][j], 0.125f * LOG2E, bc), -100.0f, 100.0f));
            } else {
                const int base = dch * 64 + qrow + 128 - 4 * quad;
#pragma unroll
                for (int kt = 0; kt < 4; ++kt)
#pragma unroll
                    for (int j = 0; j < 4; ++j) { int idx = base - kt * 16 - j; idx = idx > 256 ? 256 : idx; sc[kt][j] = __builtin_amdgcn_exp2f(__builtin_amdgcn_fmed3f(__builtin_fmaf(sc[kt][j], 0.125f * LOG2E, bt[idx]), -100.0f, 100.0f)); }
            }
#pragma unroll
            for (int s2 = 0; s2 < 2; ++s2) {
                u32x4 pw; pw.x = pk2(sc[2 * s2][0], sc[2 * s2][1]); pw.y = pk2(sc[2 * s2][2], sc[2 * s2][3]); pw.z = pk2(sc[2 * s2 + 1][0], sc[2 * s2 + 1][1]); pw.w = pk2(sc[2 * s2 + 1][2], sc[2 * s2 + 1][3]);
                const bf16x8 pf = __builtin_bit_cast(bf16x8, pw);
#pragma unroll
                for (int dt = 0; dt < 4; ++dt) O[dt] = __builtin_amdgcn_mfma_f32_16x16x32_bf16(vfr[s2][dt], pf, O[dt], 0, 0, 0);
                Lacc = __builtin_amdgcn_mfma_f32_16x16x32_bf16(ones, pf, Lacc, 0, 0, 0);
            }
        }
      }
        if (2 * it + 2 < ntile) { AT_SST((2 * it + 2) & 3, gkA, gvA); AT_SST((2 * it + 3) & 3, gkB, gvB); }
        gkA = gkC; gvA = gvC; gkB = gkD; gvB = gvD;
        AT_GLD(2 * it + 6, gkC, gvC); AT_GLD(2 * it + 7, gkD, gvD);
        lds_barrier();
    }
#undef AT_GLD
#undef AT_SST
    const float l = __shfl(Lacc[0], fr);
    const float il = 1.0f / l;
#pragma unroll
    for (int dt = 0; dt < 4; ++dt) {
        const int dcol = h * 64 + dt * 16 + 4 * quad;
        const u32x2 g = gpre[dt];
        const f32x4 o = O[dt] * il;
        u32x2 w; w.x = pk2(o[0] * siluf_(bflo(g.x)), o[1] * siluf_(bfhi(g.x))); w.y = pk2(o[2] * siluf_(bflo(g.y)), o[3] * siluf_(bfhi(g.y)));
        *(u32x2*)(YM + tq * 1024 + 512 + dcol) = w;
    }
}

constexpr int AT_GRAB = 1;
__device__ __forceinline__ void phase_mix(const Args& a, LAS unsigned char* lds, bool do_scan = true, bool do_attn = true) {
    unsigned* ctr = (unsigned*)(a.ws + WS_CTR);
    if (do_scan) for (int u = blockIdx.x; u < BATCH * 8; u += gridDim.x) scan_unit_chunked(a, lds, u);
    LAS int* uw = (LAS int*)(lds + 70000);
    if (do_attn) for (;;) {
        __syncthreads();
        if (threadIdx.x == 0) *uw = (int)atomicAdd(ctr, (unsigned)AT_GRAB);
        __syncthreads();
        const int u = *uw;
        if (u >= BATCH * 8 * 16) break;
        for (int k = 0; k < AT_GRAB && u + k < BATCH * 8 * 16; ++k) attn_unit(a, lds, u + k, (PROBE_LOOPS || N_LAUNCH_MODE == 3) ? a.rep[0] : 0);
    }
}

__device__ __forceinline__ void phase_sg_naive(const Args& a, unsigned char* ldsb) {
    const int tid = threadIdx.x;
    unsigned char* ws = a.ws;
    const bf16_t* P1 = (const bf16_t*)(ws + WS_P1); bf16_t* Y2 = (bf16_t*)(ws + WS_YMIX);
    const float* vsum = (const float*)(ws + WS_VSUM); const float* vsq = (const float*)(ws + WS_VSQ);
    float* vn = (float*)ldsb;
    const int c = tid & 127, i0 = tid >> 7;
    for (int u = blockIdx.x; u < BATCH * 16 * 8; u += gridDim.x) {
        const int g = u & 7, nb = (u >> 3) & 15, b = u >> 7;
        const int tbase = b * SEQ + nb * 128;
        const float lg = a.in[I_SGLNG][g * 128 + c], lb = a.in[I_SGLNB][g * 128 + c];
        for (int j = i0; j < 128; j += 4) {
            const int t = tbase + j; const float mean = vsum[t] * (1.0f / 1024.0f); const float var = vsq[t] * (1.0f / 1024.0f) - mean * mean;
            const float rstd = rsqrtf(fmaxf(var, 0.f) + LN_EPS);
            vn[j * 128 + c] = (bf2f(P1[(size_t)t * N3 + 1024 + g * 128 + c]) - mean) * rstd * lg + lb;
        }
        __syncthreads();
        const float* wg = a.in[I_SGW] + (size_t)g * 128 * 128; const float* sb = a.in[I_SGB] + g * 128;
        for (int i = i0; i < 128; i += 4) {
            const int jend = (i < 64) ? 64 : 128;
            float acc = 0.f;
            for (int j = 0; j < jend; ++j) acc += wg[i * 128 + j] * vn[j * 128 + c];
            const int t = tbase + i;
            const float uu = bf2f(P1[(size_t)t * N3 + g * 128 + c]), gt = bf2f(P1[(size_t)t * N3 + 2048 + g * 128 + c]);
            Y2[(size_t)t * 1024 + g * 128 + c] = f2bf(uu * (acc + sb[i]) * gt);
        }
        __syncthreads();
    }
}


__device__ __forceinline__ void phase_sg(const Args& a, LAS unsigned char* lds, int variant = 0) {
    const int tid = threadIdx.x, lane = tid & 63, wave = tid >> 6, fr = lane & 15, quad = lane >> 4;
    unsigned char* ws = a.ws;
    const bf16_t* P1 = (const bf16_t*)(ws + WS_P1); bf16_t* Y2 = (bf16_t*)(ws + WS_YMIX); const bf16_t* SGW = (const bf16_t*)(ws + WS_SGW);
    const float* vsum = (const float*)(ws + WS_VSUM); const float* vsq = (const float*)(ws + WS_VSQ);
    constexpr int VPB = 272;
    constexpr int NUN = BATCH * 16 * 8;
    const int per = (NUN + (int)gridDim.x - 1) / (int)gridDim.x;
    const int u0 = blockIdx.x * per, u1 = (u0 + per < NUN) ? u0 + per : NUN;
    u32x4 vw[4]; float vmean[4], vrstd[4];
    const int lpc = tid & 15, lrb = tid >> 4;
#define SG_VLOAD(uu_) do { const int g_ = (uu_) >> 8, tb_ = (((uu_) >> 4) & 15) * SEQ + ((uu_) & 15) * 128; \
        _Pragma("unroll") for (int q_ = 0; q_ < 4; ++q_) { const int t_ = tb_ + lrb + 32 * q_; \
            const float m_ = vsum[t_] * (1.0f / 1024.0f); const float var_ = vsq[t_] * (1.0f / 1024.0f) - m_ * m_; vmean[q_] = m_; vrstd[q_] = rsqrtf(fmaxf(var_, 0.f) + LN_EPS); \
            vw[q_] = *(const u32x4*)(P1 + (size_t)t_ * N3 + 1024 + g_ * 128 + lpc * 8); } } while (0)
    if (u0 < u1) SG_VLOAD(u0);
    for (int u = u0; u < u1; ++u) {
        const int g = u >> 8, b = (u >> 4) & 15, nb = u & 15;
        const int tbase = b * SEQ + nb * 128;
        const int irow = 16 * wave + fr;
        const int epc = tid & 15, erb = tid >> 4;
        const f32x4 g0 = *(const f32x4*)(a.in[I_SGLNG] + g * 128 + lpc * 8), g1 = *(const f32x4*)(a.in[I_SGLNG] + g * 128 + lpc * 8 + 4);
        const f32x4 b0 = *(const f32x4*)(a.in[I_SGLNB] + g * 128 + lpc * 8), b1 = *(const f32x4*)(a.in[I_SGLNB] + g * 128 + lpc * 8 + 4);
        float sbq[4];
#pragma unroll
        for (int q = 0; q < 4; ++q) sbq[q] = a.in[I_SGB][g * 128 + erb + 32 * q];
        u32x4 uu[4], gg[4];
#pragma unroll
        for (int q = 0; q < 4; ++q) { const size_t te = (size_t)tbase + erb + 32 * q; uu[q] = *(const u32x4*)(P1 + te * N3 + g * 128 + epc * 8); gg[q] = *(const u32x4*)(P1 + te * N3 + 2048 + g * 128 + epc * 8); }
        bf16x8 wf[4];
#pragma unroll
        for (int ks = 0; ks < 4; ++ks) wf[ks] = *(const bf16x8*)(SGW + (size_t)(g * 128 + irow) * 128 + ks * 32 + 8 * quad);
        if (variant != 2) {
            const int c8 = lpc * 8;
#pragma unroll
            for (int q = 0; q < 4; ++q) {
                const int j = lrb + 32 * q; const float mean = vmean[q], rstd = vrstd[q];
                const u32x4 w = vw[q];
                LAS unsigned short* vt = (LAS unsigned short*)(lds + c8 * VPB + (((j >> 3) ^ lpc) * 16) + (j & 7) * 2);
                vt[0 * (VPB / 2)] = f2bf((bflo(w.x) - mean) * rstd * g0.x + b0.x); vt[1 * (VPB / 2)] = f2bf((bfhi(w.x) - mean) * rstd * g0.y + b0.y);
                vt[2 * (VPB / 2)] = f2bf((bflo(w.y) - mean) * rstd * g0.z + b0.z); vt[3 * (VPB / 2)] = f2bf((bfhi(w.y) - mean) * rstd * g0.w + b0.w);
                vt[4 * (VPB / 2)] = f2bf((bflo(w.z) - mean) * rstd * g1.x + b1.x); vt[5 * (VPB / 2)] = f2bf((bfhi(w.z) - mean) * rstd * g1.y + b1.y);
                vt[6 * (VPB / 2)] = f2bf((bflo(w.w) - mean) * rstd * g1.z + b1.z); vt[7 * (VPB / 2)] = f2bf((bfhi(w.w) - mean) * rstd * g1.w + b1.w);
            }
        }
        if (u + 1 < u1) SG_VLOAD(u + 1);
        lds_barrier();
        if (variant == 1) { lds_barrier(); continue; }
        f32x4 acc[8];
#pragma unroll
        for (int ct = 0; ct < 8; ++ct) {
            acc[ct] = (f32x4){0.f, 0.f, 0.f, 0.f};
#pragma unroll
            for (int ks = 0; ks < 4; ++ks) {
                if (ks < 2 || wave >= 4) { const bf16x8 vf = *(const LAS bf16x8*)(lds + (ct * 16 + fr) * VPB + (((ks * 4 + quad) ^ (ct * 2 + (fr >> 3))) * 16)); acc[ct] = __builtin_amdgcn_mfma_f32_16x16x32_bf16(vf, wf[ks], acc[ct], 0, 0, 0); }
            }
        }
        {
            LAS float* ot = (LAS float*)(lds + 36864);
#pragma unroll
            for (int ct = 0; ct < 8; ++ct) *(LAS f32x4*)(ot + irow * 132 + ct * 16 + 4 * quad) = acc[ct];
            lds_barrier();
#pragma unroll
            for (int q = 0; q < 4; ++q) {
                const int i = erb + 32 * q; const size_t te = (size_t)tbase + i; const float sbv = sbq[q];
                const f32x4 s0 = *(const LAS f32x4*)(ot + i * 132 + epc * 8), s1 = *(const LAS f32x4*)(ot + i * 132 + epc * 8 + 4);
                u32x4 w;
                w.x = pk2(bflo(uu[q].x) * (s0[0] + sbv) * bflo(gg[q].x), bfhi(uu[q].x) * (s0[1] + sbv) * bfhi(gg[q].x));
                w.y = pk2(bflo(uu[q].y) * (s0[2] + sbv) * bflo(gg[q].y), bfhi(uu[q].y) * (s0[3] + sbv) * bfhi(gg[q].y));
                w.z = pk2(bflo(uu[q].z) * (s1[0] + sbv) * bflo(gg[q].z), bfhi(uu[q].z) * (s1[1] + sbv) * bfhi(gg[q].z));
                w.w = pk2(bflo(uu[q].w) * (s1[2] + sbv) * bflo(gg[q].w), bfhi(uu[q].w) * (s1[3] + sbv) * bfhi(gg[q].w));
                *(u32x4*)(Y2 + te * 1024 + g * 128 + epc * 8) = w;
            }
        }
        lds_barrier();
    }
#undef SG_VLOAD
}

__device__ __forceinline__ void phase_final(const Args& a) {
    const int tid = threadIdx.x, lane = tid & 63, wave = tid >> 6;
    const float* rs2 = (const float*)(a.ws + WS_RS2); const float* fg = a.in[I_FG];
    const int gw = blockIdx.x * 8 + wave, NGW = gridDim.x * 8;
    f32x4 g4[4];
#pragma unroll
    for (int j = 0; j < 4; ++j) g4[j] = ((const f32x4*)fg)[lane + 64 * j];
    for (int m = gw; m < M; m += NGW) {
        const float rinv = rsqrtf(rs2[m] * (1.0f / DM) + RMS_EPS);
        f32x4* p = (f32x4*)(a.out + (size_t)m * DM) + lane;
#pragma unroll
        for (int j = 0; j < 4; ++j) { f32x4 v = p[64 * j]; v = v * rinv * g4[j]; p[64 * j] = v; }
    }
}

#define XB_TMO      128
#define XB_XCNT(j)  (256  + 64 * (j))
#define XB_XSUB(j)  (1280 + 64 * (j))
#define XB_XGEN(j)  (2304 + 64 * (j))
#define XB_TOP      3328
#define XB_TOPGEN   3392
#define XCD_BAR_WORDS 3456
#define XB_SPIN_CAP (1u << 18)

__device__ __forceinline__ unsigned xb_ld(unsigned* p)              { return __hip_atomic_load(p, __ATOMIC_RELAXED, __HIP_MEMORY_SCOPE_AGENT); }
__device__ __forceinline__ unsigned xb_add(unsigned* p, unsigned v) { return __hip_atomic_fetch_add(p, v, __ATOMIC_RELAXED, __HIP_MEMORY_SCOPE_AGENT); }
__device__ __forceinline__ unsigned xb_xcc_id() { return (unsigned)__builtin_amdgcn_s_getreg((3 << 11) | 20) & 0xFu; }
#define XB_SPIN(cond, bar) do { unsigned _sp = 0; while (cond) { __builtin_amdgcn_s_sleep(1); \
    if ((++_sp & 255u) == 0u) { if (xb_ld(&(bar)[XB_TMO])) break; if (_sp > XB_SPIN_CAP) { atomicAdd(&(bar)[XB_TMO], 1u); break; } } } } while (0)

struct XcdBarrier {
    unsigned* bar; unsigned x;
    volatile LAS unsigned* st;
};

__device__ __forceinline__ XcdBarrier xcd_barrier_post(unsigned* bar, volatile LAS unsigned* st) {
    XcdBarrier b; b.bar = bar; b.x = xb_xcc_id(); b.st = st;
    if (threadIdx.x == 0) (void)xb_add(&bar[XB_XCNT(b.x)], 1u);
    return b;
}
__device__ __forceinline__ void xcd_barrier_complete(unsigned* bar, unsigned x, unsigned& nloc, unsigned& nx) {
    const unsigned G = gridDim.x * gridDim.y * gridDim.z;
    unsigned sum, cnt, mine, sp = 0u;
    for (;;) {
        sum = 0u; cnt = 0u; mine = 0u;
#pragma unroll
        for (unsigned j = 0; j < 16; ++j) { const unsigned c = xb_ld(&bar[XB_XCNT(j)]); sum += c; cnt += (c > 0u) ? 1u : 0u; mine = (j == x) ? c : mine; }
        if (sum == G) break;
        __builtin_amdgcn_s_sleep(1);
        if ((++sp & 255u) == 0u) { if (xb_ld(&bar[XB_TMO])) break; if (sp > XB_SPIN_CAP) { atomicAdd(&bar[XB_TMO], 1u); break; } }
    }
    nloc = mine > 0u ? mine : 1u; nx = cnt > 0u ? cnt : 1u;
}

__device__ __forceinline__ void xcd_barrier(const XcdBarrier& b) {
    asm volatile("s_waitcnt vmcnt(0)" ::: "memory");
    __syncthreads();
    if (threadIdx.x == 0) {
        unsigned* bar = b.bar;
        __builtin_amdgcn_s_waitcnt(0);
        unsigned nloc = b.st[0], nx = b.st[1];
        if (nloc == 0u) { xcd_barrier_complete(bar, b.x, nloc, nx); b.st[0] = nloc; b.st[1] = nx; }
        const unsigned old = xb_add(&bar[XB_XSUB(b.x)], 1u);
        const unsigned gen = old / nloc;
        if (old + 1u == (gen + 1u) * nloc) {
            __builtin_amdgcn_fence(__ATOMIC_RELEASE, "agent");
            asm volatile("s_waitcnt vmcnt(0)" ::: "memory");
            const unsigned og = xb_add(&bar[XB_TOP], 1u);
            const unsigned tg = og / nx;
            if (og + 1u == (tg + 1u) * nx) xb_add(&bar[XB_TOPGEN], 1u);
            else XB_SPIN(xb_ld(&bar[XB_TOPGEN]) == tg, bar);
            __builtin_amdgcn_fence(__ATOMIC_ACQUIRE, "agent");
            xb_add(&bar[XB_XGEN(b.x)], 1u);
            asm volatile("s_waitcnt vmcnt(0)" ::: "memory");
        } else {
            XB_SPIN(xb_ld(&bar[XB_XGEN(b.x)]) == gen, bar);
            __builtin_amdgcn_fence(__ATOMIC_ACQUIRE, "agent");
            asm volatile("s_waitcnt vmcnt(0)" ::: "memory");
        }
    }
    __syncthreads();
}

template <int PHM> __global__ void __launch_bounds__(NTHR, 2) mega(Args a) {
    extern __shared__ __attribute__((aligned(16))) unsigned char lds[];
    unsigned char* ws = a.ws;
    const int lo = a.lo, hi = a.hi;
    volatile LAS unsigned* bst = (volatile LAS unsigned*)((LAS unsigned char*)lds + (LDS_BYTES - 64));
    if (threadIdx.x < 2) bst[threadIdx.x] = 0u;
    __syncthreads();
    XcdBarrier xbar = xcd_barrier_post((unsigned*)(ws + WS_BAR), bst);
    if (hi > 1000) cg::this_grid().sync();
#define IN(k) (((PHM >> (k)) & 1) && lo <= (k) && (k) < hi)
#if PROBE_LOOPS
#define REPS(i) a.rep[i]
#else
#define REPS(i) 0
#endif
#if USE_XBAR
#define SEAM(k) do { if (IN(k) && IN((k) + 1)) { xcd_barrier(xbar); } } while (0)
#else
#define SEAM(k) do { if (IN(k) && IN((k) + 1)) { cg::this_grid().sync(); } } while (0)
#endif
    if (IN(0)) for (int r_ = 0; r_ <= REPS(0); ++r_) { phase_prologue(a, lds); if (r_ < REPS(0)) xcd_barrier(xbar); }
    SEAM(0);
    if (IN(1)) { EpiG1 f{(const float*)(ws + WS_RS0), (bf16_t*)(ws + WS_PA), (bf16_t*)(ws + WS_PB)};
        gemm_any(lds, (const bf16_t*)(ws + WS_XN), (const bf16_t*)(ws + WS_W1T), M, N1, DM, f); }
    SEAM(1);
    if (IN(2)) for (int r_ = 0; r_ <= REPS(1); ++r_) { phase_prep(a, lds, (PROBE_LOOPS || N_LAUNCH_MODE == 3) ? a.rep[0] : 0); if (r_ < REPS(1)) xcd_barrier(xbar); }
    SEAM(2);
    #if PROBE & 1
    phase_prep(a, lds); cg::this_grid().sync();
#endif
#if USE_NAIVE_MIX
    if (IN(3)) { phase_scan_naive(a); phase_attn_naive(a); }
#else
    if (IN(3)) for (int r_ = 0; r_ <= REPS(2); ++r_) { phase_mix(a, (LAS unsigned char*)lds, a.rep[0] < 2, a.rep[0] != 1); if (r_ < REPS(2)) { xcd_barrier(xbar); if (blockIdx.x == 0 && threadIdx.x == 0) *(unsigned*)(ws + WS_CTR) = 0u; xcd_barrier(xbar); } }
#endif
    SEAM(3);
#if PROBE & 2
    phase_prep(a, lds); cg::this_grid().sync(); phase_mix(a, (LAS unsigned char*)lds); cg::this_grid().sync();
#endif
#if PROBE & 64
    phase_prep(a, lds); cg::this_grid().sync(); phase_mix(a, (LAS unsigned char*)lds, true, false); cg::this_grid().sync();
#endif
#if PROBE & 32
    if (blockIdx.x == 0 && threadIdx.x == 0) *(unsigned*)(ws + WS_CTR) = 0u;
    cg::this_grid().sync(); phase_mix(a, (LAS unsigned char*)lds, false); cg::this_grid().sync();
#endif
#if PROBE & 4
    phase_prologue(a, lds); cg::this_grid().sync();
#endif
#if PROBE & 16
    { EpiG1 f{(const float*)(ws + WS_RS0), (bf16_t*)(ws + WS_PA), (bf16_t*)(ws + WS_PB)};
        gemm_any(lds, (const bf16_t*)(ws + WS_XN), (const bf16_t*)(ws + WS_W1T), M, N1, DM, f); cg::this_grid().sync(); }
#endif
    if (IN(4)) { EpiG2 f{a.in[I_X], a.out, (bf16_t*)(ws + WS_XN), (float*)(ws + WS_RS1)};
        gemm_any<EpiG2, false>(lds, (const bf16_t*)(ws + WS_YMIX), (const bf16_t*)(ws + WS_W2T), M, DM, DM, f); }
    SEAM(4);
#if PROBE & 128
    { EpiG2 f{a.in[I_X], a.out, (bf16_t*)(ws + WS_XN), (float*)(ws + 640 * 1024)};
        gemm_any(lds, (const bf16_t*)(ws + WS_YMIX), (const bf16_t*)(ws + WS_W2T), M, DM, DM, f); cg::this_grid().sync(); }
#endif
    if (IN(5)) { EpiG3 f{(const float*)(ws + WS_RS1), (bf16_t*)(ws + WS_P1), (float*)(ws + WS_VSUM), (float*)(ws + WS_VSQ)};
        gemm_any(lds, (const bf16_t*)(ws + WS_XN), (const bf16_t*)(ws + WS_W3T), M, N3, DM, f); }
    SEAM(5);
    if (IN(6)) for (int r_ = 0; r_ <= REPS(3); ++r_) { phase_sg(a, (LAS unsigned char*)lds, (PROBE_LOOPS || N_LAUNCH_MODE == 3) ? a.rep[0] : 0); if (r_ < REPS(3)) xcd_barrier(xbar); }
    SEAM(6);
#if PROBE & 8
    phase_sg(a, (LAS unsigned char*)lds); cg::this_grid().sync();
#endif
    const bool fuse_final = FUSE_FINAL && gridDim.x == 256;
    if (IN(7) && fuse_final) { pg8::Gemm g{(const bf16_t*)(ws + WS_YMIX), (const bf16_t*)(ws + WS_W4T), M, DM, DM}; pg8::StaticOrder S; S.init(M, DM, (int)gridDim.x, (int)blockIdx.x);
        EpiG4X E{a.out, a.in[I_FG], (float*)(ws + WS_EXCH), (unsigned*)(ws + WS_PCNT), (LAS unsigned char*)lds + 131072};
        pg8::gemm_phase<EpiG4X, pg8::StaticOrder, true, true>((PG8_LAS unsigned char*)lds, g, S, E); }
    if (!fuse_final) {
        if (IN(7)) { EpiG4 f{a.out, (float*)(ws + WS_RS2)};
            gemm_any<EpiG4, false>(lds, (const bf16_t*)(ws + WS_YMIX), (const bf16_t*)(ws + WS_W4T), M, DM, DM, f); }
        SEAM(7);
        if (IN(8)) { phase_final(a); }
    }
#undef IN
#undef SEAM
}
constexpr int NPHASE = 9;
}
#if defined(__HIP_DEVICE_COMPILE__)
#pragma clang attribute pop
#endif

extern "C" void kernel_launch(void* const* d_in, const int* in_sizes, int n_in, void* d_out, int out_size, void* d_ws, size_t ws_size, hipStream_t stream) {
    using namespace mk;
    static int grid = 0;
    if (grid == 0) {
        if (n_in != 22 || out_size != M * DM || ws_size < WS_END) { fprintf(stderr, "kernel_launch: unexpected shapes (n_in %d out %d ws %zu)\n", n_in, out_size, ws_size); grid = -1; return; }
        int dev = 0, cus = 0, per_cu = 0;
        (void)hipGetDevice(&dev); (void)hipDeviceGetAttribute(&cus, hipDeviceAttributeMultiprocessorCount, dev);
#if N_LAUNCH_MODE == 1 || N_LAUNCH_MODE == 3
        if (hipFuncSetAttribute((const void*)mega<0x1ff>, hipFuncAttributeMaxDynamicSharedMemorySize, LDS_BYTES) != hipSuccess) { fprintf(stderr, "kernel_launch: hipFuncSetAttribute failed\n"); grid = -1; return; }
        if (hipOccupancyMaxActiveBlocksPerMultiprocessor(&per_cu, (const void*)mega<0x1ff>, NTHR, LDS_BYTES) != hipSuccess || per_cu < 1) { fprintf(stderr, "kernel_launch: occupancy query says %d\n", per_cu); per_cu = 1; }
#else
        if (hipFuncSetAttribute((const void*)mega<0x1f7>, hipFuncAttributeMaxDynamicSharedMemorySize, LDS_BYTES) != hipSuccess || hipFuncSetAttribute((const void*)mega<0x008>, hipFuncAttributeMaxDynamicSharedMemorySize, LDS_BYTES) != hipSuccess) { fprintf(stderr, "kernel_launch: hipFuncSetAttribute failed\n"); grid = -1; return; }
#endif
        (void)hipGetLastError();
        grid = cus * 1;
        if (grid <= 0) grid = 256;
    }
    if (grid < 0) return;
    Args a{};
    for (int i = 0; i < 22; ++i) a.in[i] = (const float*)d_in[i];
    a.out = (float*)d_out; a.ws = (unsigned char*)d_ws;
    a.rep[0] = PROBE_REP0; a.rep[1] = PROBE_REP1; a.rep[2] = PROBE_REP2; a.rep[3] = PROBE_REP3;
    if (hipMemsetAsync((char*)d_ws + WS_BAR, 0, 65536 + 32768, stream) != hipSuccess) { fprintf(stderr, "kernel_launch: hipMemsetAsync failed\n"); return; }
#if N_LAUNCH_MODE == 3
    {
        constexpr int P = PROBE_PHASE; constexpr int MLO = (1 << P) - 1, MP = 1 << P, MHI = 0x0ff & ~((1 << (P + 1)) - 1);
        void* args[] = {&a};
        (void)hipFuncSetAttribute((const void*)mega<MP>, hipFuncAttributeMaxDynamicSharedMemorySize, LDS_BYTES);
        (void)hipFuncSetAttribute((const void*)mega<MHI>, hipFuncAttributeMaxDynamicSharedMemorySize, LDS_BYTES);
        if (P > 0) { (void)hipFuncSetAttribute((const void*)mega<MLO>, hipFuncAttributeMaxDynamicSharedMemorySize, LDS_BYTES);
            a.lo = 0; a.hi = P; (void)hipLaunchCooperativeKernel((const void*)mega<MLO>, dim3(grid), dim3(NTHR), args, LDS_BYTES, stream); }
        for (int r = 0; r <= PROBE_REP2; ++r) {
            a.lo = P; a.hi = P + 1; a.rep[0] = (r == PROBE_REP2) ? 0 : PROBE_MIXMODE;
            (void)hipMemsetAsync((char*)d_ws + WS_CTR, 0, 4, stream);
            (void)hipMemsetAsync((char*)d_ws + WS_BAR, 0, 16384, stream);
            hipLaunchKernelGGL(mega<MP>, dim3(grid), dim3(NTHR), LDS_BYTES, stream, a);
        }
        a.rep[0] = 0;
        (void)hipMemsetAsync((char*)d_ws + WS_BAR, 0, 16384, stream);
        a.lo = P + 1; a.hi = NPHASE;
        (void)hipLaunchCooperativeKernel((const void*)mega<MHI>, dim3(grid), dim3(NTHR), args, LDS_BYTES, stream);
    }
#elif N_LAUNCH_MODE == 2
    {
        void* args[] = {&a};
        a.lo = 0; a.hi = 3;
        hipError_t e = hipLaunchCooperativeKernel((const void*)mega<0x1f7>, dim3(grid), dim3(NTHR), args, LDS_BYTES, stream);
        if (e != hipSuccess) fprintf(stderr, "kernel_launch: cooperative launch A failed: %s (grid %d)\n", hipGetErrorString(e), grid);
        a.lo = 3; a.hi = 4;
        hipLaunchKernelGGL(mega<0x008>, dim3(grid), dim3(NTHR), LDS_BYTES, stream, a);
        a.lo = 4; a.hi = NPHASE;
        e = hipLaunchCooperativeKernel((const void*)mega<0x1f7>, dim3(grid), dim3(NTHR), args, LDS_BYTES, stream);
        if (e != hipSuccess) fprintf(stderr, "kernel_launch: cooperative launch B failed: %s (grid %d)\n", hipGetErrorString(e), grid);
    }
#elif N_LAUNCH_MODE == 1
    a.lo = 0; a.hi = NPHASE;
    void* args[] = {&a};
    hipError_t e = hipLaunchCooperativeKernel((const void*)mega<0x1ff>, dim3(grid), dim3(NTHR), args, LDS_BYTES, stream);
    if (e != hipSuccess) fprintf(stderr, "kernel_launch: cooperative launch failed: %s (grid %d)\n", hipGetErrorString(e), grid);
#else
    for (int ph = 0; ph < NPHASE; ++ph) {
        a.lo = ph; a.hi = ph + 1;
        if (ph == 3) hipLaunchKernelGGL(mega<0x008>, dim3(grid), dim3(NTHR), LDS_BYTES, stream, a);
        else hipLaunchKernelGGL(mega<0x1f7>, dim3(grid), dim3(NTHR), LDS_BYTES, stream, a);
    }
#endif
}
```
